# Optimizing an MI355X kernel written in HIP

```python
import jax
import jax.numpy as jnp
from jax import lax
import numpy as np

D_MODEL = 1024
BATCH = 16
SEQ = 256
DEPTH = 4
DEC_BATCH = 2
DEC_SEQ = 1024
PAST_LEN = 512

GRID_W = 64
N_AB = (DEPTH + 1) // 2
N_C = DEPTH // 2
D_FF = 4 * D_MODEL
EPS = 1e-6
ROPE_BASE = 10000.0
Q_BLOCK = 128
H_A = 4
DK_A = D_MODEL // 16
DV_A = D_MODEL // 8
GK_RANK = 16
GATE_NORM = 16.0
GLA_CHUNK = 64
H_B = 8
KV_B = 2
G_B = H_B // KV_B
D_B = 64
WINDOW = 128
WIN_BLOCK = 128
AB_SPLITS = (H_A * DK_A, H_A * DK_A, H_A * DV_A, H_A * DV_A, 2 * GK_RANK, H_B * D_B, KV_B * D_B, KV_B * D_B)
AB_IN = 2 * H_A * DK_A + 2 * H_A * DV_A + 2 * GK_RANK + H_B * D_B + 2 * KV_B * D_B
MIX_AB = H_A * DV_A + H_B * D_B
H_C = 16
NOPE_C = 64
ROPE_C = 32
V_C = 64
Q_LORA = 384
KV_LORA = 256
DOWN_C = Q_LORA + KV_LORA + ROPE_C

kernel_name = 'bidir_hybrid_gla_swa_mla_dit_step'


def rmsnorm(x, g):
    xf = x.astype(jnp.float32)
    y = xf * lax.rsqrt(jnp.mean(xf * xf, axis=-1, keepdims=True) + EPS)
    return (y * g.astype(jnp.float32)).astype(x.dtype)


def split_last(x, sizes):
    out, o = [], 0
    for s in sizes:
        out.append(x[..., o:o + s])
        o += s
    return out


def rope_2d(x, rows, cols):
    hd = x.shape[-1]
    nf = hd // 4
    inv = ROPE_BASE ** (-jnp.arange(nf, dtype=jnp.float32) / nf)
    ang = jnp.stack([rows[:, None] * inv, cols[:, None] * inv], axis=1)
    ang = ang.reshape((ang.shape[0],) + (1,) * (x.ndim - 3) + (2, nf))
    cos, sin = jnp.cos(ang), jnp.sin(ang)
    xr = x.astype(jnp.float32).reshape(x.shape[:-1] + (2, 2, nf))
    x1, x2 = xr[..., 0, :], xr[..., 1, :]
    out = jnp.stack([x1 * cos - x2 * sin, x1 * sin + x2 * cos], axis=-2)
    return out.reshape(x.shape).astype(x.dtype)


def adaln(cvec, w_mod, b_mod):
    m = jax.nn.silu(cvec) @ w_mod + b_mod
    m = m.reshape(cvec.shape[0], 1, 6, D_MODEL)
    return [m[:, :, i] for i in range(6)]


def pre(x, g, shift, scale):
    return rmsnorm(x, g) * (1 + scale) + shift


def post(x, out, g, gate):
    return x + gate * rmsnorm(out, g)


def sq_relu_mlp(h, w1, w2):
    return jnp.square(jax.nn.relu(h @ w1)) @ w2


def gla_chunked(q, k, v, g, s0):
    B, L, H, _ = q.shape
    dv = v.shape[-1]
    nc = L // GLA_CHUNK

    def chunks(a):
        return a.astype(jnp.float32).reshape(B, nc, GLA_CHUNK, H, a.shape[-1]).transpose(1, 0, 3, 2, 4)

    causal = jnp.tril(jnp.ones((GLA_CHUNK, GLA_CHUNK), dtype=bool))

    def step(s, inp):
        qc, kc, vc, gc = inp
        b = jnp.cumsum(gc, axis=2)
        o_inter = jnp.einsum('bhtd,bhde->bhte', qc * jnp.exp(b), s)
        diff = b[:, :, :, None, :] - b[:, :, None, :, :]
        decay = jnp.exp(jnp.where(causal[:, :, None], diff, -jnp.inf))
        att = jnp.einsum('bhtsd,bhsd->bhts', qc[:, :, :, None, :] * decay, kc)
        o_intra = jnp.einsum('bhts,bhse->bhte', att, vc)
        b_last = b[:, :, -1:, :]
        s_new = jnp.exp(b_last[:, :, 0, :])[..., None] * s + jnp.einsum('bhsd,bhse->bhde', kc * jnp.exp(b_last - b), vc)
        return s_new, o_inter + o_intra

    s_fin, o = lax.scan(step, s0.astype(jnp.float32), (chunks(q), chunks(k), chunks(v), chunks(g)))
    o = o.transpose(1, 0, 3, 2, 4).reshape(B, L, H, dv)
    return o, s_fin


def dense_attn(q, k, v, scale, sink=None):
    B, Lq, KV, G, d = q.shape
    nb = Lq // Q_BLOCK
    qb = q.reshape(B, nb, Q_BLOCK, KV, G, d).transpose(1, 0, 2, 3, 4, 5)

    def block(qblk):
        s = jnp.einsum('bqkgd,bskd->bkgqs', qblk, k).astype(jnp.float32) * scale
        if sink is not None:
            sk = jnp.broadcast_to(sink.astype(jnp.float32).reshape(1, KV, G, 1, 1), s.shape[:-1] + (1,))
            p = jax.nn.softmax(jnp.concatenate([sk, s], axis=-1), axis=-1)[..., 1:]
        else:
            p = jax.nn.softmax(s, axis=-1)
        return jnp.einsum('bkgqs,bskd->bqkgd', p.astype(v.dtype), v)

    o = lax.map(block, qb)
    return o.transpose(1, 0, 2, 3, 4, 5).reshape(B, Lq, KV, G, v.shape[-1])


def banded_attn(q, k, v, k_ctx, v_ctx, scale, sink):
    B, L, KV, G, d = q.shape
    W = WIN_BLOCK
    nb = L // W
    Lc = k_ctx.shape[1]
    qb = q.reshape(B, nb, W, KV, G, d)

    def band(a):
        ap = jnp.pad(a, ((0, 0), (W, W), (0, 0), (0, 0))).reshape(B, nb + 2, W, KV, a.shape[-1])
        return jnp.concatenate([ap[:, :-2], ap[:, 1:-1], ap[:, 2:]], axis=2)

    kb, vb = band(k), band(v)
    qi = jnp.arange(L).reshape(nb, W)
    ki = jnp.arange(nb)[:, None] * W - W + jnp.arange(3 * W)[None, :]
    mask = (ki[:, None, :] >= 0) & (ki[:, None, :] < L) & (jnp.abs(qi[:, :, None] - ki[:, None, :]) <= WINDOW)
    s_loc = jnp.einsum('bnqkgd,bnskd->bnkgqs', qb, kb).astype(jnp.float32) * scale
    s_loc = jnp.where(mask[None, :, None, None], s_loc, -jnp.inf)
    s_ctx = jnp.einsum('bnqkgd,bckd->bnkgqc', qb, k_ctx).astype(jnp.float32) * scale
    s_sink = jnp.broadcast_to(sink.astype(jnp.float32).reshape(1, 1, KV, G, 1, 1), s_ctx.shape[:-1] + (1,))
    p = jax.nn.softmax(jnp.concatenate([s_sink, s_ctx, s_loc], axis=-1), axis=-1)
    p_ctx = p[..., 1:1 + Lc].astype(v.dtype)
    p_loc = p[..., 1 + Lc:].astype(v.dtype)
    o = jnp.einsum('bnkgqc,bckd->bnqkgd', p_ctx, v_ctx) + jnp.einsum('bnkgqs,bnskd->bnqkgd', p_loc, vb)
    return o.reshape(B, L, KV, G, v.shape[-1])


def mixer_ab(h, w_in, w_gk_f, b_gk_f, w_gk_b, b_gk_b, g_gla, sink, w_out, ctx=None, pos=None):
    B, L, _ = h.shape
    q_a, k_a, v_a, g_a, gk_lo, q_b, k_b, v_b = split_last(h @ w_in, AB_SPLITS)
    q_a = q_a.reshape(B, L, H_A, DK_A) * (DK_A ** -0.5)
    k_a = k_a.reshape(B, L, H_A, DK_A)
    v_a = v_a.reshape(B, L, H_A, DV_A)

    def log_decay(lo, w, b):
        return (jax.nn.log_sigmoid((lo @ w + b).astype(jnp.float32)) / GATE_NORM).reshape(B, L, H_A, DK_A)

    ld_f = log_decay(gk_lo[..., :GK_RANK], w_gk_f, b_gk_f)
    ld_b = log_decay(gk_lo[..., GK_RANK:], w_gk_b, b_gk_b)
    if ctx is None:
        s0_f = jnp.zeros((B, H_A, DK_A, DV_A), jnp.float32)
        s0_b = jnp.zeros((B, H_A, DK_A, DV_A), jnp.float32)
    else:
        s0_f, s0_b, k_ctx, v_ctx = ctx
    rev = lambda a: jnp.flip(a, axis=1)
    o_fwd, s_fwd = gla_chunked(q_a, k_a, v_a, ld_f, s0_f)
    o_bwd, s_bwd = gla_chunked(rev(q_a), rev(k_a), rev(v_a), rev(ld_b), s0_b)
    o_gla = (o_fwd + rev(o_bwd)).astype(h.dtype)
    o_gla = rmsnorm(o_gla, g_gla) * jax.nn.silu(g_a.reshape(B, L, H_A, DV_A))

    q_b = q_b.reshape(B, L, H_B, D_B)
    k_b = k_b.reshape(B, L, KV_B, D_B)
    v_b = v_b.reshape(B, L, KV_B, D_B)
    scale = D_B ** -0.5
    sink_g = sink.reshape(KV_B, G_B)
    if ctx is None:
        o_swa = dense_attn(q_b.reshape(B, L, KV_B, G_B, D_B), k_b, v_b, scale, sink_g)
        new = (s_fwd.astype(h.dtype), s_bwd.astype(h.dtype), k_b, v_b)
    else:
        rows, cols = pos
        q_b = rope_2d(q_b, rows, cols)
        k_b = rope_2d(k_b, rows, cols)
        o_swa = banded_attn(q_b.reshape(B, L, KV_B, G_B, D_B), k_b, v_b, k_ctx, v_ctx, scale, sink_g)
        new = None
    out = jnp.concatenate([o_gla.reshape(B, L, H_A * DV_A), o_swa.reshape(B, L, H_B * D_B)], axis=-1) @ w_out
    return out, new


def mla_expand(c_kv, k_rope, w_ukv):
    B, L, _ = c_kv.shape
    kv = (c_kv @ w_ukv).reshape(B, L, H_C, NOPE_C + V_C)
    k = jnp.concatenate([kv[..., :NOPE_C], jnp.broadcast_to(k_rope[:, :, None, :], (B, L, H_C, ROPE_C))], axis=-1)
    return k, kv[..., NOPE_C:]


def mixer_c(h, w_down, g_q, g_kv, w_uq, w_ukv, w_o, ctx=None, pos=None):
    B, L, _ = h.shape
    c_q, c_kv, k_rope = split_last(h @ w_down, (Q_LORA, KV_LORA, ROPE_C))
    q = (rmsnorm(c_q, g_q) @ w_uq).reshape(B, L, H_C, NOPE_C + ROPE_C)
    c_kv = rmsnorm(c_kv, g_kv)
    if ctx is None:
        k, v = mla_expand(c_kv, k_rope, w_ukv)
        new = (c_kv, k_rope)
    else:
        rows, cols = pos
        q = jnp.concatenate([q[..., :NOPE_C], rope_2d(q[..., NOPE_C:], rows, cols)], axis=-1)
        k, v = mla_expand(c_kv, rope_2d(k_rope, rows, cols), w_ukv)
        ckv_ctx, kr_ctx = ctx
        k_c, v_c = mla_expand(ckv_ctx, kr_ctx, w_ukv)
        k = jnp.concatenate([k_c, k], axis=1)
        v = jnp.concatenate([v_c, v], axis=1)
        new = None
    o = dense_attn(q[:, :, :, None, :], k, v, (NOPE_C + ROPE_C) ** -0.5)
    return o.reshape(B, L, H_C * V_C) @ w_o, new


def setup_inputs(seed: int = 0) -> dict:
    key = jax.random.key(seed)
    ks = jax.random.split(key, 32)

    def nrm(k, shape, scale):
        return jax.random.normal(k, shape, jnp.float32) * scale

    return {
        'x_prompt': nrm(ks[0], (BATCH, SEQ, D_MODEL), 1.0),
        'x_sample': nrm(ks[1], (DEC_BATCH, DEC_SEQ, D_MODEL), 1.0),
        'state_gla_fwd': nrm(ks[2], (DEC_BATCH, N_AB, H_A, DK_A, DV_A), 0.5),
        'state_gla_bwd': nrm(ks[3], (DEC_BATCH, N_AB, H_A, DK_A, DV_A), 0.5),
        'cache_swa_k': nrm(ks[4], (DEC_BATCH, N_AB, PAST_LEN, KV_B, D_B), 1.0),
        'cache_swa_v': nrm(ks[5], (DEC_BATCH, N_AB, PAST_LEN, KV_B, D_B), 1.0),
        'cache_mla_ckv': nrm(ks[6], (DEC_BATCH, N_C, PAST_LEN, KV_LORA), 1.0),
        'cache_mla_kr': nrm(ks[7], (DEC_BATCH, N_C, PAST_LEN, ROPE_C), 1.0),
        'c': nrm(ks[8], (DEC_BATCH, D_MODEL), 1.0),
        'c_ctx': nrm(ks[9], (D_MODEL,), 1.0),
        'w_mod': nrm(ks[10], (DEPTH, D_MODEL, 6 * D_MODEL), 0.5 * D_MODEL ** -0.5),
        'b_mod': nrm(ks[11], (DEPTH, 6 * D_MODEL), 0.02),
        'g_norm': 1.0 + nrm(ks[12], (DEPTH, 4, D_MODEL), 0.05),
        'w_ff1': nrm(ks[13], (DEPTH, D_MODEL, D_FF), D_MODEL ** -0.5),
        'w_ff2': nrm(ks[14], (DEPTH, D_FF, D_MODEL), D_FF ** -0.5),
        'w_in_ab': nrm(ks[15], (N_AB, D_MODEL, AB_IN), D_MODEL ** -0.5),
        'w_gk_f': nrm(ks[16], (N_AB, GK_RANK, H_A * DK_A), GK_RANK ** -0.5),
        'b_gk_f': nrm(ks[17], (N_AB, H_A * DK_A), 0.1),
        'w_gk_b': nrm(ks[18], (N_AB, GK_RANK, H_A * DK_A), GK_RANK ** -0.5),
        'b_gk_b': nrm(ks[19], (N_AB, H_A * DK_A), 0.1),
        'g_gla': 1.0 + nrm(ks[20], (N_AB, DV_A), 0.05),
        'swa_sink': nrm(ks[21], (N_AB, H_B), 0.5),
        'w_out_ab': nrm(ks[22], (N_AB, MIX_AB, D_MODEL), MIX_AB ** -0.5),
        'w_mla_down': nrm(ks[23], (N_C, D_MODEL, DOWN_C), D_MODEL ** -0.5),
        'g_mla_q': 1.0 + nrm(ks[24], (N_C, Q_LORA), 0.05),
        'g_mla_kv': 1.0 + nrm(ks[25], (N_C, KV_LORA), 0.05),
        'w_mla_uq': nrm(ks[26], (N_C, Q_LORA, H_C * (NOPE_C + ROPE_C)), Q_LORA ** -0.5),
        'w_mla_ukv': nrm(ks[27], (N_C, KV_LORA, H_C * (NOPE_C + V_C)), KV_LORA ** -0.5),
        'w_mla_o': nrm(ks[28], (N_C, H_C * V_C, D_MODEL), (H_C * V_C) ** -0.5),
    }


def reference(x_prompt, x_sample, state_gla_fwd, state_gla_bwd, cache_swa_k, cache_swa_v, cache_mla_ckv,
              cache_mla_kr, c, c_ctx, w_mod, b_mod, g_norm, w_ff1, w_ff2, w_in_ab, w_gk_f, b_gk_f, w_gk_b,
              b_gk_b, g_gla, swa_sink, w_out_ab, w_mla_down, g_mla_q, g_mla_kv, w_mla_uq, w_mla_ukv, w_mla_o):
    n_rows = x_sample.shape[1] // GRID_W
    rows = jnp.repeat(jnp.arange(n_rows, dtype=jnp.float32), GRID_W)
    cols = jnp.tile(jnp.arange(GRID_W, dtype=jnp.float32), n_rows)
    pos = (rows, cols)

    xp, xs = x_prompt, x_sample
    st_f, st_b, sk, sv, ckv, ckr = [], [], [], [], [], []
    for l in range(DEPTH):
        mp = adaln(c_ctx[None, :], w_mod[l], b_mod[l])
        ms = adaln(c, w_mod[l], b_mod[l])
        g = g_norm[l]
        hp = pre(xp, g[0], mp[0], mp[1])
        hs = pre(xs, g[0], ms[0], ms[1])
        i = l // 2
        if l % 2 == 0:
            wts = (w_in_ab[i], w_gk_f[i], b_gk_f[i], w_gk_b[i], b_gk_b[i], g_gla[i], swa_sink[i], w_out_ab[i])
            op, (s_f, s_b, k_c, v_c) = mixer_ab(hp, *wts)
            os_, _ = mixer_ab(hs, *wts, ctx=(state_gla_fwd[:, i], state_gla_bwd[:, i], cache_swa_k[:, i], cache_swa_v[:, i]), pos=pos)
            st_f.append(s_f)
            st_b.append(s_b)
            sk.append(k_c)
            sv.append(v_c)
        else:
            wts = (w_mla_down[i], g_mla_q[i], g_mla_kv[i], w_mla_uq[i], w_mla_ukv[i], w_mla_o[i])
            op, (c_kv, k_r) = mixer_c(hp, *wts)
            os_, _ = mixer_c(hs, *wts, ctx=(cache_mla_ckv[:, i], cache_mla_kr[:, i]), pos=pos)
            ckv.append(c_kv)
            ckr.append(k_r)
        xp = post(xp, op, g[1], mp[2])
        xs = post(xs, os_, g[1], ms[2])
        xp = post(xp, sq_relu_mlp(pre(xp, g[2], mp[3], mp[4]), w_ff1[l], w_ff2[l]), g[3], mp[5])
        xs = post(xs, sq_relu_mlp(pre(xs, g[2], ms[3], ms[4]), w_ff1[l], w_ff2[l]), g[3], ms[5])

    new_state_gla_fwd = jnp.stack(st_f, axis=1)
    new_state_gla_bwd = jnp.stack(st_b, axis=1)
    new_cache_swa_k = jnp.stack(sk, axis=1)
    new_cache_swa_v = jnp.stack(sv, axis=1)
    new_cache_mla_ckv = jnp.stack(ckv, axis=1)
    new_cache_mla_kr = jnp.stack(ckr, axis=1)
    return (xp, xs, new_state_gla_fwd, new_state_gla_bwd, new_cache_swa_k, new_cache_swa_v, new_cache_mla_ckv, new_cache_mla_kr)
```

```cpp
#include <hip/hip_runtime.h>
#include <hip/hip_cooperative_groups.h>
#include <cstdio>
#include <cstdint>
namespace cg = cooperative_groups;

#ifndef MK_ONE_LAUNCH
#define MK_ONE_LAUNCH 1
#endif

#define LAS __attribute__((address_space(3)))
typedef unsigned short bf16_t;
typedef short bf16x8 __attribute__((ext_vector_type(8)));
typedef float f32x4 __attribute__((ext_vector_type(4)));
typedef float f32x2 __attribute__((ext_vector_type(2)));
typedef unsigned u32x4 __attribute__((ext_vector_type(4)));
typedef unsigned u32x2 __attribute__((ext_vector_type(2)));

constexpr int D = 1024, TP = 4096, TS = 2048, T = TP + TS, FF = 4096;
constexpr int NPROJ = 2336, NPROJ_PAD = 2560, NDOWN = 672, NDOWN_PAD = 768;
constexpr int C_QA = 0, C_KA = 256, C_VA = 512, C_GA = 1024, C_LO = 1536, C_QB = 1568, C_KB = 2080, C_VB = 2208;
constexpr float EPS = 1e-6f;
constexpr int NTHREADS = 512, NWAVES = 8;
constexpr int LDS_BYTES = 147456;

constexpr size_t O_X = 0, O_SF = 6291456, O_SB = 7340032, O_CK = 8388608, O_CV = 9437184, O_CKV = 10485760, O_CKR = 12582912;

constexpr size_t MiB = 1u << 20;
constexpr size_t WS_WFF1 = 0, WS_WFF2 = 32 * MiB, WS_WIN = 64 * MiB, WS_WOUT = 74 * MiB, WS_WDOWN = 78 * MiB, WS_WUQ = 81 * MiB,
                 WS_WUKV = 84 * MiB, WS_WO = 86 * MiB, WS_MOD = 90 * MiB, WS_TAB = 91 * MiB, WS_CSK = 92 * MiB, WS_CSV = 93 * MiB,
                 WS_H = 94 * MiB, WS_MIX = 106 * MiB, WS_OUT = 118 * MiB, WS_U = 166 * MiB, WS_PROJ = 214 * MiB;
constexpr size_t WS_LOC = WS_U, WS_DEC = WS_U + 24 * MiB;
constexpr size_t WS_Q = WS_U, WS_KVX = WS_U + 18 * MiB;
constexpr size_t WS_DOWN = WS_PROJ, WS_CQ = WS_PROJ + 18 * MiB, WS_CKV = WS_PROJ + 23 * MiB, WS_KR = WS_PROJ + 27 * MiB;
constexpr size_t OUT_SPLIT = (size_t)T * D;

__device__ __forceinline__ unsigned f2bf(float f) { unsigned u = __builtin_bit_cast(unsigned, f); return (u + 0x7fffu + ((u >> 16) & 1u)) >> 16; }
__device__ __forceinline__ unsigned pk2(float lo, float hi) { return f2bf(lo) | (f2bf(hi) << 16); }
__device__ __forceinline__ float bf2f(unsigned short b) { return __builtin_bit_cast(float, (unsigned)b << 16); }
__device__ __forceinline__ float bflo(unsigned w) { return __builtin_bit_cast(float, w << 16); }
__device__ __forceinline__ float bfhi(unsigned w) { return __builtin_bit_cast(float, w & 0xffff0000u); }
__device__ __forceinline__ void unpack8(const u32x4 v, float* f) {
    f[0] = bflo(v.x); f[1] = bfhi(v.x); f[2] = bflo(v.y); f[3] = bfhi(v.y); f[4] = bflo(v.z); f[5] = bfhi(v.z); f[6] = bflo(v.w); f[7] = bfhi(v.w);
}
__device__ __forceinline__ u32x4 pack8(const float* f) { u32x4 o; o.x = pk2(f[0], f[1]); o.y = pk2(f[2], f[3]); o.z = pk2(f[4], f[5]); o.w = pk2(f[6], f[7]); return o; }
__device__ __forceinline__ float wave_sum(float v) {
#pragma unroll
    for (int o = 1; o < 64; o <<= 1) v += __shfl_xor(v, o);
    return v;
}
__device__ __forceinline__ float silu_f(float x) { return x / (1.f + __expf(-x)); }

namespace pg8 {
constexpr int BM = 256, BK = 64, HALF = 128, HTB = HALF * BK * 2, NXCD = 8, WGM = 8;
__host__ __device__ __forceinline__ int lds_byte(int r, int c) { const int st = (r >> 4) * 2 + (c >> 5), rr = r & 15, cc = c & 31, ob = rr * 64 + cc * 2; return st * 1024 + (ob ^ (((ob >> 9) & 1) << 5)); }
__host__ __device__ __forceinline__ void stage_rc(int b, int& R, int& C) { const int st = b / 1024, sb = b % 1024, swz = sb ^ (((sb >> 9) & 1) << 5); R = (st >> 1) * 16 + swz / 64; C = (st & 1) * 32 + (swz % 64) / 2; }
__host__ __device__ __forceinline__ int perm32(int rho) { const int n = rho >> 4, i = rho & 15; return 8 * (i >> 2) + 4 * n + (i & 3); }

struct Unit { int pm, pn; };
struct Gemm { const bf16_t* A; const bf16_t* Bt; int M, N, K, lda, ldb, npn, a_split; };

struct StaticOrder {
    int nM, nN, nwg, G, c;
    __device__ void init(int M, int N, int G_, int c_) { nM = M / BM; nN = N / BM; nwg = nM * nN; G = G_; c = c_; }
    __device__ bool next(int i, Unit& u) const {
        const long L = (long)i * G + c; if (L >= nwg) return false;
        int wgid = (int)L; { const int q = nwg / NXCD, r = nwg % NXCD, xcd = wgid % NXCD, off = wgid / NXCD; wgid = (xcd < r ? xcd * (q + 1) : r * (q + 1) + (xcd - r) * q) + off; }
        const int nig = WGM * nN, gid = wgid / nig, fm = gid * WGM, gsz = (nM - fm) < WGM ? (nM - fm) : WGM;
        u.pm = fm + ((wgid % nig) % gsz); u.pn = (wgid % nig) / gsz; return true;
    }
};

__device__ __forceinline__ unsigned cvt_pk_bf16(float lo, float hi) { unsigned r; asm volatile("v_cvt_pk_bf16_f32 %0, %1, %2" : "=v"(r) : "v"(lo), "v"(hi)); return r; }

template <int ACT  > struct EpiBf16 {
    static constexpr bool PERM = true;
    bf16_t* O; int ldc;
    __device__ __forceinline__ void operator()(const f32x4 (&acc)[2][2][4][2], const Unit& u, int wr, int wc, int fr, int fq) const {
        const int row0 = u.pm * BM + wr * 64 + fr, col0 = u.pn * BM + wc * 32 + 8 * fq;
#pragma unroll
        for (int ai = 0; ai < 2; ++ai)
#pragma unroll
            for (int m = 0; m < 4; ++m) { bf16_t* rowp = O + (size_t)(row0 + ai * HALF + m * 16) * ldc + col0;
#pragma unroll
                for (int bj = 0; bj < 2; ++bj) { f32x4 v0 = acc[ai][bj][m][0], v1 = acc[ai][bj][m][1];
                    if (ACT == 1) {
#pragma unroll
                        for (int j = 0; j < 4; ++j) { float a = fmaxf(v0[j], 0.f), b = fmaxf(v1[j], 0.f); v0[j] = a * a; v1[j] = b * b; } }
                    u32x4 w; w.x = cvt_pk_bf16(v0[0], v0[1]); w.y = cvt_pk_bf16(v0[2], v0[3]); w.z = cvt_pk_bf16(v1[0], v1[1]); w.w = cvt_pk_bf16(v1[2], v1[3]);
                    *(u32x4*)(rowp + bj * HALF) = w; } }
    }
};
struct EpiProj {
    static constexpr bool PERM = true;
    bf16_t* O; float* outp; int li;
    __device__ __forceinline__ void operator()(const f32x4 (&acc)[2][2][4][2], const Unit& u, int wr, int wc, int fr, int fq) const {
        const int row0 = u.pm * BM + wr * 64 + fr, col0 = u.pn * BM + wc * 32 + 8 * fq;
#pragma unroll
        for (int ai = 0; ai < 2; ++ai)
#pragma unroll
            for (int m = 0; m < 4; ++m) { const int row = row0 + ai * HALF + m * 16; bf16_t* rowp = O + (size_t)row * NPROJ_PAD + col0;
#pragma unroll
                for (int bj = 0; bj < 2; ++bj) { const f32x4 v0 = acc[ai][bj][m][0], v1 = acc[ai][bj][m][1];
                    u32x4 w; w.x = cvt_pk_bf16(v0[0], v0[1]); w.y = cvt_pk_bf16(v0[2], v0[3]); w.z = cvt_pk_bf16(v1[0], v1[1]); w.w = cvt_pk_bf16(v1[2], v1[3]);
                    *(u32x4*)(rowp + bj * HALF) = w;
                    const int col = col0 + bj * HALF;
                    if (row < TP && col >= C_KB && col < NPROJ) {
                        const int b = row >> 8, t = row & 255;
                        float* dst = outp + ((col < C_VB) ? (O_CK - C_KB) : (O_CV - C_VB)) + ((size_t)((b * 2 + li) * 256 + t)) * 128 + col;
                        *(f32x4*)dst = v0; *(f32x4*)(dst + 4) = v1; } } }
    }
};
struct EpiF32 {
    static constexpr bool PERM = true;
    float* O; int ldc; int npn; size_t split_stride;
    __device__ __forceinline__ void operator()(const f32x4 (&acc)[2][2][4][2], const Unit& u, int wr, int wc, int fr, int fq) const {
        const int s = u.pn / npn, pn = u.pn - s * npn;
        float* base = O + (size_t)s * split_stride;
        const int row0 = u.pm * BM + wr * 64 + fr, col0 = pn * BM + wc * 32 + 8 * fq;
#pragma unroll
        for (int ai = 0; ai < 2; ++ai)
#pragma unroll
            for (int m = 0; m < 4; ++m) { float* rowp = base + (size_t)(row0 + ai * HALF + m * 16) * ldc + col0;
#pragma unroll
                for (int bj = 0; bj < 2; ++bj) { *(f32x4*)(rowp + bj * HALF) = acc[ai][bj][m][0]; *(f32x4*)(rowp + bj * HALF + 4) = acc[ai][bj][m][1]; } }
    }
};

template <class Epi, class Sched>
__device__ __forceinline__ void gemm_phase(LAS unsigned char* lds, const Gemm g, const Sched& S, const Epi& E, const int tid) {
    const int wid = __builtin_amdgcn_readfirstlane(tid >> 6), lane = tid & 63, wr = wid >> 2, wc = wid & 3, fr = lane & 15, fq = lane >> 4;
    const int K = g.K, nt = K / BK;
    unsigned voffA[2], voffB[2];
#pragma unroll
    for (int i = 0; i < 2; ++i) { int R, C; stage_rc(tid * 16 + i * 8192, R, C); const int Rb = Epi::PERM ? ((R & ~31) + perm32(R & 31)) : R;
        voffA[i] = (unsigned)(R * g.lda + C) * 2u; voffB[i] = (unsigned)(Rb * g.ldb + C) * 2u; }
    const size_t kstep = (size_t)(BK * 2);
    const size_t hstepA = (size_t)HALF * g.lda * 2, hstepB = (size_t)HALF * g.ldb * 2;
    const size_t tstepA = 2 * hstepA, tstepB = 2 * hstepB;
    const unsigned ldsw = (unsigned)wid * 1024u;
    const int aoff = lds_byte(wr * 64 + fr, fq * 8), boff = lds_byte(wc * 32 + fr, fq * 8);
#define PG8_SA(b, h) (((b) * 2 + (h)) * HTB)
#define PG8_SB(b, h) ((4 + (b) * 2 + (h)) * HTB)
#define PG8_STAGE(bufoff, gbase, voff) do { _Pragma("unroll") for (int _i = 0; _i < 2; ++_i) \
        __builtin_amdgcn_global_load_lds((const unsigned*)((const char*)(gbase) + (voff)[_i]), (LAS unsigned*)(lds + (bufoff) + ldsw + _i * 8192), 16, 0, 0); } while (0)
#define PG8_LDA(dst, b, h) do { _Pragma("unroll") for (int m = 0; m < 4; ++m) _Pragma("unroll") for (int k = 0; k < 2; ++k) dst[m][k] = *(const LAS bf16x8*)(lds + PG8_SA(b, h) + aoff + m * 2048 + k * 1024); } while (0)
#define PG8_LDB(dst, b, h) do { _Pragma("unroll") for (int n = 0; n < 2; ++n) _Pragma("unroll") for (int k = 0; k < 2; ++k) dst[n][k] = *(const LAS bf16x8*)(lds + PG8_SB(b, h) + boff + n * 2048 + k * 1024); } while (0)
#define PG8_MMA(ai, bj, At, Bt) do { __builtin_amdgcn_s_setprio(1); _Pragma("unroll") for (int m = 0; m < 4; ++m) _Pragma("unroll") for (int n = 0; n < 2; ++n) _Pragma("unroll") for (int k = 0; k < 2; ++k) \
        acc[ai][bj][m][n] = __builtin_amdgcn_mfma_f32_16x16x32_bf16(Bt[n][k], At[m][k], acc[ai][bj][m][n], 0, 0, 0); __builtin_amdgcn_s_setprio(0); } while (0)
#define PG8_WAIT_V(n) asm volatile("s_waitcnt vmcnt(" #n ")" ::: "memory")
#define PG8_WAIT_L(n) asm volatile("s_waitcnt lgkmcnt(" #n ")" ::: "memory")
#define PG8_BAR __builtin_amdgcn_s_barrier()
#define PG8_SCHED __builtin_amdgcn_sched_barrier(0)
#define PG8_UA(u) ((const char*)g.A + (size_t)(u).pm * tstepA + (size_t)((u).pn / g.npn) * (size_t)g.a_split * 2)
#define PG8_UB(u) ((const char*)g.Bt + (size_t)(u).pn * tstepB)
    Unit cur, nxt; int ui = 0;
    if (!S.next(0, cur)) return;
    f32x4 acc[2][2][4][2];
#pragma unroll
    for (int a = 0; a < 2; ++a)
#pragma unroll
        for (int b = 0; b < 2; ++b)
#pragma unroll
            for (int m = 0; m < 4; ++m)
#pragma unroll
                for (int n = 0; n < 2; ++n) acc[a][b][m][n] = (f32x4){0.f, 0.f, 0.f, 0.f};
    bf16x8 At[4][2], B0[2][2], B1[2][2];
    const char* cA = PG8_UA(cur); const char* cB = PG8_UB(cur);
    PG8_STAGE(PG8_SB(0, 0), cB, voffB); PG8_STAGE(PG8_SB(0, 1), cB + hstepB, voffB); PG8_STAGE(PG8_SA(0, 0), cA, voffA); PG8_STAGE(PG8_SA(0, 1), cA + hstepA, voffA);
    if (wr == 1) PG8_BAR;
    PG8_WAIT_V(2); PG8_BAR;
    PG8_STAGE(PG8_SB(1, 0), cB + kstep, voffB); PG8_STAGE(PG8_SA(1, 0), cA + kstep, voffA); PG8_STAGE(PG8_SB(1, 1), cB + hstepB + kstep, voffB);
    PG8_WAIT_V(6); PG8_BAR;
    for (;;) {
        const bool has_next = S.next(ui + 1, nxt);
        const char* nA = has_next ? PG8_UA(nxt) : cA; const char* nB = has_next ? PG8_UB(nxt) : cB;
        for (int t = 0; t < nt; t += 2) {
            const bool last = (t == nt - 2);
            const char* a1 = cA + (size_t)(t + 1) * kstep;
            const char* a2 = last ? nA : cA + (size_t)(t + 2) * kstep; const char* b2 = last ? nB : cB + (size_t)(t + 2) * kstep;
            const char* a3 = a2 + kstep; const char* b3 = b2 + kstep;
            PG8_LDB(B0, 0, 0); PG8_LDB(B1, 0, 1); PG8_SCHED; PG8_LDA(At, 0, 0); PG8_STAGE(PG8_SA(1, 1), a1 + hstepA, voffA);
            PG8_WAIT_V(8); PG8_WAIT_L(0); PG8_BAR; PG8_MMA(0, 0, At, B0); PG8_MMA(0, 1, At, B1); PG8_BAR; PG8_SCHED;
            PG8_LDA(At, 0, 1); PG8_STAGE(PG8_SB(0, 0), b2, voffB); PG8_STAGE(PG8_SB(0, 1), b2 + hstepB, voffB); PG8_STAGE(PG8_SA(0, 0), a2, voffA);
            PG8_WAIT_V(8); PG8_WAIT_L(0); PG8_BAR; PG8_MMA(1, 0, At, B0); PG8_MMA(1, 1, At, B1); PG8_BAR; PG8_SCHED;
            PG8_LDB(B0, 1, 0); PG8_LDB(B1, 1, 1); PG8_SCHED; PG8_LDA(At, 1, 0); PG8_STAGE(PG8_SA(0, 1), a2 + hstepA, voffA);
            PG8_WAIT_V(8); PG8_WAIT_L(0); PG8_BAR; PG8_MMA(0, 0, At, B0); PG8_MMA(0, 1, At, B1); PG8_BAR; PG8_SCHED;
            PG8_LDA(At, 1, 1); PG8_STAGE(PG8_SB(1, 0), b3, voffB); PG8_STAGE(PG8_SB(1, 1), b3 + hstepB, voffB); PG8_STAGE(PG8_SA(1, 0), a3, voffA);
            PG8_WAIT_V(8); PG8_WAIT_L(0); PG8_BAR; PG8_MMA(1, 0, At, B0); PG8_MMA(1, 1, At, B1); PG8_BAR; PG8_SCHED;
        }
        if (wr == 0) PG8_BAR;
        E(acc, cur, wr, wc, fr, fq);
        if (!has_next) break;
#pragma unroll
        for (int a = 0; a < 2; ++a)
#pragma unroll
            for (int b = 0; b < 2; ++b)
#pragma unroll
                for (int m = 0; m < 4; ++m)
#pragma unroll
                    for (int n = 0; n < 2; ++n) acc[a][b][m][n] = (f32x4){0.f, 0.f, 0.f, 0.f};
        cur = nxt; cA = nA; cB = nB; ++ui;
        if (wr == 1) PG8_BAR;
    }
    PG8_WAIT_V(0);
    PG8_BAR;
#undef PG8_SA
#undef PG8_SB
#undef PG8_STAGE
#undef PG8_LDA
#undef PG8_LDB
#undef PG8_MMA
#undef PG8_WAIT_V
#undef PG8_WAIT_L
#undef PG8_BAR
#undef PG8_SCHED
#undef PG8_UA
#undef PG8_UB
}
}

struct Args { const float* in[29]; float* out; unsigned char* ws; int ph_lo, ph_hi; };
struct Ctx { unsigned char* ws; float* out; int z, tid, bid, G; };

#define MFMA16(a, b, c) __builtin_amdgcn_mfma_f32_16x16x32_bf16((a), (b), (c), 0, 0, 0)

__device__ __forceinline__ void transpose_item(const float* W, int K, int N, bf16_t* WT, int npad, int ksub, LAS float* scr, int item, int lane) {
    const int nblk = N / 32, kb = item / nblk, nb = item % nblk, k0 = 64 * kb, n0 = 32 * nb;
#pragma unroll 8
    for (int i = 0; i < 32; ++i) { const int kk = 2 * i + (lane >> 5); scr[kk * 33 + (lane & 31)] = W[(size_t)(k0 + kk) * N + n0 + (lane & 31)]; }
    asm volatile("s_waitcnt lgkmcnt(0)" ::: "memory");
    const int c = lane & 7;
    const int ks = k0 / ksub, kin = k0 - ks * ksub;
    bf16_t* dbase = WT + (size_t)ks * npad * ksub + kin + 8 * c;
#pragma unroll
    for (int j = 0; j < 4; ++j) { const int n = (lane >> 3) + 8 * j; const LAS float* s = scr + (8 * c) * 33 + n;
        u32x4 o; o.x = pk2(s[0 * 33], s[1 * 33]); o.y = pk2(s[2 * 33], s[3 * 33]); o.z = pk2(s[4 * 33], s[5 * 33]); o.w = pk2(s[6 * 33], s[7 * 33]);
        *(u32x4*)(dbase + (size_t)(n0 + n) * ksub) = o; }
    asm volatile("s_waitcnt lgkmcnt(0)" ::: "memory");
}

struct MatDesc { const float* W; bf16_t* WT; int K, N, npad, ksub, items; };
__device__ __forceinline__ MatDesc get_mat(const Args& a, const Ctx& cx, int mi) {
    MatDesc m; unsigned char* ws = cx.ws;
    if (mi < 4)       { m.W = a.in[13 + cx.z] + (size_t)mi * D * FF; m.WT = (bf16_t*)(ws + WS_WFF1) + (size_t)mi * FF * D; m.K = D; m.N = FF; m.npad = FF; m.ksub = D; }
    else if (mi < 8)  { const int l = mi - 4; m.W = a.in[14 + cx.z] + (size_t)l * FF * D; m.WT = (bf16_t*)(ws + WS_WFF2) + (size_t)l * FF * D; m.K = FF; m.N = D; m.npad = D; m.ksub = FF / 2; }
    else if (mi < 10) { const int i = mi - 8; m.W = a.in[15 + cx.z] + (size_t)i * D * NPROJ; m.WT = (bf16_t*)(ws + WS_WIN) + (size_t)i * NPROJ_PAD * D; m.K = D; m.N = NPROJ; m.npad = NPROJ_PAD; m.ksub = D; }
    else if (mi < 12) { const int i = mi - 10; m.W = a.in[22 + cx.z] + (size_t)i * D * D; m.WT = (bf16_t*)(ws + WS_WOUT) + (size_t)i * D * D; m.K = D; m.N = D; m.npad = D; m.ksub = D / 2; }
    else if (mi < 14) { const int i = mi - 12; m.W = a.in[23 + cx.z] + (size_t)i * D * NDOWN; m.WT = (bf16_t*)(ws + WS_WDOWN) + (size_t)i * NDOWN_PAD * D; m.K = D; m.N = NDOWN; m.npad = NDOWN_PAD; m.ksub = D; }
    else if (mi < 16) { const int i = mi - 14; m.W = a.in[26 + cx.z] + (size_t)i * 384 * 1536; m.WT = (bf16_t*)(ws + WS_WUQ) + (size_t)i * 1536 * 384; m.K = 384; m.N = 1536; m.npad = 1536; m.ksub = 384; }
    else if (mi < 18) { const int i = mi - 16; m.W = a.in[27 + cx.z] + (size_t)i * 256 * 2048; m.WT = (bf16_t*)(ws + WS_WUKV) + (size_t)i * 2048 * 256; m.K = 256; m.N = 2048; m.npad = 2048; m.ksub = 256; }
    else              { const int i = mi - 18; m.W = a.in[28 + cx.z] + (size_t)i * D * D; m.WT = (bf16_t*)(ws + WS_WO) + (size_t)i * D * D; m.K = D; m.N = D; m.npad = D; m.ksub = D / 2; }
    m.items = (m.K / 64) * (m.N / 32);
    return m;
}

__device__ __forceinline__ void prologue(const Args& a, const Ctx& cx, LAS unsigned char* lds) {
    const int tid = cx.tid, lane = tid & 63, wave = tid >> 6, G = cx.G, bid = cx.bid;
    unsigned char* ws = cx.ws;
    {
        LAS float* sc = (LAS float*)lds;
        LAS float* red = (LAS float*)(lds + 12288);
        for (int i = tid; i < 3 * D; i += NTHREADS) { const int g = i >> 10, k = i & 1023; const float v = (g == 0) ? a.in[9 + cx.z][k] : a.in[8 + cx.z][(g - 1) * D + k]; sc[i] = silu_f(v); }
        __syncthreads();
        float* MOD = (float*)(ws + WS_MOD);
        for (int it = bid; it < 4 * 48; it += G) {
            const int l = it / 48, jb = it % 48, jq = tid & 31, kg = tid >> 5, j = jb * 128 + jq * 4;
            const float* wp = a.in[10 + cx.z] + ((size_t)l * D + kg * 64) * 6144 + j;
            f32x4 a0 = {0.f, 0.f, 0.f, 0.f}, a1 = a0, a2 = a0;
#pragma unroll 8
            for (int k = 0; k < 64; ++k) { const f32x4 w = *(const f32x4*)(wp + (size_t)k * 6144); const int kk = kg * 64 + k;
                a0 += w * sc[kk]; a1 += w * sc[D + kk]; a2 += w * sc[2 * D + kk]; }
#pragma unroll
            for (int e = 0; e < 4; ++e) { red[(kg * 3 + 0) * 128 + jq * 4 + e] = a0[e]; red[(kg * 3 + 1) * 128 + jq * 4 + e] = a1[e]; red[(kg * 3 + 2) * 128 + jq * 4 + e] = a2[e]; }
            __syncthreads();
            if (tid < 384) { const int g = tid >> 7, jj = tid & 127; float s = 0.f;
#pragma unroll
                for (int q = 0; q < 16; ++q) s += red[(q * 3 + g) * 128 + jj];
                MOD[((size_t)l * 3 + g) * 6144 + jb * 128 + jj] = s + a.in[11 + cx.z][(size_t)l * 6144 + jb * 128 + jj]; }
            __syncthreads();
        }
    }
    __syncthreads();
    {
        LAS float* scr = (LAS float*)(lds + wave * 16384);
        const int gw = bid * NWAVES + wave, NGW = G * NWAVES;
        int base = 0;
        for (int mi = 0; mi < 20; ++mi) {
            const MatDesc m = get_mat(a, cx, mi);
            int first = (gw - base) % NGW; if (first < 0) first += NGW;
            for (int it = first; it < m.items; it += NGW) transpose_item(m.W, m.K, m.N, m.WT, m.npad, m.ksub, scr, it, lane);
            base += m.items;
        }
    }
    {
        const size_t gt = (size_t)bid * NTHREADS + tid, NGT = (size_t)G * NTHREADS;
        for (int i = 0; i < 2; ++i) {
            u32x4* z1 = (u32x4*)((bf16_t*)(ws + WS_WIN) + (size_t)i * NPROJ_PAD * D + (size_t)NPROJ * D);
            for (size_t x = gt; x < (size_t)(NPROJ_PAD - NPROJ) * D / 8; x += NGT) z1[x] = (u32x4){0u, 0u, 0u, 0u};
            u32x4* z2 = (u32x4*)((bf16_t*)(ws + WS_WDOWN) + (size_t)i * NDOWN_PAD * D + (size_t)NDOWN * D);
            for (size_t x = gt; x < (size_t)(NDOWN_PAD - NDOWN) * D / 8; x += NGT) z2[x] = (u32x4){0u, 0u, 0u, 0u};
        }
        f32x2* tab64 = (f32x2*)(ws + WS_TAB); f32x2* tab32 = tab64 + 64 * 16;
        for (size_t x = gt; x < 64 * 16; x += NGT) { const int pos = (int)x >> 4, f = (int)x & 15; const float inv = powf(10000.f, -(float)f / 16.f); const float ang = (float)pos * inv; tab64[x] = (f32x2){cosf(ang), sinf(ang)}; }
        for (size_t x = gt; x < 64 * 8; x += NGT) { const int pos = (int)x >> 3, f = (int)x & 7; const float inv = powf(10000.f, -(float)f / 8.f); const float ang = (float)pos * inv; tab32[x] = (f32x2){cosf(ang), sinf(ang)}; }
        bf16_t* csk = (bf16_t*)(ws + WS_CSK); bf16_t* csv = (bf16_t*)(ws + WS_CSV);
        for (size_t x = gt; x < (size_t)2 * 2 * 512 * 128 / 4; x += NGT) {
            const size_t e = x * 4; const int b = (int)(e / (2 * 65536)), i = (int)(e / 65536) & 1; const size_t r = e % 65536;
            const size_t d = ((size_t)(i * 2 + b)) * 65536 + r;
            const f32x4 k = *(const f32x4*)(a.in[4 + cx.z] + e), v = *(const f32x4*)(a.in[5 + cx.z] + e);
            *(u32x2*)(csk + d) = (u32x2){pk2(k[0], k[1]), pk2(k[2], k[3])};
            *(u32x2*)(csv + d) = (u32x2){pk2(v[0], v[1]), pk2(v[2], v[3])};
        }
    }
}

__device__ __forceinline__ int mod_group(int r) { return r < TP ? 0 : 1 + ((r - TP) >> 10); }

__device__ __forceinline__ void pre_rows(const Args& a, const Ctx& cx, int l) {
    const int lane = cx.tid & 63, gw = cx.bid * NWAVES + (cx.tid >> 6), NGW = cx.G * NWAVES;
    const float* MOD = (const float*)(cx.ws + WS_MOD) + (size_t)l * 3 * 6144;
    const float* gA = a.in[12 + cx.z] + (size_t)l * 4 * D;
    bf16_t* H = (bf16_t*)(cx.ws + WS_H);
    for (int r = gw; r < T; r += NGW) {
        const float* xr = (r < TP) ? a.in[0 + cx.z] + (size_t)r * D : a.in[1 + cx.z] + (size_t)(r - TP) * D;
        const float* m = MOD + (size_t)mod_group(r) * 6144;
        f32x4 v[4]; float s = 0.f;
#pragma unroll
        for (int j = 0; j < 4; ++j) { v[j] = *(const f32x4*)(xr + lane * 4 + 256 * j); s += v[j][0] * v[j][0] + v[j][1] * v[j][1] + v[j][2] * v[j][2] + v[j][3] * v[j][3]; }
        const float rstd = rsqrtf(wave_sum(s) * (1.f / D) + EPS);
#pragma unroll
        for (int j = 0; j < 4; ++j) { const int c = lane * 4 + 256 * j;
            const f32x4 g = *(const f32x4*)(gA + c), sh = *(const f32x4*)(m + c), scl = *(const f32x4*)(m + D + c);
            const f32x4 h = v[j] * rstd * g * (scl + 1.f) + sh;
            *(u32x2*)(H + (size_t)r * D + c) = (u32x2){pk2(h[0], h[1]), pk2(h[2], h[3])}; }
    }
}

__device__ __forceinline__ void post_rows(const Args& a, const Ctx& cx, bool x_from_input, const float* gate_base  , const float* gB,
                                          bool has_next, const float* gC, const float* shift_base, const float* scale_base) {
    const int lane = cx.tid & 63, gw = cx.bid * NWAVES + (cx.tid >> 6), NGW = cx.G * NWAVES;
    const float* OUT = (const float*)(cx.ws + WS_OUT);
    bf16_t* H = (bf16_t*)(cx.ws + WS_H);
    for (int r = gw; r < T; r += NGW) {
        const float* xr = x_from_input ? ((r < TP) ? a.in[0 + cx.z] + (size_t)r * D : a.in[1 + cx.z] + (size_t)(r - TP) * D) : cx.out + (size_t)r * D;
        const size_t mg = (size_t)mod_group(r) * 6144;
        f32x4 o[4], x[4]; float s = 0.f;
#pragma unroll
        for (int j = 0; j < 4; ++j) { const int c = lane * 4 + 256 * j;
            o[j] = *(const f32x4*)(OUT + (size_t)r * D + c) + *(const f32x4*)(OUT + OUT_SPLIT + (size_t)r * D + c);
            x[j] = *(const f32x4*)(xr + c);
            s += o[j][0] * o[j][0] + o[j][1] * o[j][1] + o[j][2] * o[j][2] + o[j][3] * o[j][3]; }
        const float rstd = rsqrtf(wave_sum(s) * (1.f / D) + EPS);
        float s2 = 0.f;
#pragma unroll
        for (int j = 0; j < 4; ++j) { const int c = lane * 4 + 256 * j;
            const f32x4 g = *(const f32x4*)(gB + c), gt = *(const f32x4*)(gate_base + mg + c);
            x[j] = x[j] + gt * (o[j] * rstd * g);
            *(f32x4*)(cx.out + (size_t)r * D + c) = x[j];
            s2 += x[j][0] * x[j][0] + x[j][1] * x[j][1] + x[j][2] * x[j][2] + x[j][3] * x[j][3]; }
        if (has_next) {
            const float rstd2 = rsqrtf(wave_sum(s2) * (1.f / D) + EPS);
#pragma unroll
            for (int j = 0; j < 4; ++j) { const int c = lane * 4 + 256 * j;
                const f32x4 g = *(const f32x4*)(gC + c), sh = *(const f32x4*)(shift_base + mg + c), scl = *(const f32x4*)(scale_base + mg + c);
                const f32x4 h = x[j] * rstd2 * g * (scl + 1.f) + sh;
                *(u32x2*)(H + (size_t)r * D + c) = (u32x2){pk2(h[0], h[1]), pk2(h[2], h[3])}; }
        }
    }
}

__device__ __forceinline__ void mla_mid(const Args& a, const Ctx& cx, int i) {
    const int lane = cx.tid & 63, gw = cx.bid * NWAVES + (cx.tid >> 6), NGW = cx.G * NWAVES;
    const float* DOWN = (const float*)(cx.ws + WS_DOWN);
    bf16_t* CQ = (bf16_t*)(cx.ws + WS_CQ); bf16_t* CKV = (bf16_t*)(cx.ws + WS_CKV); bf16_t* KR = (bf16_t*)(cx.ws + WS_KR);
    const float* gq = a.in[24 + cx.z] + (size_t)i * 384; const float* gkv = a.in[25 + cx.z] + (size_t)i * 256;
    const f32x2* tab32 = (const f32x2*)(cx.ws + WS_TAB) + 64 * 16;
    for (int r = gw; r < T + 1024; r += NGW) {
        if (r < T) {
            const float* dr = DOWN + (size_t)r * NDOWN_PAD;
            float q[6]; float s = 0.f;
#pragma unroll
            for (int j = 0; j < 6; ++j) { q[j] = dr[lane + 64 * j]; s += q[j] * q[j]; }
            const float rq = rsqrtf(wave_sum(s) * (1.f / 384.f) + EPS);
#pragma unroll
            for (int j = 0; j < 6; ++j) CQ[(size_t)r * 384 + lane + 64 * j] = (bf16_t)f2bf(q[j] * rq * gq[lane + 64 * j]);
            float kv[4]; s = 0.f;
#pragma unroll
            for (int j = 0; j < 4; ++j) { kv[j] = dr[384 + lane + 64 * j]; s += kv[j] * kv[j]; }
            const float rk = rsqrtf(wave_sum(s) * (1.f / 256.f) + EPS);
#pragma unroll
            for (int j = 0; j < 4; ++j) { const float v = kv[j] * rk * gkv[lane + 64 * j]; CKV[(size_t)r * 256 + lane + 64 * j] = (bf16_t)f2bf(v);
                if (r < TP) { const int b = r >> 8, t = r & 255; cx.out[O_CKV + ((size_t)((b * 2 + i) * 256 + t)) * 256 + lane + 64 * j] = v; } }
            if (lane < 32) {
                const float kr = dr[640 + lane];
                if (r < TP) { const int b = r >> 8, t = r & 255; cx.out[O_CKR + ((size_t)((b * 2 + i) * 256 + t)) * 32 + lane] = kr; KR[(size_t)r * 32 + lane] = (bf16_t)f2bf(kr); }
                else {
                    const int t = (r - TP) & 1023, half = lane >> 4, p = (lane >> 3) & 1, f = lane & 7, pos = half ? (t & 63) : (t >> 6);
                    const float other = dr[640 + (lane ^ 8)];
                    const f32x2 cs = tab32[pos * 8 + f];
                    const float v = p ? (other * cs[1] + kr * cs[0]) : (kr * cs[0] - other * cs[1]);
                    KR[(size_t)r * 32 + lane] = (bf16_t)f2bf(v);
                }
            }
        } else {
            const int rr = r - T, b = rr >> 9, j = rr & 511;
            const float* src = a.in[6 + cx.z] + ((size_t)((b * 2 + i) * 512 + j)) * 256;
#pragma unroll
            for (int q = 0; q < 4; ++q) CKV[(size_t)r * 256 + lane + 64 * q] = (bf16_t)f2bf(src[lane + 64 * q]);
            if (lane < 32) KR[(size_t)r * 32 + lane] = (bf16_t)f2bf(a.in[7 + cx.z][((size_t)((b * 2 + i) * 512 + j)) * 32 + lane]);
        }
    }
}

struct KSeg { const bf16_t* K; int kstride; const bf16_t* K2; int k2stride; const bf16_t* V; int vstride; int k_lo, k_hi; int rope; int mask; };
struct AttnArgs { const bf16_t* Q; int qstride; int qpos0; int qrope  ; int nseg; KSeg seg0, seg1;
                  float m0, l0, scale; bf16_t* O; int ostride; const f32x2* tab64; const f32x2* tab32; };

__device__ __forceinline__ u32x4 rope8(const u32x4 own, const u32x4 partner, int p, const f32x2* tab) {
    float a[8], b[8], o[8]; unpack8(own, a); unpack8(partner, b);
#pragma unroll
    for (int e = 0; e < 8; ++e) { const f32x2 cs = tab[e]; o[e] = p ? (b[e] * cs[1] + a[e] * cs[0]) : (a[e] * cs[0] - b[e] * cs[1]); }
    return pack8(o);
}

template <int DQK>
__device__ __forceinline__ void attn_unit(LAS unsigned char* lds, const AttnArgs& A, const int tid) {
    constexpr int QS = DQK + 8, NCH = DQK / 8, NKS = DQK / 32;
    LAS bf16_t* Qs = (LAS bf16_t*)lds;
    LAS bf16_t* Ks = Qs + 128 * QS;
    LAS bf16_t* VT = Ks + 64 * QS;
    const int lane = tid & 63, w = tid >> 6, fr = lane & 15, fq = lane >> 4;
    __syncthreads();
    for (int c = tid; c < 128 * NCH; c += NTHREADS) {
        const int qi = c / NCH, ch = c % NCH, d0 = ch * 8;
        const bf16_t* src = A.Q + (size_t)qi * A.qstride;
        u32x4 v = *(const u32x4*)(src + d0);
        const int t = A.qpos0 + qi;
        if (A.qrope == 1) { const int half = ch >> 2, p = (ch >> 1) & 1, f0 = (ch & 1) * 8, pos = half ? (t & 63) : (t >> 6);
            const u32x4 pv = *(const u32x4*)(src + (d0 ^ 16)); v = rope8(v, pv, p, A.tab64 + pos * 16 + f0); }
        else if (A.qrope == 2 && ch >= 8) { const int c2 = ch - 8, half = c2 >> 1, p = c2 & 1, pos = half ? (t & 63) : (t >> 6);
            const u32x4 pv = *(const u32x4*)(src + 64 + ((c2 ^ 1) * 8)); v = rope8(v, pv, p, A.tab32 + pos * 8); }
        *(LAS u32x4*)(Qs + qi * QS + d0) = v;
    }
    __syncthreads();
    bf16x8 Qf[NKS];
#pragma unroll
    for (int ks = 0; ks < NKS; ++ks) Qf[ks] = *(const LAS bf16x8*)(Qs + (w * 16 + fr) * QS + ks * 32 + fq * 8);
    float m = A.m0, l = A.l0;
    f32x4 Oa[4];
#pragma unroll
    for (int dt = 0; dt < 4; ++dt) Oa[dt] = (f32x4){0.f, 0.f, 0.f, 0.f};
    const int qp = A.qpos0 + w * 16 + fr;
    for (int sg = 0; sg < A.nseg; ++sg) {
        const KSeg S = (sg == 0) ? A.seg0 : A.seg1;
        for (int kt = S.k_lo; kt < S.k_hi; kt += 64) {
            __syncthreads();
            for (int c = tid; c < 64 * NCH; c += NTHREADS) {
                const int key = c / NCH, ch = c % NCH, d0 = ch * 8;
                u32x4 v;
                if (DQK == 96 && ch >= 8) v = *(const u32x4*)(S.K2 + (size_t)(kt + key) * S.k2stride + (d0 - 64));
                else {
                    const bf16_t* src = S.K + (size_t)(kt + key) * S.kstride;
                    v = *(const u32x4*)(src + d0);
                    if (S.rope) { const int t = kt + key, half = ch >> 2, p = (ch >> 1) & 1, f0 = (ch & 1) * 8, pos = half ? (t & 63) : (t >> 6);
                        const u32x4 pv = *(const u32x4*)(src + (d0 ^ 16)); v = rope8(v, pv, p, A.tab64 + pos * 16 + f0); }
                }
                *(LAS u32x4*)(Ks + key * QS + d0) = v;
            }
            { const int key = tid >> 3, ch = tid & 7;
              const u32x4 v = *(const u32x4*)(S.V + (size_t)(kt + key) * S.vstride + ch * 8);
              LAS bf16_t* dst = VT + (ch * 8) * 72 + key;
              dst[0 * 72] = (bf16_t)(v.x & 0xffff); dst[1 * 72] = (bf16_t)(v.x >> 16); dst[2 * 72] = (bf16_t)(v.y & 0xffff); dst[3 * 72] = (bf16_t)(v.y >> 16);
              dst[4 * 72] = (bf16_t)(v.z & 0xffff); dst[5 * 72] = (bf16_t)(v.z >> 16); dst[6 * 72] = (bf16_t)(v.w & 0xffff); dst[7 * 72] = (bf16_t)(v.w >> 16); }
            __syncthreads();
            f32x4 st[4];
#pragma unroll
            for (int nt = 0; nt < 4; ++nt) { st[nt] = (f32x4){0.f, 0.f, 0.f, 0.f};
#pragma unroll
                for (int ks = 0; ks < NKS; ++ks) { const bf16x8 kf = *(const LAS bf16x8*)(Ks + (nt * 16 + fr) * QS + ks * 32 + fq * 8); st[nt] = MFMA16(kf, Qf[ks], st[nt]); } }
            float mx = -1e30f;
#pragma unroll
            for (int nt = 0; nt < 4; ++nt)
#pragma unroll
                for (int j = 0; j < 4; ++j) { float s = st[nt][j] * A.scale;
                    if (S.mask) { const int kp = kt + nt * 16 + fq * 4 + j; const int dd = qp - kp; if (dd > 128 || dd < -128) s = -1e30f; }
                    st[nt][j] = s; mx = fmaxf(mx, s); }
            mx = fmaxf(mx, __shfl_xor(mx, 16)); mx = fmaxf(mx, __shfl_xor(mx, 32));
            const float mn = fmaxf(m, mx), alpha = __expf(m - mn);
            float rs = 0.f;
#pragma unroll
            for (int nt = 0; nt < 4; ++nt)
#pragma unroll
                for (int j = 0; j < 4; ++j) { const float p = __expf(st[nt][j] - mn); st[nt][j] = p; rs += p; }
            rs += __shfl_xor(rs, 16); rs += __shfl_xor(rs, 32);
            l = l * alpha + rs; m = mn;
#pragma unroll
            for (int dt = 0; dt < 4; ++dt) Oa[dt] = Oa[dt] * alpha;
#pragma unroll
            for (int kk = 0; kk < 2; ++kk) {
                u32x4 pb; pb.x = pk2(st[2 * kk][0], st[2 * kk][1]); pb.y = pk2(st[2 * kk][2], st[2 * kk][3]); pb.z = pk2(st[2 * kk + 1][0], st[2 * kk + 1][1]); pb.w = pk2(st[2 * kk + 1][2], st[2 * kk + 1][3]);
                const bf16x8 pf = __builtin_bit_cast(bf16x8, pb);
#pragma unroll
                for (int dt = 0; dt < 4; ++dt) {
                    const LAS bf16_t* vp = VT + (dt * 16 + fr) * 72 + 32 * kk + fq * 4;
                    const u32x2 v0 = *(const LAS u32x2*)vp, v1 = *(const LAS u32x2*)(vp + 16);
                    const u32x4 vv = {v0.x, v0.y, v1.x, v1.y};
                    Oa[dt] = MFMA16(__builtin_bit_cast(bf16x8, vv), pf, Oa[dt]);
                }
            }
        }
    }
    const float inv = 1.f / l;
    bf16_t* op = A.O + (size_t)(w * 16 + fr) * A.ostride + fq * 4;
#pragma unroll
    for (int dt = 0; dt < 4; ++dt) *(u32x2*)(op + dt * 16) = (u32x2){pk2(Oa[dt][0] * inv, Oa[dt][1] * inv), pk2(Oa[dt][2] * inv, Oa[dt][3] * inv)};
}

__device__ __forceinline__ void swa_unit(const Args& a, const Ctx& cx, LAS unsigned char* lds, int i, int u) {
    const bf16_t* PROJ = (const bf16_t*)(cx.ws + WS_PROJ); bf16_t* MIX = (bf16_t*)(cx.ws + WS_MIX);
    AttnArgs A;
    A.tab64 = (const f32x2*)(cx.ws + WS_TAB); A.tab32 = A.tab64 + 64 * 16;
    A.qstride = NPROJ_PAD; A.ostride = D; A.scale = 0.125f; A.l0 = 1.f;
    if (u < 128) {
        const int b = u >> 6, hq = (u >> 3) & 7, qt = u & 7, kv = hq >> 2, row0 = TP + b * 1024, q0 = qt * 128;
        A.Q = PROJ + (size_t)(row0 + q0) * NPROJ_PAD + C_QB + hq * 64; A.qpos0 = q0; A.qrope = 1; A.nseg = 2;
        A.m0 = a.in[21 + cx.z][i * 8 + hq];
        const bf16_t* csk = (const bf16_t*)(cx.ws + WS_CSK) + ((size_t)(i * 2 + b)) * 65536 + kv * 64;
        const bf16_t* csv = (const bf16_t*)(cx.ws + WS_CSV) + ((size_t)(i * 2 + b)) * 65536 + kv * 64;
        A.seg0 = KSeg{csk, 128, nullptr, 0, csv, 128, 0, 512, 0, 0};
        const int lo = q0 - 128 < 0 ? 0 : q0 - 128, hi = q0 + 256 > 1024 ? 1024 : q0 + 256;
        A.seg1 = KSeg{PROJ + (size_t)row0 * NPROJ_PAD + C_KB + kv * 64, NPROJ_PAD, nullptr, 0, PROJ + (size_t)row0 * NPROJ_PAD + C_VB + kv * 64, NPROJ_PAD, lo, hi, 1, 1};
        A.O = MIX + (size_t)(row0 + q0) * D + 512 + hq * 64;
    } else {
        const int v = u - 128, b = v >> 4, hq = (v >> 1) & 7, qt = v & 1, kv = hq >> 2, row0 = b * 256, q0 = qt * 128;
        A.Q = PROJ + (size_t)(row0 + q0) * NPROJ_PAD + C_QB + hq * 64; A.qpos0 = q0; A.qrope = 0; A.nseg = 1;
        A.m0 = a.in[21 + cx.z][i * 8 + hq];
        A.seg0 = KSeg{PROJ + (size_t)row0 * NPROJ_PAD + C_KB + kv * 64, NPROJ_PAD, nullptr, 0, PROJ + (size_t)row0 * NPROJ_PAD + C_VB + kv * 64, NPROJ_PAD, 0, 256, 0, 0};
        A.seg1 = A.seg0;
        A.O = MIX + (size_t)(row0 + q0) * D + 512 + hq * 64;
    }
    attn_unit<64>(lds, A, cx.tid);
}

__device__ __forceinline__ void mla_unit(const Args& a, const Ctx& cx, LAS unsigned char* lds, int u) {
    const bf16_t* Q = (const bf16_t*)(cx.ws + WS_Q); const bf16_t* KVX = (const bf16_t*)(cx.ws + WS_KVX); const bf16_t* KR = (const bf16_t*)(cx.ws + WS_KR);
    bf16_t* MIX = (bf16_t*)(cx.ws + WS_MIX);
    AttnArgs A;
    A.tab64 = (const f32x2*)(cx.ws + WS_TAB); A.tab32 = A.tab64 + 64 * 16;
    A.qstride = 1536; A.ostride = D; A.scale = 0.10206207261596577f; A.l0 = 0.f; A.m0 = -1e30f;
    if (u < 256) {
        const int b = u >> 7, h = (u >> 3) & 15, qt = u & 7, row0 = TP + b * 1024, q0 = qt * 128, crow0 = T + b * 512;
        A.Q = Q + (size_t)(row0 + q0) * 1536 + h * 96; A.qpos0 = q0; A.qrope = 2; A.nseg = 2;
        A.seg0 = KSeg{KVX + (size_t)crow0 * 2048 + h * 128, 2048, KR + (size_t)crow0 * 32, 32, KVX + (size_t)crow0 * 2048 + h * 128 + 64, 2048, 0, 512, 0, 0};
        A.seg1 = KSeg{KVX + (size_t)row0 * 2048 + h * 128, 2048, KR + (size_t)row0 * 32, 32, KVX + (size_t)row0 * 2048 + h * 128 + 64, 2048, 0, 1024, 0, 0};
        A.O = MIX + (size_t)(row0 + q0) * D + h * 64;
    } else {
        const int v = u - 256, b = v >> 5, h = (v >> 1) & 15, qt = v & 1, row0 = b * 256, q0 = qt * 128;
        A.Q = Q + (size_t)(row0 + q0) * 1536 + h * 96; A.qpos0 = q0; A.qrope = 0; A.nseg = 1;
        A.seg0 = KSeg{KVX + (size_t)row0 * 2048 + h * 128, 2048, KR + (size_t)row0 * 32, 32, KVX + (size_t)row0 * 2048 + h * 128 + 64, 2048, 0, 256, 0, 0};
        A.seg1 = A.seg0;
        A.O = MIX + (size_t)(row0 + q0) * D + h * 64;
    }
    attn_unit<96>(lds, A, cx.tid);
}

constexpr int GL_G = 0;
constexpr int GL_STF = 32768, GL_STB = 51200;
constexpr int GL_LO = 32768, GL_WF = 40960, GL_WB = 45056, GL_BF = 49152, GL_BB = 49408;
constexpr int GL_QF = 69632, GL_KF = 78848, GL_QB = 88064, GL_KB = 97280;
constexpr int GL_VT = 106496;
constexpr int GL_AF = 124928, GL_AB = 134144;

__device__ __forceinline__ void gla_gates(const Args& a, const Ctx& cx, LAS unsigned char* lds, int i, int tok0, int h) {
    const int tid = cx.tid;
    const bf16_t* PROJ = (const bf16_t*)(cx.ws + WS_PROJ);
    LAS float* LO = (LAS float*)(lds + GL_LO); LAS float* WF = (LAS float*)(lds + GL_WF); LAS float* WB = (LAS float*)(lds + GL_WB);
    LAS float* BF = (LAS float*)(lds + GL_BF); LAS float* BB = (LAS float*)(lds + GL_BB);
    LAS float* Gf = (LAS float*)(lds + GL_G); LAS float* Gb = Gf + 4096;
    { const int t = tid >> 3, j0 = (tid & 7) * 4; const u32x2 v = *(const u32x2*)(PROJ + (size_t)(tok0 + t) * NPROJ_PAD + C_LO + j0);
      LO[t * 32 + j0] = bflo(v.x); LO[t * 32 + j0 + 1] = bfhi(v.x); LO[t * 32 + j0 + 2] = bflo(v.y); LO[t * 32 + j0 + 3] = bfhi(v.y); }
    for (int x = tid; x < 1024; x += NTHREADS) { const int r = x >> 6, d = x & 63;
        WF[x] = a.in[16 + cx.z][((size_t)i * 16 + r) * 256 + h * 64 + d]; WB[x] = a.in[18 + cx.z][((size_t)i * 16 + r) * 256 + h * 64 + d]; }
    if (tid < 64) { BF[tid] = a.in[17 + cx.z][i * 256 + h * 64 + tid]; BB[tid] = a.in[19 + cx.z][i * 256 + h * 64 + tid]; }
    __syncthreads();
    { const int d = tid & 63, tg = tid >> 6;
      float wf[16], wb[16];
#pragma unroll
      for (int r = 0; r < 16; ++r) { wf[r] = WF[r * 64 + d]; wb[r] = WB[r * 64 + d]; }
      const float bfv = BF[d], bbv = BB[d];
#pragma unroll
      for (int tt = 0; tt < 8; ++tt) { const int t = tg * 8 + tt; float xf = bfv, xb = bbv;
#pragma unroll
          for (int r = 0; r < 16; ++r) { xf += LO[t * 32 + r] * wf[r]; xb += LO[t * 32 + 16 + r] * wb[r]; }
          const float lf = fminf(xf, 0.f) - log1pf(__expf(-fabsf(xf))), lb = fminf(xb, 0.f) - log1pf(__expf(-fabsf(xb)));
          Gf[t * 64 + d] = lf * (1.f / 16.f); Gb[t * 64 + d] = lb * (1.f / 16.f); } }
    __syncthreads();
    if (tid < 64) { float s = 0.f; for (int t = 0; t < 64; ++t) { s += Gf[t * 64 + tid]; Gf[t * 64 + tid] = s; } }
    else if (tid < 128) { const int d = tid - 64; float s = 0.f; for (int t = 63; t >= 0; --t) { s += Gb[t * 64 + d]; Gb[t * 64 + d] = s; } }
    __syncthreads();
}

__device__ __forceinline__ void gla_load_vt(const bf16_t* PROJ, LAS unsigned char* lds, int tok0, int h, const int tid) {
    const int s = tid >> 3, e0 = (tid & 7) * 16;
    LAS bf16_t* VT = (LAS bf16_t*)(lds + GL_VT);
    const bf16_t* src = PROJ + (size_t)(tok0 + s) * NPROJ_PAD + C_VA + h * 128 + e0;
#pragma unroll
    for (int q = 0; q < 2; ++q) { const u32x4 v = *(const u32x4*)(src + q * 8); LAS bf16_t* dst = VT + (e0 + q * 8) * 72 + s;
        dst[0 * 72] = (bf16_t)(v.x & 0xffff); dst[1 * 72] = (bf16_t)(v.x >> 16); dst[2 * 72] = (bf16_t)(v.y & 0xffff); dst[3 * 72] = (bf16_t)(v.y >> 16);
        dst[4 * 72] = (bf16_t)(v.z & 0xffff); dst[5 * 72] = (bf16_t)(v.z >> 16); dst[6 * 72] = (bf16_t)(v.w & 0xffff); dst[7 * 72] = (bf16_t)(v.w >> 16); }
}

__device__ __forceinline__ void gla_local_unit(const Args& a, const Ctx& cx, LAS unsigned char* lds, int i, int u) {
    const int cg_ = u >> 2, h = u & 3, tok0 = cg_ * 64, tid = cx.tid, lane = tid & 63, w = tid >> 6, fr = lane & 15, fq = lane >> 4;
    const bf16_t* PROJ = (const bf16_t*)(cx.ws + WS_PROJ);
    float* LOC = (float*)(cx.ws + WS_LOC); float* DEC = (float*)(cx.ws + WS_DEC);
    __syncthreads();
    gla_gates(a, cx, lds, i, tok0, h);
    LAS float* Gf = (LAS float*)(lds + GL_G); LAS float* Gb = Gf + 4096;
    LAS bf16_t* KTf = (LAS bf16_t*)(lds + GL_KF); LAS bf16_t* KTb = (LAS bf16_t*)(lds + GL_KB);
    LAS bf16_t* VT = (LAS bf16_t*)(lds + GL_VT);
    { const int s = tid >> 3, d0 = (tid & 7) * 8; const u32x4 kv = *(const u32x4*)(PROJ + (size_t)(tok0 + s) * NPROJ_PAD + C_KA + h * 64 + d0);
      float k[8]; unpack8(kv, k);
#pragma unroll
      for (int e = 0; e < 8; ++e) { const int d = d0 + e;
          KTf[d * 72 + s] = (bf16_t)f2bf(k[e] * __expf(Gf[63 * 64 + d] - Gf[s * 64 + d]));
          KTb[d * 72 + s] = (bf16_t)f2bf(k[e] * __expf(Gb[d] - Gb[s * 64 + d])); } }
    gla_load_vt(PROJ, lds, tok0, h, tid);
    if (tid < 128) { const int dir = tid >> 6, d = tid & 63; DEC[((size_t)(dir * 96 + cg_) * 4 + h) * 64 + d] = __expf(dir ? Gb[d] : Gf[63 * 64 + d]); }
    __syncthreads();
    const int dir = w >> 2, dtile = w & 3;
    const LAS bf16_t* KT = dir ? KTb : KTf;
    bf16x8 af[2];
#pragma unroll
    for (int ks = 0; ks < 2; ++ks) af[ks] = *(const LAS bf16x8*)(KT + (dtile * 16 + fr) * 72 + ks * 32 + fq * 8);
    float* dst = LOC + ((size_t)(dir * 96 + cg_) * 4 + h) * 8192;
#pragma unroll
    for (int et = 0; et < 8; ++et) { f32x4 acc = {0.f, 0.f, 0.f, 0.f};
#pragma unroll
        for (int ks = 0; ks < 2; ++ks) { const bf16x8 bfv = *(const LAS bf16x8*)(VT + (et * 16 + fr) * 72 + ks * 32 + fq * 8); acc = MFMA16(af[ks], bfv, acc); }
#pragma unroll
        for (int j = 0; j < 4; ++j) dst[(dtile * 16 + fq * 4 + j) * 128 + et * 16 + fr] = acc[j]; }
}

__device__ __forceinline__ void gla_out_unit(const Args& a, const Ctx& cx, LAS unsigned char* lds, int i, int u) {
    const int cg_ = u >> 2, h = u & 3, tok0 = cg_ * 64, tid = cx.tid, lane = tid & 63, w = tid >> 6, fr = lane & 15, fq = lane >> 4;
    const bf16_t* PROJ = (const bf16_t*)(cx.ws + WS_PROJ); bf16_t* MIX = (bf16_t*)(cx.ws + WS_MIX);
    const float* LOC = (const float*)(cx.ws + WS_LOC); const float* DEC = (const float*)(cx.ws + WS_DEC);
    __syncthreads();
    gla_gates(a, cx, lds, i, tok0, h);
    LAS float* Gf = (LAS float*)(lds + GL_G); LAS float* Gb = Gf + 4096;
    const bool samp = cg_ >= 64;
    const int b = samp ? (cg_ - 64) >> 4 : cg_ >> 2, c = samp ? (cg_ - 64) & 15 : cg_ & 3, nc = samp ? 16 : 4, cbase = cg_ - c;
    {
        const int d = tid >> 3, e0 = (tid & 7) * 16;
        f32x4 Sf[4], Sb[4];
        if (samp) { const float* s0f = a.in[2 + cx.z] + ((size_t)((b * 2 + i) * 4 + h)) * 8192 + d * 128 + e0; const float* s0b = a.in[3 + cx.z] + ((size_t)((b * 2 + i) * 4 + h)) * 8192 + d * 128 + e0;
#pragma unroll
            for (int q = 0; q < 4; ++q) { Sf[q] = *(const f32x4*)(s0f + q * 4); Sb[q] = *(const f32x4*)(s0b + q * 4); } }
        else {
#pragma unroll
            for (int q = 0; q < 4; ++q) { Sf[q] = (f32x4){0.f, 0.f, 0.f, 0.f}; Sb[q] = Sf[q]; } }
        for (int j = 0; j < c; ++j) { const size_t ix = (size_t)(0 * 96 + cbase + j) * 4 + h; const float dec = DEC[ix * 64 + d]; const float* lp = LOC + ix * 8192 + d * 128 + e0;
#pragma unroll
            for (int q = 0; q < 4; ++q) Sf[q] = Sf[q] * dec + *(const f32x4*)(lp + q * 4); }
        for (int j = nc - 1; j > c; --j) { const size_t ix = (size_t)(1 * 96 + cbase + j) * 4 + h; const float dec = DEC[ix * 64 + d]; const float* lp = LOC + ix * 8192 + d * 128 + e0;
#pragma unroll
            for (int q = 0; q < 4; ++q) Sb[q] = Sb[q] * dec + *(const f32x4*)(lp + q * 4); }
        if (!samp) {
            if (c == nc - 1) { const size_t ix = (size_t)(0 * 96 + cg_) * 4 + h; const float dec = DEC[ix * 64 + d]; const float* lp = LOC + ix * 8192 + d * 128 + e0;
                float* o = cx.out + O_SF + ((size_t)((b * 2 + i) * 4 + h)) * 8192 + d * 128 + e0;
#pragma unroll
                for (int q = 0; q < 4; ++q) *(f32x4*)(o + q * 4) = Sf[q] * dec + *(const f32x4*)(lp + q * 4); }
            if (c == 0) { const size_t ix = (size_t)(1 * 96 + cg_) * 4 + h; const float dec = DEC[ix * 64 + d]; const float* lp = LOC + ix * 8192 + d * 128 + e0;
                float* o = cx.out + O_SB + ((size_t)((b * 2 + i) * 4 + h)) * 8192 + d * 128 + e0;
#pragma unroll
                for (int q = 0; q < 4; ++q) *(f32x4*)(o + q * 4) = Sb[q] * dec + *(const f32x4*)(lp + q * 4); }
        }
        LAS bf16_t* STf = (LAS bf16_t*)(lds + GL_STF); LAS bf16_t* STb = (LAS bf16_t*)(lds + GL_STB);
#pragma unroll
        for (int q = 0; q < 4; ++q)
#pragma unroll
            for (int e = 0; e < 4; ++e) { STf[(e0 + q * 4 + e) * 72 + d] = (bf16_t)f2bf(Sf[q][e]); STb[(e0 + q * 4 + e) * 72 + d] = (bf16_t)f2bf(Sb[q][e]); }
    }
    {
        const int t = tid >> 3, d0 = (tid & 7) * 8;
        const u32x4 qv = *(const u32x4*)(PROJ + (size_t)(tok0 + t) * NPROJ_PAD + C_QA + h * 64 + d0);
        const u32x4 kv = *(const u32x4*)(PROJ + (size_t)(tok0 + t) * NPROJ_PAD + C_KA + h * 64 + d0);
        float q[8], k[8], o1[8], o2[8], o3[8], o4[8]; unpack8(qv, q); unpack8(kv, k);
#pragma unroll
        for (int e = 0; e < 8; ++e) { const float gf = Gf[t * 64 + d0 + e], gb = Gb[t * 64 + d0 + e];
            o1[e] = q[e] * 0.125f * __expf(gf); o2[e] = k[e] * __expf(-gf); o3[e] = q[e] * 0.125f * __expf(gb); o4[e] = k[e] * __expf(-gb); }
        *(LAS u32x4*)((LAS bf16_t*)(lds + GL_QF) + t * 72 + d0) = pack8(o1);
        *(LAS u32x4*)((LAS bf16_t*)(lds + GL_KF) + t * 72 + d0) = pack8(o2);
        *(LAS u32x4*)((LAS bf16_t*)(lds + GL_QB) + t * 72 + d0) = pack8(o3);
        *(LAS u32x4*)((LAS bf16_t*)(lds + GL_KB) + t * 72 + d0) = pack8(o4);
    }
    gla_load_vt(PROJ, lds, tok0, h, tid);
    __syncthreads();
    {
        const int dir = w >> 2, tt = w & 3;
        const LAS bf16_t* Qm = (const LAS bf16_t*)(lds + (dir ? GL_QB : GL_QF)); const LAS bf16_t* Km = (const LAS bf16_t*)(lds + (dir ? GL_KB : GL_KF));
        LAS bf16_t* AT = (LAS bf16_t*)(lds + (dir ? GL_AB : GL_AF));
        bf16x8 af[2];
#pragma unroll
        for (int ks = 0; ks < 2; ++ks) af[ks] = *(const LAS bf16x8*)(Qm + (tt * 16 + fr) * 72 + ks * 32 + fq * 8);
#pragma unroll
        for (int st = 0; st < 4; ++st) { f32x4 acc = {0.f, 0.f, 0.f, 0.f};
#pragma unroll
            for (int ks = 0; ks < 2; ++ks) { const bf16x8 bfv = *(const LAS bf16x8*)(Km + (st * 16 + fr) * 72 + ks * 32 + fq * 8); acc = MFMA16(af[ks], bfv, acc); }
#pragma unroll
            for (int j = 0; j < 4; ++j) { const int t = tt * 16 + fq * 4 + j, s = st * 16 + fr; const bool keep = dir ? (s >= t) : (s <= t);
                AT[t * 72 + s] = (bf16_t)f2bf(keep ? acc[j] : 0.f); } }
    }
    __syncthreads();
    {
        const int tt = w & 3, eg = w >> 2;
        LAS float* OS = (LAS float*)(lds + GL_G);
        const LAS bf16_t* VT = (const LAS bf16_t*)(lds + GL_VT);
        bf16x8 a1[2], a2[2], a3[2], a4[2];
#pragma unroll
        for (int ks = 0; ks < 2; ++ks) { const int off = (tt * 16 + fr) * 72 + ks * 32 + fq * 8;
            a1[ks] = *(const LAS bf16x8*)((const LAS bf16_t*)(lds + GL_QF) + off); a2[ks] = *(const LAS bf16x8*)((const LAS bf16_t*)(lds + GL_AF) + off);
            a3[ks] = *(const LAS bf16x8*)((const LAS bf16_t*)(lds + GL_QB) + off); a4[ks] = *(const LAS bf16x8*)((const LAS bf16_t*)(lds + GL_AB) + off); }
        f32x4 accs[4];
#pragma unroll
        for (int q = 0; q < 4; ++q) { const int et = eg * 4 + q; f32x4 acc = {0.f, 0.f, 0.f, 0.f};
#pragma unroll
            for (int ks = 0; ks < 2; ++ks) { const int off = (et * 16 + fr) * 72 + ks * 32 + fq * 8;
                const bf16x8 b1 = *(const LAS bf16x8*)((const LAS bf16_t*)(lds + GL_STF) + off), b2 = *(const LAS bf16x8*)(VT + off), b3 = *(const LAS bf16x8*)((const LAS bf16_t*)(lds + GL_STB) + off);
                acc = MFMA16(a1[ks], b1, acc); acc = MFMA16(a2[ks], b2, acc); acc = MFMA16(a3[ks], b3, acc); acc = MFMA16(a4[ks], b2, acc); }
            accs[q] = acc; }
#pragma unroll
        for (int q = 0; q < 4; ++q)
#pragma unroll
            for (int j = 0; j < 4; ++j) OS[(tt * 16 + fq * 4 + j) * 128 + (eg * 4 + q) * 16 + fr] = accs[q][j];
    }
    __syncthreads();
    {
        const int t = tid >> 3, e0 = (tid & 7) * 16;
        const LAS float* OS = (const LAS float*)(lds + GL_G);
        float o[16]; float ss = 0.f;
#pragma unroll
        for (int e = 0; e < 16; ++e) { o[e] = OS[t * 128 + e0 + e]; ss += o[e] * o[e]; }
        ss += __shfl_xor(ss, 1); ss += __shfl_xor(ss, 2); ss += __shfl_xor(ss, 4);
        const float rstd = rsqrtf(ss * (1.f / 128.f) + EPS);
        const bf16_t* gp = PROJ + (size_t)(tok0 + t) * NPROJ_PAD + C_GA + h * 128 + e0;
        const float* gg = a.in[20 + cx.z] + i * 128 + e0;
        float gt[16]; unpack8(*(const u32x4*)gp, gt); unpack8(*(const u32x4*)(gp + 8), gt + 8);
#pragma unroll
        for (int e = 0; e < 16; ++e) o[e] = o[e] * rstd * gg[e] * silu_f(gt[e]);
        bf16_t* op = MIX + (size_t)(tok0 + t) * D + h * 128 + e0;
        *(u32x4*)op = pack8(o); *(u32x4*)(op + 8) = pack8(o + 8);
    }
}

enum { K_PRO = 0, K_PRE, K_G1, K_A1, K_A2, K_DOWN, K_MID, K_UQKV, K_MLA, K_OUTP, K_POST1, K_FF1, K_FF2, K_POST2 };
constexpr int N_PHASES = 2 + 2 * 8 + 2 * 9;
#ifndef EN_MASK
#define EN_MASK 0xFFFFFFFFu
#endif
#define ENB(k) (((EN_MASK) >> (k)) & 1u)

__global__ void __launch_bounds__(NTHREADS, 2) mega_fwd(Args args) {
    extern __shared__ __attribute__((aligned(16))) unsigned char lds_raw[];
    LAS unsigned char* lds = (LAS unsigned char*)lds_raw;
    const int lo = args.ph_lo, hi = args.ph_hi;
    for (int p = lo; p < hi; ++p) {
        int kind, l;
        if (p == 0) { kind = K_PRO; l = 0; }
        else if (p == 1) { kind = K_PRE; l = 0; }
        else {
            const int q = p - 2, pair = q / 17, r = q - pair * 17;
            if (r < 8) { l = 2 * pair; kind = (r == 0) ? K_G1 : (r == 1) ? K_A1 : (r == 2) ? K_A2 : (r == 3) ? K_OUTP : (r == 4) ? K_POST1 : (r == 5) ? K_FF1 : (r == 6) ? K_FF2 : K_POST2; }
            else { const int r2 = r - 8; l = 2 * pair + 1; kind = (r2 == 0) ? K_DOWN : (r2 == 1) ? K_MID : (r2 == 2) ? K_UQKV : (r2 == 3) ? K_MLA : (r2 == 4) ? K_OUTP : (r2 == 5) ? K_POST1 : (r2 == 6) ? K_FF1 : (r2 == 7) ? K_FF2 : K_POST2; }
        }
        Ctx cx; cx.ws = args.ws; cx.out = args.out; cx.z = 0; cx.tid = threadIdx.x; cx.bid = blockIdx.x; cx.G = gridDim.x;
        asm volatile("" : "+s"(cx.ws), "+s"(cx.out), "+s"(cx.z), "+s"(kind), "+s"(l), "+v"(cx.tid), "+s"(cx.bid), "+s"(cx.G));
        unsigned char* ws = cx.ws;
        const int i = l >> 1, G = cx.G, bid = cx.bid;
        switch (kind) {
        case K_PRO: if (ENB(0)) prologue(args, cx, lds); break;
        case K_PRE: if (ENB(1)) pre_rows(args, cx, 0); break;
        case K_G1: if (ENB(2)) {
            pg8::Gemm g{(const bf16_t*)(ws + WS_H), (const bf16_t*)(ws + WS_WIN) + (size_t)i * NPROJ_PAD * D, T, NPROJ_PAD, D, D, D, NPROJ_PAD / 256, 0};
            pg8::StaticOrder S; S.init(T, NPROJ_PAD, G, bid);
            pg8::EpiProj E{(bf16_t*)(ws + WS_PROJ), cx.out, i};
            pg8::gemm_phase<pg8::EpiProj, pg8::StaticOrder>(lds, g, S, E, cx.tid);
        } break;
        case K_A1:
            for (int u = bid; u < 768; u += G) { if (u < 384) { if (ENB(3)) swa_unit(args, cx, lds, i, u); } else { if (ENB(4)) gla_local_unit(args, cx, lds, i, u - 384); } }
            break;
        case K_A2:
            for (int u = bid; u < 384; u += G) { const int uu = (u < 128) ? (256 + u) : (u - 128); if (ENB(5)) gla_out_unit(args, cx, lds, i, uu); }
            break;
        case K_MID: if (ENB(7)) mla_mid(args, cx, i); break;
        case K_UQKV: if (ENB(8)) {
            for (int s = 0; s < 2; ++s) {
                pg8::Gemm g;
                if (s == 0) g = pg8::Gemm{(const bf16_t*)(ws + WS_CQ), (const bf16_t*)(ws + WS_WUQ) + (size_t)i * 1536 * 384, T, 1536, 384, 384, 384, 6, 0};
                else        g = pg8::Gemm{(const bf16_t*)(ws + WS_CKV), (const bf16_t*)(ws + WS_WUKV) + (size_t)i * 2048 * 256, T + 1024, 2048, 256, 256, 256, 8, 0};
                pg8::StaticOrder S; S.init(g.M, g.N, G, (s == 0 || G != 256) ? bid : ((bid + 144) & 255));
                pg8::EpiBf16<0> E{s == 0 ? (bf16_t*)(ws + WS_Q) : (bf16_t*)(ws + WS_KVX), g.N};
                pg8::gemm_phase<pg8::EpiBf16<0>, pg8::StaticOrder>(lds, g, S, E, cx.tid);
            }
        } break;
        case K_MLA: if (ENB(9)) { for (int u = bid; u < 768; u += G) mla_unit(args, cx, lds, u); } break;
        case K_DOWN: case K_OUTP: case K_FF2: if (ENB(10)) {
            pg8::Gemm g; pg8::EpiF32 E;
            if (kind == K_DOWN) {
                g = pg8::Gemm{(const bf16_t*)(ws + WS_H), (const bf16_t*)(ws + WS_WDOWN) + (size_t)i * NDOWN_PAD * D, T, NDOWN_PAD, D, D, D, NDOWN_PAD / 256, 0};
                E = pg8::EpiF32{(float*)(ws + WS_DOWN), NDOWN_PAD, NDOWN_PAD / 256, 0};
            } else if (kind == K_OUTP) {
                const bf16_t* Wt = (l & 1) ? (const bf16_t*)(ws + WS_WO) + (size_t)i * D * D : (const bf16_t*)(ws + WS_WOUT) + (size_t)i * D * D;
                g = pg8::Gemm{(const bf16_t*)(ws + WS_MIX), Wt, T, 2 * D, D / 2, D, D / 2, 4, D / 2};
                E = pg8::EpiF32{(float*)(ws + WS_OUT), D, 4, OUT_SPLIT};
            } else {
                g = pg8::Gemm{(const bf16_t*)(ws + WS_U), (const bf16_t*)(ws + WS_WFF2) + (size_t)l * FF * D, T, 2 * D, FF / 2, FF, FF / 2, 4, FF / 2};
                E = pg8::EpiF32{(float*)(ws + WS_OUT), D, 4, OUT_SPLIT};
            }
            pg8::StaticOrder S; S.init(g.M, g.N, G, bid);
            pg8::gemm_phase<pg8::EpiF32, pg8::StaticOrder>(lds, g, S, E, cx.tid);
        } break;
        case K_FF1: if (ENB(12)) {
            pg8::Gemm g{(const bf16_t*)(ws + WS_H), (const bf16_t*)(ws + WS_WFF1) + (size_t)l * FF * D, T, FF, D, D, D, FF / 256, 0};
            pg8::StaticOrder S; S.init(T, FF, G, bid);
            pg8::EpiBf16<1> E{(bf16_t*)(ws + WS_U), FF};
            pg8::gemm_phase<pg8::EpiBf16<1>, pg8::StaticOrder>(lds, g, S, E, cx.tid);
        } break;
        case K_POST1: if (ENB(11)) {
            const float* MODL = (const float*)(ws + WS_MOD) + (size_t)l * 3 * 6144; const float* gN = args.in[12 + cx.z] + (size_t)l * 4 * D;
            post_rows(args, cx, l == 0, MODL + 2 * D, gN + D, true, gN + 2 * D, MODL + 3 * D, MODL + 4 * D);
        } break;
        case K_POST2: if (ENB(14)) {
            const float* MODL = (const float*)(ws + WS_MOD) + (size_t)l * 3 * 6144; const float* gN = args.in[12 + cx.z] + (size_t)l * 4 * D;
            const float* MODN = MODL + 3 * 6144; const float* gNn = gN + 4 * D;
            post_rows(args, cx, false, MODL + 5 * D, gN + 3 * D, l < 3, gNn, MODN, MODN + D);
        } break;
        default: break;
        }
        if (p + 1 < hi) cg::this_grid().sync();
    }
}

extern "C" void kernel_launch(void* const* d_in, const int* in_sizes, int n_in, void* d_out, int out_size, void* d_ws, size_t ws_size, hipStream_t stream) {
    static int grid = 0;
    if (grid == 0) {
        int dev = 0, cus = 0, per_cu = 0;
        hipGetDevice(&dev);
        hipDeviceGetAttribute(&cus, hipDeviceAttributeMultiprocessorCount, dev);
        hipFuncSetAttribute((const void*)mega_fwd, hipFuncAttributeMaxDynamicSharedMemorySize, LDS_BYTES);
        hipOccupancyMaxActiveBlocksPerMultiprocessor(&per_cu, (const void*)mega_fwd, NTHREADS, LDS_BYTES);
        if (per_cu < 1) { fprintf(stderr, "kernel_launch: occupancy query says %d blocks per CU\n", per_cu); per_cu = 1; }
        (void)hipGetLastError();
        grid = cus;
        if (ws_size < 256 * MiB) fprintf(stderr, "kernel_launch: workspace too small (%zu)\n", ws_size);
    }
    Args a{};
    for (int i = 0; i < 29; ++i) a.in[i] = (const float*)d_in[i];
    a.out = (float*)d_out; a.ws = (unsigned char*)d_ws;
#if MK_ONE_LAUNCH
    a.ph_lo = 0; a.ph_hi = N_PHASES;
    void* kargs[] = {&a};
    hipError_t e = hipLaunchCooperativeKernel((const void*)mega_fwd, dim3(grid), dim3(NTHREADS), kargs, LDS_BYTES, stream);
    if (e != hipSuccess) fprintf(stderr, "cooperative launch failed: %s (grid %d)\n", hipGetErrorString(e), grid);
#else
    for (int p = 0; p < N_PHASES; ++p) {
        a.ph_lo = p; a.ph_hi = p + 1;
        hipLaunchKernelGGL(mega_fwd, dim3(grid), dim3(NTHREADS), LDS_BYTES, stream, a);
    }
#endif
}
```

```cpp
#include <hip/hip_runtime.h>
#include <hip/hip_cooperative_groups.h>
#include <cstdio>
#include <cstdint>
namespace cg = cooperative_groups;

#ifndef MK_ONE_LAUNCH
#define MK_ONE_LAUNCH 1
#endif

#define LAS __attribute__((address_space(3)))
typedef unsigned short bf16_t;
typedef short bf16x8 __attribute__((ext_vector_type(8)));
typedef float f32x4 __attribute__((ext_vector_type(4)));
typedef float f32x2 __attribute__((ext_vector_type(2)));
typedef unsigned u32x4 __attribute__((ext_vector_type(4)));
typedef unsigned u32x2 __attribute__((ext_vector_type(2)));

constexpr int D = 1024, TP = 4096, TS = 2048, T = TP + TS, FF = 4096;
constexpr int NPROJ = 2336, NPROJ_PAD = 2560, NDOWN = 672, NDOWN_PAD = 768;
constexpr int C_QA = 0, C_KA = 256, C_VA = 512, C_GA = 1024, C_LO = 1536, C_QB = 1568, C_KB = 2080, C_VB = 2208;
constexpr float EPS = 1e-6f;
constexpr int NTHREADS = 512, NWAVES = 8;
constexpr int LDS_BYTES = 147456;

constexpr size_t O_X = 0, O_SF = 6291456, O_SB = 7340032, O_CK = 8388608, O_CV = 9437184, O_CKV = 10485760, O_CKR = 12582912;

constexpr size_t MiB = 1u << 20;
constexpr size_t WS_WFF1 = 0, WS_WFF2 = 32 * MiB, WS_WIN = 64 * MiB, WS_WOUT = 74 * MiB, WS_WDOWN = 78 * MiB, WS_WUQ = 81 * MiB,
                 WS_WUKV = 84 * MiB, WS_WO = 86 * MiB, WS_MOD = 90 * MiB, WS_TAB = 91 * MiB, WS_CSK = 92 * MiB, WS_CSV = 93 * MiB,
                 WS_H = 94 * MiB, WS_MIX = 106 * MiB, WS_OUT = 118 * MiB, WS_U = 166 * MiB, WS_PROJ = 214 * MiB, WS_CTL = 250 * MiB;
constexpr size_t CTL_BYTES = 16384;
constexpr size_t WS_LOC = WS_U, WS_DEC = WS_U + 24 * MiB;
constexpr size_t WS_Q = WS_U, WS_KVX = WS_U + 18 * MiB;
constexpr size_t WS_DOWN = WS_PROJ, WS_CQ = WS_PROJ + 18 * MiB, WS_CKV = WS_PROJ + 23 * MiB, WS_KR = WS_PROJ + 27 * MiB;
constexpr size_t OUT_SPLIT = (size_t)T * D;

__device__ __forceinline__ unsigned f2bf(float f) { unsigned u = __builtin_bit_cast(unsigned, f); return (u + 0x7fffu + ((u >> 16) & 1u)) >> 16; }
__device__ __forceinline__ unsigned pk2(float lo, float hi) { return f2bf(lo) | (f2bf(hi) << 16); }
__device__ __forceinline__ float bf2f(unsigned short b) { return __builtin_bit_cast(float, (unsigned)b << 16); }
__device__ __forceinline__ float bflo(unsigned w) { return __builtin_bit_cast(float, w << 16); }
__device__ __forceinline__ float bfhi(unsigned w) { return __builtin_bit_cast(float, w & 0xffff0000u); }
__device__ __forceinline__ void unpack8(const u32x4 v, float* f) {
    f[0] = bflo(v.x); f[1] = bfhi(v.x); f[2] = bflo(v.y); f[3] = bfhi(v.y); f[4] = bflo(v.z); f[5] = bfhi(v.z); f[6] = bflo(v.w); f[7] = bfhi(v.w);
}
__device__ __forceinline__ u32x4 pack8(const float* f) { u32x4 o; o.x = pk2(f[0], f[1]); o.y = pk2(f[2], f[3]); o.z = pk2(f[4], f[5]); o.w = pk2(f[6], f[7]); return o; }
__device__ __forceinline__ float wave_sum(float v) {
#pragma unroll
    for (int o = 1; o < 64; o <<= 1) v += __shfl_xor(v, o);
    return v;
}
__device__ __forceinline__ float silu_f(float x) { return x / (1.f + __expf(-x)); }

namespace pg8 {
constexpr int BM = 256, BK = 64, HALF = 128, HTB = HALF * BK * 2, NXCD = 8, WGM = 8;
__host__ __device__ __forceinline__ int lds_byte(int r, int c) { const int st = (r >> 4) * 2 + (c >> 5), rr = r & 15, cc = c & 31, ob = rr * 64 + cc * 2; return st * 1024 + (ob ^ (((ob >> 9) & 1) << 5)); }
__host__ __device__ __forceinline__ void stage_rc(int b, int& R, int& C) { const int st = b / 1024, sb = b % 1024, swz = sb ^ (((sb >> 9) & 1) << 5); R = (st >> 1) * 16 + swz / 64; C = (st & 1) * 32 + (swz % 64) / 2; }
__host__ __device__ __forceinline__ int perm32(int rho) { const int n = rho >> 4, i = rho & 15; return 8 * (i >> 2) + 4 * n + (i & 3); }

struct Unit { int pm, pn; };
struct Gemm { const bf16_t* A; const bf16_t* Bt; int M, N, K, lda, ldb, npn, a_split; };

struct StaticOrder {
    int nM, nN, nwg, G, c;
    __device__ void init(int M, int N, int G_, int c_) { nM = M / BM; nN = N / BM; nwg = nM * nN; G = G_; c = c_; }
    __device__ bool next(int i, Unit& u) const {
        const long L = (long)i * G + c; if (L >= nwg) return false;
        int wgid = (int)L; { const int q = nwg / NXCD, r = nwg % NXCD, xcd = wgid % NXCD, off = wgid / NXCD; wgid = (xcd < r ? xcd * (q + 1) : r * (q + 1) + (xcd - r) * q) + off; }
        const int nig = WGM * nN, gid = wgid / nig, fm = gid * WGM, gsz = (nM - fm) < WGM ? (nM - fm) : WGM;
        u.pm = fm + ((wgid % nig) % gsz); u.pn = (wgid % nig) / gsz; return true;
    }
};

__device__ __forceinline__ unsigned cvt_pk_bf16(float lo, float hi) { unsigned r; asm volatile("v_cvt_pk_bf16_f32 %0, %1, %2" : "=v"(r) : "v"(lo), "v"(hi)); return r; }

template <int ACT  > struct EpiBf16 {
    static constexpr bool PERM = true;
    bf16_t* O; int ldc;
    __device__ __forceinline__ void operator()(const f32x4 (&acc)[2][2][4][2], const Unit& u, int wr, int wc, int fr, int fq) const {
        const int row0 = u.pm * BM + wr * 64 + fr, col0 = u.pn * BM + wc * 32 + 8 * fq;
#pragma unroll
        for (int ai = 0; ai < 2; ++ai)
#pragma unroll
            for (int m = 0; m < 4; ++m) { bf16_t* rowp = O + (size_t)(row0 + ai * HALF + m * 16) * ldc + col0;
#pragma unroll
                for (int bj = 0; bj < 2; ++bj) { f32x4 v0 = acc[ai][bj][m][0], v1 = acc[ai][bj][m][1];
                    if (ACT == 1) {
#pragma unroll
                        for (int j = 0; j < 4; ++j) { float a = fmaxf(v0[j], 0.f), b = fmaxf(v1[j], 0.f); v0[j] = a * a; v1[j] = b * b; } }
                    u32x4 w; w.x = cvt_pk_bf16(v0[0], v0[1]); w.y = cvt_pk_bf16(v0[2], v0[3]); w.z = cvt_pk_bf16(v1[0], v1[1]); w.w = cvt_pk_bf16(v1[2], v1[3]);
                    *(u32x4*)(rowp + bj * HALF) = w; } }
    }
};
struct EpiProj {
    static constexpr bool PERM = true;
    bf16_t* O; float* outp; int li;
    __device__ __forceinline__ void operator()(const f32x4 (&acc)[2][2][4][2], const Unit& u, int wr, int wc, int fr, int fq) const {
        const int row0 = u.pm * BM + wr * 64 + fr, col0 = u.pn * BM + wc * 32 + 8 * fq;
#pragma unroll
        for (int ai = 0; ai < 2; ++ai)
#pragma unroll
            for (int m = 0; m < 4; ++m) { const int row = row0 + ai * HALF + m * 16; bf16_t* rowp = O + (size_t)row * NPROJ_PAD + col0;
#pragma unroll
                for (int bj = 0; bj < 2; ++bj) { const f32x4 v0 = acc[ai][bj][m][0], v1 = acc[ai][bj][m][1];
                    u32x4 w; w.x = cvt_pk_bf16(v0[0], v0[1]); w.y = cvt_pk_bf16(v0[2], v0[3]); w.z = cvt_pk_bf16(v1[0], v1[1]); w.w = cvt_pk_bf16(v1[2], v1[3]);
                    *(u32x4*)(rowp + bj * HALF) = w;
                    const int col = col0 + bj * HALF;
                    if (row < TP && col >= C_KB && col < NPROJ) {
                        const int b = row >> 8, t = row & 255;
                        float* dst = outp + ((col < C_VB) ? (O_CK - C_KB) : (O_CV - C_VB)) + ((size_t)((b * 2 + li) * 256 + t)) * 128 + col;
                        *(f32x4*)dst = v0; *(f32x4*)(dst + 4) = v1; } } }
    }
};
struct EpiF32 {
    static constexpr bool PERM = true;
    float* O; int ldc; int npn; size_t split_stride;
    __device__ __forceinline__ void operator()(const f32x4 (&acc)[2][2][4][2], const Unit& u, int wr, int wc, int fr, int fq) const {
        const int s = u.pn / npn, pn = u.pn - s * npn;
        float* base = O + (size_t)s * split_stride;
        const int row0 = u.pm * BM + wr * 64 + fr, col0 = pn * BM + wc * 32 + 8 * fq;
#pragma unroll
        for (int ai = 0; ai < 2; ++ai)
#pragma unroll
            for (int m = 0; m < 4; ++m) { float* rowp = base + (size_t)(row0 + ai * HALF + m * 16) * ldc + col0;
#pragma unroll
                for (int bj = 0; bj < 2; ++bj) { *(f32x4*)(rowp + bj * HALF) = acc[ai][bj][m][0]; *(f32x4*)(rowp + bj * HALF + 4) = acc[ai][bj][m][1]; } }
    }
};

template <class Epi, class Sched>
__device__ __forceinline__ void gemm_phase(LAS unsigned char* lds, const Gemm g, const Sched& S, const Epi& E, const int tid) {
    const int wid = __builtin_amdgcn_readfirstlane(tid >> 6), lane = tid & 63, wr = wid >> 2, wc = wid & 3, fr = lane & 15, fq = lane >> 4;
    const int K = g.K, nt = K / BK;
    unsigned voffA[2], voffB[2];
#pragma unroll
    for (int i = 0; i < 2; ++i) { int R, C; stage_rc(tid * 16 + i * 8192, R, C); const int Rb = Epi::PERM ? ((R & ~31) + perm32(R & 31)) : R;
        voffA[i] = (unsigned)(R * g.lda + C) * 2u; voffB[i] = (unsigned)(Rb * g.ldb + C) * 2u; }
    const size_t kstep = (size_t)(BK * 2);
    const size_t hstepA = (size_t)HALF * g.lda * 2, hstepB = (size_t)HALF * g.ldb * 2;
    const size_t tstepA = 2 * hstepA, tstepB = 2 * hstepB;
    const unsigned ldsw = (unsigned)wid * 1024u;
    const int aoff = lds_byte(wr * 64 + fr, fq * 8), boff = lds_byte(wc * 32 + fr, fq * 8);
#define PG8_SA(b, h) (((b) * 2 + (h)) * HTB)
#define PG8_SB(b, h) ((4 + (b) * 2 + (h)) * HTB)
#define PG8_STAGE(bufoff, gbase, voff) do { _Pragma("unroll") for (int _i = 0; _i < 2; ++_i) \
        __builtin_amdgcn_global_load_lds((const unsigned*)((const char*)(gbase) + (voff)[_i]), (LAS unsigned*)(lds + (bufoff) + ldsw + _i * 8192), 16, 0, 0); } while (0)
#define PG8_LDA(dst, b, h) do { _Pragma("unroll") for (int m = 0; m < 4; ++m) _Pragma("unroll") for (int k = 0; k < 2; ++k) dst[m][k] = *(const LAS bf16x8*)(lds + PG8_SA(b, h) + aoff + m * 2048 + k * 1024); } while (0)
#define PG8_LDB(dst, b, h) do { _Pragma("unroll") for (int n = 0; n < 2; ++n) _Pragma("unroll") for (int k = 0; k < 2; ++k) dst[n][k] = *(const LAS bf16x8*)(lds + PG8_SB(b, h) + boff + n * 2048 + k * 1024); } while (0)
#define PG8_MMA(ai, bj, At, Bt) do { __builtin_amdgcn_s_setprio(1); _Pragma("unroll") for (int m = 0; m < 4; ++m) _Pragma("unroll") for (int n = 0; n < 2; ++n) _Pragma("unroll") for (int k = 0; k < 2; ++k) \
        acc[ai][bj][m][n] = __builtin_amdgcn_mfma_f32_16x16x32_bf16(Bt[n][k], At[m][k], acc[ai][bj][m][n], 0, 0, 0); __builtin_amdgcn_s_setprio(0); } while (0)
#define PG8_WAIT_V(n) asm volatile("s_waitcnt vmcnt(" #n ")" ::: "memory")
#define PG8_WAIT_L(n) asm volatile("s_waitcnt lgkmcnt(" #n ")" ::: "memory")
#define PG8_BAR __builtin_amdgcn_s_barrier()
#define PG8_SCHED __builtin_amdgcn_sched_barrier(0)
#define PG8_UA(u) ((const char*)g.A + (size_t)(u).pm * tstepA + (size_t)((u).pn / g.npn) * (size_t)g.a_split * 2)
#define PG8_UB(u) ((const char*)g.Bt + (size_t)(u).pn * tstepB)
    Unit cur, nxt; int ui = 0;
    if (!S.next(0, cur)) return;
    f32x4 acc[2][2][4][2];
#pragma unroll
    for (int a = 0; a < 2; ++a)
#pragma unroll
        for (int b = 0; b < 2; ++b)
#pragma unroll
            for (int m = 0; m < 4; ++m)
#pragma unroll
                for (int n = 0; n < 2; ++n) acc[a][b][m][n] = (f32x4){0.f, 0.f, 0.f, 0.f};
    bf16x8 At[4][2], B0[2][2], B1[2][2];
    const char* cA = PG8_UA(cur); const char* cB = PG8_UB(cur);
    PG8_STAGE(PG8_SB(0, 0), cB, voffB); PG8_STAGE(PG8_SB(0, 1), cB + hstepB, voffB); PG8_STAGE(PG8_SA(0, 0), cA, voffA); PG8_STAGE(PG8_SA(0, 1), cA + hstepA, voffA);
    if (wr == 1) PG8_BAR;
    PG8_WAIT_V(2); PG8_BAR;
    PG8_STAGE(PG8_SB(1, 0), cB + kstep, voffB); PG8_STAGE(PG8_SA(1, 0), cA + kstep, voffA); PG8_STAGE(PG8_SB(1, 1), cB + hstepB + kstep, voffB);
    PG8_WAIT_V(6); PG8_BAR;
    for (;;) {
        const bool has_next = S.next(ui + 1, nxt);
        const char* nA = has_next ? PG8_UA(nxt) : cA; const char* nB = has_next ? PG8_UB(nxt) : cB;
        for (int t = 0; t < nt; t += 2) {
            const bool last = (t == nt - 2);
            const char* a1 = cA + (size_t)(t + 1) * kstep;
            const char* a2 = last ? nA : cA + (size_t)(t + 2) * kstep; const char* b2 = last ? nB : cB + (size_t)(t + 2) * kstep;
            const char* a3 = a2 + kstep; const char* b3 = b2 + kstep;
            PG8_LDB(B0, 0, 0); PG8_LDB(B1, 0, 1); PG8_SCHED; PG8_LDA(At, 0, 0); PG8_STAGE(PG8_SA(1, 1), a1 + hstepA, voffA);
            PG8_WAIT_V(8); PG8_WAIT_L(0); PG8_BAR; PG8_MMA(0, 0, At, B0); PG8_MMA(0, 1, At, B1); PG8_BAR; PG8_SCHED;
            PG8_LDA(At, 0, 1); PG8_STAGE(PG8_SB(0, 0), b2, voffB); PG8_STAGE(PG8_SB(0, 1), b2 + hstepB, voffB); PG8_STAGE(PG8_SA(0, 0), a2, voffA);
            PG8_WAIT_V(8); PG8_WAIT_L(0); PG8_BAR; PG8_MMA(1, 0, At, B0); PG8_MMA(1, 1, At, B1); PG8_BAR; PG8_SCHED;
            PG8_LDB(B0, 1, 0); PG8_LDB(B1, 1, 1); PG8_SCHED; PG8_LDA(At, 1, 0); PG8_STAGE(PG8_SA(0, 1), a2 + hstepA, voffA);
            PG8_WAIT_V(8); PG8_WAIT_L(0); PG8_BAR; PG8_MMA(0, 0, At, B0); PG8_MMA(0, 1, At, B1); PG8_BAR; PG8_SCHED;
            PG8_LDA(At, 1, 1); PG8_STAGE(PG8_SB(1, 0), b3, voffB); PG8_STAGE(PG8_SB(1, 1), b3 + hstepB, voffB); PG8_STAGE(PG8_SA(1, 0), a3, voffA);
            PG8_WAIT_V(8); PG8_WAIT_L(0); PG8_BAR; PG8_MMA(1, 0, At, B0); PG8_MMA(1, 1, At, B1); PG8_BAR; PG8_SCHED;
        }
        if (wr == 0) PG8_BAR;
        E(acc, cur, wr, wc, fr, fq);
        if (!has_next) break;
#pragma unroll
        for (int a = 0; a < 2; ++a)
#pragma unroll
            for (int b = 0; b < 2; ++b)
#pragma unroll
                for (int m = 0; m < 4; ++m)
#pragma unroll
                    for (int n = 0; n < 2; ++n) acc[a][b][m][n] = (f32x4){0.f, 0.f, 0.f, 0.f};
        cur = nxt; cA = nA; cB = nB; ++ui;
        if (wr == 1) PG8_BAR;
    }
    PG8_WAIT_V(0);
    PG8_BAR;
#undef PG8_SA
#undef PG8_SB
#undef PG8_STAGE
#undef PG8_LDA
#undef PG8_LDB
#undef PG8_MMA
#undef PG8_WAIT_V
#undef PG8_WAIT_L
#undef PG8_BAR
#undef PG8_SCHED
#undef PG8_UA
#undef PG8_UB
}
}

struct Args { const float* in[29]; float* out; unsigned char* ws; int ph_lo, ph_hi; };
struct Ctx { unsigned char* ws; float* out; int z, tid, bid, G; };

#define MFMA16(a, b, c) __builtin_amdgcn_mfma_f32_16x16x32_bf16((a), (b), (c), 0, 0, 0)

__device__ __forceinline__ void transpose_item(const float* W, int K, int N, bf16_t* WT, int npad, int ksub, LAS float* scr, int item, int lane) {
    const int nblk = N / 32, kb = item / nblk, nb = item % nblk, k0 = 64 * kb, n0 = 32 * nb;
#pragma unroll 8
    for (int i = 0; i < 32; ++i) { const int kk = 2 * i + (lane >> 5); scr[kk * 33 + (lane & 31)] = W[(size_t)(k0 + kk) * N + n0 + (lane & 31)]; }
    asm volatile("s_waitcnt lgkmcnt(0)" ::: "memory");
    const int c = lane & 7;
    const int ks = k0 / ksub, kin = k0 - ks * ksub;
    bf16_t* dbase = WT + (size_t)ks * npad * ksub + kin + 8 * c;
#pragma unroll
    for (int j = 0; j < 4; ++j) { const int n = (lane >> 3) + 8 * j; const LAS float* s = scr + (8 * c) * 33 + n;
        u32x4 o; o.x = pk2(s[0 * 33], s[1 * 33]); o.y = pk2(s[2 * 33], s[3 * 33]); o.z = pk2(s[4 * 33], s[5 * 33]); o.w = pk2(s[6 * 33], s[7 * 33]);
        *(u32x4*)(dbase + (size_t)(n0 + n) * ksub) = o; }
    asm volatile("s_waitcnt lgkmcnt(0)" ::: "memory");
}

struct MatDesc { const float* W; bf16_t* WT; int K, N, npad, ksub, items; };
__device__ __forceinline__ MatDesc get_mat(const Args& a, const Ctx& cx, int mi) {
    MatDesc m; unsigned char* ws = cx.ws;
    if (mi < 4)       { m.W = a.in[13 + cx.z] + (size_t)mi * D * FF; m.WT = (bf16_t*)(ws + WS_WFF1) + (size_t)mi * FF * D; m.K = D; m.N = FF; m.npad = FF; m.ksub = D; }
    else if (mi < 8)  { const int l = mi - 4; m.W = a.in[14 + cx.z] + (size_t)l * FF * D; m.WT = (bf16_t*)(ws + WS_WFF2) + (size_t)l * FF * D; m.K = FF; m.N = D; m.npad = D; m.ksub = FF / 2; }
    else if (mi < 10) { const int i = mi - 8; m.W = a.in[15 + cx.z] + (size_t)i * D * NPROJ; m.WT = (bf16_t*)(ws + WS_WIN) + (size_t)i * NPROJ_PAD * D; m.K = D; m.N = NPROJ; m.npad = NPROJ_PAD; m.ksub = D; }
    else if (mi < 12) { const int i = mi - 10; m.W = a.in[22 + cx.z] + (size_t)i * D * D; m.WT = (bf16_t*)(ws + WS_WOUT) + (size_t)i * D * D; m.K = D; m.N = D; m.npad = D; m.ksub = D / 2; }
    else if (mi < 14) { const int i = mi - 12; m.W = a.in[23 + cx.z] + (size_t)i * D * NDOWN; m.WT = (bf16_t*)(ws + WS_WDOWN) + (size_t)i * NDOWN_PAD * D; m.K = D; m.N = NDOWN; m.npad = NDOWN_PAD; m.ksub = D; }
    else if (mi < 16) { const int i = mi - 14; m.W = a.in[26 + cx.z] + (size_t)i * 384 * 1536; m.WT = (bf16_t*)(ws + WS_WUQ) + (size_t)i * 1536 * 384; m.K = 384; m.N = 1536; m.npad = 1536; m.ksub = 384; }
    else if (mi < 18) { const int i = mi - 16; m.W = a.in[27 + cx.z] + (size_t)i * 256 * 2048; m.WT = (bf16_t*)(ws + WS_WUKV) + (size_t)i * 2048 * 256; m.K = 256; m.N = 2048; m.npad = 2048; m.ksub = 256; }
    else              { const int i = mi - 18; m.W = a.in[28 + cx.z] + (size_t)i * D * D; m.WT = (bf16_t*)(ws + WS_WO) + (size_t)i * D * D; m.K = D; m.N = D; m.npad = D; m.ksub = D / 2; }
    m.items = (m.K / 64) * (m.N / 32);
    return m;
}

__device__ __forceinline__ void prologue(const Args& a, const Ctx& cx, LAS unsigned char* lds) {
    const int tid = cx.tid, lane = tid & 63, wave = tid >> 6, G = cx.G, bid = cx.bid;
    unsigned char* ws = cx.ws;
    {
        LAS float* sc = (LAS float*)lds;
        LAS float* red = (LAS float*)(lds + 12288);
        for (int i = tid; i < 3 * D; i += NTHREADS) { const int g = i >> 10, k = i & 1023; const float v = (g == 0) ? a.in[9 + cx.z][k] : a.in[8 + cx.z][(g - 1) * D + k]; sc[i] = silu_f(v); }
        __syncthreads();
        float* MOD = (float*)(ws + WS_MOD);
        for (int it = bid; it < 4 * 48; it += G) {
            const int l = it / 48, jb = it % 48, jq = tid & 31, kg = tid >> 5, j = jb * 128 + jq * 4;
            const float* wp = a.in[10 + cx.z] + ((size_t)l * D + kg * 64) * 6144 + j;
            f32x4 a0 = {0.f, 0.f, 0.f, 0.f}, a1 = a0, a2 = a0;
#pragma unroll 8
            for (int k = 0; k < 64; ++k) { const f32x4 w = *(const f32x4*)(wp + (size_t)k * 6144); const int kk = kg * 64 + k;
                a0 += w * sc[kk]; a1 += w * sc[D + kk]; a2 += w * sc[2 * D + kk]; }
#pragma unroll
            for (int e = 0; e < 4; ++e) { red[(kg * 3 + 0) * 128 + jq * 4 + e] = a0[e]; red[(kg * 3 + 1) * 128 + jq * 4 + e] = a1[e]; red[(kg * 3 + 2) * 128 + jq * 4 + e] = a2[e]; }
            __syncthreads();
            if (tid < 384) { const int g = tid >> 7, jj = tid & 127; float s = 0.f;
#pragma unroll
                for (int q = 0; q < 16; ++q) s += red[(q * 3 + g) * 128 + jj];
                MOD[((size_t)l * 3 + g) * 6144 + jb * 128 + jj] = s + a.in[11 + cx.z][(size_t)l * 6144 + jb * 128 + jj]; }
            __syncthreads();
        }
    }
    __syncthreads();
    {
        LAS float* scr = (LAS float*)(lds + wave * 16384);
        const int gw = bid * NWAVES + wave, NGW = G * NWAVES;
        int base = 0;
        for (int mi = 0; mi < 20; ++mi) {
            const MatDesc m = get_mat(a, cx, mi);
            int first = (gw - base) % NGW; if (first < 0) first += NGW;
            for (int it = first; it < m.items; it += NGW) transpose_item(m.W, m.K, m.N, m.WT, m.npad, m.ksub, scr, it, lane);
            base += m.items;
        }
    }
    {
        const size_t gt = (size_t)bid * NTHREADS + tid, NGT = (size_t)G * NTHREADS;
        for (int i = 0; i < 2; ++i) {
            u32x4* z1 = (u32x4*)((bf16_t*)(ws + WS_WIN) + (size_t)i * NPROJ_PAD * D + (size_t)NPROJ * D);
            for (size_t x = gt; x < (size_t)(NPROJ_PAD - NPROJ) * D / 8; x += NGT) z1[x] = (u32x4){0u, 0u, 0u, 0u};
            u32x4* z2 = (u32x4*)((bf16_t*)(ws + WS_WDOWN) + (size_t)i * NDOWN_PAD * D + (size_t)NDOWN * D);
            for (size_t x = gt; x < (size_t)(NDOWN_PAD - NDOWN) * D / 8; x += NGT) z2[x] = (u32x4){0u, 0u, 0u, 0u};
        }
        f32x2* tab64 = (f32x2*)(ws + WS_TAB); f32x2* tab32 = tab64 + 64 * 16;
        for (size_t x = gt; x < 64 * 16; x += NGT) { const int pos = (int)x >> 4, f = (int)x & 15; const float inv = powf(10000.f, -(float)f / 16.f); const float ang = (float)pos * inv; tab64[x] = (f32x2){cosf(ang), sinf(ang)}; }
        for (size_t x = gt; x < 64 * 8; x += NGT) { const int pos = (int)x >> 3, f = (int)x & 7; const float inv = powf(10000.f, -(float)f / 8.f); const float ang = (float)pos * inv; tab32[x] = (f32x2){cosf(ang), sinf(ang)}; }
        bf16_t* csk = (bf16_t*)(ws + WS_CSK); bf16_t* csv = (bf16_t*)(ws + WS_CSV);
        for (size_t x = gt; x < (size_t)2 * 2 * 512 * 128 / 4; x += NGT) {
            const size_t e = x * 4; const int b = (int)(e / (2 * 65536)), i = (int)(e / 65536) & 1; const size_t r = e % 65536;
            const size_t d = ((size_t)(i * 2 + b)) * 65536 + r;
            const f32x4 k = *(const f32x4*)(a.in[4 + cx.z] + e), v = *(const f32x4*)(a.in[5 + cx.z] + e);
            *(u32x2*)(csk + d) = (u32x2){pk2(k[0], k[1]), pk2(k[2], k[3])};
            *(u32x2*)(csv + d) = (u32x2){pk2(v[0], v[1]), pk2(v[2], v[3])};
        }
    }
}

__device__ __forceinline__ int mod_group(int r) { return r < TP ? 0 : 1 + ((r - TP) >> 10); }

__device__ __forceinline__ void pre_rows(const Args& a, const Ctx& cx, int l) {
    const int lane = cx.tid & 63, gw = cx.bid * NWAVES + (cx.tid >> 6), NGW = cx.G * NWAVES;
    const float* MOD = (const float*)(cx.ws + WS_MOD) + (size_t)l * 3 * 6144;
    const float* gA = a.in[12 + cx.z] + (size_t)l * 4 * D;
    bf16_t* H = (bf16_t*)(cx.ws + WS_H);
    for (int r = gw; r < T; r += NGW) {
        const float* xr = (r < TP) ? a.in[0 + cx.z] + (size_t)r * D : a.in[1 + cx.z] + (size_t)(r - TP) * D;
        const float* m = MOD + (size_t)mod_group(r) * 6144;
        f32x4 v[4]; float s = 0.f;
#pragma unroll
        for (int j = 0; j < 4; ++j) { v[j] = *(const f32x4*)(xr + lane * 4 + 256 * j); s += v[j][0] * v[j][0] + v[j][1] * v[j][1] + v[j][2] * v[j][2] + v[j][3] * v[j][3]; }
        const float rstd = rsqrtf(wave_sum(s) * (1.f / D) + EPS);
#pragma unroll
        for (int j = 0; j < 4; ++j) { const int c = lane * 4 + 256 * j;
            const f32x4 g = *(const f32x4*)(gA + c), sh = *(const f32x4*)(m + c), scl = *(const f32x4*)(m + D + c);
            const f32x4 h = v[j] * rstd * g * (scl + 1.f) + sh;
            *(u32x2*)(H + (size_t)r * D + c) = (u32x2){pk2(h[0], h[1]), pk2(h[2], h[3])}; }
    }
}

__device__ __forceinline__ void post_rows(const Args& a, const Ctx& cx, bool x_from_input, const float* gate_base  , const float* gB,
                                          bool has_next, const float* gC, const float* shift_base, const float* scale_base) {
    const int lane = cx.tid & 63, gw = cx.bid * NWAVES + (cx.tid >> 6), NGW = cx.G * NWAVES;
    const float* OUT = (const float*)(cx.ws + WS_OUT);
    bf16_t* H = (bf16_t*)(cx.ws + WS_H);
    for (int r = gw; r < T; r += NGW) {
        const float* xr = x_from_input ? ((r < TP) ? a.in[0 + cx.z] + (size_t)r * D : a.in[1 + cx.z] + (size_t)(r - TP) * D) : cx.out + (size_t)r * D;
        const size_t mg = (size_t)mod_group(r) * 6144;
        f32x4 o[4], x[4]; float s = 0.f;
#pragma unroll
        for (int j = 0; j < 4; ++j) { const int c = lane * 4 + 256 * j;
            o[j] = *(const f32x4*)(OUT + (size_t)r * D + c) + *(const f32x4*)(OUT + OUT_SPLIT + (size_t)r * D + c);
            x[j] = *(const f32x4*)(xr + c);
            s += o[j][0] * o[j][0] + o[j][1] * o[j][1] + o[j][2] * o[j][2] + o[j][3] * o[j][3]; }
        const float rstd = rsqrtf(wave_sum(s) * (1.f / D) + EPS);
        float s2 = 0.f;
#pragma unroll
        for (int j = 0; j < 4; ++j) { const int c = lane * 4 + 256 * j;
            const f32x4 g = *(const f32x4*)(gB + c), gt = *(const f32x4*)(gate_base + mg + c);
            x[j] = x[j] + gt * (o[j] * rstd * g);
            *(f32x4*)(cx.out + (size_t)r * D + c) = x[j];
            s2 += x[j][0] * x[j][0] + x[j][1] * x[j][1] + x[j][2] * x[j][2] + x[j][3] * x[j][3]; }
        if (has_next) {
            const float rstd2 = rsqrtf(wave_sum(s2) * (1.f / D) + EPS);
#pragma unroll
            for (int j = 0; j < 4; ++j) { const int c = lane * 4 + 256 * j;
                const f32x4 g = *(const f32x4*)(gC + c), sh = *(const f32x4*)(shift_base + mg + c), scl = *(const f32x4*)(scale_base + mg + c);
                const f32x4 h = x[j] * rstd2 * g * (scl + 1.f) + sh;
                *(u32x2*)(H + (size_t)r * D + c) = (u32x2){pk2(h[0], h[1]), pk2(h[2], h[3])}; }
        }
    }
}

__device__ __forceinline__ void mla_mid(const Args& a, const Ctx& cx, int i) {
    const int lane = cx.tid & 63, gw = cx.bid * NWAVES + (cx.tid >> 6), NGW = cx.G * NWAVES;
    const float* DOWN = (const float*)(cx.ws + WS_DOWN);
    bf16_t* CQ = (bf16_t*)(cx.ws + WS_CQ); bf16_t* CKV = (bf16_t*)(cx.ws + WS_CKV); bf16_t* KR = (bf16_t*)(cx.ws + WS_KR);
    const float* gq = a.in[24 + cx.z] + (size_t)i * 384; const float* gkv = a.in[25 + cx.z] + (size_t)i * 256;
    const f32x2* tab32 = (const f32x2*)(cx.ws + WS_TAB) + 64 * 16;
    for (int r = gw; r < T + 1024; r += NGW) {
        if (r < T) {
            const float* dr = DOWN + (size_t)r * NDOWN_PAD;
            float q[6]; float s = 0.f;
#pragma unroll
            for (int j = 0; j < 6; ++j) { q[j] = dr[lane + 64 * j]; s += q[j] * q[j]; }
            const float rq = rsqrtf(wave_sum(s) * (1.f / 384.f) + EPS);
#pragma unroll
            for (int j = 0; j < 6; ++j) CQ[(size_t)r * 384 + lane + 64 * j] = (bf16_t)f2bf(q[j] * rq * gq[lane + 64 * j]);
            float kv[4]; s = 0.f;
#pragma unroll
            for (int j = 0; j < 4; ++j) { kv[j] = dr[384 + lane + 64 * j]; s += kv[j] * kv[j]; }
            const float rk = rsqrtf(wave_sum(s) * (1.f / 256.f) + EPS);
#pragma unroll
            for (int j = 0; j < 4; ++j) { const float v = kv[j] * rk * gkv[lane + 64 * j]; CKV[(size_t)r * 256 + lane + 64 * j] = (bf16_t)f2bf(v);
                if (r < TP) { const int b = r >> 8, t = r & 255; cx.out[O_CKV + ((size_t)((b * 2 + i) * 256 + t)) * 256 + lane + 64 * j] = v; } }
            if (lane < 32) {
                const float kr = dr[640 + lane];
                if (r < TP) { const int b = r >> 8, t = r & 255; cx.out[O_CKR + ((size_t)((b * 2 + i) * 256 + t)) * 32 + lane] = kr; KR[(size_t)r * 32 + lane] = (bf16_t)f2bf(kr); }
                else {
                    const int t = (r - TP) & 1023, half = lane >> 4, p = (lane >> 3) & 1, f = lane & 7, pos = half ? (t & 63) : (t >> 6);
                    const float other = dr[640 + (lane ^ 8)];
                    const f32x2 cs = tab32[pos * 8 + f];
                    const float v = p ? (other * cs[1] + kr * cs[0]) : (kr * cs[0] - other * cs[1]);
                    KR[(size_t)r * 32 + lane] = (bf16_t)f2bf(v);
                }
            }
        } else {
            const int rr = r - T, b = rr >> 9, j = rr & 511;
            const float* src = a.in[6 + cx.z] + ((size_t)((b * 2 + i) * 512 + j)) * 256;
#pragma unroll
            for (int q = 0; q < 4; ++q) CKV[(size_t)r * 256 + lane + 64 * q] = (bf16_t)f2bf(src[lane + 64 * q]);
            if (lane < 32) KR[(size_t)r * 32 + lane] = (bf16_t)f2bf(a.in[7 + cx.z][((size_t)((b * 2 + i) * 512 + j)) * 32 + lane]);
        }
    }
}

struct KSeg { const bf16_t* K; int kstride; const bf16_t* K2; int k2stride; const bf16_t* V; int vstride; int k_lo, k_hi; int rope; int mask; };
struct AttnArgs { const bf16_t* Q; int qstride; int qpos0; int qrope  ; int nseg; KSeg seg0, seg1;
                  float m0, l0, scale; bf16_t* O; int ostride; const f32x2* tab64; const f32x2* tab32; };

__device__ __forceinline__ u32x4 rope8(const u32x4 own, const u32x4 partner, int p, const f32x2* tab) {
    float a[8], b[8], o[8]; unpack8(own, a); unpack8(partner, b);
#pragma unroll
    for (int e = 0; e < 8; ++e) { const f32x2 cs = tab[e]; o[e] = p ? (b[e] * cs[1] + a[e] * cs[0]) : (a[e] * cs[0] - b[e] * cs[1]); }
    return pack8(o);
}

template <int DQK>
__device__ __forceinline__ void attn_unit(LAS unsigned char* lds, const AttnArgs& A, const int tid) {
    constexpr int QS = DQK + 8, NCH = DQK / 8, NKS = DQK / 32;
    LAS bf16_t* Qs = (LAS bf16_t*)lds;
    LAS bf16_t* Ks = Qs + 128 * QS;
    LAS bf16_t* VT = Ks + 64 * QS;
    const int lane = tid & 63, w = tid >> 6, fr = lane & 15, fq = lane >> 4;
    __syncthreads();
    for (int c = tid; c < 128 * NCH; c += NTHREADS) {
        const int qi = c / NCH, ch = c % NCH, d0 = ch * 8;
        const bf16_t* src = A.Q + (size_t)qi * A.qstride;
        u32x4 v = *(const u32x4*)(src + d0);
        const int t = A.qpos0 + qi;
        if (A.qrope == 1) { const int half = ch >> 2, p = (ch >> 1) & 1, f0 = (ch & 1) * 8, pos = half ? (t & 63) : (t >> 6);
            const u32x4 pv = *(const u32x4*)(src + (d0 ^ 16)); v = rope8(v, pv, p, A.tab64 + pos * 16 + f0); }
        else if (A.qrope == 2 && ch >= 8) { const int c2 = ch - 8, half = c2 >> 1, p = c2 & 1, pos = half ? (t & 63) : (t >> 6);
            const u32x4 pv = *(const u32x4*)(src + 64 + ((c2 ^ 1) * 8)); v = rope8(v, pv, p, A.tab32 + pos * 8); }
        *(LAS u32x4*)(Qs + qi * QS + d0) = v;
    }
    __syncthreads();
    bf16x8 Qf[NKS];
#pragma unroll
    for (int ks = 0; ks < NKS; ++ks) Qf[ks] = *(const LAS bf16x8*)(Qs + (w * 16 + fr) * QS + ks * 32 + fq * 8);
    float m = A.m0, l = A.l0;
    f32x4 Oa[4];
#pragma unroll
    for (int dt = 0; dt < 4; ++dt) Oa[dt] = (f32x4){0.f, 0.f, 0.f, 0.f};
    const int qp = A.qpos0 + w * 16 + fr;
    for (int sg = 0; sg < A.nseg; ++sg) {
        const KSeg S = (sg == 0) ? A.seg0 : A.seg1;
        for (int kt = S.k_lo; kt < S.k_hi; kt += 64) {
            __syncthreads();
            for (int c = tid; c < 64 * NCH; c += NTHREADS) {
                const int key = c / NCH, ch = c % NCH, d0 = ch * 8;
                u32x4 v;
                if (DQK == 96 && ch >= 8) v = *(const u32x4*)(S.K2 + (size_t)(kt + key) * S.k2stride + (d0 - 64));
                else {
                    const bf16_t* src = S.K + (size_t)(kt + key) * S.kstride;
                    v = *(const u32x4*)(src + d0);
                    if (S.rope) { const int t = kt + key, half = ch >> 2, p = (ch >> 1) & 1, f0 = (ch & 1) * 8, pos = half ? (t & 63) : (t >> 6);
                        const u32x4 pv = *(const u32x4*)(src + (d0 ^ 16)); v = rope8(v, pv, p, A.tab64 + pos * 16 + f0); }
                }
                *(LAS u32x4*)(Ks + key * QS + d0) = v;
            }
            { const int key = tid >> 3, ch = tid & 7;
              const u32x4 v = *(const u32x4*)(S.V + (size_t)(kt + key) * S.vstride + ch * 8);
              LAS bf16_t* dst = VT + (ch * 8) * 72 + key;
              dst[0 * 72] = (bf16_t)(v.x & 0xffff); dst[1 * 72] = (bf16_t)(v.x >> 16); dst[2 * 72] = (bf16_t)(v.y & 0xffff); dst[3 * 72] = (bf16_t)(v.y >> 16);
              dst[4 * 72] = (bf16_t)(v.z & 0xffff); dst[5 * 72] = (bf16_t)(v.z >> 16); dst[6 * 72] = (bf16_t)(v.w & 0xffff); dst[7 * 72] = (bf16_t)(v.w >> 16); }
            __syncthreads();
            f32x4 st[4];
#pragma unroll
            for (int nt = 0; nt < 4; ++nt) { st[nt] = (f32x4){0.f, 0.f, 0.f, 0.f};
#pragma unroll
                for (int ks = 0; ks < NKS; ++ks) { const bf16x8 kf = *(const LAS bf16x8*)(Ks + (nt * 16 + fr) * QS + ks * 32 + fq * 8); st[nt] = MFMA16(kf, Qf[ks], st[nt]); } }
            float mx = -1e30f;
#pragma unroll
            for (int nt = 0; nt < 4; ++nt)
#pragma unroll
                for (int j = 0; j < 4; ++j) { float s = st[nt][j] * A.scale;
                    if (S.mask) { const int kp = kt + nt * 16 + fq * 4 + j; const int dd = qp - kp; if (dd > 128 || dd < -128) s = -1e30f; }
                    st[nt][j] = s; mx = fmaxf(mx, s); }
            mx = fmaxf(mx, __shfl_xor(mx, 16)); mx = fmaxf(mx, __shfl_xor(mx, 32));
            const float mn = fmaxf(m, mx), alpha = __expf(m - mn);
            float rs = 0.f;
#pragma unroll
            for (int nt = 0; nt < 4; ++nt)
#pragma unroll
                for (int j = 0; j < 4; ++j) { const float p = __expf(st[nt][j] - mn); st[nt][j] = p; rs += p; }
            rs += __shfl_xor(rs, 16); rs += __shfl_xor(rs, 32);
            l = l * alpha + rs; m = mn;
#pragma unroll
            for (int dt = 0; dt < 4; ++dt) Oa[dt] = Oa[dt] * alpha;
#pragma unroll
            for (int kk = 0; kk < 2; ++kk) {
                u32x4 pb; pb.x = pk2(st[2 * kk][0], st[2 * kk][1]); pb.y = pk2(st[2 * kk][2], st[2 * kk][3]); pb.z = pk2(st[2 * kk + 1][0], st[2 * kk + 1][1]); pb.w = pk2(st[2 * kk + 1][2], st[2 * kk + 1][3]);
                const bf16x8 pf = __builtin_bit_cast(bf16x8, pb);
#pragma unroll
                for (int dt = 0; dt < 4; ++dt) {
                    const LAS bf16_t* vp = VT + (dt * 16 + fr) * 72 + 32 * kk + fq * 4;
                    const u32x2 v0 = *(const LAS u32x2*)vp, v1 = *(const LAS u32x2*)(vp + 16);
                    const u32x4 vv = {v0.x, v0.y, v1.x, v1.y};
                    Oa[dt] = MFMA16(__builtin_bit_cast(bf16x8, vv), pf, Oa[dt]);
                }
            }
        }
    }
    const float inv = 1.f / l;
    bf16_t* op = A.O + (size_t)(w * 16 + fr) * A.ostride + fq * 4;
#pragma unroll
    for (int dt = 0; dt < 4; ++dt) *(u32x2*)(op + dt * 16) = (u32x2){pk2(Oa[dt][0] * inv, Oa[dt][1] * inv), pk2(Oa[dt][2] * inv, Oa[dt][3] * inv)};
}

__device__ __forceinline__ void swa_unit(const Args& a, const Ctx& cx, LAS unsigned char* lds, int i, int u) {
    const bf16_t* PROJ = (const bf16_t*)(cx.ws + WS_PROJ); bf16_t* MIX = (bf16_t*)(cx.ws + WS_MIX);
    AttnArgs A;
    A.tab64 = (const f32x2*)(cx.ws + WS_TAB); A.tab32 = A.tab64 + 64 * 16;
    A.qstride = NPROJ_PAD; A.ostride = D; A.scale = 0.125f; A.l0 = 1.f;
    if (u < 128) {
        const int b = u >> 6, hq = (u >> 3) & 7, qt = u & 7, kv = hq >> 2, row0 = TP + b * 1024, q0 = qt * 128;
        A.Q = PROJ + (size_t)(row0 + q0) * NPROJ_PAD + C_QB + hq * 64; A.qpos0 = q0; A.qrope = 1; A.nseg = 2;
        A.m0 = a.in[21 + cx.z][i * 8 + hq];
        const bf16_t* csk = (const bf16_t*)(cx.ws + WS_CSK) + ((size_t)(i * 2 + b)) * 65536 + kv * 64;
        const bf16_t* csv = (const bf16_t*)(cx.ws + WS_CSV) + ((size_t)(i * 2 + b)) * 65536 + kv * 64;
        A.seg0 = KSeg{csk, 128, nullptr, 0, csv, 128, 0, 512, 0, 0};
        const int lo = q0 - 128 < 0 ? 0 : q0 - 128, hi = q0 + 256 > 1024 ? 1024 : q0 + 256;
        A.seg1 = KSeg{PROJ + (size_t)row0 * NPROJ_PAD + C_KB + kv * 64, NPROJ_PAD, nullptr, 0, PROJ + (size_t)row0 * NPROJ_PAD + C_VB + kv * 64, NPROJ_PAD, lo, hi, 1, 1};
        A.O = MIX + (size_t)(row0 + q0) * D + 512 + hq * 64;
    } else {
        const int v = u - 128, b = v >> 4, hq = (v >> 1) & 7, qt = v & 1, kv = hq >> 2, row0 = b * 256, q0 = qt * 128;
        A.Q = PROJ + (size_t)(row0 + q0) * NPROJ_PAD + C_QB + hq * 64; A.qpos0 = q0; A.qrope = 0; A.nseg = 1;
        A.m0 = a.in[21 + cx.z][i * 8 + hq];
        A.seg0 = KSeg{PROJ + (size_t)row0 * NPROJ_PAD + C_KB + kv * 64, NPROJ_PAD, nullptr, 0, PROJ + (size_t)row0 * NPROJ_PAD + C_VB + kv * 64, NPROJ_PAD, 0, 256, 0, 0};
        A.seg1 = A.seg0;
        A.O = MIX + (size_t)(row0 + q0) * D + 512 + hq * 64;
    }
    attn_unit<64>(lds, A, cx.tid);
}

__device__ __forceinline__ void mla_unit(const Args& a, const Ctx& cx, LAS unsigned char* lds, int u) {
    const bf16_t* Q = (const bf16_t*)(cx.ws + WS_Q); const bf16_t* KVX = (const bf16_t*)(cx.ws + WS_KVX); const bf16_t* KR = (const bf16_t*)(cx.ws + WS_KR);
    bf16_t* MIX = (bf16_t*)(cx.ws + WS_MIX);
    AttnArgs A;
    A.tab64 = (const f32x2*)(cx.ws + WS_TAB); A.tab32 = A.tab64 + 64 * 16;
    A.qstride = 1536; A.ostride = D; A.scale = 0.10206207261596577f; A.l0 = 0.f; A.m0 = -1e30f;
    if (u < 256) {
        const int b = u >> 7, h = (u >> 3) & 15, qt = u & 7, row0 = TP + b * 1024, q0 = qt * 128, crow0 = T + b * 512;
        A.Q = Q + (size_t)(row0 + q0) * 1536 + h * 96; A.qpos0 = q0; A.qrope = 2; A.nseg = 2;
        A.seg0 = KSeg{KVX + (size_t)crow0 * 2048 + h * 128, 2048, KR + (size_t)crow0 * 32, 32, KVX + (size_t)crow0 * 2048 + h * 128 + 64, 2048, 0, 512, 0, 0};
        A.seg1 = KSeg{KVX + (size_t)row0 * 2048 + h * 128, 2048, KR + (size_t)row0 * 32, 32, KVX + (size_t)row0 * 2048 + h * 128 + 64, 2048, 0, 1024, 0, 0};
        A.O = MIX + (size_t)(row0 + q0) * D + h * 64;
    } else {
        const int v = u - 256, b = v >> 5, h = (v >> 1) & 15, qt = v & 1, row0 = b * 256, q0 = qt * 128;
        A.Q = Q + (size_t)(row0 + q0) * 1536 + h * 96; A.qpos0 = q0; A.qrope = 0; A.nseg = 1;
        A.seg0 = KSeg{KVX + (size_t)row0 * 2048 + h * 128, 2048, KR + (size_t)row0 * 32, 32, KVX + (size_t)row0 * 2048 + h * 128 + 64, 2048, 0, 256, 0, 0};
        A.seg1 = A.seg0;
        A.O = MIX + (size_t)(row0 + q0) * D + h * 64;
    }
    attn_unit<96>(lds, A, cx.tid);
}

constexpr int GL_G = 0;
constexpr int GL_STF = 32768, GL_STB = 51200;
constexpr int GL_LO = 32768, GL_WF = 40960, GL_WB = 45056, GL_BF = 49152, GL_BB = 49408;
constexpr int GL_QF = 69632, GL_KF = 78848, GL_QB = 88064, GL_KB = 97280;
constexpr int GL_VT = 106496;
constexpr int GL_AF = 124928, GL_AB = 134144;

__device__ __forceinline__ void gla_gates(const Args& a, const Ctx& cx, LAS unsigned char* lds, int i, int tok0, int h) {
    const int tid = cx.tid;
    const bf16_t* PROJ = (const bf16_t*)(cx.ws + WS_PROJ);
    LAS float* LO = (LAS float*)(lds + GL_LO); LAS float* WF = (LAS float*)(lds + GL_WF); LAS float* WB = (LAS float*)(lds + GL_WB);
    LAS float* BF = (LAS float*)(lds + GL_BF); LAS float* BB = (LAS float*)(lds + GL_BB);
    LAS float* Gf = (LAS float*)(lds + GL_G); LAS float* Gb = Gf + 4096;
    { const int t = tid >> 3, j0 = (tid & 7) * 4; const u32x2 v = *(const u32x2*)(PROJ + (size_t)(tok0 + t) * NPROJ_PAD + C_LO + j0);
      LO[t * 32 + j0] = bflo(v.x); LO[t * 32 + j0 + 1] = bfhi(v.x); LO[t * 32 + j0 + 2] = bflo(v.y); LO[t * 32 + j0 + 3] = bfhi(v.y); }
    for (int x = tid; x < 1024; x += NTHREADS) { const int r = x >> 6, d = x & 63;
        WF[x] = a.in[16 + cx.z][((size_t)i * 16 + r) * 256 + h * 64 + d]; WB[x] = a.in[18 + cx.z][((size_t)i * 16 + r) * 256 + h * 64 + d]; }
    if (tid < 64) { BF[tid] = a.in[17 + cx.z][i * 256 + h * 64 + tid]; BB[tid] = a.in[19 + cx.z][i * 256 + h * 64 + tid]; }
    __syncthreads();
    { const int d = tid & 63, tg = tid >> 6;
      float wf[16], wb[16];
#pragma unroll
      for (int r = 0; r < 16; ++r) { wf[r] = WF[r * 64 + d]; wb[r] = WB[r * 64 + d]; }
      const float bfv = BF[d], bbv = BB[d];
#pragma unroll
      for (int tt = 0; tt < 8; ++tt) { const int t = tg * 8 + tt; float xf = bfv, xb = bbv;
#pragma unroll
          for (int r = 0; r < 16; ++r) { xf += LO[t * 32 + r] * wf[r]; xb += LO[t * 32 + 16 + r] * wb[r]; }
          const float lf = fminf(xf, 0.f) - log1pf(__expf(-fabsf(xf))), lb = fminf(xb, 0.f) - log1pf(__expf(-fabsf(xb)));
          Gf[t * 64 + d] = lf * (1.f / 16.f); Gb[t * 64 + d] = lb * (1.f / 16.f); } }
    __syncthreads();
    if (tid < 64) { float s = 0.f; for (int t = 0; t < 64; ++t) { s += Gf[t * 64 + tid]; Gf[t * 64 + tid] = s; } }
    else if (tid < 128) { const int d = tid - 64; float s = 0.f; for (int t = 63; t >= 0; --t) { s += Gb[t * 64 + d]; Gb[t * 64 + d] = s; } }
    __syncthreads();
}

__device__ __forceinline__ void gla_load_vt(const bf16_t* PROJ, LAS unsigned char* lds, int tok0, int h, const int tid) {
    const int s = tid >> 3, e0 = (tid & 7) * 16;
    LAS bf16_t* VT = (LAS bf16_t*)(lds + GL_VT);
    const bf16_t* src = PROJ + (size_t)(tok0 + s) * NPROJ_PAD + C_VA + h * 128 + e0;
#pragma unroll
    for (int q = 0; q < 2; ++q) { const u32x4 v = *(const u32x4*)(src + q * 8); LAS bf16_t* dst = VT + (e0 + q * 8) * 72 + s;
        dst[0 * 72] = (bf16_t)(v.x & 0xffff); dst[1 * 72] = (bf16_t)(v.x >> 16); dst[2 * 72] = (bf16_t)(v.y & 0xffff); dst[3 * 72] = (bf16_t)(v.y >> 16);
        dst[4 * 72] = (bf16_t)(v.z & 0xffff); dst[5 * 72] = (bf16_t)(v.z >> 16); dst[6 * 72] = (bf16_t)(v.w & 0xffff); dst[7 * 72] = (bf16_t)(v.w >> 16); }
}

__device__ __forceinline__ void gla_local_unit(const Args& a, const Ctx& cx, LAS unsigned char* lds, int i, int u) {
    const int cg_ = u >> 2, h = u & 3, tok0 = cg_ * 64, tid = cx.tid, lane = tid & 63, w = tid >> 6, fr = lane & 15, fq = lane >> 4;
    const bf16_t* PROJ = (const bf16_t*)(cx.ws + WS_PROJ);
    float* LOC = (float*)(cx.ws + WS_LOC); float* DEC = (float*)(cx.ws + WS_DEC);
    __syncthreads();
    gla_gates(a, cx, lds, i, tok0, h);
    LAS float* Gf = (LAS float*)(lds + GL_G); LAS float* Gb = Gf + 4096;
    LAS bf16_t* KTf = (LAS bf16_t*)(lds + GL_KF); LAS bf16_t* KTb = (LAS bf16_t*)(lds + GL_KB);
    LAS bf16_t* VT = (LAS bf16_t*)(lds + GL_VT);
    { const int s = tid >> 3, d0 = (tid & 7) * 8; const u32x4 kv = *(const u32x4*)(PROJ + (size_t)(tok0 + s) * NPROJ_PAD + C_KA + h * 64 + d0);
      float k[8]; unpack8(kv, k);
#pragma unroll
      for (int e = 0; e < 8; ++e) { const int d = d0 + e;
          KTf[d * 72 + s] = (bf16_t)f2bf(k[e] * __expf(Gf[63 * 64 + d] - Gf[s * 64 + d]));
          KTb[d * 72 + s] = (bf16_t)f2bf(k[e] * __expf(Gb[d] - Gb[s * 64 + d])); } }
    gla_load_vt(PROJ, lds, tok0, h, tid);
    if (tid < 128) { const int dir = tid >> 6, d = tid & 63; DEC[((size_t)(dir * 96 + cg_) * 4 + h) * 64 + d] = __expf(dir ? Gb[d] : Gf[63 * 64 + d]); }
    __syncthreads();
    const int dir = w >> 2, dtile = w & 3;
    const LAS bf16_t* KT = dir ? KTb : KTf;
    bf16x8 af[2];
#pragma unroll
    for (int ks = 0; ks < 2; ++ks) af[ks] = *(const LAS bf16x8*)(KT + (dtile * 16 + fr) * 72 + ks * 32 + fq * 8);
    float* dst = LOC + ((size_t)(dir * 96 + cg_) * 4 + h) * 8192;
#pragma unroll
    for (int et = 0; et < 8; ++et) { f32x4 acc = {0.f, 0.f, 0.f, 0.f};
#pragma unroll
        for (int ks = 0; ks < 2; ++ks) { const bf16x8 bfv = *(const LAS bf16x8*)(VT + (et * 16 + fr) * 72 + ks * 32 + fq * 8); acc = MFMA16(af[ks], bfv, acc); }
#pragma unroll
        for (int j = 0; j < 4; ++j) dst[(dtile * 16 + fq * 4 + j) * 128 + et * 16 + fr] = acc[j]; }
}

__device__ __forceinline__ void gla_out_unit(const Args& a, const Ctx& cx, LAS unsigned char* lds, int i, int u) {
    const int cg_ = u >> 2, h = u & 3, tok0 = cg_ * 64, tid = cx.tid, lane = tid & 63, w = tid >> 6, fr = lane & 15, fq = lane >> 4;
    const bf16_t* PROJ = (const bf16_t*)(cx.ws + WS_PROJ); bf16_t* MIX = (bf16_t*)(cx.ws + WS_MIX);
    const float* LOC = (const float*)(cx.ws + WS_LOC); const float* DEC = (const float*)(cx.ws + WS_DEC);
    __syncthreads();
    gla_gates(a, cx, lds, i, tok0, h);
    LAS float* Gf = (LAS float*)(lds + GL_G); LAS float* Gb = Gf + 4096;
    const bool samp = cg_ >= 64;
    const int b = samp ? (cg_ - 64) >> 4 : cg_ >> 2, c = samp ? (cg_ - 64) & 15 : cg_ & 3, nc = samp ? 16 : 4, cbase = cg_ - c;
    {
        const int d = tid >> 3, e0 = (tid & 7) * 16;
        f32x4 Sf[4], Sb[4];
        if (samp) { const float* s0f = a.in[2 + cx.z] + ((size_t)((b * 2 + i) * 4 + h)) * 8192 + d * 128 + e0; const float* s0b = a.in[3 + cx.z] + ((size_t)((b * 2 + i) * 4 + h)) * 8192 + d * 128 + e0;
#pragma unroll
            for (int q = 0; q < 4; ++q) { Sf[q] = *(const f32x4*)(s0f + q * 4); Sb[q] = *(const f32x4*)(s0b + q * 4); } }
        else {
#pragma unroll
            for (int q = 0; q < 4; ++q) { Sf[q] = (f32x4){0.f, 0.f, 0.f, 0.f}; Sb[q] = Sf[q]; } }
        for (int j = 0; j < c; ++j) { const size_t ix = (size_t)(0 * 96 + cbase + j) * 4 + h; const float dec = DEC[ix * 64 + d]; const float* lp = LOC + ix * 8192 + d * 128 + e0;
#pragma unroll
            for (int q = 0; q < 4; ++q) Sf[q] = Sf[q] * dec + *(const f32x4*)(lp + q * 4); }
        for (int j = nc - 1; j > c; --j) { const size_t ix = (size_t)(1 * 96 + cbase + j) * 4 + h; const float dec = DEC[ix * 64 + d]; const float* lp = LOC + ix * 8192 + d * 128 + e0;
#pragma unroll
            for (int q = 0; q < 4; ++q) Sb[q] = Sb[q] * dec + *(const f32x4*)(lp + q * 4); }
        if (!samp) {
            if (c == nc - 1) { const size_t ix = (size_t)(0 * 96 + cg_) * 4 + h; const float dec = DEC[ix * 64 + d]; const float* lp = LOC + ix * 8192 + d * 128 + e0;
                float* o = cx.out + O_SF + ((size_t)((b * 2 + i) * 4 + h)) * 8192 + d * 128 + e0;
#pragma unroll
                for (int q = 0; q < 4; ++q) *(f32x4*)(o + q * 4) = Sf[q] * dec + *(const f32x4*)(lp + q * 4); }
            if (c == 0) { const size_t ix = (size_t)(1 * 96 + cg_) * 4 + h; const float dec = DEC[ix * 64 + d]; const float* lp = LOC + ix * 8192 + d * 128 + e0;
                float* o = cx.out + O_SB + ((size_t)((b * 2 + i) * 4 + h)) * 8192 + d * 128 + e0;
#pragma unroll
                for (int q = 0; q < 4; ++q) *(f32x4*)(o + q * 4) = Sb[q] * dec + *(const f32x4*)(lp + q * 4); }
        }
        LAS bf16_t* STf = (LAS bf16_t*)(lds + GL_STF); LAS bf16_t* STb = (LAS bf16_t*)(lds + GL_STB);
#pragma unroll
        for (int q = 0; q < 4; ++q)
#pragma unroll
            for (int e = 0; e < 4; ++e) { STf[(e0 + q * 4 + e) * 72 + d] = (bf16_t)f2bf(Sf[q][e]); STb[(e0 + q * 4 + e) * 72 + d] = (bf16_t)f2bf(Sb[q][e]); }
    }
    {
        const int t = tid >> 3, d0 = (tid & 7) * 8;
        const u32x4 qv = *(const u32x4*)(PROJ + (size_t)(tok0 + t) * NPROJ_PAD + C_QA + h * 64 + d0);
        const u32x4 kv = *(const u32x4*)(PROJ + (size_t)(tok0 + t) * NPROJ_PAD + C_KA + h * 64 + d0);
        float q[8], k[8], o1[8], o2[8], o3[8], o4[8]; unpack8(qv, q); unpack8(kv, k);
#pragma unroll
        for (int e = 0; e < 8; ++e) { const float gf = Gf[t * 64 + d0 + e], gb = Gb[t * 64 + d0 + e];
            o1[e] = q[e] * 0.125f * __expf(gf); o2[e] = k[e] * __expf(-gf); o3[e] = q[e] * 0.125f * __expf(gb); o4[e] = k[e] * __expf(-gb); }
        *(LAS u32x4*)((LAS bf16_t*)(lds + GL_QF) + t * 72 + d0) = pack8(o1);
        *(LAS u32x4*)((LAS bf16_t*)(lds + GL_KF) + t * 72 + d0) = pack8(o2);
        *(LAS u32x4*)((LAS bf16_t*)(lds + GL_QB) + t * 72 + d0) = pack8(o3);
        *(LAS u32x4*)((LAS bf16_t*)(lds + GL_KB) + t * 72 + d0) = pack8(o4);
    }
    gla_load_vt(PROJ, lds, tok0, h, tid);
    __syncthreads();
    {
        const int dir = w >> 2, tt = w & 3;
        const LAS bf16_t* Qm = (const LAS bf16_t*)(lds + (dir ? GL_QB : GL_QF)); const LAS bf16_t* Km = (const LAS bf16_t*)(lds + (dir ? GL_KB : GL_KF));
        LAS bf16_t* AT = (LAS bf16_t*)(lds + (dir ? GL_AB : GL_AF));
        bf16x8 af[2];
#pragma unroll
        for (int ks = 0; ks < 2; ++ks) af[ks] = *(const LAS bf16x8*)(Qm + (tt * 16 + fr) * 72 + ks * 32 + fq * 8);
#pragma unroll
        for (int st = 0; st < 4; ++st) { f32x4 acc = {0.f, 0.f, 0.f, 0.f};
#pragma unroll
            for (int ks = 0; ks < 2; ++ks) { const bf16x8 bfv = *(const LAS bf16x8*)(Km + (st * 16 + fr) * 72 + ks * 32 + fq * 8); acc = MFMA16(af[ks], bfv, acc); }
#pragma unroll
            for (int j = 0; j < 4; ++j) { const int t = tt * 16 + fq * 4 + j, s = st * 16 + fr; const bool keep = dir ? (s >= t) : (s <= t);
                AT[t * 72 + s] = (bf16_t)f2bf(keep ? acc[j] : 0.f); } }
    }
    __syncthreads();
    {
        const int tt = w & 3, eg = w >> 2;
        LAS float* OS = (LAS float*)(lds + GL_G);
        const LAS bf16_t* VT = (const LAS bf16_t*)(lds + GL_VT);
        bf16x8 a1[2], a2[2], a3[2], a4[2];
#pragma unroll
        for (int ks = 0; ks < 2; ++ks) { const int off = (tt * 16 + fr) * 72 + ks * 32 + fq * 8;
            a1[ks] = *(const LAS bf16x8*)((const LAS bf16_t*)(lds + GL_QF) + off); a2[ks] = *(const LAS bf16x8*)((const LAS bf16_t*)(lds + GL_AF) + off);
            a3[ks] = *(const LAS bf16x8*)((const LAS bf16_t*)(lds + GL_QB) + off); a4[ks] = *(const LAS bf16x8*)((const LAS bf16_t*)(lds + GL_AB) + off); }
        f32x4 accs[4];
#pragma unroll
        for (int q = 0; q < 4; ++q) { const int et = eg * 4 + q; f32x4 acc = {0.f, 0.f, 0.f, 0.f};
#pragma unroll
            for (int ks = 0; ks < 2; ++ks) { const int off = (et * 16 + fr) * 72 + ks * 32 + fq * 8;
                const bf16x8 b1 = *(const LAS bf16x8*)((const LAS bf16_t*)(lds + GL_STF) + off), b2 = *(const LAS bf16x8*)(VT + off), b3 = *(const LAS bf16x8*)((const LAS bf16_t*)(lds + GL_STB) + off);
                acc = MFMA16(a1[ks], b1, acc); acc = MFMA16(a2[ks], b2, acc); acc = MFMA16(a3[ks], b3, acc); acc = MFMA16(a4[ks], b2, acc); }
            accs[q] = acc; }
#pragma unroll
        for (int q = 0; q < 4; ++q)
#pragma unroll
            for (int j = 0; j < 4; ++j) OS[(tt * 16 + fq * 4 + j) * 128 + (eg * 4 + q) * 16 + fr] = accs[q][j];
    }
    __syncthreads();
    {
        const int t = tid >> 3, e0 = (tid & 7) * 16;
        const LAS float* OS = (const LAS float*)(lds + GL_G);
        float o[16]; float ss = 0.f;
#pragma unroll
        for (int e = 0; e < 16; ++e) { o[e] = OS[t * 128 + e0 + e]; ss += o[e] * o[e]; }
        ss += __shfl_xor(ss, 1); ss += __shfl_xor(ss, 2); ss += __shfl_xor(ss, 4);
        const float rstd = rsqrtf(ss * (1.f / 128.f) + EPS);
        const bf16_t* gp = PROJ + (size_t)(tok0 + t) * NPROJ_PAD + C_GA + h * 128 + e0;
        const float* gg = a.in[20 + cx.z] + i * 128 + e0;
        float gt[16]; unpack8(*(const u32x4*)gp, gt); unpack8(*(const u32x4*)(gp + 8), gt + 8);
#pragma unroll
        for (int e = 0; e < 16; ++e) o[e] = o[e] * rstd * gg[e] * silu_f(gt[e]);
        bf16_t* op = MIX + (size_t)(tok0 + t) * D + h * 128 + e0;
        *(u32x4*)op = pack8(o); *(u32x4*)(op + 8) = pack8(o + 8);
    }
}


#define XB_TMO      128
#define XB_XCNT(j)  (256  + 64 * (j))
#define XB_XSUB(j)  (1280 + 64 * (j))
#define XB_XGEN(j)  (2304 + 64 * (j))
#define XB_TOP      3328
#define XB_TOPGEN   3392
#define XCD_BAR_WORDS 3456
#define XB_SPIN_CAP (1u << 18)
__device__ __forceinline__ unsigned xb_ld(unsigned* p)              { return __hip_atomic_load(p, __ATOMIC_RELAXED, __HIP_MEMORY_SCOPE_AGENT); }
__device__ __forceinline__ unsigned xb_add(unsigned* p, unsigned v) { return __hip_atomic_fetch_add(p, v, __ATOMIC_RELAXED, __HIP_MEMORY_SCOPE_AGENT); }
__device__ __forceinline__ unsigned xb_xcc_id() { return (unsigned)__builtin_amdgcn_s_getreg((3 << 11) | 20) & 0xFu; }
#define XB_SPIN(cond, bar) do { unsigned _sp = 0; while (cond) { __builtin_amdgcn_s_sleep(1); \
    if ((++_sp & 255u) == 0u) { if (xb_ld(&(bar)[XB_TMO])) break; if (_sp > XB_SPIN_CAP) { atomicAdd(&(bar)[XB_TMO], 1u); break; } } } } while (0)
struct XcdBarrier { unsigned* bar; unsigned x; volatile LAS unsigned* st; };
__device__ __forceinline__ XcdBarrier xcd_barrier_post(unsigned* bar, volatile LAS unsigned* st) {
    XcdBarrier b; b.bar = bar; b.x = xb_xcc_id(); b.st = st;
    if (threadIdx.x == 0) (void)xb_add(&bar[XB_XCNT(b.x)], 1u);
    return b;
}
__device__ __forceinline__ void xcd_barrier_complete(unsigned* bar, unsigned x, unsigned& nloc, unsigned& nx) {
    const unsigned G = gridDim.x * gridDim.y * gridDim.z;
    unsigned sum, cnt, mine, sp = 0u;
    for (;;) {
        sum = 0u; cnt = 0u; mine = 0u;
#pragma unroll
        for (unsigned j = 0; j < 16; ++j) { const unsigned c = xb_ld(&bar[XB_XCNT(j)]); sum += c; cnt += (c > 0u) ? 1u : 0u; mine = (j == x) ? c : mine; }
        if (sum == G) break;
        __builtin_amdgcn_s_sleep(1);
        if ((++sp & 255u) == 0u) { if (xb_ld(&bar[XB_TMO])) break; if (sp > XB_SPIN_CAP) { atomicAdd(&bar[XB_TMO], 1u); break; } }
    }
    nloc = mine > 0u ? mine : 1u; nx = cnt > 0u ? cnt : 1u;
}
__device__ __forceinline__ void xcd_barrier(const XcdBarrier& b) {
    asm volatile("s_waitcnt vmcnt(0)" ::: "memory");
    __syncthreads();
    if (threadIdx.x == 0) {
        unsigned* bar = b.bar;
        __builtin_amdgcn_s_waitcnt(0);
        unsigned nloc = b.st[0], nx = b.st[1];
        if (nloc == 0u) { xcd_barrier_complete(bar, b.x, nloc, nx); b.st[0] = nloc; b.st[1] = nx; }
        const unsigned old = xb_add(&bar[XB_XSUB(b.x)], 1u);
        const unsigned gen = old / nloc;
        if (old + 1u == (gen + 1u) * nloc) {
            __builtin_amdgcn_fence(__ATOMIC_RELEASE, "agent");
            asm volatile("s_waitcnt vmcnt(0)" ::: "memory");
            const unsigned og = xb_add(&bar[XB_TOP], 1u);
            const unsigned tg = og / nx;
            if (og + 1u == (tg + 1u) * nx) xb_add(&bar[XB_TOPGEN], 1u);
            else XB_SPIN(xb_ld(&bar[XB_TOPGEN]) == tg, bar);
            __builtin_amdgcn_fence(__ATOMIC_ACQUIRE, "agent");
            xb_add(&bar[XB_XGEN(b.x)], 1u);
            asm volatile("s_waitcnt vmcnt(0)" ::: "memory");
        } else {
            XB_SPIN(xb_ld(&bar[XB_XGEN(b.x)]) == gen, bar);
            __builtin_amdgcn_fence(__ATOMIC_ACQUIRE, "agent");
            asm volatile("s_waitcnt vmcnt(0)" ::: "memory");
        }
    }
    __syncthreads();
}

enum { K_PRO = 0, K_PRE, K_G1, K_A1, K_A2, K_DOWN, K_MID, K_UQKV, K_MLA, K_OUTP, K_POST1, K_FF1, K_FF2, K_POST2 };
constexpr int N_PHASES = 2 + 2 * 8 + 2 * 9;
#ifndef EN_MASK
#define EN_MASK 0xFFFFFFFFu
#endif
#define ENB(k) (((EN_MASK) >> (k)) & 1u)

__global__ void __launch_bounds__(NTHREADS, 2) mega_fwd(Args args) {
    extern __shared__ __attribute__((aligned(16))) unsigned char lds_raw[];
    LAS unsigned char* lds = (LAS unsigned char*)lds_raw;
    const int lo = args.ph_lo, hi = args.ph_hi;
    volatile LAS unsigned* bst = (volatile LAS unsigned*)(lds + LDS_BYTES - 64);
    if (threadIdx.x < 2) bst[threadIdx.x] = 0u;
    __syncthreads();
    (void)xcd_barrier_post((unsigned*)(args.ws + WS_CTL), bst);
    for (int p = lo; p < hi; ++p) {
        int kind, l;
        if (p == 0) { kind = K_PRO; l = 0; }
        else if (p == 1) { kind = K_PRE; l = 0; }
        else {
            const int q = p - 2, pair = q / 17, r = q - pair * 17;
            if (r < 8) { l = 2 * pair; kind = (r == 0) ? K_G1 : (r == 1) ? K_A1 : (r == 2) ? K_A2 : (r == 3) ? K_OUTP : (r == 4) ? K_POST1 : (r == 5) ? K_FF1 : (r == 6) ? K_FF2 : K_POST2; }
            else { const int r2 = r - 8; l = 2 * pair + 1; kind = (r2 == 0) ? K_DOWN : (r2 == 1) ? K_MID : (r2 == 2) ? K_UQKV : (r2 == 3) ? K_MLA : (r2 == 4) ? K_OUTP : (r2 == 5) ? K_POST1 : (r2 == 6) ? K_FF1 : (r2 == 7) ? K_FF2 : K_POST2; }
        }
        Ctx cx; cx.ws = args.ws; cx.out = args.out; cx.z = 0; cx.tid = threadIdx.x; cx.bid = blockIdx.x; cx.G = gridDim.x;
        asm volatile("" : "+s"(cx.ws), "+s"(cx.out), "+s"(cx.z), "+s"(kind), "+s"(l), "+v"(cx.tid), "+s"(cx.bid), "+s"(cx.G));
        unsigned char* ws = cx.ws;
        const int i = l >> 1, G = cx.G, bid = cx.bid;
        switch (kind) {
        case K_PRO: if (ENB(0)) prologue(args, cx, lds); break;
        case K_PRE: if (ENB(1)) pre_rows(args, cx, 0); break;
        case K_G1: if (ENB(2)) {
            pg8::Gemm g{(const bf16_t*)(ws + WS_H), (const bf16_t*)(ws + WS_WIN) + (size_t)i * NPROJ_PAD * D, T, NPROJ_PAD, D, D, D, NPROJ_PAD / 256, 0};
            pg8::StaticOrder S; S.init(T, NPROJ_PAD, G, bid);
            pg8::EpiProj E{(bf16_t*)(ws + WS_PROJ), cx.out, i};
            pg8::gemm_phase<pg8::EpiProj, pg8::StaticOrder>(lds, g, S, E, cx.tid);
        } break;
        case K_A1:
            for (int u = bid; u < 768; u += G) { if (u < 384) { if (ENB(3)) swa_unit(args, cx, lds, i, u); } else { if (ENB(4)) gla_local_unit(args, cx, lds, i, u - 384); } }
            break;
        case K_A2:
            for (int u = bid; u < 384; u += G) { const int uu = (u < 128) ? (256 + u) : (u - 128); if (ENB(5)) gla_out_unit(args, cx, lds, i, uu); }
            break;
        case K_MID: if (ENB(7)) mla_mid(args, cx, i); break;
        case K_UQKV: if (ENB(8)) {
            for (int s = 0; s < 2; ++s) {
                pg8::Gemm g;
                if (s == 0) g = pg8::Gemm{(const bf16_t*)(ws + WS_CQ), (const bf16_t*)(ws + WS_WUQ) + (size_t)i * 1536 * 384, T, 1536, 384, 384, 384, 6, 0};
                else        g = pg8::Gemm{(const bf16_t*)(ws + WS_CKV), (const bf16_t*)(ws + WS_WUKV) + (size_t)i * 2048 * 256, T + 1024, 2048, 256, 256, 256, 8, 0};
                pg8::StaticOrder S; S.init(g.M, g.N, G, (s == 0 || G != 256) ? bid : ((bid + 144) & 255));
                pg8::EpiBf16<0> E{s == 0 ? (bf16_t*)(ws + WS_Q) : (bf16_t*)(ws + WS_KVX), g.N};
                pg8::gemm_phase<pg8::EpiBf16<0>, pg8::StaticOrder>(lds, g, S, E, cx.tid);
            }
        } break;
        case K_MLA: if (ENB(9)) { for (int u = bid; u < 768; u += G) mla_unit(args, cx, lds, u); } break;
        case K_DOWN: case K_OUTP: case K_FF2: if (ENB(10)) {
            pg8::Gemm g; pg8::EpiF32 E;
            if (kind == K_DOWN) {
                g = pg8::Gemm{(const bf16_t*)(ws + WS_H), (const bf16_t*)(ws + WS_WDOWN) + (size_t)i * NDOWN_PAD * D, T, NDOWN_PAD, D, D, D, NDOWN_PAD / 256, 0};
                E = pg8::EpiF32{(float*)(ws + WS_DOWN), NDOWN_PAD, NDOWN_PAD / 256, 0};
            } else if (kind == K_OUTP) {
                const bf16_t* Wt = (l & 1) ? (const bf16_t*)(ws + WS_WO) + (size_t)i * D * D : (const bf16_t*)(ws + WS_WOUT) + (size_t)i * D * D;
                g = pg8::Gemm{(const bf16_t*)(ws + WS_MIX), Wt, T, 2 * D, D / 2, D, D / 2, 4, D / 2};
                E = pg8::EpiF32{(float*)(ws + WS_OUT), D, 4, OUT_SPLIT};
            } else {
                g = pg8::Gemm{(const bf16_t*)(ws + WS_U), (const bf16_t*)(ws + WS_WFF2) + (size_t)l * FF * D, T, 2 * D, FF / 2, FF, FF / 2, 4, FF / 2};
                E = pg8::EpiF32{(float*)(ws + WS_OUT), D, 4, OUT_SPLIT};
            }
            pg8::StaticOrder S; S.init(g.M, g.N, G, bid);
            pg8::gemm_phase<pg8::EpiF32, pg8::StaticOrder>(lds, g, S, E, cx.tid);
        } break;
        case K_FF1: if (ENB(12)) {
            pg8::Gemm g{(const bf16_t*)(ws + WS_H), (const bf16_t*)(ws + WS_WFF1) + (size_t)l * FF * D, T, FF, D, D, D, FF / 256, 0};
            pg8::StaticOrder S; S.init(T, FF, G, bid);
            pg8::EpiBf16<1> E{(bf16_t*)(ws + WS_U), FF};
            pg8::gemm_phase<pg8::EpiBf16<1>, pg8::StaticOrder>(lds, g, S, E, cx.tid);
        } break;
        case K_POST1: if (ENB(11)) {
            const float* MODL = (const float*)(ws + WS_MOD) + (size_t)l * 3 * 6144; const float* gN = args.in[12 + cx.z] + (size_t)l * 4 * D;
            post_rows(args, cx, l == 0, MODL + 2 * D, gN + D, true, gN + 2 * D, MODL + 3 * D, MODL + 4 * D);
        } break;
        case K_POST2: if (ENB(14)) {
            const float* MODL = (const float*)(ws + WS_MOD) + (size_t)l * 3 * 6144; const float* gN = args.in[12 + cx.z] + (size_t)l * 4 * D;
            const float* MODN = MODL + 3 * 6144; const float* gNn = gN + 4 * D;
            post_rows(args, cx, false, MODL + 5 * D, gN + 3 * D, l < 3, gNn, MODN, MODN + D);
        } break;
        default: break;
        }
        if (p + 1 < hi) { if (p == lo) cg::this_grid().sync(); else { XcdBarrier xb; xb.bar = (unsigned*)(cx.ws + WS_CTL); xb.x = xb_xcc_id(); xb.st = (volatile LAS unsigned*)(lds + LDS_BYTES - 64); xcd_barrier(xb); } }
    }
}

extern "C" void kernel_launch(void* const* d_in, const int* in_sizes, int n_in, void* d_out, int out_size, void* d_ws, size_t ws_size, hipStream_t stream) {
    static int grid = 0;
    if (grid == 0) {
        int dev = 0, cus = 0, per_cu = 0;
        hipGetDevice(&dev);
        hipDeviceGetAttribute(&cus, hipDeviceAttributeMultiprocessorCount, dev);
        hipFuncSetAttribute((const void*)mega_fwd, hipFuncAttributeMaxDynamicSharedMemorySize, LDS_BYTES);
        hipOccupancyMaxActiveBlocksPerMultiprocessor(&per_cu, (const void*)mega_fwd, NTHREADS, LDS_BYTES);
        if (per_cu < 1) { fprintf(stderr, "kernel_launch: occupancy query says %d blocks per CU\n", per_cu); per_cu = 1; }
        (void)hipGetLastError();
        grid = cus;
        if (ws_size < 256 * MiB) fprintf(stderr, "kernel_launch: workspace too small (%zu)\n", ws_size);
    }
    (void)hipMemsetAsync((char*)d_ws + WS_CTL, 0, CTL_BYTES, stream);
    Args a{};
    for (int i = 0; i < 29; ++i) a.in[i] = (const float*)d_in[i];
    a.out = (float*)d_out; a.ws = (unsigned char*)d_ws;
#if MK_ONE_LAUNCH
    a.ph_lo = 0; a.ph_hi = N_PHASES;
    void* kargs[] = {&a};
    hipError_t e = hipLaunchCooperativeKernel((const void*)mega_fwd, dim3(grid), dim3(NTHREADS), kargs, LDS_BYTES, stream);
    if (e != hipSuccess) fprintf(stderr, "cooperative launch failed: %s (grid %d)\n", hipGetErrorString(e), grid);
#else
    for (int p = 0; p < N_PHASES; ++p) {
        a.ph_lo = p; a.ph_hi = p + 1;
        hipLaunchKernelGGL(mega_fwd, dim3(grid), dim3(NTHREADS), LDS_BYTES, stream, a);
    }
#endif
}
```

```cpp
#include <hip/hip_runtime.h>
#include <hip/hip_cooperative_groups.h>
#include <cstdio>
#include <cstdint>
namespace cg = cooperative_groups;

#ifndef MK_ONE_LAUNCH
#define MK_ONE_LAUNCH 1
#endif

#define LAS __attribute__((address_space(3)))
typedef unsigned short bf16_t;
typedef short bf16x8 __attribute__((ext_vector_type(8)));
typedef float f32x4 __attribute__((ext_vector_type(4)));
typedef float f32x2 __attribute__((ext_vector_type(2)));
typedef unsigned u32x4 __attribute__((ext_vector_type(4)));
typedef unsigned u32x2 __attribute__((ext_vector_type(2)));

constexpr int D = 1024, TP = 4096, TS = 2048, T = TP + TS, FF = 4096;
constexpr int NPROJ = 2336, NPROJ_PAD = 2560, NDOWN = 672, NDOWN_PAD = 768;
constexpr int C_QA = 0, C_KA = 256, C_VA = 512, C_GA = 1024, C_LO = 1536, C_QB = 1568, C_KB = 2080, C_VB = 2208;
constexpr float EPS = 1e-6f;
constexpr int NTHREADS = 512, NWAVES = 8;
constexpr int LDS_BYTES = 147456;

constexpr size_t O_X = 0, O_SF = 6291456, O_SB = 7340032, O_CK = 8388608, O_CV = 9437184, O_CKV = 10485760, O_CKR = 12582912;

constexpr size_t MiB = 1u << 20;
constexpr size_t WS_WFF1 = 0, WS_WFF2 = 32 * MiB, WS_WIN = 64 * MiB, WS_WOUT = 74 * MiB, WS_WDOWN = 78 * MiB, WS_WUQ = 81 * MiB,
                 WS_WUKV = 84 * MiB, WS_WO = 86 * MiB, WS_MOD = 90 * MiB, WS_TAB = 91 * MiB, WS_CSK = 92 * MiB, WS_CSV = 93 * MiB,
                 WS_H = 94 * MiB, WS_MIX = 106 * MiB, WS_OUT = 118 * MiB, WS_U = 166 * MiB, WS_PROJ = 214 * MiB, WS_CTL = 250 * MiB;
constexpr size_t CTL_BYTES = 16384;
constexpr size_t WS_LOC = WS_U, WS_DEC = WS_U + 24 * MiB;
constexpr size_t WS_Q = WS_U, WS_KVX = WS_U + 18 * MiB;
constexpr size_t WS_DOWN = WS_PROJ, WS_CQ = WS_PROJ + 18 * MiB, WS_CKV = WS_PROJ + 23 * MiB, WS_KR = WS_PROJ + 27 * MiB;
constexpr size_t OUT_SPLIT = (size_t)T * D;
constexpr size_t DOWN_SPLIT = (WS_DOWN - WS_OUT) / 4;

__device__ __forceinline__ unsigned f2bf(float f) { unsigned u = __builtin_bit_cast(unsigned, f); return (u + 0x7fffu + ((u >> 16) & 1u)) >> 16; }
__device__ __forceinline__ unsigned pk2(float lo, float hi) { return f2bf(lo) | (f2bf(hi) << 16); }
__device__ __forceinline__ float bf2f(unsigned short b) { return __builtin_bit_cast(float, (unsigned)b << 16); }
__device__ __forceinline__ float bflo(unsigned w) { return __builtin_bit_cast(float, w << 16); }
__device__ __forceinline__ float bfhi(unsigned w) { return __builtin_bit_cast(float, w & 0xffff0000u); }
__device__ __forceinline__ void unpack8(const u32x4 v, float* f) {
    f[0] = bflo(v.x); f[1] = bfhi(v.x); f[2] = bflo(v.y); f[3] = bfhi(v.y); f[4] = bflo(v.z); f[5] = bfhi(v.z); f[6] = bflo(v.w); f[7] = bfhi(v.w);
}
__device__ __forceinline__ u32x4 pack8(const float* f) { u32x4 o; o.x = pk2(f[0], f[1]); o.y = pk2(f[2], f[3]); o.z = pk2(f[4], f[5]); o.w = pk2(f[6], f[7]); return o; }
__device__ __forceinline__ float wave_sum(float v) {
#pragma unroll
    for (int o = 1; o < 64; o <<= 1) v += __shfl_xor(v, o);
    return v;
}
__device__ __forceinline__ float silu_f(float x) { return x / (1.f + __expf(-x)); }

namespace pg8 {
constexpr int BM = 256, BK = 64, HALF = 128, HTB = HALF * BK * 2, NXCD = 8, WGM = 8;
__host__ __device__ __forceinline__ int lds_byte(int r, int c) { const int st = (r >> 4) * 2 + (c >> 5), rr = r & 15, cc = c & 31, ob = rr * 64 + cc * 2; return st * 1024 + (ob ^ (((ob >> 9) & 1) << 5)); }
__host__ __device__ __forceinline__ void stage_rc(int b, int& R, int& C) { const int st = b / 1024, sb = b % 1024, swz = sb ^ (((sb >> 9) & 1) << 5); R = (st >> 1) * 16 + swz / 64; C = (st & 1) * 32 + (swz % 64) / 2; }
__host__ __device__ __forceinline__ int perm32(int rho) { const int n = rho >> 4, i = rho & 15; return 8 * (i >> 2) + 4 * n + (i & 3); }

struct Unit { int pm, pn; };
struct Gemm { const bf16_t* A; const bf16_t* Bt; int M, N, K, lda, ldb, npn, a_split; };

struct StaticOrder {
    int nM, nN, nwg, G, c;
    __device__ void init(int M, int N, int G_, int c_) { nM = M / BM; nN = N / BM; nwg = nM * nN; G = G_; c = c_; }
    __device__ bool next(int i, Unit& u) const {
        const long L = (long)i * G + c; if (L >= nwg) return false;
        int wgid = (int)L; { const int q = nwg / NXCD, r = nwg % NXCD, xcd = wgid % NXCD, off = wgid / NXCD; wgid = (xcd < r ? xcd * (q + 1) : r * (q + 1) + (xcd - r) * q) + off; }
        const int nig = WGM * nN, gid = wgid / nig, fm = gid * WGM, gsz = (nM - fm) < WGM ? (nM - fm) : WGM;
        u.pm = fm + ((wgid % nig) % gsz); u.pn = (wgid % nig) / gsz; return true;
    }
};

__device__ __forceinline__ unsigned cvt_pk_bf16(float lo, float hi) { unsigned r; asm volatile("v_cvt_pk_bf16_f32 %0, %1, %2" : "=v"(r) : "v"(lo), "v"(hi)); return r; }

template <int ACT  > struct EpiBf16 {
    static constexpr bool PERM = true;
    bf16_t* O; int ldc;
    __device__ __forceinline__ void operator()(const f32x4 (&acc)[2][2][4][2], const Unit& u, int wr, int wc, int fr, int fq) const {
        const int row0 = u.pm * BM + wr * 64 + fr, col0 = u.pn * BM + wc * 32 + 8 * fq;
#pragma unroll
        for (int ai = 0; ai < 2; ++ai)
#pragma unroll
            for (int m = 0; m < 4; ++m) { __builtin_amdgcn_sched_barrier(0); bf16_t* rowp = O + (size_t)(row0 + ai * HALF + m * 16) * ldc + col0;
#pragma unroll
                for (int bj = 0; bj < 2; ++bj) { f32x4 v0 = acc[ai][bj][m][0], v1 = acc[ai][bj][m][1];
                    if (ACT == 1) {
#pragma unroll
                        for (int j = 0; j < 4; ++j) { float a = fmaxf(v0[j], 0.f), b = fmaxf(v1[j], 0.f); v0[j] = a * a; v1[j] = b * b; } }
                    u32x4 w; w.x = cvt_pk_bf16(v0[0], v0[1]); w.y = cvt_pk_bf16(v0[2], v0[3]); w.z = cvt_pk_bf16(v1[0], v1[1]); w.w = cvt_pk_bf16(v1[2], v1[3]);
                    *(u32x4*)(rowp + bj * HALF) = w; } }
    }
};
struct EpiProj {
    static constexpr bool PERM = true;
    bf16_t* O; float* outp; int li;
    __device__ __forceinline__ void operator()(const f32x4 (&acc)[2][2][4][2], const Unit& u, int wr, int wc, int fr, int fq) const {
        const int row0 = u.pm * BM + wr * 64 + fr, col0 = u.pn * BM + wc * 32 + 8 * fq;
#pragma unroll
        for (int ai = 0; ai < 2; ++ai)
#pragma unroll
            for (int m = 0; m < 4; ++m) { __builtin_amdgcn_sched_barrier(0); const int row = row0 + ai * HALF + m * 16; bf16_t* rowp = O + (size_t)row * NPROJ_PAD + col0;
#pragma unroll
                for (int bj = 0; bj < 2; ++bj) { const f32x4 v0 = acc[ai][bj][m][0], v1 = acc[ai][bj][m][1];
                    u32x4 w; w.x = cvt_pk_bf16(v0[0], v0[1]); w.y = cvt_pk_bf16(v0[2], v0[3]); w.z = cvt_pk_bf16(v1[0], v1[1]); w.w = cvt_pk_bf16(v1[2], v1[3]);
                    *(u32x4*)(rowp + bj * HALF) = w;
                    const int col = col0 + bj * HALF;
                    if (row < TP && col >= C_KB && col < NPROJ) {
                        const int b = row >> 8, t = row & 255;
                        float* dst = outp + ((col < C_VB) ? (O_CK - C_KB) : (O_CV - C_VB)) + ((size_t)((b * 2 + li) * 256 + t)) * 128 + col;
                        *(f32x4*)dst = v0; *(f32x4*)(dst + 4) = v1; } } }
    }
};
struct EpiF32 {
    static constexpr bool PERM = true;
    float* O; int ldc; int npn; size_t split_stride;
    __device__ __forceinline__ void operator()(const f32x4 (&acc)[2][2][4][2], const Unit& u, int wr, int wc, int fr, int fq) const {
        const int s = u.pn / npn, pn = u.pn - s * npn;
        float* base = O + (size_t)s * split_stride;
        const int row0 = u.pm * BM + wr * 64 + fr, col0 = pn * BM + wc * 32 + 8 * fq;
#pragma unroll
        for (int ai = 0; ai < 2; ++ai)
#pragma unroll
            for (int m = 0; m < 4; ++m) { __builtin_amdgcn_sched_barrier(0); float* rowp = base + (size_t)(row0 + ai * HALF + m * 16) * ldc + col0;
#pragma unroll
                for (int bj = 0; bj < 2; ++bj) { *(f32x4*)(rowp + bj * HALF) = acc[ai][bj][m][0]; *(f32x4*)(rowp + bj * HALF + 4) = acc[ai][bj][m][1]; } }
    }
};

template <class Epi, class Sched>
__device__ __forceinline__ void gemm_phase(LAS unsigned char* lds, const Gemm g, const Sched& S, const Epi& E, const int tid) {
    const int wid = __builtin_amdgcn_readfirstlane(tid >> 6), lane = tid & 63, wr = wid >> 2, wc = wid & 3, fr = lane & 15, fq = lane >> 4;
    const int K = g.K, nt = K / BK;
    unsigned voffA[2], voffB[2];
#pragma unroll
    for (int i = 0; i < 2; ++i) { int R, C; stage_rc(tid * 16 + i * 8192, R, C); const int Rb = Epi::PERM ? ((R & ~31) + perm32(R & 31)) : R;
        voffA[i] = (unsigned)(R * g.lda + C) * 2u; voffB[i] = (unsigned)(Rb * g.ldb + C) * 2u; }
    const size_t kstep = (size_t)(BK * 2);
    const size_t hstepA = (size_t)HALF * g.lda * 2, hstepB = (size_t)HALF * g.ldb * 2;
    const size_t tstepA = 2 * hstepA, tstepB = 2 * hstepB;
    const unsigned ldsw = (unsigned)wid * 1024u;
    const int aoff = lds_byte(wr * 64 + fr, fq * 8), boff = lds_byte(wc * 32 + fr, fq * 8);
#define PG8_SA(b, h) (((b) * 2 + (h)) * HTB)
#define PG8_SB(b, h) ((4 + (b) * 2 + (h)) * HTB)
#define PG8_STAGE(bufoff, gbase, voff) do { _Pragma("unroll") for (int _i = 0; _i < 2; ++_i) \
        __builtin_amdgcn_global_load_lds((const unsigned*)((const char*)(gbase) + (voff)[_i]), (LAS unsigned*)(lds + (bufoff) + ldsw + _i * 8192), 16, 0, 0); } while (0)
#define PG8_LDA(dst, b, h) do { _Pragma("unroll") for (int m = 0; m < 4; ++m) _Pragma("unroll") for (int k = 0; k < 2; ++k) dst[m][k] = *(const LAS bf16x8*)(lds + PG8_SA(b, h) + aoff + m * 2048 + k * 1024); } while (0)
#define PG8_LDB(dst, b, h) do { _Pragma("unroll") for (int n = 0; n < 2; ++n) _Pragma("unroll") for (int k = 0; k < 2; ++k) dst[n][k] = *(const LAS bf16x8*)(lds + PG8_SB(b, h) + boff + n * 2048 + k * 1024); } while (0)
#define PG8_MMA(ai, bj, At, Bt) do { __builtin_amdgcn_s_setprio(1); _Pragma("unroll") for (int m = 0; m < 4; ++m) _Pragma("unroll") for (int n = 0; n < 2; ++n) _Pragma("unroll") for (int k = 0; k < 2; ++k) \
        acc[ai][bj][m][n] = __builtin_amdgcn_mfma_f32_16x16x32_bf16(Bt[n][k], At[m][k], acc[ai][bj][m][n], 0, 0, 0); __builtin_amdgcn_s_setprio(0); } while (0)
#define PG8_WAIT_V(n) asm volatile("s_waitcnt vmcnt(" #n ")" ::: "memory")
#define PG8_WAIT_L(n) asm volatile("s_waitcnt lgkmcnt(" #n ")" ::: "memory")
#define PG8_BAR __builtin_amdgcn_s_barrier()
#define PG8_SCHED __builtin_amdgcn_sched_barrier(0)
#define PG8_UA(u) ((const char*)g.A + (size_t)(u).pm * tstepA + (size_t)((u).pn / g.npn) * (size_t)g.a_split * 2)
#define PG8_UB(u) ((const char*)g.Bt + (size_t)(u).pn * tstepB)
    Unit cur, nxt; int ui = 0;
    if (!S.next(0, cur)) return;
    f32x4 acc[2][2][4][2];
#pragma unroll
    for (int a = 0; a < 2; ++a)
#pragma unroll
        for (int b = 0; b < 2; ++b)
#pragma unroll
            for (int m = 0; m < 4; ++m)
#pragma unroll
                for (int n = 0; n < 2; ++n) acc[a][b][m][n] = (f32x4){0.f, 0.f, 0.f, 0.f};
    bf16x8 At[4][2], B0[2][2], B1[2][2];
    const char* cA = PG8_UA(cur); const char* cB = PG8_UB(cur);
    PG8_STAGE(PG8_SB(0, 0), cB, voffB); PG8_STAGE(PG8_SB(0, 1), cB + hstepB, voffB); PG8_STAGE(PG8_SA(0, 0), cA, voffA); PG8_STAGE(PG8_SA(0, 1), cA + hstepA, voffA);
    if (wr == 1) PG8_BAR;
    PG8_WAIT_V(2); PG8_BAR;
    PG8_STAGE(PG8_SB(1, 0), cB + kstep, voffB); PG8_STAGE(PG8_SA(1, 0), cA + kstep, voffA); PG8_STAGE(PG8_SB(1, 1), cB + hstepB + kstep, voffB);
    PG8_WAIT_V(6); PG8_BAR;
    for (;;) {
        const bool has_next = S.next(ui + 1, nxt);
        const char* nA = has_next ? PG8_UA(nxt) : cA; const char* nB = has_next ? PG8_UB(nxt) : cB;
        for (int t = 0; t < nt; t += 2) {
            const bool last = (t == nt - 2);
            const char* a1 = cA + (size_t)(t + 1) * kstep;
            const char* a2 = last ? nA : cA + (size_t)(t + 2) * kstep; const char* b2 = last ? nB : cB + (size_t)(t + 2) * kstep;
            const char* a3 = a2 + kstep; const char* b3 = b2 + kstep;
            PG8_LDB(B0, 0, 0); PG8_LDB(B1, 0, 1); PG8_SCHED; PG8_LDA(At, 0, 0); PG8_STAGE(PG8_SA(1, 1), a1 + hstepA, voffA);
            PG8_WAIT_V(8); PG8_WAIT_L(0); PG8_BAR; PG8_MMA(0, 0, At, B0); PG8_MMA(0, 1, At, B1); PG8_BAR; PG8_SCHED;
            PG8_LDA(At, 0, 1); PG8_STAGE(PG8_SB(0, 0), b2, voffB); PG8_STAGE(PG8_SB(0, 1), b2 + hstepB, voffB); PG8_STAGE(PG8_SA(0, 0), a2, voffA);
            PG8_WAIT_V(8); PG8_WAIT_L(0); PG8_BAR; PG8_MMA(1, 0, At, B0); PG8_MMA(1, 1, At, B1); PG8_BAR; PG8_SCHED;
            PG8_LDB(B0, 1, 0); PG8_LDB(B1, 1, 1); PG8_SCHED; PG8_LDA(At, 1, 0); PG8_STAGE(PG8_SA(0, 1), a2 + hstepA, voffA);
            PG8_WAIT_V(8); PG8_WAIT_L(0); PG8_BAR; PG8_MMA(0, 0, At, B0); PG8_MMA(0, 1, At, B1); PG8_BAR; PG8_SCHED;
            PG8_LDA(At, 1, 1); PG8_STAGE(PG8_SB(1, 0), b3, voffB); PG8_STAGE(PG8_SB(1, 1), b3 + hstepB, voffB); PG8_STAGE(PG8_SA(1, 0), a3, voffA);
            PG8_WAIT_V(8); PG8_WAIT_L(0); PG8_BAR; PG8_MMA(1, 0, At, B0); PG8_MMA(1, 1, At, B1); PG8_BAR; PG8_SCHED;
        }
        if (wr == 0) PG8_BAR;
        E(acc, cur, wr, wc, fr, fq);
        if (!has_next) break;
#pragma unroll
        for (int a = 0; a < 2; ++a)
#pragma unroll
            for (int b = 0; b < 2; ++b)
#pragma unroll
                for (int m = 0; m < 4; ++m)
#pragma unroll
                    for (int n = 0; n < 2; ++n) acc[a][b][m][n] = (f32x4){0.f, 0.f, 0.f, 0.f};
        cur = nxt; cA = nA; cB = nB; ++ui;
        if (wr == 1) PG8_BAR;
    }
    PG8_WAIT_V(0);
    PG8_BAR;
#undef PG8_SA
#undef PG8_SB
#undef PG8_STAGE
#undef PG8_LDA
#undef PG8_LDB
#undef PG8_MMA
#undef PG8_WAIT_V
#undef PG8_WAIT_L
#undef PG8_BAR
#undef PG8_SCHED
#undef PG8_UA
#undef PG8_UB
}
}

struct Args { const float* in[29]; float* out; unsigned char* ws; int ph_lo, ph_hi; };
struct Ctx { unsigned char* ws; float* out; int z, tid, bid, G; };

#define MFMA16(a, b, c) __builtin_amdgcn_mfma_f32_16x16x32_bf16((a), (b), (c), 0, 0, 0)

__device__ __forceinline__ void transpose_item(const float* W, int K, int N, bf16_t* WT, int npad, int ksub, LAS float* scr, int item, int lane) {
    const int nblk = N / 32, kb = item / nblk, nb = item % nblk, k0 = 64 * kb, n0 = 32 * nb;
#pragma unroll 8
    for (int i = 0; i < 32; ++i) { const int kk = 2 * i + (lane >> 5); scr[kk * 33 + (lane & 31)] = W[(size_t)(k0 + kk) * N + n0 + (lane & 31)]; }
    asm volatile("s_waitcnt lgkmcnt(0)" ::: "memory");
    const int c = lane & 7;
    const int ks = k0 / ksub, kin = k0 - ks * ksub;
    bf16_t* dbase = WT + (size_t)ks * npad * ksub + kin + 8 * c;
#pragma unroll
    for (int j = 0; j < 4; ++j) { const int n = (lane >> 3) + 8 * j; const LAS float* s = scr + (8 * c) * 33 + n;
        u32x4 o; o.x = pk2(s[0 * 33], s[1 * 33]); o.y = pk2(s[2 * 33], s[3 * 33]); o.z = pk2(s[4 * 33], s[5 * 33]); o.w = pk2(s[6 * 33], s[7 * 33]);
        *(u32x4*)(dbase + (size_t)(n0 + n) * ksub) = o; }
    asm volatile("s_waitcnt lgkmcnt(0)" ::: "memory");
}

struct MatDesc { const float* W; bf16_t* WT; int K, N, npad, ksub, items; };
__device__ __forceinline__ MatDesc get_mat(const Args& a, const Ctx& cx, int mi) {
    MatDesc m; unsigned char* ws = cx.ws;
    if (mi < 4)       { m.W = a.in[13 + cx.z] + (size_t)mi * D * FF; m.WT = (bf16_t*)(ws + WS_WFF1) + (size_t)mi * FF * D; m.K = D; m.N = FF; m.npad = FF; m.ksub = D; }
    else if (mi < 8)  { const int l = mi - 4; m.W = a.in[14 + cx.z] + (size_t)l * FF * D; m.WT = (bf16_t*)(ws + WS_WFF2) + (size_t)l * FF * D; m.K = FF; m.N = D; m.npad = D; m.ksub = FF / 2; }
    else if (mi < 10) { const int i = mi - 8; m.W = a.in[15 + cx.z] + (size_t)i * D * NPROJ; m.WT = (bf16_t*)(ws + WS_WIN) + (size_t)i * NPROJ_PAD * D; m.K = D; m.N = NPROJ; m.npad = NPROJ_PAD; m.ksub = D; }
    else if (mi < 12) { const int i = mi - 10; m.W = a.in[22 + cx.z] + (size_t)i * D * D; m.WT = (bf16_t*)(ws + WS_WOUT) + (size_t)i * D * D; m.K = D; m.N = D; m.npad = D; m.ksub = D / 2; }
    else if (mi < 14) { const int i = mi - 12; m.W = a.in[23 + cx.z] + (size_t)i * D * NDOWN; m.WT = (bf16_t*)(ws + WS_WDOWN) + (size_t)i * NDOWN_PAD * D; m.K = D; m.N = NDOWN; m.npad = NDOWN_PAD; m.ksub = D / 2; }
    else if (mi < 16) { const int i = mi - 14; m.W = a.in[26 + cx.z] + (size_t)i * 384 * 1536; m.WT = (bf16_t*)(ws + WS_WUQ) + (size_t)i * 1536 * 384; m.K = 384; m.N = 1536; m.npad = 1536; m.ksub = 384; }
    else if (mi < 18) { const int i = mi - 16; m.W = a.in[27 + cx.z] + (size_t)i * 256 * 2048; m.WT = (bf16_t*)(ws + WS_WUKV) + (size_t)i * 2048 * 256; m.K = 256; m.N = 2048; m.npad = 2048; m.ksub = 256; }
    else              { const int i = mi - 18; m.W = a.in[28 + cx.z] + (size_t)i * D * D; m.WT = (bf16_t*)(ws + WS_WO) + (size_t)i * D * D; m.K = D; m.N = D; m.npad = D; m.ksub = D / 2; }
    m.items = (m.K / 64) * (m.N / 32);
    return m;
}

__device__ __forceinline__ void prologue(const Args& a, const Ctx& cx, LAS unsigned char* lds) {
    const int tid = cx.tid, lane = tid & 63, wave = tid >> 6, G = cx.G, bid = cx.bid;
    unsigned char* ws = cx.ws;
    {
        LAS float* sc = (LAS float*)lds;
        LAS float* red = (LAS float*)(lds + 12288);
        for (int i = tid; i < 3 * D; i += NTHREADS) { const int g = i >> 10, k = i & 1023; const float v = (g == 0) ? a.in[9 + cx.z][k] : a.in[8 + cx.z][(g - 1) * D + k]; sc[i] = silu_f(v); }
        __syncthreads();
        float* MOD = (float*)(ws + WS_MOD);
        for (int it = bid; it < 4 * 48; it += G) {
            const int l = it / 48, jb = it % 48, jq = tid & 31, kg = tid >> 5, j = jb * 128 + jq * 4;
            const float* wp = a.in[10 + cx.z] + ((size_t)l * D + kg * 64) * 6144 + j;
            f32x4 a0 = {0.f, 0.f, 0.f, 0.f}, a1 = a0, a2 = a0;
#pragma unroll 8
            for (int k = 0; k < 64; ++k) { const f32x4 w = *(const f32x4*)(wp + (size_t)k * 6144); const int kk = kg * 64 + k;
                a0 += w * sc[kk]; a1 += w * sc[D + kk]; a2 += w * sc[2 * D + kk]; }
#pragma unroll
            for (int e = 0; e < 4; ++e) { red[(kg * 3 + 0) * 128 + jq * 4 + e] = a0[e]; red[(kg * 3 + 1) * 128 + jq * 4 + e] = a1[e]; red[(kg * 3 + 2) * 128 + jq * 4 + e] = a2[e]; }
            __syncthreads();
            if (tid < 384) { const int g = tid >> 7, jj = tid & 127; float s = 0.f;
#pragma unroll
                for (int q = 0; q < 16; ++q) s += red[(q * 3 + g) * 128 + jj];
                MOD[((size_t)l * 3 + g) * 6144 + jb * 128 + jj] = s + a.in[11 + cx.z][(size_t)l * 6144 + jb * 128 + jj]; }
            __syncthreads();
        }
    }
    __syncthreads();
    {
        LAS float* scr = (LAS float*)(lds + wave * 16384);
        const int gw = bid * NWAVES + wave, NGW = G * NWAVES;
        int base = 0;
        for (int mi = 0; mi < 20; ++mi) {
            const MatDesc m = get_mat(a, cx, mi);
            int first = (gw - base) % NGW; if (first < 0) first += NGW;
            for (int it = first; it < m.items; it += NGW) transpose_item(m.W, m.K, m.N, m.WT, m.npad, m.ksub, scr, it, lane);
            base += m.items;
        }
    }
    {
        const size_t gt = (size_t)bid * NTHREADS + tid, NGT = (size_t)G * NTHREADS;
        for (int i = 0; i < 2; ++i) {
            u32x4* z1 = (u32x4*)((bf16_t*)(ws + WS_WIN) + (size_t)i * NPROJ_PAD * D + (size_t)NPROJ * D);
            for (size_t x = gt; x < (size_t)(NPROJ_PAD - NPROJ) * D / 8; x += NGT) z1[x] = (u32x4){0u, 0u, 0u, 0u};
            for (int ks = 0; ks < 2; ++ks) {
                u32x4* z2 = (u32x4*)((bf16_t*)(ws + WS_WDOWN) + (size_t)i * NDOWN_PAD * D + (size_t)ks * NDOWN_PAD * (D / 2) + (size_t)NDOWN * (D / 2));
                for (size_t x = gt; x < (size_t)(NDOWN_PAD - NDOWN) * (D / 2) / 8; x += NGT) z2[x] = (u32x4){0u, 0u, 0u, 0u}; }
        }
        f32x2* tab64 = (f32x2*)(ws + WS_TAB); f32x2* tab32 = tab64 + 64 * 16;
        for (size_t x = gt; x < 64 * 16; x += NGT) { const int pos = (int)x >> 4, f = (int)x & 15; const float inv = powf(10000.f, -(float)f / 16.f); const float ang = (float)pos * inv; tab64[x] = (f32x2){cosf(ang), sinf(ang)}; }
        for (size_t x = gt; x < 64 * 8; x += NGT) { const int pos = (int)x >> 3, f = (int)x & 7; const float inv = powf(10000.f, -(float)f / 8.f); const float ang = (float)pos * inv; tab32[x] = (f32x2){cosf(ang), sinf(ang)}; }
        bf16_t* csk = (bf16_t*)(ws + WS_CSK); bf16_t* csv = (bf16_t*)(ws + WS_CSV);
        for (size_t x = gt; x < (size_t)2 * 2 * 512 * 128 / 4; x += NGT) {
            const size_t e = x * 4; const int b = (int)(e / (2 * 65536)), i = (int)(e / 65536) & 1; const size_t r = e % 65536;
            const size_t d = ((size_t)(i * 2 + b)) * 65536 + r;
            const f32x4 k = *(const f32x4*)(a.in[4 + cx.z] + e), v = *(const f32x4*)(a.in[5 + cx.z] + e);
            *(u32x2*)(csk + d) = (u32x2){pk2(k[0], k[1]), pk2(k[2], k[3])};
            *(u32x2*)(csv + d) = (u32x2){pk2(v[0], v[1]), pk2(v[2], v[3])};
        }
    }
}

__device__ __forceinline__ int mod_group(int r) { return r < TP ? 0 : 1 + ((r - TP) >> 10); }

__device__ __forceinline__ void pre_rows(const Args& a, const Ctx& cx, int l) {
    const int lane = cx.tid & 63, gw = cx.bid * NWAVES + (cx.tid >> 6), NGW = cx.G * NWAVES;
    const float* MOD = (const float*)(cx.ws + WS_MOD) + (size_t)l * 3 * 6144;
    const float* gA = a.in[12 + cx.z] + (size_t)l * 4 * D;
    bf16_t* H = (bf16_t*)(cx.ws + WS_H);
    for (int r = gw; r < T; r += NGW) {
        const float* xr = (r < TP) ? a.in[0 + cx.z] + (size_t)r * D : a.in[1 + cx.z] + (size_t)(r - TP) * D;
        const float* m = MOD + (size_t)mod_group(r) * 6144;
        f32x4 v[4]; float s = 0.f;
#pragma unroll
        for (int j = 0; j < 4; ++j) { v[j] = *(const f32x4*)(xr + lane * 4 + 256 * j); s += v[j][0] * v[j][0] + v[j][1] * v[j][1] + v[j][2] * v[j][2] + v[j][3] * v[j][3]; }
        const float rstd = rsqrtf(wave_sum(s) * (1.f / D) + EPS);
#pragma unroll
        for (int j = 0; j < 4; ++j) { const int c = lane * 4 + 256 * j;
            const f32x4 g = *(const f32x4*)(gA + c), sh = *(const f32x4*)(m + c), scl = *(const f32x4*)(m + D + c);
            const f32x4 h = v[j] * rstd * g * (scl + 1.f) + sh;
            *(u32x2*)(H + (size_t)r * D + c) = (u32x2){pk2(h[0], h[1]), pk2(h[2], h[3])}; }
    }
}

__device__ __forceinline__ void post_rows(const Args& a, const Ctx& cx, bool x_from_input, const float* gate_base  , const float* gB,
                                          bool has_next, const float* gC, const float* shift_base, const float* scale_base) {
    const int lane = cx.tid & 63, gw = cx.bid * NWAVES + (cx.tid >> 6), NGW = cx.G * NWAVES;
    const float* OUT = (const float*)(cx.ws + WS_OUT);
    bf16_t* H = (bf16_t*)(cx.ws + WS_H);
    for (int r = gw; r < T; r += NGW) {
        const float* xr = x_from_input ? ((r < TP) ? a.in[0 + cx.z] + (size_t)r * D : a.in[1 + cx.z] + (size_t)(r - TP) * D) : cx.out + (size_t)r * D;
        const size_t mg = (size_t)mod_group(r) * 6144;
        f32x4 o[4], x[4]; float s = 0.f;
#pragma unroll
        for (int j = 0; j < 4; ++j) { const int c = lane * 4 + 256 * j;
            o[j] = *(const f32x4*)(OUT + (size_t)r * D + c) + *(const f32x4*)(OUT + OUT_SPLIT + (size_t)r * D + c);
            x[j] = *(const f32x4*)(xr + c);
            s += o[j][0] * o[j][0] + o[j][1] * o[j][1] + o[j][2] * o[j][2] + o[j][3] * o[j][3]; }
        const float rstd = rsqrtf(wave_sum(s) * (1.f / D) + EPS);
        float s2 = 0.f;
#pragma unroll
        for (int j = 0; j < 4; ++j) { const int c = lane * 4 + 256 * j;
            const f32x4 g = *(const f32x4*)(gB + c), gt = *(const f32x4*)(gate_base + mg + c);
            x[j] = x[j] + gt * (o[j] * rstd * g);
            *(f32x4*)(cx.out + (size_t)r * D + c) = x[j];
            s2 += x[j][0] * x[j][0] + x[j][1] * x[j][1] + x[j][2] * x[j][2] + x[j][3] * x[j][3]; }
        if (has_next) {
            const float rstd2 = rsqrtf(wave_sum(s2) * (1.f / D) + EPS);
#pragma unroll
            for (int j = 0; j < 4; ++j) { const int c = lane * 4 + 256 * j;
                const f32x4 g = *(const f32x4*)(gC + c), sh = *(const f32x4*)(shift_base + mg + c), scl = *(const f32x4*)(scale_base + mg + c);
                const f32x4 h = x[j] * rstd2 * g * (scl + 1.f) + sh;
                *(u32x2*)(H + (size_t)r * D + c) = (u32x2){pk2(h[0], h[1]), pk2(h[2], h[3])}; }
        }
    }
}

__device__ __forceinline__ void mla_mid(const Args& a, const Ctx& cx, int i) {
    const int lane = cx.tid & 63, gw = cx.bid * NWAVES + (cx.tid >> 6), NGW = cx.G * NWAVES;
    const float* DOWN = (const float*)(cx.ws + WS_OUT);
    bf16_t* CQ = (bf16_t*)(cx.ws + WS_CQ); bf16_t* CKV = (bf16_t*)(cx.ws + WS_CKV); bf16_t* KR = (bf16_t*)(cx.ws + WS_KR);
    const float* gq = a.in[24 + cx.z] + (size_t)i * 384; const float* gkv = a.in[25 + cx.z] + (size_t)i * 256;
    const f32x2* tab32 = (const f32x2*)(cx.ws + WS_TAB) + 64 * 16;
    for (int r = gw; r < T + 1024; r += NGW) {
        if (r < T) {
            const float* dr = DOWN + (size_t)r * NDOWN_PAD;
            float q[6]; float s = 0.f;
#pragma unroll
            for (int j = 0; j < 6; ++j) { q[j] = dr[lane + 64 * j] + dr[DOWN_SPLIT + lane + 64 * j]; s += q[j] * q[j]; }
            const float rq = rsqrtf(wave_sum(s) * (1.f / 384.f) + EPS);
#pragma unroll
            for (int j = 0; j < 6; ++j) CQ[(size_t)r * 384 + lane + 64 * j] = (bf16_t)f2bf(q[j] * rq * gq[lane + 64 * j]);
            float kv[4]; s = 0.f;
#pragma unroll
            for (int j = 0; j < 4; ++j) { kv[j] = dr[384 + lane + 64 * j] + dr[DOWN_SPLIT + 384 + lane + 64 * j]; s += kv[j] * kv[j]; }
            const float rk = rsqrtf(wave_sum(s) * (1.f / 256.f) + EPS);
#pragma unroll
            for (int j = 0; j < 4; ++j) { const float v = kv[j] * rk * gkv[lane + 64 * j]; CKV[(size_t)r * 256 + lane + 64 * j] = (bf16_t)f2bf(v);
                if (r < TP) { const int b = r >> 8, t = r & 255; cx.out[O_CKV + ((size_t)((b * 2 + i) * 256 + t)) * 256 + lane + 64 * j] = v; } }
            if (lane < 32) {
                const float kr = dr[640 + lane] + dr[DOWN_SPLIT + 640 + lane];
                if (r < TP) { const int b = r >> 8, t = r & 255; cx.out[O_CKR + ((size_t)((b * 2 + i) * 256 + t)) * 32 + lane] = kr; KR[(size_t)r * 32 + lane] = (bf16_t)f2bf(kr); }
                else {
                    const int t = (r - TP) & 1023, half = lane >> 4, p = (lane >> 3) & 1, f = lane & 7, pos = half ? (t & 63) : (t >> 6);
                    const float other = dr[640 + (lane ^ 8)] + dr[DOWN_SPLIT + 640 + (lane ^ 8)];
                    const f32x2 cs = tab32[pos * 8 + f];
                    const float v = p ? (other * cs[1] + kr * cs[0]) : (kr * cs[0] - other * cs[1]);
                    KR[(size_t)r * 32 + lane] = (bf16_t)f2bf(v);
                }
            }
        } else {
            const int rr = r - T, b = rr >> 9, j = rr & 511;
            const float* src = a.in[6 + cx.z] + ((size_t)((b * 2 + i) * 512 + j)) * 256;
#pragma unroll
            for (int q = 0; q < 4; ++q) CKV[(size_t)r * 256 + lane + 64 * q] = (bf16_t)f2bf(src[lane + 64 * q]);
            if (lane < 32) KR[(size_t)r * 32 + lane] = (bf16_t)f2bf(a.in[7 + cx.z][((size_t)((b * 2 + i) * 512 + j)) * 32 + lane]);
        }
    }
}

struct KSeg { const bf16_t* K; int kstride; const bf16_t* K2; int k2stride; const bf16_t* V; int vstride; int k_lo, k_hi; int rope; int mask; };
struct AttnArgs { const bf16_t* Q; int qstride; int qpos0; int qrope  ; int nseg; KSeg seg0, seg1;
                  float m0, l0, scale; bf16_t* O; int ostride; const f32x2* tab64; const f32x2* tab32; };

__device__ __forceinline__ u32x4 rope8(const u32x4 own, const u32x4 partner, int p, const f32x2* tab) {
    float a[8], b[8], o[8]; unpack8(own, a); unpack8(partner, b);
#pragma unroll
    for (int e = 0; e < 8; ++e) { const f32x2 cs = tab[e]; o[e] = p ? (b[e] * cs[1] + a[e] * cs[0]) : (a[e] * cs[0] - b[e] * cs[1]); }
    return pack8(o);
}

template <int DQK>
__device__ __forceinline__ void attn_unit(LAS unsigned char* lds, const AttnArgs& A, const int tid) {
    constexpr int QS = DQK + 8, NCH = DQK / 8, NKS = DQK / 32, KCH = 64 * NCH, KPT = (KCH + NTHREADS - 1) / NTHREADS;
    LAS bf16_t* Qs = (LAS bf16_t*)lds;
    LAS bf16_t* Ks = Qs + 128 * QS;
    LAS bf16_t* VT = Ks + 2 * 64 * QS;
    const int lane = tid & 63, w = tid >> 6, fr = lane & 15, fq = lane >> 4;
    const int n0 = (A.seg0.k_hi - A.seg0.k_lo) >> 6, n1 = (A.nseg > 1) ? ((A.seg1.k_hi - A.seg1.k_lo) >> 6) : 0, ntiles = n0 + n1;
    int kkey[KPT], kch[KPT];
#pragma unroll
    for (int i = 0; i < KPT; ++i) { const int c = tid + i * NTHREADS; kkey[i] = c / NCH; kch[i] = c % NCH; }
    const int vkey = tid & 63, vch = tid >> 6;
    u32x4 kr[KPT], kp[KPT], vr; int pf_kt = 0, pf_rope = 0, pf_mask = 0;
#define ATT_PREFETCH(j) do { const bool s0_ = (j) < n0; const KSeg S = s0_ ? A.seg0 : A.seg1; const int kt = s0_ ? (A.seg0.k_lo + 64 * (j)) : (A.seg1.k_lo + 64 * ((j) - n0)); \
        _Pragma("unroll") for (int i = 0; i < KPT; ++i) if (tid + i * NTHREADS < KCH) { const int d0 = kch[i] * 8; \
            if (DQK == 96 && kch[i] >= 8) kr[i] = *(const u32x4*)(S.K2 + (size_t)(kt + kkey[i]) * S.k2stride + (d0 - 64)); \
            else { const bf16_t* src = S.K + (size_t)(kt + kkey[i]) * S.kstride; kr[i] = *(const u32x4*)(src + d0); if (DQK == 64 && S.rope) kp[i] = *(const u32x4*)(src + (d0 ^ 16)); } } \
        vr = *(const u32x4*)(S.V + (size_t)(kt + vkey) * S.vstride + vch * 8); pf_kt = kt; pf_rope = S.rope; pf_mask = S.mask; } while (0)
#define ATT_WRITE(buf) do { LAS bf16_t* Kb = Ks + (buf) * 64 * QS; LAS bf16_t* Vb = VT + (buf) * 64 * 72; \
        _Pragma("unroll") for (int i = 0; i < KPT; ++i) if (tid + i * NTHREADS < KCH) { u32x4 v = kr[i]; \
            if (DQK == 64 && pf_rope) { const int t = pf_kt + kkey[i], ch = kch[i], half = ch >> 2, p = (ch >> 1) & 1, f0 = (ch & 1) * 8, pos = half ? (t & 63) : (t >> 6); v = rope8(v, kp[i], p, A.tab64 + pos * 16 + f0); } \
            *(LAS u32x4*)(Kb + kkey[i] * QS + kch[i] * 8) = v; } \
        { LAS bf16_t* dst = Vb + (vch * 8) * 72 + vkey; const u32x4 v = vr; \
          dst[0 * 72] = (bf16_t)(v.x & 0xffff); dst[1 * 72] = (bf16_t)(v.x >> 16); dst[2 * 72] = (bf16_t)(v.y & 0xffff); dst[3 * 72] = (bf16_t)(v.y >> 16); \
          dst[4 * 72] = (bf16_t)(v.z & 0xffff); dst[5 * 72] = (bf16_t)(v.z >> 16); dst[6 * 72] = (bf16_t)(v.w & 0xffff); dst[7 * 72] = (bf16_t)(v.w >> 16); } } while (0)
    ATT_PREFETCH(0);
    __syncthreads();
    for (int c = tid; c < 128 * NCH; c += NTHREADS) {
        const int qi = c / NCH, ch = c % NCH, d0 = ch * 8;
        const bf16_t* src = A.Q + (size_t)qi * A.qstride;
        u32x4 v = *(const u32x4*)(src + d0);
        const int t = A.qpos0 + qi;
        if (A.qrope == 1) { const int half = ch >> 2, p = (ch >> 1) & 1, f0 = (ch & 1) * 8, pos = half ? (t & 63) : (t >> 6);
            const u32x4 pv = *(const u32x4*)(src + (d0 ^ 16)); v = rope8(v, pv, p, A.tab64 + pos * 16 + f0); }
        else if (A.qrope == 2 && ch >= 8) { const int c2 = ch - 8, half = c2 >> 1, p = c2 & 1, pos = half ? (t & 63) : (t >> 6);
            const u32x4 pv = *(const u32x4*)(src + 64 + ((c2 ^ 1) * 8)); v = rope8(v, pv, p, A.tab32 + pos * 8); }
        *(LAS u32x4*)(Qs + qi * QS + d0) = v;
    }
    ATT_WRITE(0);
    int cur_kt = pf_kt, cur_mask = pf_mask;
    if (ntiles > 1) ATT_PREFETCH(1);
    __syncthreads();
    bf16x8 Qf[NKS];
#pragma unroll
    for (int ks = 0; ks < NKS; ++ks) Qf[ks] = *(const LAS bf16x8*)(Qs + (w * 16 + fr) * QS + ks * 32 + fq * 8);
    float m = A.m0, l = A.l0;
    f32x4 Oa[4];
#pragma unroll
    for (int dt = 0; dt < 4; ++dt) Oa[dt] = (f32x4){0.f, 0.f, 0.f, 0.f};
    const int qp = A.qpos0 + w * 16 + fr;
    for (int j = 0; j < ntiles; ++j) {
        const LAS bf16_t* Kb = Ks + (j & 1) * 64 * QS; const LAS bf16_t* Vb = VT + (j & 1) * 64 * 72;
        f32x4 st[4];
#pragma unroll
        for (int nt = 0; nt < 4; ++nt) { st[nt] = (f32x4){0.f, 0.f, 0.f, 0.f};
#pragma unroll
            for (int ks = 0; ks < NKS; ++ks) { const bf16x8 kf = *(const LAS bf16x8*)(Kb + (nt * 16 + fr) * QS + ks * 32 + fq * 8); st[nt] = MFMA16(kf, Qf[ks], st[nt]); } }
        float mx = -1e30f;
#pragma unroll
        for (int nt = 0; nt < 4; ++nt)
#pragma unroll
            for (int jj = 0; jj < 4; ++jj) { float sc = st[nt][jj] * A.scale;
                if (cur_mask) { const int kpos = cur_kt + nt * 16 + fq * 4 + jj; const int dd = qp - kpos; if (dd > 128 || dd < -128) sc = -1e30f; }
                st[nt][jj] = sc; mx = fmaxf(mx, sc); }
        mx = fmaxf(mx, __shfl_xor(mx, 16)); mx = fmaxf(mx, __shfl_xor(mx, 32));
        const float mn = fmaxf(m, mx), alpha = __expf(m - mn);
        float rs = 0.f;
#pragma unroll
        for (int nt = 0; nt < 4; ++nt)
#pragma unroll
            for (int jj = 0; jj < 4; ++jj) { const float pe = __expf(st[nt][jj] - mn); st[nt][jj] = pe; rs += pe; }
        rs += __shfl_xor(rs, 16); rs += __shfl_xor(rs, 32);
        l = l * alpha + rs; m = mn;
#pragma unroll
        for (int dt = 0; dt < 4; ++dt) Oa[dt] = Oa[dt] * alpha;
#pragma unroll
        for (int kk = 0; kk < 2; ++kk) {
            u32x4 pb; pb.x = pk2(st[2 * kk][0], st[2 * kk][1]); pb.y = pk2(st[2 * kk][2], st[2 * kk][3]); pb.z = pk2(st[2 * kk + 1][0], st[2 * kk + 1][1]); pb.w = pk2(st[2 * kk + 1][2], st[2 * kk + 1][3]);
            const bf16x8 pf = __builtin_bit_cast(bf16x8, pb);
#pragma unroll
            for (int dt = 0; dt < 4; ++dt) {
                const LAS bf16_t* vp = Vb + (dt * 16 + fr) * 72 + 32 * kk + fq * 4;
                const u32x2 v0 = *(const LAS u32x2*)vp, v1 = *(const LAS u32x2*)(vp + 16);
                const u32x4 vv = {v0.x, v0.y, v1.x, v1.y};
                Oa[dt] = MFMA16(__builtin_bit_cast(bf16x8, vv), pf, Oa[dt]);
            }
        }
        if (j + 1 < ntiles) { ATT_WRITE((j + 1) & 1); cur_kt = pf_kt; cur_mask = pf_mask; if (j + 2 < ntiles) ATT_PREFETCH(j + 2); }
        __syncthreads();
    }
#undef ATT_PREFETCH
#undef ATT_WRITE
    const float inv = 1.f / l;
    bf16_t* op = A.O + (size_t)(w * 16 + fr) * A.ostride + fq * 4;
#pragma unroll
    for (int dt = 0; dt < 4; ++dt) *(u32x2*)(op + dt * 16) = (u32x2){pk2(Oa[dt][0] * inv, Oa[dt][1] * inv), pk2(Oa[dt][2] * inv, Oa[dt][3] * inv)};
}

__device__ __forceinline__ void swa_unit(const Args& a, const Ctx& cx, LAS unsigned char* lds, int i, int u) {
    const bf16_t* PROJ = (const bf16_t*)(cx.ws + WS_PROJ); bf16_t* MIX = (bf16_t*)(cx.ws + WS_MIX);
    AttnArgs A;
    A.tab64 = (const f32x2*)(cx.ws + WS_TAB); A.tab32 = A.tab64 + 64 * 16;
    A.qstride = NPROJ_PAD; A.ostride = D; A.scale = 0.125f; A.l0 = 1.f;
    if (u < 128) {
        const int b = u >> 6, hq = (u >> 3) & 7, qt = u & 7, kv = hq >> 2, row0 = TP + b * 1024, q0 = qt * 128;
        A.Q = PROJ + (size_t)(row0 + q0) * NPROJ_PAD + C_QB + hq * 64; A.qpos0 = q0; A.qrope = 1; A.nseg = 2;
        A.m0 = a.in[21 + cx.z][i * 8 + hq];
        const bf16_t* csk = (const bf16_t*)(cx.ws + WS_CSK) + ((size_t)(i * 2 + b)) * 65536 + kv * 64;
        const bf16_t* csv = (const bf16_t*)(cx.ws + WS_CSV) + ((size_t)(i * 2 + b)) * 65536 + kv * 64;
        A.seg0 = KSeg{csk, 128, nullptr, 0, csv, 128, 0, 512, 0, 0};
        const int lo = q0 - 128 < 0 ? 0 : q0 - 128, hi = q0 + 256 > 1024 ? 1024 : q0 + 256;
        A.seg1 = KSeg{PROJ + (size_t)row0 * NPROJ_PAD + C_KB + kv * 64, NPROJ_PAD, nullptr, 0, PROJ + (size_t)row0 * NPROJ_PAD + C_VB + kv * 64, NPROJ_PAD, lo, hi, 1, 1};
        A.O = MIX + (size_t)(row0 + q0) * D + 512 + hq * 64;
    } else {
        const int v = u - 128, b = v >> 4, hq = (v >> 1) & 7, qt = v & 1, kv = hq >> 2, row0 = b * 256, q0 = qt * 128;
        A.Q = PROJ + (size_t)(row0 + q0) * NPROJ_PAD + C_QB + hq * 64; A.qpos0 = q0; A.qrope = 0; A.nseg = 1;
        A.m0 = a.in[21 + cx.z][i * 8 + hq];
        A.seg0 = KSeg{PROJ + (size_t)row0 * NPROJ_PAD + C_KB + kv * 64, NPROJ_PAD, nullptr, 0, PROJ + (size_t)row0 * NPROJ_PAD + C_VB + kv * 64, NPROJ_PAD, 0, 256, 0, 0};
        A.seg1 = A.seg0;
        A.O = MIX + (size_t)(row0 + q0) * D + 512 + hq * 64;
    }
    attn_unit<64>(lds, A, cx.tid);
}

__device__ __forceinline__ void mla_unit(const Args& a, const Ctx& cx, LAS unsigned char* lds, int u) {
    const bf16_t* Q = (const bf16_t*)(cx.ws + WS_Q); const bf16_t* KVX = (const bf16_t*)(cx.ws + WS_KVX); const bf16_t* KR = (const bf16_t*)(cx.ws + WS_KR);
    bf16_t* MIX = (bf16_t*)(cx.ws + WS_MIX);
    AttnArgs A;
    A.tab64 = (const f32x2*)(cx.ws + WS_TAB); A.tab32 = A.tab64 + 64 * 16;
    A.qstride = 1536; A.ostride = D; A.scale = 0.10206207261596577f; A.l0 = 0.f; A.m0 = -1e30f;
    if (u < 256) {
        const int b = u >> 7, h = (u >> 3) & 15, qt = u & 7, row0 = TP + b * 1024, q0 = qt * 128, crow0 = T + b * 512;
        A.Q = Q + (size_t)(row0 + q0) * 1536 + h * 96; A.qpos0 = q0; A.qrope = 2; A.nseg = 2;
        A.seg0 = KSeg{KVX + (size_t)crow0 * 2048 + h * 128, 2048, KR + (size_t)crow0 * 32, 32, KVX + (size_t)crow0 * 2048 + h * 128 + 64, 2048, 0, 512, 0, 0};
        A.seg1 = KSeg{KVX + (size_t)row0 * 2048 + h * 128, 2048, KR + (size_t)row0 * 32, 32, KVX + (size_t)row0 * 2048 + h * 128 + 64, 2048, 0, 1024, 0, 0};
        A.O = MIX + (size_t)(row0 + q0) * D + h * 64;
    } else {
        const int v = u - 256, b = v >> 5, h = (v >> 1) & 15, qt = v & 1, row0 = b * 256, q0 = qt * 128;
        A.Q = Q + (size_t)(row0 + q0) * 1536 + h * 96; A.qpos0 = q0; A.qrope = 0; A.nseg = 1;
        A.seg0 = KSeg{KVX + (size_t)row0 * 2048 + h * 128, 2048, KR + (size_t)row0 * 32, 32, KVX + (size_t)row0 * 2048 + h * 128 + 64, 2048, 0, 256, 0, 0};
        A.seg1 = A.seg0;
        A.O = MIX + (size_t)(row0 + q0) * D + h * 64;
    }
    attn_unit<96>(lds, A, cx.tid);
}

constexpr int GL_G = 0;
constexpr int GL_STF = 32768, GL_STB = 51200;
constexpr int GL_LO = 32768, GL_WF = 40960, GL_WB = 45056, GL_BF = 49152, GL_BB = 49408;
constexpr int GL_QF = 69632, GL_KF = 78848, GL_QB = 88064, GL_KB = 97280;
constexpr int GL_VT = 106496;
constexpr int GL_AF = 124928, GL_AB = 134144;

__device__ __forceinline__ void gla_gates(const Args& a, const Ctx& cx, LAS unsigned char* lds, int i, int tok0, int h) {
    const int tid = cx.tid;
    const bf16_t* PROJ = (const bf16_t*)(cx.ws + WS_PROJ);
    LAS float* LO = (LAS float*)(lds + GL_LO); LAS float* WF = (LAS float*)(lds + GL_WF); LAS float* WB = (LAS float*)(lds + GL_WB);
    LAS float* BF = (LAS float*)(lds + GL_BF); LAS float* BB = (LAS float*)(lds + GL_BB);
    LAS float* Gf = (LAS float*)(lds + GL_G); LAS float* Gb = Gf + 4096;
    { const int t = tid >> 3, j0 = (tid & 7) * 4; const u32x2 v = *(const u32x2*)(PROJ + (size_t)(tok0 + t) * NPROJ_PAD + C_LO + j0);
      LO[t * 32 + j0] = bflo(v.x); LO[t * 32 + j0 + 1] = bfhi(v.x); LO[t * 32 + j0 + 2] = bflo(v.y); LO[t * 32 + j0 + 3] = bfhi(v.y); }
    for (int x = tid; x < 1024; x += NTHREADS) { const int r = x >> 6, d = x & 63;
        WF[x] = a.in[16 + cx.z][((size_t)i * 16 + r) * 256 + h * 64 + d]; WB[x] = a.in[18 + cx.z][((size_t)i * 16 + r) * 256 + h * 64 + d]; }
    if (tid < 64) { BF[tid] = a.in[17 + cx.z][i * 256 + h * 64 + tid]; BB[tid] = a.in[19 + cx.z][i * 256 + h * 64 + tid]; }
    __syncthreads();
    { const int d = tid & 63, tg = tid >> 6;
      LAS float* SEG = (LAS float*)(lds + GL_LO + 8192 + 8192 + 1024);
      float wf[16], wb[16];
#pragma unroll
      for (int r = 0; r < 16; ++r) { wf[r] = WF[r * 64 + d]; wb[r] = WB[r * 64 + d]; }
      const float bfv = BF[d], bbv = BB[d];
      float gf[8], gb[8];
#pragma unroll
      for (int tt = 0; tt < 8; ++tt) { const int t = tg * 8 + tt; float xf = bfv, xb = bbv;
#pragma unroll
          for (int r = 0; r < 16; ++r) { xf += LO[t * 32 + r] * wf[r]; xb += LO[t * 32 + 16 + r] * wb[r]; }
          gf[tt] = (fminf(xf, 0.f) - log1pf(__expf(-fabsf(xf)))) * (1.f / 16.f); gb[tt] = (fminf(xb, 0.f) - log1pf(__expf(-fabsf(xb)))) * (1.f / 16.f); }
#pragma unroll
      for (int tt = 1; tt < 8; ++tt) gf[tt] += gf[tt - 1];
#pragma unroll
      for (int tt = 6; tt >= 0; --tt) gb[tt] += gb[tt + 1];
      SEG[tg * 64 + d] = gf[7]; SEG[512 + tg * 64 + d] = gb[0];
      __syncthreads();
      float offf = 0.f, offb = 0.f;
#pragma unroll
      for (int q = 0; q < 8; ++q) { const float a_ = SEG[q * 64 + d], b_ = SEG[512 + q * 64 + d]; offf += (q < tg) ? a_ : 0.f; offb += (q > tg) ? b_ : 0.f; }
#pragma unroll
      for (int tt = 0; tt < 8; ++tt) { const int t = tg * 8 + tt; Gf[t * 64 + d] = gf[tt] + offf; Gb[t * 64 + d] = gb[tt] + offb; } }
    __syncthreads();
}

__device__ __forceinline__ void gla_load_vt(const bf16_t* PROJ, LAS unsigned char* lds, int tok0, int h, const int tid) {
    const int s = tid & 63, e0 = (tid >> 6) * 16;
    LAS bf16_t* VT = (LAS bf16_t*)(lds + GL_VT);
    const bf16_t* src = PROJ + (size_t)(tok0 + s) * NPROJ_PAD + C_VA + h * 128 + e0;
#pragma unroll
    for (int q = 0; q < 2; ++q) { const u32x4 v = *(const u32x4*)(src + q * 8); LAS bf16_t* dst = VT + (e0 + q * 8) * 72 + s;
        dst[0 * 72] = (bf16_t)(v.x & 0xffff); dst[1 * 72] = (bf16_t)(v.x >> 16); dst[2 * 72] = (bf16_t)(v.y & 0xffff); dst[3 * 72] = (bf16_t)(v.y >> 16);
        dst[4 * 72] = (bf16_t)(v.z & 0xffff); dst[5 * 72] = (bf16_t)(v.z >> 16); dst[6 * 72] = (bf16_t)(v.w & 0xffff); dst[7 * 72] = (bf16_t)(v.w >> 16); }
}

__device__ __forceinline__ void gla_local_unit(const Args& a, const Ctx& cx, LAS unsigned char* lds, int i, int u) {
    const int cg_ = u >> 2, h = u & 3, tok0 = cg_ * 64, tid = cx.tid, lane = tid & 63, w = tid >> 6, fr = lane & 15, fq = lane >> 4;
    const bf16_t* PROJ = (const bf16_t*)(cx.ws + WS_PROJ);
    float* LOC = (float*)(cx.ws + WS_LOC); float* DEC = (float*)(cx.ws + WS_DEC);
    __syncthreads();
    gla_gates(a, cx, lds, i, tok0, h);
    LAS float* Gf = (LAS float*)(lds + GL_G); LAS float* Gb = Gf + 4096;
    LAS bf16_t* KTf = (LAS bf16_t*)(lds + GL_KF); LAS bf16_t* KTb = (LAS bf16_t*)(lds + GL_KB);
    LAS bf16_t* VT = (LAS bf16_t*)(lds + GL_VT);
    { const int s = tid >> 3, d0 = (tid & 7) * 8; const u32x4 kv = *(const u32x4*)(PROJ + (size_t)(tok0 + s) * NPROJ_PAD + C_KA + h * 64 + d0);
      float k[8]; unpack8(kv, k);
#pragma unroll
      for (int e = 0; e < 8; ++e) { const int d = d0 + e;
          KTf[d * 72 + s] = (bf16_t)f2bf(k[e] * __expf(Gf[63 * 64 + d] - Gf[s * 64 + d]));
          KTb[d * 72 + s] = (bf16_t)f2bf(k[e] * __expf(Gb[d] - Gb[s * 64 + d])); } }
    gla_load_vt(PROJ, lds, tok0, h, tid);
    if (tid < 128) { const int dir = tid >> 6, d = tid & 63; DEC[((size_t)(dir * 96 + cg_) * 4 + h) * 64 + d] = __expf(dir ? Gb[d] : Gf[63 * 64 + d]); }
    __syncthreads();
    const int dir = w >> 2, dtile = w & 3;
    const LAS bf16_t* KT = dir ? KTb : KTf;
    bf16x8 af[2];
#pragma unroll
    for (int ks = 0; ks < 2; ++ks) af[ks] = *(const LAS bf16x8*)(KT + (dtile * 16 + fr) * 72 + ks * 32 + fq * 8);
    float* dst = LOC + ((size_t)(dir * 96 + cg_) * 4 + h) * 8192;
#pragma unroll
    for (int et = 0; et < 8; ++et) { f32x4 acc = {0.f, 0.f, 0.f, 0.f};
#pragma unroll
        for (int ks = 0; ks < 2; ++ks) { const bf16x8 bfv = *(const LAS bf16x8*)(VT + (et * 16 + fr) * 72 + ks * 32 + fq * 8); acc = MFMA16(af[ks], bfv, acc); }
#pragma unroll
        for (int j = 0; j < 4; ++j) dst[(dtile * 16 + fq * 4 + j) * 128 + et * 16 + fr] = acc[j]; }
}

__device__ __forceinline__ void gla_out_unit(const Args& a, const Ctx& cx, LAS unsigned char* lds, int i, int u) {
    const int cg_ = u >> 2, h = u & 3, tok0 = cg_ * 64, tid = cx.tid, lane = tid & 63, w = tid >> 6, fr = lane & 15, fq = lane >> 4;
    const bf16_t* PROJ = (const bf16_t*)(cx.ws + WS_PROJ); bf16_t* MIX = (bf16_t*)(cx.ws + WS_MIX);
    const float* LOC = (const float*)(cx.ws + WS_LOC); const float* DEC = (const float*)(cx.ws + WS_DEC);
    __syncthreads();
    gla_gates(a, cx, lds, i, tok0, h);
    LAS float* Gf = (LAS float*)(lds + GL_G); LAS float* Gb = Gf + 4096;
    const bool samp = cg_ >= 64;
    const int b = samp ? (cg_ - 64) >> 4 : cg_ >> 2, c = samp ? (cg_ - 64) & 15 : cg_ & 3, nc = samp ? 16 : 4, cbase = cg_ - c;
    {
        const int d = tid >> 3, e0 = (tid & 7) * 16;
        f32x4 Sf[4], Sb[4];
        if (samp) { const float* s0f = a.in[2 + cx.z] + ((size_t)((b * 2 + i) * 4 + h)) * 8192 + d * 128 + e0; const float* s0b = a.in[3 + cx.z] + ((size_t)((b * 2 + i) * 4 + h)) * 8192 + d * 128 + e0;
#pragma unroll
            for (int q = 0; q < 4; ++q) { Sf[q] = *(const f32x4*)(s0f + q * 4); Sb[q] = *(const f32x4*)(s0b + q * 4); } }
        else {
#pragma unroll
            for (int q = 0; q < 4; ++q) { Sf[q] = (f32x4){0.f, 0.f, 0.f, 0.f}; Sb[q] = Sf[q]; } }
        for (int j = 0; j < c; ++j) { const size_t ix = (size_t)(0 * 96 + cbase + j) * 4 + h; const float dec = DEC[ix * 64 + d]; const float* lp = LOC + ix * 8192 + d * 128 + e0;
#pragma unroll
            for (int q = 0; q < 4; ++q) Sf[q] = Sf[q] * dec + *(const f32x4*)(lp + q * 4); }
        for (int j = nc - 1; j > c; --j) { const size_t ix = (size_t)(1 * 96 + cbase + j) * 4 + h; const float dec = DEC[ix * 64 + d]; const float* lp = LOC + ix * 8192 + d * 128 + e0;
#pragma unroll
            for (int q = 0; q < 4; ++q) Sb[q] = Sb[q] * dec + *(const f32x4*)(lp + q * 4); }
        if (!samp) {
            if (c == nc - 1) { const size_t ix = (size_t)(0 * 96 + cg_) * 4 + h; const float dec = DEC[ix * 64 + d]; const float* lp = LOC + ix * 8192 + d * 128 + e0;
                float* o = cx.out + O_SF + ((size_t)((b * 2 + i) * 4 + h)) * 8192 + d * 128 + e0;
#pragma unroll
                for (int q = 0; q < 4; ++q) *(f32x4*)(o + q * 4) = Sf[q] * dec + *(const f32x4*)(lp + q * 4); }
            if (c == 0) { const size_t ix = (size_t)(1 * 96 + cg_) * 4 + h; const float dec = DEC[ix * 64 + d]; const float* lp = LOC + ix * 8192 + d * 128 + e0;
                float* o = cx.out + O_SB + ((size_t)((b * 2 + i) * 4 + h)) * 8192 + d * 128 + e0;
#pragma unroll
                for (int q = 0; q < 4; ++q) *(f32x4*)(o + q * 4) = Sb[q] * dec + *(const f32x4*)(lp + q * 4); }
        }
        LAS bf16_t* STf = (LAS bf16_t*)(lds + GL_STF); LAS bf16_t* STb = (LAS bf16_t*)(lds + GL_STB);
#pragma unroll
        for (int q = 0; q < 4; ++q)
#pragma unroll
            for (int e = 0; e < 4; ++e) { STf[(e0 + q * 4 + e) * 72 + d] = (bf16_t)f2bf(Sf[q][e]); STb[(e0 + q * 4 + e) * 72 + d] = (bf16_t)f2bf(Sb[q][e]); }
    }
    {
        const int t = tid >> 3, d0 = (tid & 7) * 8;
        const u32x4 qv = *(const u32x4*)(PROJ + (size_t)(tok0 + t) * NPROJ_PAD + C_QA + h * 64 + d0);
        const u32x4 kv = *(const u32x4*)(PROJ + (size_t)(tok0 + t) * NPROJ_PAD + C_KA + h * 64 + d0);
        float q[8], k[8], o1[8], o2[8], o3[8], o4[8]; unpack8(qv, q); unpack8(kv, k);
#pragma unroll
        for (int e = 0; e < 8; ++e) { const float gf = Gf[t * 64 + d0 + e], gb = Gb[t * 64 + d0 + e];
            o1[e] = q[e] * 0.125f * __expf(gf); o2[e] = k[e] * __expf(-gf); o3[e] = q[e] * 0.125f * __expf(gb); o4[e] = k[e] * __expf(-gb); }
        *(LAS u32x4*)((LAS bf16_t*)(lds + GL_QF) + t * 72 + d0) = pack8(o1);
        *(LAS u32x4*)((LAS bf16_t*)(lds + GL_KF) + t * 72 + d0) = pack8(o2);
        *(LAS u32x4*)((LAS bf16_t*)(lds + GL_QB) + t * 72 + d0) = pack8(o3);
        *(LAS u32x4*)((LAS bf16_t*)(lds + GL_KB) + t * 72 + d0) = pack8(o4);
    }
    gla_load_vt(PROJ, lds, tok0, h, tid);
    __syncthreads();
    {
        const int dir = w >> 2, tt = w & 3;
        const LAS bf16_t* Qm = (const LAS bf16_t*)(lds + (dir ? GL_QB : GL_QF)); const LAS bf16_t* Km = (const LAS bf16_t*)(lds + (dir ? GL_KB : GL_KF));
        LAS bf16_t* AT = (LAS bf16_t*)(lds + (dir ? GL_AB : GL_AF));
        bf16x8 af[2];
#pragma unroll
        for (int ks = 0; ks < 2; ++ks) af[ks] = *(const LAS bf16x8*)(Qm + (tt * 16 + fr) * 72 + ks * 32 + fq * 8);
#pragma unroll
        for (int st = 0; st < 4; ++st) { f32x4 acc = {0.f, 0.f, 0.f, 0.f};
#pragma unroll
            for (int ks = 0; ks < 2; ++ks) { const bf16x8 bfv = *(const LAS bf16x8*)(Km + (st * 16 + fr) * 72 + ks * 32 + fq * 8); acc = MFMA16(af[ks], bfv, acc); }
#pragma unroll
            for (int j = 0; j < 4; ++j) { const int t = tt * 16 + fq * 4 + j, s = st * 16 + fr; const bool keep = dir ? (s >= t) : (s <= t);
                AT[t * 72 + s] = (bf16_t)f2bf(keep ? acc[j] : 0.f); } }
    }
    __syncthreads();
    {
        const int tt = w & 3, eg = w >> 2;
        LAS float* OS = (LAS float*)(lds + GL_G);
        const LAS bf16_t* VT = (const LAS bf16_t*)(lds + GL_VT);
        bf16x8 a1[2], a2[2], a3[2], a4[2];
#pragma unroll
        for (int ks = 0; ks < 2; ++ks) { const int off = (tt * 16 + fr) * 72 + ks * 32 + fq * 8;
            a1[ks] = *(const LAS bf16x8*)((const LAS bf16_t*)(lds + GL_QF) + off); a2[ks] = *(const LAS bf16x8*)((const LAS bf16_t*)(lds + GL_AF) + off);
            a3[ks] = *(const LAS bf16x8*)((const LAS bf16_t*)(lds + GL_QB) + off); a4[ks] = *(const LAS bf16x8*)((const LAS bf16_t*)(lds + GL_AB) + off); }
        f32x4 accs[4];
#pragma unroll
        for (int q = 0; q < 4; ++q) { const int et = eg * 4 + q; f32x4 acc = {0.f, 0.f, 0.f, 0.f};
#pragma unroll
            for (int ks = 0; ks < 2; ++ks) { const int off = (et * 16 + fr) * 72 + ks * 32 + fq * 8;
                const bf16x8 b1 = *(const LAS bf16x8*)((const LAS bf16_t*)(lds + GL_STF) + off), b2 = *(const LAS bf16x8*)(VT + off), b3 = *(const LAS bf16x8*)((const LAS bf16_t*)(lds + GL_STB) + off);
                acc = MFMA16(a1[ks], b1, acc); acc = MFMA16(a2[ks], b2, acc); acc = MFMA16(a3[ks], b3, acc); acc = MFMA16(a4[ks], b2, acc); }
            accs[q] = acc; }
#pragma unroll
        for (int q = 0; q < 4; ++q)
#pragma unroll
            for (int j = 0; j < 4; ++j) OS[(tt * 16 + fq * 4 + j) * 128 + (eg * 4 + q) * 16 + fr] = accs[q][j];
    }
    __syncthreads();
    {
        const int t = tid >> 3, e0 = (tid & 7) * 16;
        const LAS float* OS = (const LAS float*)(lds + GL_G);
        float o[16]; float ss = 0.f;
#pragma unroll
        for (int e = 0; e < 16; ++e) { o[e] = OS[t * 128 + e0 + e]; ss += o[e] * o[e]; }
        ss += __shfl_xor(ss, 1); ss += __shfl_xor(ss, 2); ss += __shfl_xor(ss, 4);
        const float rstd = rsqrtf(ss * (1.f / 128.f) + EPS);
        const bf16_t* gp = PROJ + (size_t)(tok0 + t) * NPROJ_PAD + C_GA + h * 128 + e0;
        const float* gg = a.in[20 + cx.z] + i * 128 + e0;
        float gt[16]; unpack8(*(const u32x4*)gp, gt); unpack8(*(const u32x4*)(gp + 8), gt + 8);
#pragma unroll
        for (int e = 0; e < 16; ++e) o[e] = o[e] * rstd * gg[e] * silu_f(gt[e]);
        bf16_t* op = MIX + (size_t)(tok0 + t) * D + h * 128 + e0;
        *(u32x4*)op = pack8(o); *(u32x4*)(op + 8) = pack8(o + 8);
    }
}


#define XB_TMO      128
#define XB_XCNT(j)  (256  + 64 * (j))
#define XB_XSUB(j)  (1280 + 64 * (j))
#define XB_XGEN(j)  (2304 + 64 * (j))
#define XB_TOP      3328
#define XB_TOPGEN   3392
#define XCD_BAR_WORDS 3456
#define XB_SPIN_CAP (1u << 18)
__device__ __forceinline__ unsigned xb_ld(unsigned* p)              { return __hip_atomic_load(p, __ATOMIC_RELAXED, __HIP_MEMORY_SCOPE_AGENT); }
__device__ __forceinline__ unsigned xb_add(unsigned* p, unsigned v) { return __hip_atomic_fetch_add(p, v, __ATOMIC_RELAXED, __HIP_MEMORY_SCOPE_AGENT); }
__device__ __forceinline__ unsigned xb_xcc_id() { return (unsigned)__builtin_amdgcn_s_getreg((3 << 11) | 20) & 0xFu; }
#define XB_SPIN(cond, bar) do { unsigned _sp = 0; while (cond) { __builtin_amdgcn_s_sleep(1); \
    if ((++_sp & 255u) == 0u) { if (xb_ld(&(bar)[XB_TMO])) break; if (_sp > XB_SPIN_CAP) { atomicAdd(&(bar)[XB_TMO], 1u); break; } } } } while (0)
struct XcdBarrier { unsigned* bar; unsigned x; volatile LAS unsigned* st; };
__device__ __forceinline__ XcdBarrier xcd_barrier_post(unsigned* bar, volatile LAS unsigned* st, const int tid) {
    XcdBarrier b; b.bar = bar; b.x = xb_xcc_id(); b.st = st;
    if (tid == 0) (void)xb_add(&bar[XB_XCNT(b.x)], 1u);
    return b;
}
__device__ __forceinline__ void xcd_barrier_complete(unsigned* bar, unsigned x, unsigned& nloc, unsigned& nx) {
    const unsigned G = gridDim.x * gridDim.y * gridDim.z;
    unsigned sum, cnt, mine, sp = 0u;
    for (;;) {
        sum = 0u; cnt = 0u; mine = 0u;
#pragma unroll
        for (unsigned j = 0; j < 16; ++j) { const unsigned c = xb_ld(&bar[XB_XCNT(j)]); sum += c; cnt += (c > 0u) ? 1u : 0u; mine = (j == x) ? c : mine; }
        if (sum == G) break;
        __builtin_amdgcn_s_sleep(1);
        if ((++sp & 255u) == 0u) { if (xb_ld(&bar[XB_TMO])) break; if (sp > XB_SPIN_CAP) { atomicAdd(&bar[XB_TMO], 1u); break; } }
    }
    nloc = mine > 0u ? mine : 1u; nx = cnt > 0u ? cnt : 1u;
}
__device__ __forceinline__ void xcd_barrier(const XcdBarrier& b, const int tid) {
    asm volatile("s_waitcnt vmcnt(0)" ::: "memory");
    __syncthreads();
    if (tid == 0) {
        unsigned* bar = b.bar;
        __builtin_amdgcn_s_waitcnt(0);
        unsigned nloc = b.st[0], nx = b.st[1];
        if (nloc == 0u) { xcd_barrier_complete(bar, b.x, nloc, nx); b.st[0] = nloc; b.st[1] = nx; }
        const unsigned old = xb_add(&bar[XB_XSUB(b.x)], 1u);
        const unsigned gen = old / nloc;
        if (old + 1u == (gen + 1u) * nloc) {
            __builtin_amdgcn_fence(__ATOMIC_RELEASE, "agent");
            asm volatile("s_waitcnt vmcnt(0)" ::: "memory");
            const unsigned og = xb_add(&bar[XB_TOP], 1u);
            const unsigned tg = og / nx;
            if (og + 1u == (tg + 1u) * nx) xb_add(&bar[XB_TOPGEN], 1u);
            else XB_SPIN(xb_ld(&bar[XB_TOPGEN]) == tg, bar);
            __builtin_amdgcn_fence(__ATOMIC_ACQUIRE, "agent");
            xb_add(&bar[XB_XGEN(b.x)], 1u);
            asm volatile("s_waitcnt vmcnt(0)" ::: "memory");
        } else {
            XB_SPIN(xb_ld(&bar[XB_XGEN(b.x)]) == gen, bar);
            __builtin_amdgcn_fence(__ATOMIC_ACQUIRE, "agent");
            asm volatile("s_waitcnt vmcnt(0)" ::: "memory");
        }
    }
    __syncthreads();
}

enum { K_PRO = 0, K_PRE, K_G1, K_A1, K_A2, K_DOWN, K_MID, K_UQKV, K_MLA, K_OUTP, K_POST1, K_FF1, K_FF2, K_POST2 };
constexpr int N_PHASES = 2 + 2 * 8 + 2 * 9;
#ifndef EN_MASK
#define EN_MASK 0xFFFFFFFFu
#endif
#define ENB(k) (((EN_MASK) >> (k)) & 1u)
#ifndef DUP_MASK
#define DUP_MASK 0u
#endif
#ifndef BAR_REPS
#define BAR_REPS 1
#endif

__global__ void __launch_bounds__(NTHREADS, 2) mega_fwd(Args args) {
    extern __shared__ __attribute__((aligned(16))) unsigned char lds_raw[];
    LAS unsigned char* lds = (LAS unsigned char*)lds_raw;
    const int lo = args.ph_lo, hi = args.ph_hi;
    const int wave_s = __builtin_amdgcn_readfirstlane((int)(threadIdx.x >> 6));
#define MY_TID(dst) do { int _l; asm volatile("v_mbcnt_lo_u32_b32 %0, -1, 0\n\tv_mbcnt_hi_u32_b32 %0, -1, %0" : "=v"(_l)); dst = wave_s * 64 + _l; } while (0)
    {
        int tid0; MY_TID(tid0);
        volatile LAS unsigned* bst = (volatile LAS unsigned*)(lds + LDS_BYTES - 64);
        if (tid0 < 2) bst[tid0] = 0u;
        __syncthreads();
        (void)xcd_barrier_post((unsigned*)(args.ws + WS_CTL), bst, tid0);
    }
    for (int p = lo; p < hi; ++p) {
        int kind, l;
        if (p == 0) { kind = K_PRO; l = 0; }
        else if (p == 1) { kind = K_PRE; l = 0; }
        else {
            const int q = p - 2, pair = q / 17, r = q - pair * 17;
            if (r < 8) { l = 2 * pair; kind = (r == 0) ? K_G1 : (r == 1) ? K_A1 : (r == 2) ? K_A2 : (r == 3) ? K_OUTP : (r == 4) ? K_POST1 : (r == 5) ? K_FF1 : (r == 6) ? K_FF2 : K_POST2; }
            else { const int r2 = r - 8; l = 2 * pair + 1; kind = (r2 == 0) ? K_DOWN : (r2 == 1) ? K_MID : (r2 == 2) ? K_UQKV : (r2 == 3) ? K_MLA : (r2 == 4) ? K_OUTP : (r2 == 5) ? K_POST1 : (r2 == 6) ? K_FF1 : (r2 == 7) ? K_FF2 : K_POST2; }
        }
        const int reps = ((DUP_MASK >> kind) & 1u) ? 2 : 1;
        for (int rep = 0; rep < reps; ++rep) {
        if (rep) __syncthreads();
        Ctx cx; cx.ws = args.ws; cx.out = args.out; cx.z = 0; MY_TID(cx.tid); cx.bid = blockIdx.x; cx.G = gridDim.x;
        asm volatile("" : "+s"(cx.ws), "+s"(cx.out), "+s"(cx.z), "+s"(kind), "+s"(l), "+v"(cx.tid), "+s"(cx.bid), "+s"(cx.G));
        unsigned char* ws = cx.ws;
        const int i = l >> 1, G = cx.G, bid = cx.bid;
        switch (kind) {
        case K_PRO: if (ENB(0)) prologue(args, cx, lds); break;
        case K_PRE: if (ENB(1)) pre_rows(args, cx, 0); break;
        case K_G1: if (ENB(2)) {
            pg8::Gemm g{(const bf16_t*)(ws + WS_H), (const bf16_t*)(ws + WS_WIN) + (size_t)i * NPROJ_PAD * D, T, NPROJ_PAD, D, D, D, NPROJ_PAD / 256, 0};
            pg8::StaticOrder S; S.init(T, NPROJ_PAD, G, bid);
            pg8::EpiProj E{(bf16_t*)(ws + WS_PROJ), cx.out, i};
            pg8::gemm_phase<pg8::EpiProj, pg8::StaticOrder>(lds, g, S, E, cx.tid);
        } break;
        case K_A1:
            for (int u = bid; u < 768; u += G) { if (u < 384) { if (ENB(3)) swa_unit(args, cx, lds, i, u); } else { if (ENB(4)) gla_local_unit(args, cx, lds, i, u - 384); } }
            break;
        case K_A2:
            if (G == 256) {
                if (bid < 128) { if (ENB(5)) gla_out_unit(args, cx, lds, i, 256 + bid); }
                else { for (int q = 0; q < 2; ++q) if (ENB(5)) gla_out_unit(args, cx, lds, i, (bid - 128) + 128 * q); }
            } else { for (int u = bid; u < 384; u += G) if (ENB(5)) gla_out_unit(args, cx, lds, i, u); }
            break;
        case K_MID: if (ENB(7)) mla_mid(args, cx, i); break;
        case K_UQKV: if (ENB(8)) {
            for (int s = 0; s < 2; ++s) {
                pg8::Gemm g;
                if (s == 0) g = pg8::Gemm{(const bf16_t*)(ws + WS_CQ), (const bf16_t*)(ws + WS_WUQ) + (size_t)i * 1536 * 384, T, 1536, 384, 384, 384, 6, 0};
                else        g = pg8::Gemm{(const bf16_t*)(ws + WS_CKV), (const bf16_t*)(ws + WS_WUKV) + (size_t)i * 2048 * 256, T + 1024, 2048, 256, 256, 256, 8, 0};
                pg8::StaticOrder S; S.init(g.M, g.N, G, (s == 0 || G != 256) ? bid : ((bid + 144) & 255));
                pg8::EpiBf16<0> E{s == 0 ? (bf16_t*)(ws + WS_Q) : (bf16_t*)(ws + WS_KVX), g.N};
                pg8::gemm_phase<pg8::EpiBf16<0>, pg8::StaticOrder>(lds, g, S, E, cx.tid);
            }
        } break;
        case K_MLA: if (ENB(9)) { for (int u = bid; u < 768; u += G) mla_unit(args, cx, lds, u); } break;
        case K_DOWN: case K_OUTP: case K_FF2: if (ENB(10)) {
            pg8::Gemm g; pg8::EpiF32 E;
            if (kind == K_DOWN) {
                g = pg8::Gemm{(const bf16_t*)(ws + WS_H), (const bf16_t*)(ws + WS_WDOWN) + (size_t)i * NDOWN_PAD * D, T, 2 * NDOWN_PAD, D / 2, D, D / 2, NDOWN_PAD / 256, D / 2};
                E = pg8::EpiF32{(float*)(ws + WS_OUT), NDOWN_PAD, NDOWN_PAD / 256, DOWN_SPLIT};
            } else if (kind == K_OUTP) {
                const bf16_t* Wt = (l & 1) ? (const bf16_t*)(ws + WS_WO) + (size_t)i * D * D : (const bf16_t*)(ws + WS_WOUT) + (size_t)i * D * D;
                g = pg8::Gemm{(const bf16_t*)(ws + WS_MIX), Wt, T, 2 * D, D / 2, D, D / 2, 4, D / 2};
                E = pg8::EpiF32{(float*)(ws + WS_OUT), D, 4, OUT_SPLIT};
            } else {
                g = pg8::Gemm{(const bf16_t*)(ws + WS_U), (const bf16_t*)(ws + WS_WFF2) + (size_t)l * FF * D, T, 2 * D, FF / 2, FF, FF / 2, 4, FF / 2};
                E = pg8::EpiF32{(float*)(ws + WS_OUT), D, 4, OUT_SPLIT};
            }
            pg8::StaticOrder S; S.init(g.M, g.N, G, bid);
            pg8::gemm_phase<pg8::EpiF32, pg8::StaticOrder>(lds, g, S, E, cx.tid);
        } break;
        case K_FF1: if (ENB(12)) {
            pg8::Gemm g{(const bf16_t*)(ws + WS_H), (const bf16_t*)(ws + WS_WFF1) + (size_t)l * FF * D, T, FF, D, D, D, FF / 256, 0};
            pg8::StaticOrder S; S.init(T, FF, G, bid);
            pg8::EpiBf16<1> E{(bf16_t*)(ws + WS_U), FF};
            pg8::gemm_phase<pg8::EpiBf16<1>, pg8::StaticOrder>(lds, g, S, E, cx.tid);
        } break;
        case K_POST1: if (ENB(11)) {
            const float* MODL = (const float*)(ws + WS_MOD) + (size_t)l * 3 * 6144; const float* gN = args.in[12 + cx.z] + (size_t)l * 4 * D;
            post_rows(args, cx, l == 0, MODL + 2 * D, gN + D, true, gN + 2 * D, MODL + 3 * D, MODL + 4 * D);
        } break;
        case K_POST2: if (ENB(14)) {
            const float* MODL = (const float*)(ws + WS_MOD) + (size_t)l * 3 * 6144; const float* gN = args.in[12 + cx.z] + (size_t)l * 4 * D;
            const float* MODN = MODL + 3 * 6144; const float* gNn = gN + 4 * D;
            post_rows(args, cx, false, MODL + 5 * D, gN + 3 * D, l < 3, gNn, MODN, MODN + D);
        } break;
        default: break;
        }
        }
        if (p + 1 < hi) { if (p == lo) cg::this_grid().sync(); else { XcdBarrier xb; xb.bar = (unsigned*)(args.ws + WS_CTL); xb.x = xb_xcc_id(); xb.st = (volatile LAS unsigned*)(lds + LDS_BYTES - 64); int tidb; MY_TID(tidb); for (int br = 0; br < BAR_REPS; ++br) xcd_barrier(xb, tidb); } }
    }
}

extern "C" void kernel_launch(void* const* d_in, const int* in_sizes, int n_in, void* d_out, int out_size, void* d_ws, size_t ws_size, hipStream_t stream) {
    static int grid = 0;
    if (grid == 0) {
        int dev = 0, cus = 0, per_cu = 0;
        hipGetDevice(&dev);
        hipDeviceGetAttribute(&cus, hipDeviceAttributeMultiprocessorCount, dev);
        hipFuncSetAttribute((const void*)mega_fwd, hipFuncAttributeMaxDynamicSharedMemorySize, LDS_BYTES);
        hipOccupancyMaxActiveBlocksPerMultiprocessor(&per_cu, (const void*)mega_fwd, NTHREADS, LDS_BYTES);
        if (per_cu < 1) { fprintf(stderr, "kernel_launch: occupancy query says %d blocks per CU\n", per_cu); per_cu = 1; }
        (void)hipGetLastError();
        grid = cus;
        if (ws_size < 256 * MiB) fprintf(stderr, "kernel_launch: workspace too small (%zu)\n", ws_size);
    }
    (void)hipMemsetAsync((char*)d_ws + WS_CTL, 0, CTL_BYTES, stream);
    Args a{};
    for (int i = 0; i < 29; ++i) a.in[i] = (const float*)d_in[i];
    a.out = (float*)d_out; a.ws = (unsigned char*)d_ws;
#if MK_ONE_LAUNCH
    a.ph_lo = 0; a.ph_hi = N_PHASES;
    void* kargs[] = {&a};
    hipError_t e = hipLaunchCooperativeKernel((const void*)mega_fwd, dim3(grid), dim3(NTHREADS), kargs, LDS_BYTES, stream);
    if (e != hipSuccess) fprintf(stderr, "cooperative launch failed: %s (grid %d)\n", hipGetErrorString(e), grid);
#else
    for (int p = 0; p < N_PHASES; ++p) {
        a.ph_lo = p; a.ph_hi = p + 1;
        hipLaunchKernelGGL(mega_fwd, dim3(grid), dim3(NTHREADS), LDS_BYTES, stream, a);
    }
#endif
}
```

```cpp
#include <hip/hip_runtime.h>
#include <hip/hip_cooperative_groups.h>
#include <cstdio>
#include <cstdint>
namespace cg = cooperative_groups;

#ifndef MK_ONE_LAUNCH
#define MK_ONE_LAUNCH 1
#endif

#define LAS __attribute__((address_space(3)))
#define GAS __attribute__((address_space(1)))
typedef unsigned short bf16_t;
typedef short bf16x8 __attribute__((ext_vector_type(8)));
typedef float f32x4 __attribute__((ext_vector_type(4)));
typedef float f32x2 __attribute__((ext_vector_type(2)));
typedef unsigned u32x4 __attribute__((ext_vector_type(4)));
typedef unsigned u32x2 __attribute__((ext_vector_type(2)));

constexpr int D = 1024, TP = 4096, TS = 2048, T = TP + TS, FF = 4096;
constexpr int NPROJ = 2336, NPROJ_PAD = 2560, NDOWN = 672, NDOWN_PAD = 768;
constexpr int C_QA = 0, C_KA = 256, C_VA = 512, C_GA = 1024, C_LO = 1536, C_QB = 1568, C_KB = 2080, C_VB = 2208;
constexpr float EPS = 1e-6f;
constexpr int NTHREADS = 512, NWAVES = 8;
constexpr int LDS_BYTES = 147456;

constexpr size_t O_X = 0, O_SF = 6291456, O_SB = 7340032, O_CK = 8388608, O_CV = 9437184, O_CKV = 10485760, O_CKR = 12582912;

constexpr size_t MiB = 1u << 20;
constexpr size_t WS_WFF1 = 0, WS_WFF2 = 32 * MiB, WS_WIN = 64 * MiB, WS_WOUT = 74 * MiB, WS_WDOWN = 78 * MiB, WS_WUQ = 81 * MiB,
                 WS_WUKV = 84 * MiB, WS_WO = 86 * MiB, WS_MOD = 90 * MiB, WS_TAB = 91 * MiB, WS_CSK = 92 * MiB, WS_CSV = 93 * MiB,
                 WS_H = 94 * MiB, WS_MIX = 106 * MiB, WS_OUT = 118 * MiB, WS_U = 166 * MiB, WS_PROJ = 214 * MiB, WS_CTL = 250 * MiB;
constexpr size_t CTL_BYTES = 16384;
constexpr size_t WS_LOC = WS_U, WS_DEC = WS_U + 24 * MiB;
constexpr size_t WS_Q = WS_U, WS_KVX = WS_U + 18 * MiB;
constexpr size_t WS_DOWN = WS_PROJ, WS_CQ = WS_PROJ + 18 * MiB, WS_CKV = WS_PROJ + 23 * MiB, WS_KR = WS_PROJ + 27 * MiB;
constexpr size_t OUT_SPLIT = (size_t)T * D;
constexpr size_t DOWN_SPLIT = (WS_DOWN - WS_OUT) / 4;

__device__ __forceinline__ unsigned f2bf(float f) { unsigned u = __builtin_bit_cast(unsigned, f); return (u + 0x7fffu + ((u >> 16) & 1u)) >> 16; }
__device__ __forceinline__ unsigned pk2(float lo, float hi) { return f2bf(lo) | (f2bf(hi) << 16); }
__device__ __forceinline__ float bf2f(unsigned short b) { return __builtin_bit_cast(float, (unsigned)b << 16); }
__device__ __forceinline__ float bflo(unsigned w) { return __builtin_bit_cast(float, w << 16); }
__device__ __forceinline__ float bfhi(unsigned w) { return __builtin_bit_cast(float, w & 0xffff0000u); }
__device__ __forceinline__ void unpack8(const u32x4 v, float* f) {
    f[0] = bflo(v.x); f[1] = bfhi(v.x); f[2] = bflo(v.y); f[3] = bfhi(v.y); f[4] = bflo(v.z); f[5] = bfhi(v.z); f[6] = bflo(v.w); f[7] = bfhi(v.w);
}
__device__ __forceinline__ u32x4 pack8(const float* f) { u32x4 o; o.x = pk2(f[0], f[1]); o.y = pk2(f[2], f[3]); o.z = pk2(f[4], f[5]); o.w = pk2(f[6], f[7]); return o; }
__device__ __forceinline__ float wave_sum(float v) {
#pragma unroll
    for (int o = 1; o < 64; o <<= 1) v += __shfl_xor(v, o);
    return v;
}
__device__ __forceinline__ float xor16_max(float x) { const unsigned u = __builtin_bit_cast(unsigned, x); auto r = __builtin_amdgcn_permlane16_swap(u, u, false, false); return fmaxf(__builtin_bit_cast(float, (unsigned)r[0]), __builtin_bit_cast(float, (unsigned)r[1])); }
__device__ __forceinline__ float xor32_max(float x) { const unsigned u = __builtin_bit_cast(unsigned, x); auto r = __builtin_amdgcn_permlane32_swap(u, u, false, false); return fmaxf(__builtin_bit_cast(float, (unsigned)r[0]), __builtin_bit_cast(float, (unsigned)r[1])); }
__device__ __forceinline__ float xor16_add(float x) { const unsigned u = __builtin_bit_cast(unsigned, x); auto r = __builtin_amdgcn_permlane16_swap(u, u, false, false); return __builtin_bit_cast(float, (unsigned)r[0]) + __builtin_bit_cast(float, (unsigned)r[1]); }
__device__ __forceinline__ float xor32_add(float x) { const unsigned u = __builtin_bit_cast(unsigned, x); auto r = __builtin_amdgcn_permlane32_swap(u, u, false, false); return __builtin_bit_cast(float, (unsigned)r[0]) + __builtin_bit_cast(float, (unsigned)r[1]); }
__device__ __forceinline__ unsigned cvtpk(float lo, float hi) { unsigned r; asm volatile("v_cvt_pk_bf16_f32 %0, %1, %2" : "=v"(r) : "v"(lo), "v"(hi)); return r; }
__device__ __forceinline__ float silu_f(float x) { return x / (1.f + __expf(-x)); }

namespace pg8 {
constexpr int BM = 256, BK = 64, HALF = 128, HTB = HALF * BK * 2, NXCD = 8, WGM = 8;
__host__ __device__ __forceinline__ int lds_byte(int r, int c) { const int st = (r >> 4) * 2 + (c >> 5), rr = r & 15, cc = c & 31, ob = rr * 64 + cc * 2; return st * 1024 + (ob ^ (((ob >> 9) & 1) << 5)); }
__host__ __device__ __forceinline__ void stage_rc(int b, int& R, int& C) { const int st = b / 1024, sb = b % 1024, swz = sb ^ (((sb >> 9) & 1) << 5); R = (st >> 1) * 16 + swz / 64; C = (st & 1) * 32 + (swz % 64) / 2; }
__host__ __device__ __forceinline__ int perm32(int rho) { const int n = rho >> 4, i = rho & 15; return 8 * (i >> 2) + 4 * n + (i & 3); }

struct Unit { int pm, pn; };
struct Gemm { const bf16_t* A; const bf16_t* Bt; int M, N, K, lda, ldb, npn, a_split; };

struct StaticOrder {
    int nM, nN, nwg, G, c;
    __device__ void init(int M, int N, int G_, int c_) { nM = M / BM; nN = N / BM; nwg = nM * nN; G = G_; c = c_; }
    __device__ bool next(int i, Unit& u) const {
        const long L = (long)i * G + c; if (L >= nwg) return false;
        int wgid = (int)L; { const int q = nwg / NXCD, r = nwg % NXCD, xcd = wgid % NXCD, off = wgid / NXCD; wgid = (xcd < r ? xcd * (q + 1) : r * (q + 1) + (xcd - r) * q) + off; }
        const int nig = WGM * nN, gid = wgid / nig, fm = gid * WGM, gsz = (nM - fm) < WGM ? (nM - fm) : WGM;
        u.pm = fm + ((wgid % nig) % gsz); u.pn = (wgid % nig) / gsz; return true;
    }
};

__device__ __forceinline__ unsigned cvt_pk_bf16(float lo, float hi) { unsigned r; asm volatile("v_cvt_pk_bf16_f32 %0, %1, %2" : "=v"(r) : "v"(lo), "v"(hi)); return r; }

template <int ACT  > struct EpiBf16 {
    static constexpr bool PERM = true;
    bf16_t* O; int ldc;
    __device__ __forceinline__ void operator()(const f32x4 (&acc)[2][2][4][2], const Unit& u, int wr, int wc, int fr, int fq) const {
        const int row0 = u.pm * BM + wr * 64 + fr, col0 = u.pn * BM + wc * 32 + 8 * fq;
#pragma unroll
        for (int ai = 0; ai < 2; ++ai)
#pragma unroll
            for (int m = 0; m < 4; ++m) { __builtin_amdgcn_sched_barrier(0); bf16_t* rowp = O + (size_t)(row0 + ai * HALF + m * 16) * ldc + col0;
#pragma unroll
                for (int bj = 0; bj < 2; ++bj) { f32x4 v0 = acc[ai][bj][m][0], v1 = acc[ai][bj][m][1];
                    if (ACT == 1) {
#pragma unroll
                        for (int j = 0; j < 4; ++j) { float a = fmaxf(v0[j], 0.f), b = fmaxf(v1[j], 0.f); v0[j] = a * a; v1[j] = b * b; } }
                    u32x4 w; w.x = cvt_pk_bf16(v0[0], v0[1]); w.y = cvt_pk_bf16(v0[2], v0[3]); w.z = cvt_pk_bf16(v1[0], v1[1]); w.w = cvt_pk_bf16(v1[2], v1[3]);
                    *(u32x4*)(rowp + bj * HALF) = w; } }
    }
};
struct EpiProj {
    static constexpr bool PERM = true;
    bf16_t* O; float* outp; int li;
    __device__ __forceinline__ void operator()(const f32x4 (&acc)[2][2][4][2], const Unit& u, int wr, int wc, int fr, int fq) const {
        const int row0 = u.pm * BM + wr * 64 + fr, col0 = u.pn * BM + wc * 32 + 8 * fq;
#pragma unroll
        for (int ai = 0; ai < 2; ++ai)
#pragma unroll
            for (int m = 0; m < 4; ++m) { __builtin_amdgcn_sched_barrier(0); const int row = row0 + ai * HALF + m * 16; bf16_t* rowp = O + (size_t)row * NPROJ_PAD + col0;
#pragma unroll
                for (int bj = 0; bj < 2; ++bj) { const f32x4 v0 = acc[ai][bj][m][0], v1 = acc[ai][bj][m][1];
                    u32x4 w; w.x = cvt_pk_bf16(v0[0], v0[1]); w.y = cvt_pk_bf16(v0[2], v0[3]); w.z = cvt_pk_bf16(v1[0], v1[1]); w.w = cvt_pk_bf16(v1[2], v1[3]);
                    *(u32x4*)(rowp + bj * HALF) = w;
                    const int col = col0 + bj * HALF;
                    if (row < TP && col >= C_KB && col < NPROJ) {
                        const int b = row >> 8, t = row & 255;
                        float* dst = outp + ((col < C_VB) ? (O_CK - C_KB) : (O_CV - C_VB)) + ((size_t)((b * 2 + li) * 256 + t)) * 128 + col;
                        *(f32x4*)dst = v0; *(f32x4*)(dst + 4) = v1; } } }
    }
};
struct EpiF32 {
    static constexpr bool PERM = true;
    float* O; int ldc; int npn; size_t split_stride;
    __device__ __forceinline__ void operator()(const f32x4 (&acc)[2][2][4][2], const Unit& u, int wr, int wc, int fr, int fq) const {
        const int s = u.pn / npn, pn = u.pn - s * npn;
        float* base = O + (size_t)s * split_stride;
        const int row0 = u.pm * BM + wr * 64 + fr, col0 = pn * BM + wc * 32 + 8 * fq;
#pragma unroll
        for (int ai = 0; ai < 2; ++ai)
#pragma unroll
            for (int m = 0; m < 4; ++m) { __builtin_amdgcn_sched_barrier(0); float* rowp = base + (size_t)(row0 + ai * HALF + m * 16) * ldc + col0;
#pragma unroll
                for (int bj = 0; bj < 2; ++bj) { *(f32x4*)(rowp + bj * HALF) = acc[ai][bj][m][0]; *(f32x4*)(rowp + bj * HALF + 4) = acc[ai][bj][m][1]; } }
    }
};

template <class Epi, class Sched>
__device__ __forceinline__ void gemm_phase(LAS unsigned char* lds, const Gemm g, const Sched& S, const Epi& E, const int tid) {
    const int wid = __builtin_amdgcn_readfirstlane(tid >> 6), lane = tid & 63, wr = wid >> 2, wc = wid & 3, fr = lane & 15, fq = lane >> 4;
    const int K = g.K, nt = K / BK;
    unsigned voffA[2], voffB[2];
#pragma unroll
    for (int i = 0; i < 2; ++i) { int R, C; stage_rc(tid * 16 + i * 8192, R, C); const int Rb = Epi::PERM ? ((R & ~31) + perm32(R & 31)) : R;
        voffA[i] = (unsigned)(R * g.lda + C) * 2u; voffB[i] = (unsigned)(Rb * g.ldb + C) * 2u; }
    const size_t kstep = (size_t)(BK * 2);
    const size_t hstepA = (size_t)HALF * g.lda * 2, hstepB = (size_t)HALF * g.ldb * 2;
    const size_t tstepA = 2 * hstepA, tstepB = 2 * hstepB;
    const unsigned ldsw = (unsigned)wid * 1024u;
    const int aoff = lds_byte(wr * 64 + fr, fq * 8), boff = lds_byte(wc * 32 + fr, fq * 8);
#define PG8_SA(b, h) (((b) * 2 + (h)) * HTB)
#define PG8_SB(b, h) ((4 + (b) * 2 + (h)) * HTB)
#define PG8_STAGE(bufoff, gbase, voff) do { _Pragma("unroll") for (int _i = 0; _i < 2; ++_i) \
        __builtin_amdgcn_global_load_lds((const unsigned*)((const char*)(gbase) + (voff)[_i]), (LAS unsigned*)(lds + (bufoff) + ldsw + _i * 8192), 16, 0, 0); } while (0)
#define PG8_LDA(dst, b, h) do { _Pragma("unroll") for (int m = 0; m < 4; ++m) _Pragma("unroll") for (int k = 0; k < 2; ++k) dst[m][k] = *(const LAS bf16x8*)(lds + PG8_SA(b, h) + aoff + m * 2048 + k * 1024); } while (0)
#define PG8_LDB(dst, b, h) do { _Pragma("unroll") for (int n = 0; n < 2; ++n) _Pragma("unroll") for (int k = 0; k < 2; ++k) dst[n][k] = *(const LAS bf16x8*)(lds + PG8_SB(b, h) + boff + n * 2048 + k * 1024); } while (0)
#define PG8_MMA(ai, bj, At, Bt) do { __builtin_amdgcn_s_setprio(1); _Pragma("unroll") for (int m = 0; m < 4; ++m) _Pragma("unroll") for (int n = 0; n < 2; ++n) _Pragma("unroll") for (int k = 0; k < 2; ++k) \
        acc[ai][bj][m][n] = __builtin_amdgcn_mfma_f32_16x16x32_bf16(Bt[n][k], At[m][k], acc[ai][bj][m][n], 0, 0, 0); __builtin_amdgcn_s_setprio(0); } while (0)
#define PG8_WAIT_V(n) asm volatile("s_waitcnt vmcnt(" #n ")" ::: "memory")
#define PG8_WAIT_L(n) asm volatile("s_waitcnt lgkmcnt(" #n ")" ::: "memory")
#define PG8_BAR __builtin_amdgcn_s_barrier()
#define PG8_SCHED __builtin_amdgcn_sched_barrier(0)
#define PG8_UA(u) ((const char*)g.A + (size_t)(u).pm * tstepA + (size_t)((u).pn / g.npn) * (size_t)g.a_split * 2)
#define PG8_UB(u) ((const char*)g.Bt + (size_t)(u).pn * tstepB)
    Unit cur, nxt; int ui = 0;
    if (!S.next(0, cur)) return;
    f32x4 acc[2][2][4][2];
#pragma unroll
    for (int a = 0; a < 2; ++a)
#pragma unroll
        for (int b = 0; b < 2; ++b)
#pragma unroll
            for (int m = 0; m < 4; ++m)
#pragma unroll
                for (int n = 0; n < 2; ++n) acc[a][b][m][n] = (f32x4){0.f, 0.f, 0.f, 0.f};
    bf16x8 At[4][2], B0[2][2], B1[2][2];
    const char* cA = PG8_UA(cur); const char* cB = PG8_UB(cur);
    PG8_STAGE(PG8_SB(0, 0), cB, voffB); PG8_STAGE(PG8_SB(0, 1), cB + hstepB, voffB); PG8_STAGE(PG8_SA(0, 0), cA, voffA); PG8_STAGE(PG8_SA(0, 1), cA + hstepA, voffA);
    if (wr == 1) PG8_BAR;
    PG8_WAIT_V(2); PG8_BAR;
    PG8_STAGE(PG8_SB(1, 0), cB + kstep, voffB); PG8_STAGE(PG8_SA(1, 0), cA + kstep, voffA); PG8_STAGE(PG8_SB(1, 1), cB + hstepB + kstep, voffB);
    PG8_WAIT_V(6); PG8_BAR;
    for (;;) {
        const bool has_next = S.next(ui + 1, nxt);
        const char* nA = has_next ? PG8_UA(nxt) : cA; const char* nB = has_next ? PG8_UB(nxt) : cB;
        for (int t = 0; t < nt; t += 2) {
            const bool last = (t == nt - 2);
            const char* a1 = cA + (size_t)(t + 1) * kstep;
            const char* a2 = last ? nA : cA + (size_t)(t + 2) * kstep; const char* b2 = last ? nB : cB + (size_t)(t + 2) * kstep;
            const char* a3 = a2 + kstep; const char* b3 = b2 + kstep;
            PG8_LDB(B0, 0, 0); PG8_LDB(B1, 0, 1); PG8_SCHED; PG8_LDA(At, 0, 0); PG8_STAGE(PG8_SA(1, 1), a1 + hstepA, voffA);
            PG8_WAIT_V(8); PG8_WAIT_L(0); PG8_BAR; PG8_MMA(0, 0, At, B0); PG8_MMA(0, 1, At, B1); PG8_BAR; PG8_SCHED;
            PG8_LDA(At, 0, 1); PG8_STAGE(PG8_SB(0, 0), b2, voffB); PG8_STAGE(PG8_SB(0, 1), b2 + hstepB, voffB); PG8_STAGE(PG8_SA(0, 0), a2, voffA);
            PG8_WAIT_V(8); PG8_WAIT_L(0); PG8_BAR; PG8_MMA(1, 0, At, B0); PG8_MMA(1, 1, At, B1); PG8_BAR; PG8_SCHED;
            PG8_LDB(B0, 1, 0); PG8_LDB(B1, 1, 1); PG8_SCHED; PG8_LDA(At, 1, 0); PG8_STAGE(PG8_SA(0, 1), a2 + hstepA, voffA);
            PG8_WAIT_V(8); PG8_WAIT_L(0); PG8_BAR; PG8_MMA(0, 0, At, B0); PG8_MMA(0, 1, At, B1); PG8_BAR; PG8_SCHED;
            PG8_LDA(At, 1, 1); PG8_STAGE(PG8_SB(1, 0), b3, voffB); PG8_STAGE(PG8_SB(1, 1), b3 + hstepB, voffB); PG8_STAGE(PG8_SA(1, 0), a3, voffA);
            PG8_WAIT_V(8); PG8_WAIT_L(0); PG8_BAR; PG8_MMA(1, 0, At, B0); PG8_MMA(1, 1, At, B1); PG8_BAR; PG8_SCHED;
        }
        if (wr == 0) PG8_BAR;
        E(acc, cur, wr, wc, fr, fq);
        if (!has_next) break;
#pragma unroll
        for (int a = 0; a < 2; ++a)
#pragma unroll
            for (int b = 0; b < 2; ++b)
#pragma unroll
                for (int m = 0; m < 4; ++m)
#pragma unroll
                    for (int n = 0; n < 2; ++n) acc[a][b][m][n] = (f32x4){0.f, 0.f, 0.f, 0.f};
        cur = nxt; cA = nA; cB = nB; ++ui;
        if (wr == 1) PG8_BAR;
    }
    PG8_WAIT_V(0);
    PG8_BAR;
#undef PG8_SA
#undef PG8_SB
#undef PG8_STAGE
#undef PG8_LDA
#undef PG8_LDB
#undef PG8_MMA
#undef PG8_WAIT_V
#undef PG8_WAIT_L
#undef PG8_BAR
#undef PG8_SCHED
#undef PG8_UA
#undef PG8_UB
}
}

struct Args { const float* in[29]; float* out; unsigned char* ws; int ph_lo, ph_hi; };
struct Ctx { unsigned char* ws; float* out; int z, tid, bid, G; };

#define MFMA16(a, b, c) __builtin_amdgcn_mfma_f32_16x16x32_bf16((a), (b), (c), 0, 0, 0)

__device__ __forceinline__ void transpose_item(const float* W, int K, int N, bf16_t* WT, int npad, int ksub, LAS float* scr, int item, int lane) {
    const int nblk = N / 32, kb = item / nblk, nb = item % nblk, k0 = 64 * kb, n0 = 32 * nb;
#pragma unroll 8
    for (int i = 0; i < 32; ++i) { const int kk = 2 * i + (lane >> 5); scr[kk * 33 + (lane & 31)] = W[(size_t)(k0 + kk) * N + n0 + (lane & 31)]; }
    asm volatile("s_waitcnt lgkmcnt(0)" ::: "memory");
    const int c = lane & 7;
    const int ks = k0 / ksub, kin = k0 - ks * ksub;
    bf16_t* dbase = WT + (size_t)ks * npad * ksub + kin + 8 * c;
#pragma unroll
    for (int j = 0; j < 4; ++j) { const int n = (lane >> 3) + 8 * j; const LAS float* s = scr + (8 * c) * 33 + n;
        u32x4 o; o.x = pk2(s[0 * 33], s[1 * 33]); o.y = pk2(s[2 * 33], s[3 * 33]); o.z = pk2(s[4 * 33], s[5 * 33]); o.w = pk2(s[6 * 33], s[7 * 33]);
        *(u32x4*)(dbase + (size_t)(n0 + n) * ksub) = o; }
    asm volatile("s_waitcnt lgkmcnt(0)" ::: "memory");
}

struct MatDesc { const float* W; bf16_t* WT; int K, N, npad, ksub, items; };
__device__ __forceinline__ MatDesc get_mat(const Args& a, const Ctx& cx, int mi) {
    MatDesc m; unsigned char* ws = cx.ws;
    if (mi < 4)       { m.W = (a.in[13] + cx.z) + (size_t)mi * D * FF; m.WT = (bf16_t*)(ws + WS_WFF1) + (size_t)mi * FF * D; m.K = D; m.N = FF; m.npad = FF; m.ksub = D; }
    else if (mi < 8)  { const int l = mi - 4; m.W = (a.in[14] + cx.z) + (size_t)l * FF * D; m.WT = (bf16_t*)(ws + WS_WFF2) + (size_t)l * FF * D; m.K = FF; m.N = D; m.npad = D; m.ksub = FF / 2; }
    else if (mi < 10) { const int i = mi - 8; m.W = (a.in[15] + cx.z) + (size_t)i * D * NPROJ; m.WT = (bf16_t*)(ws + WS_WIN) + (size_t)i * NPROJ_PAD * D; m.K = D; m.N = NPROJ; m.npad = NPROJ_PAD; m.ksub = D; }
    else if (mi < 12) { const int i = mi - 10; m.W = (a.in[22] + cx.z) + (size_t)i * D * D; m.WT = (bf16_t*)(ws + WS_WOUT) + (size_t)i * D * D; m.K = D; m.N = D; m.npad = D; m.ksub = D / 2; }
    else if (mi < 14) { const int i = mi - 12; m.W = (a.in[23] + cx.z) + (size_t)i * D * NDOWN; m.WT = (bf16_t*)(ws + WS_WDOWN) + (size_t)i * NDOWN_PAD * D; m.K = D; m.N = NDOWN; m.npad = NDOWN_PAD; m.ksub = D / 2; }
    else if (mi < 16) { const int i = mi - 14; m.W = (a.in[26] + cx.z) + (size_t)i * 384 * 1536; m.WT = (bf16_t*)(ws + WS_WUQ) + (size_t)i * 1536 * 384; m.K = 384; m.N = 1536; m.npad = 1536; m.ksub = 384; }
    else if (mi < 18) { const int i = mi - 16; m.W = (a.in[27] + cx.z) + (size_t)i * 256 * 2048; m.WT = (bf16_t*)(ws + WS_WUKV) + (size_t)i * 2048 * 256; m.K = 256; m.N = 2048; m.npad = 2048; m.ksub = 256; }
    else              { const int i = mi - 18; m.W = (a.in[28] + cx.z) + (size_t)i * D * D; m.WT = (bf16_t*)(ws + WS_WO) + (size_t)i * D * D; m.K = D; m.N = D; m.npad = D; m.ksub = D / 2; }
    m.items = (m.K / 64) * (m.N / 32);
    return m;
}

__device__ __forceinline__ void prologue(const Args& a, const Ctx& cx, LAS unsigned char* lds) {
    const int tid = cx.tid, lane = tid & 63, wave = tid >> 6, G = cx.G, bid = cx.bid;
    unsigned char* ws = cx.ws;
    {
        LAS float* sc = (LAS float*)lds;
        LAS float* red = (LAS float*)(lds + 12288);
        for (int i = tid; i < 3 * D; i += NTHREADS) { const int g = i >> 10, k = i & 1023; const float v = (g == 0) ? (a.in[9] + cx.z)[k] : (a.in[8] + cx.z)[(g - 1) * D + k]; sc[i] = silu_f(v); }
        __syncthreads();
        float* MOD = (float*)(ws + WS_MOD);
        for (int it = bid; it < 4 * 48; it += G) {
            const int l = it / 48, jb = it % 48, jq = tid & 31, kg = tid >> 5, j = jb * 128 + jq * 4;
            const float* wp = (a.in[10] + cx.z) + ((size_t)l * D + kg * 64) * 6144 + j;
            f32x4 a0 = {0.f, 0.f, 0.f, 0.f}, a1 = a0, a2 = a0;
#pragma unroll 8
            for (int k = 0; k < 64; ++k) { const f32x4 w = *(const f32x4*)(wp + (size_t)k * 6144); const int kk = kg * 64 + k;
                a0 += w * sc[kk]; a1 += w * sc[D + kk]; a2 += w * sc[2 * D + kk]; }
#pragma unroll
            for (int e = 0; e < 4; ++e) { red[(kg * 3 + 0) * 128 + jq * 4 + e] = a0[e]; red[(kg * 3 + 1) * 128 + jq * 4 + e] = a1[e]; red[(kg * 3 + 2) * 128 + jq * 4 + e] = a2[e]; }
            __syncthreads();
            if (tid < 384) { const int g = tid >> 7, jj = tid & 127; float s = 0.f;
#pragma unroll
                for (int q = 0; q < 16; ++q) s += red[(q * 3 + g) * 128 + jj];
                MOD[((size_t)l * 3 + g) * 6144 + jb * 128 + jj] = s + (a.in[11] + cx.z)[(size_t)l * 6144 + jb * 128 + jj]; }
            __syncthreads();
        }
    }
    __syncthreads();
    {
        LAS float* scr = (LAS float*)(lds + wave * 16384);
        const int gw = bid * NWAVES + wave, NGW = G * NWAVES;
        int base = 0;
        for (int mi = 0; mi < 20; ++mi) {
            const MatDesc m = get_mat(a, cx, mi);
            int first = (gw - base) % NGW; if (first < 0) first += NGW;
            for (int it = first; it < m.items; it += NGW) transpose_item(m.W, m.K, m.N, m.WT, m.npad, m.ksub, scr, it, lane);
            base += m.items;
        }
    }
    {
        const size_t gt = (size_t)bid * NTHREADS + tid, NGT = (size_t)G * NTHREADS;
        for (int i = 0; i < 2; ++i) {
            u32x4* z1 = (u32x4*)((bf16_t*)(ws + WS_WIN) + (size_t)i * NPROJ_PAD * D + (size_t)NPROJ * D);
            for (size_t x = gt; x < (size_t)(NPROJ_PAD - NPROJ) * D / 8; x += NGT) z1[x] = (u32x4){0u, 0u, 0u, 0u};
            for (int ks = 0; ks < 2; ++ks) {
                u32x4* z2 = (u32x4*)((bf16_t*)(ws + WS_WDOWN) + (size_t)i * NDOWN_PAD * D + (size_t)ks * NDOWN_PAD * (D / 2) + (size_t)NDOWN * (D / 2));
                for (size_t x = gt; x < (size_t)(NDOWN_PAD - NDOWN) * (D / 2) / 8; x += NGT) z2[x] = (u32x4){0u, 0u, 0u, 0u}; }
        }
        f32x2* tab64 = (f32x2*)(ws + WS_TAB); f32x2* tab32 = tab64 + 64 * 16;
        for (size_t x = gt; x < 64 * 16; x += NGT) { const int pos = (int)x >> 4, f = (int)x & 15; const float inv = powf(10000.f, -(float)f / 16.f); const float ang = (float)pos * inv; tab64[x] = (f32x2){cosf(ang), sinf(ang)}; }
        for (size_t x = gt; x < 64 * 8; x += NGT) { const int pos = (int)x >> 3, f = (int)x & 7; const float inv = powf(10000.f, -(float)f / 8.f); const float ang = (float)pos * inv; tab32[x] = (f32x2){cosf(ang), sinf(ang)}; }
        bf16_t* csk = (bf16_t*)(ws + WS_CSK); bf16_t* csv = (bf16_t*)(ws + WS_CSV);
        for (size_t x = gt; x < (size_t)2 * 2 * 512 * 128 / 4; x += NGT) {
            const size_t e = x * 4; const int b = (int)(e / (2 * 65536)), i = (int)(e / 65536) & 1; const size_t r = e % 65536;
            const size_t d = ((size_t)(i * 2 + b)) * 65536 + r;
            const f32x4 k = *(const f32x4*)((a.in[4] + cx.z) + e), v = *(const f32x4*)((a.in[5] + cx.z) + e);
            *(u32x2*)(csk + d) = (u32x2){pk2(k[0], k[1]), pk2(k[2], k[3])};
            *(u32x2*)(csv + d) = (u32x2){pk2(v[0], v[1]), pk2(v[2], v[3])};
        }
    }
}

__device__ __forceinline__ int mod_group(int r) { return r < TP ? 0 : 1 + ((r - TP) >> 10); }

__device__ __forceinline__ void pre_rows(const Args& a, const Ctx& cx, int l) {
    const int lane = cx.tid & 63, gw = cx.bid * NWAVES + (cx.tid >> 6), NGW = cx.G * NWAVES;
    const float* MOD = (const float*)(cx.ws + WS_MOD) + (size_t)l * 3 * 6144;
    const float* gA = (a.in[12] + cx.z) + (size_t)l * 4 * D;
    bf16_t* H = (bf16_t*)(cx.ws + WS_H);
    for (int r = gw; r < T; r += NGW) {
        const float* xr = (r < TP) ? (a.in[0] + cx.z) + (size_t)r * D : (a.in[1] + cx.z) + (size_t)(r - TP) * D;
        const float* m = MOD + (size_t)mod_group(r) * 6144;
        f32x4 v[4]; float s = 0.f;
#pragma unroll
        for (int j = 0; j < 4; ++j) { v[j] = *(const f32x4*)(xr + lane * 4 + 256 * j); s += v[j][0] * v[j][0] + v[j][1] * v[j][1] + v[j][2] * v[j][2] + v[j][3] * v[j][3]; }
        const float rstd = rsqrtf(wave_sum(s) * (1.f / D) + EPS);
#pragma unroll
        for (int j = 0; j < 4; ++j) { const int c = lane * 4 + 256 * j;
            const f32x4 g = *(const f32x4*)(gA + c), sh = *(const f32x4*)(m + c), scl = *(const f32x4*)(m + D + c);
            const f32x4 h = v[j] * rstd * g * (scl + 1.f) + sh;
            *(u32x2*)(H + (size_t)r * D + c) = (u32x2){pk2(h[0], h[1]), pk2(h[2], h[3])}; }
    }
}

__device__ __forceinline__ void post_rows(const Args& a, const Ctx& cx, bool x_from_input, const float* gate_base  , const float* gB,
                                          bool has_next, const float* gC, const float* shift_base, const float* scale_base, bool dry) {
    constexpr int RB = 3;
    const int lane = cx.tid & 63, gw = cx.bid * NWAVES + (cx.tid >> 6), NGW = cx.G * NWAVES;
    const float* OUT = (const float*)(cx.ws + WS_OUT);
    bf16_t* H = dry ? (bf16_t*)(cx.ws + WS_U + 24 * MiB) : (bf16_t*)(cx.ws + WS_H);
    float* xout = dry ? (float*)(cx.ws + WS_U) : cx.out;
    for (int rb = gw * RB; rb < T; rb += NGW * RB) {
        f32x4 o[RB][4], x[RB][4]; float s[RB], s2[RB]; size_t mg[RB];
#pragma unroll
        for (int q = 0; q < RB; ++q) { const int r = (rb + q < T) ? rb + q : T - 1;
            const float* xr = x_from_input ? ((r < TP) ? (a.in[0] + cx.z) + (size_t)r * D : (a.in[1] + cx.z) + (size_t)(r - TP) * D) : cx.out + (size_t)r * D;
            mg[q] = (size_t)mod_group(r) * 6144;
#pragma unroll
            for (int j = 0; j < 4; ++j) { const int c = lane * 4 + 256 * j;
                o[q][j] = *(const f32x4*)(OUT + (size_t)r * D + c) + *(const f32x4*)(OUT + OUT_SPLIT + (size_t)r * D + c);
                x[q][j] = *(const f32x4*)(xr + c); } }
#pragma unroll
        for (int q = 0; q < RB; ++q) { float t = 0.f;
#pragma unroll
            for (int j = 0; j < 4; ++j) t += o[q][j][0] * o[q][j][0] + o[q][j][1] * o[q][j][1] + o[q][j][2] * o[q][j][2] + o[q][j][3] * o[q][j][3];
            s[q] = t; }
#pragma unroll
        for (int off = 1; off < 64; off <<= 1) {
#pragma unroll
            for (int q = 0; q < RB; ++q) s[q] += __shfl_xor(s[q], off); }
#pragma unroll
        for (int q = 0; q < RB; ++q) { const int r = rb + q; const float rstd = rsqrtf(s[q] * (1.f / D) + EPS); float t = 0.f;
#pragma unroll
            for (int j = 0; j < 4; ++j) { const int c = lane * 4 + 256 * j;
                const f32x4 g = *(const f32x4*)(gB + c), gt = *(const f32x4*)(gate_base + mg[q] + c);
                x[q][j] = x[q][j] + gt * (o[q][j] * rstd * g);
                if (r < T) *(f32x4*)(xout + (size_t)r * D + c) = x[q][j];
                t += x[q][j][0] * x[q][j][0] + x[q][j][1] * x[q][j][1] + x[q][j][2] * x[q][j][2] + x[q][j][3] * x[q][j][3]; }
            s2[q] = t; }
        if (has_next) {
#pragma unroll
            for (int off = 1; off < 64; off <<= 1) {
#pragma unroll
                for (int q = 0; q < RB; ++q) s2[q] += __shfl_xor(s2[q], off); }
#pragma unroll
            for (int q = 0; q < RB; ++q) { const int r = rb + q; const float rstd2 = rsqrtf(s2[q] * (1.f / D) + EPS);
#pragma unroll
                for (int j = 0; j < 4; ++j) { const int c = lane * 4 + 256 * j;
                    const f32x4 g = *(const f32x4*)(gC + c), sh = *(const f32x4*)(shift_base + mg[q] + c), scl = *(const f32x4*)(scale_base + mg[q] + c);
                    const f32x4 h = x[q][j] * rstd2 * g * (scl + 1.f) + sh;
                    if (r < T) *(u32x2*)(H + (size_t)r * D + c) = (u32x2){pk2(h[0], h[1]), pk2(h[2], h[3])}; } }
        }
    }
}

__device__ __forceinline__ void mla_mid(const Args& a, const Ctx& cx, int i) {
    const int lane = cx.tid & 63, gw = cx.bid * NWAVES + (cx.tid >> 6), NGW = cx.G * NWAVES;
    const float* DOWN = (const float*)(cx.ws + WS_OUT);
    bf16_t* CQ = (bf16_t*)(cx.ws + WS_CQ); bf16_t* CKV = (bf16_t*)(cx.ws + WS_CKV); bf16_t* KR = (bf16_t*)(cx.ws + WS_KR);
    const float* gq = (a.in[24] + cx.z) + (size_t)i * 384; const float* gkv = (a.in[25] + cx.z) + (size_t)i * 256;
    const f32x2* tab32 = (const f32x2*)(cx.ws + WS_TAB) + 64 * 16;
    for (int r = gw; r < T + 1024; r += NGW) {
        if (r < T) {
            const float* dr = DOWN + (size_t)r * NDOWN_PAD;
            float q[6]; float s = 0.f;
#pragma unroll
            for (int j = 0; j < 6; ++j) { q[j] = dr[lane + 64 * j] + dr[DOWN_SPLIT + lane + 64 * j]; s += q[j] * q[j]; }
            const float rq = rsqrtf(wave_sum(s) * (1.f / 384.f) + EPS);
#pragma unroll
            for (int j = 0; j < 6; ++j) CQ[(size_t)r * 384 + lane + 64 * j] = (bf16_t)f2bf(q[j] * rq * gq[lane + 64 * j]);
            float kv[4]; s = 0.f;
#pragma unroll
            for (int j = 0; j < 4; ++j) { kv[j] = dr[384 + lane + 64 * j] + dr[DOWN_SPLIT + 384 + lane + 64 * j]; s += kv[j] * kv[j]; }
            const float rk = rsqrtf(wave_sum(s) * (1.f / 256.f) + EPS);
#pragma unroll
            for (int j = 0; j < 4; ++j) { const float v = kv[j] * rk * gkv[lane + 64 * j]; CKV[(size_t)r * 256 + lane + 64 * j] = (bf16_t)f2bf(v);
                if (r < TP) { const int b = r >> 8, t = r & 255; cx.out[O_CKV + ((size_t)((b * 2 + i) * 256 + t)) * 256 + lane + 64 * j] = v; } }
            if (lane < 32) {
                const float kr = dr[640 + lane] + dr[DOWN_SPLIT + 640 + lane];
                if (r < TP) { const int b = r >> 8, t = r & 255; cx.out[O_CKR + ((size_t)((b * 2 + i) * 256 + t)) * 32 + lane] = kr; KR[(size_t)r * 32 + lane] = (bf16_t)f2bf(kr); }
                else {
                    const int t = (r - TP) & 1023, half = lane >> 4, p = (lane >> 3) & 1, f = lane & 7, pos = half ? (t & 63) : (t >> 6);
                    const float other = dr[640 + (lane ^ 8)] + dr[DOWN_SPLIT + 640 + (lane ^ 8)];
                    const f32x2 cs = tab32[pos * 8 + f];
                    const float v = p ? (other * cs[1] + kr * cs[0]) : (kr * cs[0] - other * cs[1]);
                    KR[(size_t)r * 32 + lane] = (bf16_t)f2bf(v);
                }
            }
        } else {
            const int rr = r - T, b = rr >> 9, j = rr & 511;
            const float* src = (a.in[6] + cx.z) + ((size_t)((b * 2 + i) * 512 + j)) * 256;
#pragma unroll
            for (int q = 0; q < 4; ++q) CKV[(size_t)r * 256 + lane + 64 * q] = (bf16_t)f2bf(src[lane + 64 * q]);
            if (lane < 32) KR[(size_t)r * 32 + lane] = (bf16_t)f2bf((a.in[7] + cx.z)[((size_t)((b * 2 + i) * 512 + j)) * 32 + lane]);
        }
    }
}

struct KSeg { const bf16_t* K; int kstride; const bf16_t* K2; int k2stride; const bf16_t* V; int vstride; int k_lo, k_hi; int rope; int mask; };
struct AttnArgs { const bf16_t* Q; int qstride; int qpos0; int qrope  ; int nseg; KSeg seg0, seg1;
                  float m0, l0, scale; bf16_t* O; int ostride; const f32x2* tab64; const f32x2* tab32; };

__device__ __forceinline__ u32x4 rope8(const u32x4 own, const u32x4 partner, int p, const f32x2* tab) {
    float a[8], b[8], o[8]; unpack8(own, a); unpack8(partner, b);
#pragma unroll
    for (int e = 0; e < 8; ++e) { const f32x2 cs = tab[e]; o[e] = p ? (b[e] * cs[1] + a[e] * cs[0]) : (a[e] * cs[0] - b[e] * cs[1]); }
    return pack8(o);
}

template <int DQK>
__device__ __forceinline__ void attn_unit(LAS unsigned char* lds, const AttnArgs& A, const int tid) {
    constexpr int KT = 64;
    constexpr int QS = DQK + 8, VS = KT + 8, NCH = DQK / 8, NKS = DQK / 32, KCH = KT * NCH, KPT = (KCH + NTHREADS - 1) / NTHREADS, VPT = KT / 64, NT = KT / 16;
    LAS bf16_t* Qs = (LAS bf16_t*)lds;
    LAS bf16_t* Ks = Qs + 128 * QS;
    LAS bf16_t* VT = Ks + 2 * KT * QS;
    const int lane = tid & 63, w = tid >> 6, fr = lane & 15, fq = lane >> 4;
    const int n0 = (A.seg0.k_hi - A.seg0.k_lo) / KT, n1 = (A.nseg > 1) ? ((A.seg1.k_hi - A.seg1.k_lo) / KT) : 0, ntiles = n0 + n1;
    int kkey[KPT], kch[KPT];
#pragma unroll
    for (int i = 0; i < KPT; ++i) { const int c = tid + i * NTHREADS; kkey[i] = c / NCH; kch[i] = c % NCH; }
    const int vkey = tid & 63, vch = tid >> 6;
    u32x4 kr[KPT], kp[KPT], vr[VPT]; int pf_kt = 0, pf_rope = 0, pf_mask = 0;
#define ATT_PREFETCH(j) do { const bool s0_ = (j) < n0; const KSeg S = s0_ ? A.seg0 : A.seg1; const int kt = s0_ ? (A.seg0.k_lo + KT * (j)) : (A.seg1.k_lo + KT * ((j) - n0)); \
        _Pragma("unroll") for (int i = 0; i < KPT; ++i) if (tid + i * NTHREADS < KCH) { const int d0 = kch[i] * 8; \
            if (DQK == 96 && kch[i] >= 8) kr[i] = *(const u32x4*)(S.K2 + (size_t)(kt + kkey[i]) * S.k2stride + (d0 - 64)); \
            else { const bf16_t* src = S.K + (size_t)(kt + kkey[i]) * S.kstride; kr[i] = *(const u32x4*)(src + d0); if (DQK == 64 && S.rope) kp[i] = *(const u32x4*)(src + (d0 ^ 16)); } } \
        _Pragma("unroll") for (int i = 0; i < VPT; ++i) vr[i] = *(const u32x4*)(S.V + (size_t)(kt + vkey + 64 * i) * S.vstride + vch * 8); \
        pf_kt = kt; pf_rope = S.rope; pf_mask = S.mask; } while (0)
#define ATT_WRITE(buf) do { LAS bf16_t* Kb = Ks + (buf) * KT * QS; LAS bf16_t* Vb = VT + (buf) * 64 * VS; \
        _Pragma("unroll") for (int i = 0; i < KPT; ++i) if (tid + i * NTHREADS < KCH) { u32x4 v = kr[i]; \
            if (DQK == 64 && pf_rope) { const int t = pf_kt + kkey[i], ch = kch[i], half = ch >> 2, p = (ch >> 1) & 1, f0 = (ch & 1) * 8, pos = half ? (t & 63) : (t >> 6); v = rope8(v, kp[i], p, A.tab64 + pos * 16 + f0); } \
            *(LAS u32x4*)(Kb + kkey[i] * QS + kch[i] * 8) = v; } \
        _Pragma("unroll") for (int i = 0; i < VPT; ++i) { LAS bf16_t* dst = Vb + (vch * 8) * VS + vkey + 64 * i; const u32x4 v = vr[i]; \
          dst[0 * VS] = (bf16_t)(v.x & 0xffff); dst[1 * VS] = (bf16_t)(v.x >> 16); dst[2 * VS] = (bf16_t)(v.y & 0xffff); dst[3 * VS] = (bf16_t)(v.y >> 16); \
          dst[4 * VS] = (bf16_t)(v.z & 0xffff); dst[5 * VS] = (bf16_t)(v.z >> 16); dst[6 * VS] = (bf16_t)(v.w & 0xffff); dst[7 * VS] = (bf16_t)(v.w >> 16); } } while (0)
    ATT_PREFETCH(0);
    __syncthreads();
    for (int c = tid; c < 128 * NCH; c += NTHREADS) {
        const int qi = c / NCH, ch = c % NCH, d0 = ch * 8;
        const bf16_t* src = A.Q + (size_t)qi * A.qstride;
        u32x4 v = *(const u32x4*)(src + d0);
        const int t = A.qpos0 + qi;
        if (A.qrope == 1) { const int half = ch >> 2, p = (ch >> 1) & 1, f0 = (ch & 1) * 8, pos = half ? (t & 63) : (t >> 6);
            const u32x4 pv = *(const u32x4*)(src + (d0 ^ 16)); v = rope8(v, pv, p, A.tab64 + pos * 16 + f0); }
        else if (A.qrope == 2 && ch >= 8) { const int c2 = ch - 8, half = c2 >> 1, p = c2 & 1, pos = half ? (t & 63) : (t >> 6);
            const u32x4 pv = *(const u32x4*)(src + 64 + ((c2 ^ 1) * 8)); v = rope8(v, pv, p, A.tab32 + pos * 8); }
        *(LAS u32x4*)(Qs + qi * QS + d0) = v;
    }
    ATT_WRITE(0);
    int cur_kt = pf_kt, cur_mask = pf_mask;
    if (ntiles > 1) ATT_PREFETCH(1);
    __syncthreads();
    bf16x8 Qf[NKS];
#pragma unroll
    for (int ks = 0; ks < NKS; ++ks) Qf[ks] = *(const LAS bf16x8*)(Qs + (w * 16 + fr) * QS + ks * 32 + fq * 8);
    const float scl2 = A.scale * 1.4426950408889634f;
    float m = (A.m0 > -1e29f) ? A.m0 * 1.4426950408889634f : A.m0, l = (fq == 0) ? A.l0 : 0.f;
    f32x4 Oa[4];
#pragma unroll
    for (int dt = 0; dt < 4; ++dt) Oa[dt] = (f32x4){0.f, 0.f, 0.f, 0.f};
    const int qp = A.qpos0 + w * 16 + fr;
    for (int j = 0; j < ntiles; ++j) {
        const LAS bf16_t* Kb = Ks + (j & 1) * KT * QS; const LAS bf16_t* Vb = VT + (j & 1) * 64 * VS;
        f32x4 st[NT];
#pragma unroll
        for (int nt = 0; nt < NT; ++nt) { st[nt] = (f32x4){0.f, 0.f, 0.f, 0.f};
#pragma unroll
            for (int ks = 0; ks < NKS; ++ks) { const bf16x8 kf = *(const LAS bf16x8*)(Kb + (nt * 16 + fr) * QS + ks * 32 + fq * 8); st[nt] = MFMA16(kf, Qf[ks], st[nt]); } }
        float mx = -1e30f;
#pragma unroll
        for (int nt = 0; nt < NT; ++nt)
#pragma unroll
            for (int jj = 0; jj < 4; ++jj) { float sc = st[nt][jj] * scl2;
                if (cur_mask) { const int kpos = cur_kt + nt * 16 + fq * 4 + jj; const int dd = qp - kpos; if (dd > 128 || dd < -128) sc = -1e30f; }
                st[nt][jj] = sc; mx = fmaxf(mx, sc); }
        mx = xor16_max(mx); mx = xor32_max(mx);
        const float mn = fmaxf(m, mx), alpha = __builtin_amdgcn_exp2f(m - mn);
        float rs = 0.f;
#pragma unroll
        for (int nt = 0; nt < NT; ++nt)
#pragma unroll
            for (int jj = 0; jj < 4; ++jj) { const float pe = __builtin_amdgcn_exp2f(st[nt][jj] - mn); st[nt][jj] = pe; rs += pe; }
        l = l * alpha + rs; m = mn;
#pragma unroll
        for (int dt = 0; dt < 4; ++dt) Oa[dt] = Oa[dt] * alpha;
#pragma unroll
        for (int kk = 0; kk < KT / 32; ++kk) {
            u32x4 pb; pb.x = cvtpk(st[2 * kk][0], st[2 * kk][1]); pb.y = cvtpk(st[2 * kk][2], st[2 * kk][3]); pb.z = cvtpk(st[2 * kk + 1][0], st[2 * kk + 1][1]); pb.w = cvtpk(st[2 * kk + 1][2], st[2 * kk + 1][3]);
            const bf16x8 pf = __builtin_bit_cast(bf16x8, pb);
#pragma unroll
            for (int dt = 0; dt < 4; ++dt) {
                const LAS bf16_t* vp = Vb + (dt * 16 + fr) * VS + 32 * kk + fq * 4;
                const u32x2 v0 = *(const LAS u32x2*)vp, v1 = *(const LAS u32x2*)(vp + 16);
                const u32x4 vv = {v0.x, v0.y, v1.x, v1.y};
                Oa[dt] = MFMA16(__builtin_bit_cast(bf16x8, vv), pf, Oa[dt]);
            }
        }
        if (j + 1 < ntiles) { ATT_WRITE((j + 1) & 1); cur_kt = pf_kt; cur_mask = pf_mask; if (j + 2 < ntiles) ATT_PREFETCH(j + 2); }
        __syncthreads();
    }
#undef ATT_PREFETCH
#undef ATT_WRITE
    l = xor16_add(l); l = xor32_add(l);
    const float inv = 1.f / l;
    bf16_t* op = A.O + (size_t)(w * 16 + fr) * A.ostride + fq * 4;
#pragma unroll
    for (int dt = 0; dt < 4; ++dt) *(u32x2*)(op + dt * 16) = (u32x2){pk2(Oa[dt][0] * inv, Oa[dt][1] * inv), pk2(Oa[dt][2] * inv, Oa[dt][3] * inv)};
}

__device__ __forceinline__ void swa_unit(const Args& a, const Ctx& cx, LAS unsigned char* lds, int i, int u) {
    const bf16_t* PROJ = (const bf16_t*)(cx.ws + WS_PROJ); bf16_t* MIX = (bf16_t*)(cx.ws + WS_MIX);
    AttnArgs A;
    A.tab64 = (const f32x2*)(cx.ws + WS_TAB); A.tab32 = A.tab64 + 64 * 16;
    A.qstride = NPROJ_PAD; A.ostride = D; A.scale = 0.125f; A.l0 = 1.f;
    if (u < 128) {
        const int b = u >> 6, hq = (u >> 3) & 7, qt = u & 7, kv = hq >> 2, row0 = TP + b * 1024, q0 = qt * 128;
        A.Q = PROJ + (size_t)(row0 + q0) * NPROJ_PAD + C_QB + hq * 64; A.qpos0 = q0; A.qrope = 1; A.nseg = 2;
        A.m0 = (a.in[21] + cx.z)[i * 8 + hq];
        const bf16_t* csk = (const bf16_t*)(cx.ws + WS_CSK) + ((size_t)(i * 2 + b)) * 65536 + kv * 64;
        const bf16_t* csv = (const bf16_t*)(cx.ws + WS_CSV) + ((size_t)(i * 2 + b)) * 65536 + kv * 64;
        A.seg0 = KSeg{csk, 128, nullptr, 0, csv, 128, 0, 512, 0, 0};
        const int lo = q0 - 128 < 0 ? 0 : q0 - 128, hi = q0 + 256 > 1024 ? 1024 : q0 + 256;
        A.seg1 = KSeg{PROJ + (size_t)row0 * NPROJ_PAD + C_KB + kv * 64, NPROJ_PAD, nullptr, 0, PROJ + (size_t)row0 * NPROJ_PAD + C_VB + kv * 64, NPROJ_PAD, lo, hi, 1, 1};
        A.O = MIX + (size_t)(row0 + q0) * D + 512 + hq * 64;
    } else {
        const int v = u - 128, b = v >> 4, hq = (v >> 1) & 7, qt = v & 1, kv = hq >> 2, row0 = b * 256, q0 = qt * 128;
        A.Q = PROJ + (size_t)(row0 + q0) * NPROJ_PAD + C_QB + hq * 64; A.qpos0 = q0; A.qrope = 0; A.nseg = 1;
        A.m0 = (a.in[21] + cx.z)[i * 8 + hq];
        A.seg0 = KSeg{PROJ + (size_t)row0 * NPROJ_PAD + C_KB + kv * 64, NPROJ_PAD, nullptr, 0, PROJ + (size_t)row0 * NPROJ_PAD + C_VB + kv * 64, NPROJ_PAD, 0, 256, 0, 0};
        A.seg1 = A.seg0;
        A.O = MIX + (size_t)(row0 + q0) * D + 512 + hq * 64;
    }
    attn_unit<64>(lds, A, cx.tid);
}

__device__ __forceinline__ void mla_unit(const Args& a, const Ctx& cx, LAS unsigned char* lds, int u) {
    const bf16_t* Q = (const bf16_t*)(cx.ws + WS_Q); const bf16_t* KVX = (const bf16_t*)(cx.ws + WS_KVX); const bf16_t* KR = (const bf16_t*)(cx.ws + WS_KR);
    bf16_t* MIX = (bf16_t*)(cx.ws + WS_MIX);
    AttnArgs A;
    A.tab64 = (const f32x2*)(cx.ws + WS_TAB); A.tab32 = A.tab64 + 64 * 16;
    A.qstride = 1536; A.ostride = D; A.scale = 0.10206207261596577f; A.l0 = 0.f; A.m0 = -1e30f;
    if (u < 256) {
        const int b = u >> 7, h = (u >> 3) & 15, qt = u & 7, row0 = TP + b * 1024, q0 = qt * 128, crow0 = T + b * 512;
        A.Q = Q + (size_t)(row0 + q0) * 1536 + h * 96; A.qpos0 = q0; A.qrope = 2; A.nseg = 2;
        A.seg0 = KSeg{KVX + (size_t)crow0 * 2048 + h * 128, 2048, KR + (size_t)crow0 * 32, 32, KVX + (size_t)crow0 * 2048 + h * 128 + 64, 2048, 0, 512, 0, 0};
        A.seg1 = KSeg{KVX + (size_t)row0 * 2048 + h * 128, 2048, KR + (size_t)row0 * 32, 32, KVX + (size_t)row0 * 2048 + h * 128 + 64, 2048, 0, 1024, 0, 0};
        A.O = MIX + (size_t)(row0 + q0) * D + h * 64;
    } else {
        const int v = u - 256, b = v >> 5, h = (v >> 1) & 15, qt = v & 1, row0 = b * 256, q0 = qt * 128;
        A.Q = Q + (size_t)(row0 + q0) * 1536 + h * 96; A.qpos0 = q0; A.qrope = 0; A.nseg = 1;
        A.seg0 = KSeg{KVX + (size_t)row0 * 2048 + h * 128, 2048, KR + (size_t)row0 * 32, 32, KVX + (size_t)row0 * 2048 + h * 128 + 64, 2048, 0, 256, 0, 0};
        A.seg1 = A.seg0;
        A.O = MIX + (size_t)(row0 + q0) * D + h * 64;
    }
    attn_unit<96>(lds, A, cx.tid);
}

constexpr int GL_G = 0;
constexpr int GL_STF = 32768, GL_STB = 51200;
constexpr int GL_LO = 32768, GL_WF = 40960, GL_WB = 45056, GL_BF = 49152, GL_BB = 49408;
constexpr int GL_QF = 69632, GL_KF = 78848, GL_QB = 88064, GL_KB = 97280;
constexpr int GL_VT = 106496;
constexpr int GL_AF = 124928, GL_AB = 134144;

__device__ __forceinline__ void gla_gates(const Args& a, const Ctx& cx, LAS unsigned char* lds, int i, int tok0, int h) {
    const int tid = cx.tid;
    const bf16_t* PROJ = (const bf16_t*)(cx.ws + WS_PROJ);
    LAS float* LO = (LAS float*)(lds + GL_LO); LAS float* WF = (LAS float*)(lds + GL_WF); LAS float* WB = (LAS float*)(lds + GL_WB);
    LAS float* BF = (LAS float*)(lds + GL_BF); LAS float* BB = (LAS float*)(lds + GL_BB);
    LAS float* Gf = (LAS float*)(lds + GL_G); LAS float* Gb = Gf + 4096;
    { const int t = tid >> 3, j0 = (tid & 7) * 4; const u32x2 v = *(const u32x2*)(PROJ + (size_t)(tok0 + t) * NPROJ_PAD + C_LO + j0);
      LO[t * 32 + j0] = bflo(v.x); LO[t * 32 + j0 + 1] = bfhi(v.x); LO[t * 32 + j0 + 2] = bflo(v.y); LO[t * 32 + j0 + 3] = bfhi(v.y); }
    for (int x = tid; x < 1024; x += NTHREADS) { const int r = x >> 6, d = x & 63;
        WF[x] = (a.in[16] + cx.z)[((size_t)i * 16 + r) * 256 + h * 64 + d]; WB[x] = (a.in[18] + cx.z)[((size_t)i * 16 + r) * 256 + h * 64 + d]; }
    if (tid < 64) { BF[tid] = (a.in[17] + cx.z)[i * 256 + h * 64 + tid]; BB[tid] = (a.in[19] + cx.z)[i * 256 + h * 64 + tid]; }
    __syncthreads();
    { const int d = tid & 63, tg = tid >> 6;
      LAS float* SEG = (LAS float*)(lds + GL_LO + 8192 + 8192 + 1024);
      float wf[16], wb[16];
#pragma unroll
      for (int r = 0; r < 16; ++r) { wf[r] = WF[r * 64 + d]; wb[r] = WB[r * 64 + d]; }
      const float bfv = BF[d], bbv = BB[d];
      float gf[8], gb[8];
#pragma unroll
      for (int tt = 0; tt < 8; ++tt) { const int t = tg * 8 + tt; float xf = bfv, xb = bbv;
#pragma unroll
          for (int r = 0; r < 16; ++r) { xf += LO[t * 32 + r] * wf[r]; xb += LO[t * 32 + 16 + r] * wb[r]; }
          gf[tt] = (fminf(xf, 0.f) - log1pf(__expf(-fabsf(xf)))) * (1.f / 16.f); gb[tt] = (fminf(xb, 0.f) - log1pf(__expf(-fabsf(xb)))) * (1.f / 16.f); }
#pragma unroll
      for (int tt = 1; tt < 8; ++tt) gf[tt] += gf[tt - 1];
#pragma unroll
      for (int tt = 6; tt >= 0; --tt) gb[tt] += gb[tt + 1];
      SEG[tg * 64 + d] = gf[7]; SEG[512 + tg * 64 + d] = gb[0];
      __syncthreads();
      float offf = 0.f, offb = 0.f;
#pragma unroll
      for (int q = 0; q < 8; ++q) { const float a_ = SEG[q * 64 + d], b_ = SEG[512 + q * 64 + d]; offf += (q < tg) ? a_ : 0.f; offb += (q > tg) ? b_ : 0.f; }
#pragma unroll
      for (int tt = 0; tt < 8; ++tt) { const int t = tg * 8 + tt; Gf[t * 64 + d] = gf[tt] + offf; Gb[t * 64 + d] = gb[tt] + offb; } }
    __syncthreads();
}

__device__ __forceinline__ void gla_load_vt(const bf16_t* PROJ, LAS unsigned char* lds, int tok0, int h, const int tid) {
    const int s = tid & 63, e0 = (tid >> 6) * 16;
    LAS bf16_t* VT = (LAS bf16_t*)(lds + GL_VT);
    const bf16_t* src = PROJ + (size_t)(tok0 + s) * NPROJ_PAD + C_VA + h * 128 + e0;
#pragma unroll
    for (int q = 0; q < 2; ++q) { const u32x4 v = *(const u32x4*)(src + q * 8); LAS bf16_t* dst = VT + (e0 + q * 8) * 72 + s;
        dst[0 * 72] = (bf16_t)(v.x & 0xffff); dst[1 * 72] = (bf16_t)(v.x >> 16); dst[2 * 72] = (bf16_t)(v.y & 0xffff); dst[3 * 72] = (bf16_t)(v.y >> 16);
        dst[4 * 72] = (bf16_t)(v.z & 0xffff); dst[5 * 72] = (bf16_t)(v.z >> 16); dst[6 * 72] = (bf16_t)(v.w & 0xffff); dst[7 * 72] = (bf16_t)(v.w >> 16); }
}

__device__ __forceinline__ void gla_local_unit(const Args& a, const Ctx& cx, LAS unsigned char* lds, int i, int u) {
    const int cg_ = u >> 2, h = u & 3, tok0 = cg_ * 64, tid = cx.tid, lane = tid & 63, w = tid >> 6, fr = lane & 15, fq = lane >> 4;
    const bf16_t* PROJ = (const bf16_t*)(cx.ws + WS_PROJ);
    float* LOC = (float*)(cx.ws + WS_LOC); float* DEC = (float*)(cx.ws + WS_DEC);
    __syncthreads();
    gla_gates(a, cx, lds, i, tok0, h);
    LAS float* Gf = (LAS float*)(lds + GL_G); LAS float* Gb = Gf + 4096;
    LAS bf16_t* KTf = (LAS bf16_t*)(lds + GL_KF); LAS bf16_t* KTb = (LAS bf16_t*)(lds + GL_KB);
    LAS bf16_t* VT = (LAS bf16_t*)(lds + GL_VT);
    { const int s = tid >> 3, d0 = (tid & 7) * 8; const u32x4 kv = *(const u32x4*)(PROJ + (size_t)(tok0 + s) * NPROJ_PAD + C_KA + h * 64 + d0);
      float k[8]; unpack8(kv, k);
#pragma unroll
      for (int e = 0; e < 8; ++e) { const int d = d0 + e;
          KTf[d * 72 + s] = (bf16_t)f2bf(k[e] * __expf(Gf[63 * 64 + d] - Gf[s * 64 + d]));
          KTb[d * 72 + s] = (bf16_t)f2bf(k[e] * __expf(Gb[d] - Gb[s * 64 + d])); } }
    gla_load_vt(PROJ, lds, tok0, h, tid);
    if (tid < 128) { const int dir = tid >> 6, d = tid & 63; DEC[((size_t)(dir * 96 + cg_) * 4 + h) * 64 + d] = __expf(dir ? Gb[d] : Gf[63 * 64 + d]); }
    __syncthreads();
    const int dir = w >> 2, dtile = w & 3;
    const LAS bf16_t* KT = dir ? KTb : KTf;
    bf16x8 af[2];
#pragma unroll
    for (int ks = 0; ks < 2; ++ks) af[ks] = *(const LAS bf16x8*)(KT + (dtile * 16 + fr) * 72 + ks * 32 + fq * 8);
    float* dst = LOC + ((size_t)(dir * 96 + cg_) * 4 + h) * 8192;
#pragma unroll
    for (int et = 0; et < 8; ++et) { f32x4 acc = {0.f, 0.f, 0.f, 0.f};
#pragma unroll
        for (int ks = 0; ks < 2; ++ks) { const bf16x8 bfv = *(const LAS bf16x8*)(VT + (et * 16 + fr) * 72 + ks * 32 + fq * 8); acc = MFMA16(af[ks], bfv, acc); }
#pragma unroll
        for (int j = 0; j < 4; ++j) dst[(dtile * 16 + fq * 4 + j) * 128 + et * 16 + fr] = acc[j]; }
}

__device__ __forceinline__ void gla_out_unit(const Args& a, const Ctx& cx, LAS unsigned char* lds, int i, int u) {
    const int cg_ = u >> 2, h = u & 3, tok0 = cg_ * 64, tid = cx.tid, lane = tid & 63, w = tid >> 6, fr = lane & 15, fq = lane >> 4;
    const bf16_t* PROJ = (const bf16_t*)(cx.ws + WS_PROJ); bf16_t* MIX = (bf16_t*)(cx.ws + WS_MIX);
    const float* LOC = (const float*)(cx.ws + WS_LOC); const float* DEC = (const float*)(cx.ws + WS_DEC);
    __syncthreads();
    gla_gates(a, cx, lds, i, tok0, h);
    LAS float* Gf = (LAS float*)(lds + GL_G); LAS float* Gb = Gf + 4096;
    const bool samp = cg_ >= 64;
    const int b = samp ? (cg_ - 64) >> 4 : cg_ >> 2, c = samp ? (cg_ - 64) & 15 : cg_ & 3, nc = samp ? 16 : 4, cbase = cg_ - c;
    {
        const int d = tid >> 3, e0 = (tid & 7) * 16;
        f32x4 Sf[4], Sb[4];
        if (samp) { const float* s0f = (a.in[2] + cx.z) + ((size_t)((b * 2 + i) * 4 + h)) * 8192 + d * 128 + e0; const float* s0b = (a.in[3] + cx.z) + ((size_t)((b * 2 + i) * 4 + h)) * 8192 + d * 128 + e0;
#pragma unroll
            for (int q = 0; q < 4; ++q) { Sf[q] = *(const f32x4*)(s0f + q * 4); Sb[q] = *(const f32x4*)(s0b + q * 4); } }
        else {
#pragma unroll
            for (int q = 0; q < 4; ++q) { Sf[q] = (f32x4){0.f, 0.f, 0.f, 0.f}; Sb[q] = Sf[q]; } }
        for (int j = 0; j < c; ++j) { const size_t ix = (size_t)(0 * 96 + cbase + j) * 4 + h; const float dec = DEC[ix * 64 + d]; const float* lp = LOC + ix * 8192 + d * 128 + e0;
#pragma unroll
            for (int q = 0; q < 4; ++q) Sf[q] = Sf[q] * dec + *(const f32x4*)(lp + q * 4); }
        for (int j = nc - 1; j > c; --j) { const size_t ix = (size_t)(1 * 96 + cbase + j) * 4 + h; const float dec = DEC[ix * 64 + d]; const float* lp = LOC + ix * 8192 + d * 128 + e0;
#pragma unroll
            for (int q = 0; q < 4; ++q) Sb[q] = Sb[q] * dec + *(const f32x4*)(lp + q * 4); }
        if (!samp) {
            if (c == nc - 1) { const size_t ix = (size_t)(0 * 96 + cg_) * 4 + h; const float dec = DEC[ix * 64 + d]; const float* lp = LOC + ix * 8192 + d * 128 + e0;
                float* o = cx.out + O_SF + ((size_t)((b * 2 + i) * 4 + h)) * 8192 + d * 128 + e0;
#pragma unroll
                for (int q = 0; q < 4; ++q) *(f32x4*)(o + q * 4) = Sf[q] * dec + *(const f32x4*)(lp + q * 4); }
            if (c == 0) { const size_t ix = (size_t)(1 * 96 + cg_) * 4 + h; const float dec = DEC[ix * 64 + d]; const float* lp = LOC + ix * 8192 + d * 128 + e0;
                float* o = cx.out + O_SB + ((size_t)((b * 2 + i) * 4 + h)) * 8192 + d * 128 + e0;
#pragma unroll
                for (int q = 0; q < 4; ++q) *(f32x4*)(o + q * 4) = Sb[q] * dec + *(const f32x4*)(lp + q * 4); }
        }
        LAS bf16_t* STf = (LAS bf16_t*)(lds + GL_STF); LAS bf16_t* STb = (LAS bf16_t*)(lds + GL_STB);
#pragma unroll
        for (int q = 0; q < 4; ++q)
#pragma unroll
            for (int e = 0; e < 4; ++e) { STf[(e0 + q * 4 + e) * 72 + d] = (bf16_t)f2bf(Sf[q][e]); STb[(e0 + q * 4 + e) * 72 + d] = (bf16_t)f2bf(Sb[q][e]); }
    }
    {
        const int t = tid >> 3, d0 = (tid & 7) * 8;
        const u32x4 qv = *(const u32x4*)(PROJ + (size_t)(tok0 + t) * NPROJ_PAD + C_QA + h * 64 + d0);
        const u32x4 kv = *(const u32x4*)(PROJ + (size_t)(tok0 + t) * NPROJ_PAD + C_KA + h * 64 + d0);
        float q[8], k[8], o1[8], o2[8], o3[8], o4[8]; unpack8(qv, q); unpack8(kv, k);
#pragma unroll
        for (int e = 0; e < 8; ++e) { const float gf = Gf[t * 64 + d0 + e], gb = Gb[t * 64 + d0 + e];
            o1[e] = q[e] * 0.125f * __expf(gf); o2[e] = k[e] * __expf(-gf); o3[e] = q[e] * 0.125f * __expf(gb); o4[e] = k[e] * __expf(-gb); }
        *(LAS u32x4*)((LAS bf16_t*)(lds + GL_QF) + t * 72 + d0) = pack8(o1);
        *(LAS u32x4*)((LAS bf16_t*)(lds + GL_KF) + t * 72 + d0) = pack8(o2);
        *(LAS u32x4*)((LAS bf16_t*)(lds + GL_QB) + t * 72 + d0) = pack8(o3);
        *(LAS u32x4*)((LAS bf16_t*)(lds + GL_KB) + t * 72 + d0) = pack8(o4);
    }
    gla_load_vt(PROJ, lds, tok0, h, tid);
    __syncthreads();
    {
        const int dir = w >> 2, tt = w & 3;
        const LAS bf16_t* Qm = (const LAS bf16_t*)(lds + (dir ? GL_QB : GL_QF)); const LAS bf16_t* Km = (const LAS bf16_t*)(lds + (dir ? GL_KB : GL_KF));
        LAS bf16_t* AT = (LAS bf16_t*)(lds + (dir ? GL_AB : GL_AF));
        bf16x8 af[2];
#pragma unroll
        for (int ks = 0; ks < 2; ++ks) af[ks] = *(const LAS bf16x8*)(Qm + (tt * 16 + fr) * 72 + ks * 32 + fq * 8);
#pragma unroll
        for (int st = 0; st < 4; ++st) { f32x4 acc = {0.f, 0.f, 0.f, 0.f};
#pragma unroll
            for (int ks = 0; ks < 2; ++ks) { const bf16x8 bfv = *(const LAS bf16x8*)(Km + (st * 16 + fr) * 72 + ks * 32 + fq * 8); acc = MFMA16(af[ks], bfv, acc); }
#pragma unroll
            for (int j = 0; j < 4; ++j) { const int t = tt * 16 + fq * 4 + j, s = st * 16 + fr; const bool keep = dir ? (s >= t) : (s <= t);
                AT[t * 72 + s] = (bf16_t)f2bf(keep ? acc[j] : 0.f); } }
    }
    __syncthreads();
    {
        const int tt = w & 3, eg = w >> 2;
        LAS float* OS = (LAS float*)(lds + GL_G);
        const LAS bf16_t* VT = (const LAS bf16_t*)(lds + GL_VT);
        bf16x8 a1[2], a2[2], a3[2], a4[2];
#pragma unroll
        for (int ks = 0; ks < 2; ++ks) { const int off = (tt * 16 + fr) * 72 + ks * 32 + fq * 8;
            a1[ks] = *(const LAS bf16x8*)((const LAS bf16_t*)(lds + GL_QF) + off); a2[ks] = *(const LAS bf16x8*)((const LAS bf16_t*)(lds + GL_AF) + off);
            a3[ks] = *(const LAS bf16x8*)((const LAS bf16_t*)(lds + GL_QB) + off); a4[ks] = *(const LAS bf16x8*)((const LAS bf16_t*)(lds + GL_AB) + off); }
        f32x4 accs[4];
#pragma unroll
        for (int q = 0; q < 4; ++q) { const int et = eg * 4 + q; f32x4 acc = {0.f, 0.f, 0.f, 0.f};
#pragma unroll
            for (int ks = 0; ks < 2; ++ks) { const int off = (et * 16 + fr) * 72 + ks * 32 + fq * 8;
                const bf16x8 b1 = *(const LAS bf16x8*)((const LAS bf16_t*)(lds + GL_STF) + off), b2 = *(const LAS bf16x8*)(VT + off), b3 = *(const LAS bf16x8*)((const LAS bf16_t*)(lds + GL_STB) + off);
                acc = MFMA16(a1[ks], b1, acc); acc = MFMA16(a2[ks], b2, acc); acc = MFMA16(a3[ks], b3, acc); acc = MFMA16(a4[ks], b2, acc); }
            accs[q] = acc; }
#pragma unroll
        for (int q = 0; q < 4; ++q)
#pragma unroll
            for (int j = 0; j < 4; ++j) OS[(tt * 16 + fq * 4 + j) * 128 + (eg * 4 + q) * 16 + fr] = accs[q][j];
    }
    __syncthreads();
    {
        const int t = tid >> 3, e0 = (tid & 7) * 16;
        const LAS float* OS = (const LAS float*)(lds + GL_G);
        float o[16]; float ss = 0.f;
#pragma unroll
        for (int e = 0; e < 16; ++e) { o[e] = OS[t * 128 + e0 + e]; ss += o[e] * o[e]; }
        ss += __shfl_xor(ss, 1); ss += __shfl_xor(ss, 2); ss += __shfl_xor(ss, 4);
        const float rstd = rsqrtf(ss * (1.f / 128.f) + EPS);
        const bf16_t* gp = PROJ + (size_t)(tok0 + t) * NPROJ_PAD + C_GA + h * 128 + e0;
        const float* gg = (a.in[20] + cx.z) + i * 128 + e0;
        float gt[16]; unpack8(*(const u32x4*)gp, gt); unpack8(*(const u32x4*)(gp + 8), gt + 8);
#pragma unroll
        for (int e = 0; e < 16; ++e) o[e] = o[e] * rstd * gg[e] * silu_f(gt[e]);
        bf16_t* op = MIX + (size_t)(tok0 + t) * D + h * 128 + e0;
        *(u32x4*)op = pack8(o); *(u32x4*)(op + 8) = pack8(o + 8);
    }
}


#define XB_TMO      128
#define XB_XCNT(j)  (256  + 64 * (j))
#define XB_XSUB(j)  (1280 + 64 * (j))
#define XB_XGEN(j)  (2304 + 64 * (j))
#define XB_TOP      3328
#define XB_TOPGEN   3392
#define XCD_BAR_WORDS 3456
#define XB_SPIN_CAP (1u << 18)
__device__ __forceinline__ unsigned xb_ld(unsigned* p)              { return __hip_atomic_load(p, __ATOMIC_RELAXED, __HIP_MEMORY_SCOPE_AGENT); }
__device__ __forceinline__ unsigned xb_add(unsigned* p, unsigned v) { return __hip_atomic_fetch_add(p, v, __ATOMIC_RELAXED, __HIP_MEMORY_SCOPE_AGENT); }
__device__ __forceinline__ unsigned xb_xcc_id() { return (unsigned)__builtin_amdgcn_s_getreg((3 << 11) | 20) & 0xFu; }
#define XB_SPIN(cond, bar) do { unsigned _sp = 0; while (cond) { __builtin_amdgcn_s_sleep(1); \
    if ((++_sp & 255u) == 0u) { if (xb_ld(&(bar)[XB_TMO])) break; if (_sp > XB_SPIN_CAP) { atomicAdd(&(bar)[XB_TMO], 1u); break; } } } } while (0)
struct XcdBarrier { unsigned* bar; unsigned x; volatile LAS unsigned* st; };
__device__ __forceinline__ XcdBarrier xcd_barrier_post(unsigned* bar, volatile LAS unsigned* st, const int tid) {
    XcdBarrier b; b.bar = bar; b.x = xb_xcc_id(); b.st = st;
    if (tid == 0) (void)xb_add(&bar[XB_XCNT(b.x)], 1u);
    return b;
}
__device__ __forceinline__ void xcd_barrier_complete(unsigned* bar, unsigned x, unsigned& nloc, unsigned& nx) {
    const unsigned G = gridDim.x * gridDim.y * gridDim.z;
    unsigned sum, cnt, mine, sp = 0u;
    for (;;) {
        sum = 0u; cnt = 0u; mine = 0u;
#pragma unroll
        for (unsigned j = 0; j < 16; ++j) { const unsigned c = xb_ld(&bar[XB_XCNT(j)]); sum += c; cnt += (c > 0u) ? 1u : 0u; mine = (j == x) ? c : mine; }
        if (sum == G) break;
        __builtin_amdgcn_s_sleep(1);
        if ((++sp & 255u) == 0u) { if (xb_ld(&bar[XB_TMO])) break; if (sp > XB_SPIN_CAP) { atomicAdd(&bar[XB_TMO], 1u); break; } }
    }
    nloc = mine > 0u ? mine : 1u; nx = cnt > 0u ? cnt : 1u;
}
__device__ __forceinline__ void xcd_barrier(const XcdBarrier& b, const int tid) {
    asm volatile("s_waitcnt vmcnt(0)" ::: "memory");
    __syncthreads();
    if (tid == 0) {
        unsigned* bar = b.bar;
        __builtin_amdgcn_s_waitcnt(0);
        unsigned nloc = b.st[0], nx = b.st[1];
        if (nloc == 0u) { xcd_barrier_complete(bar, b.x, nloc, nx); b.st[0] = nloc; b.st[1] = nx; }
        const unsigned old = xb_add(&bar[XB_XSUB(b.x)], 1u);
        const unsigned gen = old / nloc;
        if (old + 1u == (gen + 1u) * nloc) {
            __builtin_amdgcn_fence(__ATOMIC_RELEASE, "agent");
            asm volatile("s_waitcnt vmcnt(0)" ::: "memory");
            const unsigned og = xb_add(&bar[XB_TOP], 1u);
            const unsigned tg = og / nx;
            if (og + 1u == (tg + 1u) * nx) xb_add(&bar[XB_TOPGEN], 1u);
            else XB_SPIN(xb_ld(&bar[XB_TOPGEN]) == tg, bar);
            __builtin_amdgcn_fence(__ATOMIC_ACQUIRE, "agent");
            xb_add(&bar[XB_XGEN(b.x)], 1u);
            asm volatile("s_waitcnt vmcnt(0)" ::: "memory");
        } else {
            XB_SPIN(xb_ld(&bar[XB_XGEN(b.x)]) == gen, bar);
            __builtin_amdgcn_fence(__ATOMIC_ACQUIRE, "agent");
            asm volatile("s_waitcnt vmcnt(0)" ::: "memory");
        }
    }
    __syncthreads();
}

enum { K_PRO = 0, K_PRE, K_G1, K_A1, K_A2, K_DOWN, K_MID, K_UQKV, K_MLA, K_OUTP, K_POST1, K_FF1, K_FF2, K_POST2 };
constexpr int N_PHASES = 2 + 2 * 8 + 2 * 9;
#ifndef EN_MASK
#define EN_MASK 0xFFFFFFFFu
#endif
#define ENB(k) (((EN_MASK) >> (k)) & 1u)
#ifndef DUP_MASK
#define DUP_MASK 0u
#endif
#ifndef BAR_REPS
#define BAR_REPS 1
#endif

__global__ void __launch_bounds__(NTHREADS, 2) mega_fwd(Args args) {
    extern __shared__ __attribute__((aligned(16))) unsigned char lds_raw[];
    LAS unsigned char* lds = (LAS unsigned char*)lds_raw;
    const int lo = args.ph_lo, hi = args.ph_hi;
    const int wave_s = __builtin_amdgcn_readfirstlane((int)(threadIdx.x >> 6));
#define MY_TID(dst) do { int _l; asm volatile("v_mbcnt_lo_u32_b32 %0, -1, 0\n\tv_mbcnt_hi_u32_b32 %0, -1, %0" : "=v"(_l)); dst = wave_s * 64 + _l; } while (0)
    {
        int tid0; MY_TID(tid0);
        volatile LAS unsigned* bst = (volatile LAS unsigned*)(lds + LDS_BYTES - 64);
        if (tid0 < 2) bst[tid0] = 0u;
        __syncthreads();
        (void)xcd_barrier_post((unsigned*)(args.ws + WS_CTL), bst, tid0);
    }
    for (int p = lo; p < hi; ++p) {
        int kind, l;
        if (p == 0) { kind = K_PRO; l = 0; }
        else if (p == 1) { kind = K_PRE; l = 0; }
        else {
            const int q = p - 2, pair = q / 17, r = q - pair * 17;
            if (r < 8) { l = 2 * pair; kind = (r == 0) ? K_G1 : (r == 1) ? K_A1 : (r == 2) ? K_A2 : (r == 3) ? K_OUTP : (r == 4) ? K_POST1 : (r == 5) ? K_FF1 : (r == 6) ? K_FF2 : K_POST2; }
            else { const int r2 = r - 8; l = 2 * pair + 1; kind = (r2 == 0) ? K_DOWN : (r2 == 1) ? K_MID : (r2 == 2) ? K_UQKV : (r2 == 3) ? K_MLA : (r2 == 4) ? K_OUTP : (r2 == 5) ? K_POST1 : (r2 == 6) ? K_FF1 : (r2 == 7) ? K_FF2 : K_POST2; }
        }
        const int reps = ((DUP_MASK >> kind) & 1u) ? 2 : 1;
        for (int rep = 0; rep < reps; ++rep) {
        if (rep) __syncthreads();
        Ctx cx; cx.z = 0; MY_TID(cx.tid); cx.bid = blockIdx.x; cx.G = gridDim.x;
        asm volatile("" : "+s"(cx.z), "+s"(kind), "+s"(l), "+v"(cx.tid), "+s"(cx.bid), "+s"(cx.G));
        cx.ws = args.ws + cx.z; cx.out = args.out + cx.z;
        unsigned char* ws = cx.ws;
        const int i = l >> 1, G = cx.G, bid = cx.bid;
        switch (kind) {
        case K_PRO: if (ENB(0)) prologue(args, cx, lds); break;
        case K_PRE: if (ENB(1)) pre_rows(args, cx, 0); break;
        case K_G1: if (ENB(2)) {
            pg8::Gemm g{(const bf16_t*)(ws + WS_H), (const bf16_t*)(ws + WS_WIN) + (size_t)i * NPROJ_PAD * D, T, NPROJ_PAD, D, D, D, NPROJ_PAD / 256, 0};
            pg8::StaticOrder S; S.init(T, NPROJ_PAD, G, bid);
            pg8::EpiProj E{(bf16_t*)(ws + WS_PROJ), cx.out, i};
            pg8::gemm_phase<pg8::EpiProj, pg8::StaticOrder>(lds, g, S, E, cx.tid);
        } break;
        case K_A1:
            if (G == 256) {
                if (bid < 128) { if (ENB(3)) swa_unit(args, cx, lds, i, bid); if (ENB(4)) gla_local_unit(args, cx, lds, i, bid); }
                else { const int q = bid - 128; if (ENB(3)) { swa_unit(args, cx, lds, i, 128 + 2 * q); swa_unit(args, cx, lds, i, 128 + 2 * q + 1); }
                       if (ENB(4)) { gla_local_unit(args, cx, lds, i, 128 + 2 * q); gla_local_unit(args, cx, lds, i, 128 + 2 * q + 1); } }
            } else { for (int u = bid; u < 768; u += G) { if (u < 384) { if (ENB(3)) swa_unit(args, cx, lds, i, u); } else { if (ENB(4)) gla_local_unit(args, cx, lds, i, u - 384); } } }
            break;
        case K_A2:
            if (G == 256) {
                if (bid < 128) { if (ENB(5)) gla_out_unit(args, cx, lds, i, 256 + bid); }
                else { for (int q = 0; q < 2; ++q) if (ENB(5)) gla_out_unit(args, cx, lds, i, (bid - 128) + 128 * q); }
            } else { for (int u = bid; u < 384; u += G) if (ENB(5)) gla_out_unit(args, cx, lds, i, u); }
            break;
        case K_MID: if (ENB(7)) mla_mid(args, cx, i); break;
        case K_UQKV: if (ENB(8)) {
            for (int s = 0; s < 2; ++s) {
                pg8::Gemm g;
                if (s == 0) g = pg8::Gemm{(const bf16_t*)(ws + WS_CQ), (const bf16_t*)(ws + WS_WUQ) + (size_t)i * 1536 * 384, T, 1536, 384, 384, 384, 6, 0};
                else        g = pg8::Gemm{(const bf16_t*)(ws + WS_CKV), (const bf16_t*)(ws + WS_WUKV) + (size_t)i * 2048 * 256, T + 1024, 2048, 256, 256, 256, 8, 0};
                pg8::StaticOrder S; S.init(g.M, g.N, G, (s == 0 || G != 256) ? bid : ((bid + 144) & 255));
                pg8::EpiBf16<0> E{s == 0 ? (bf16_t*)(ws + WS_Q) : (bf16_t*)(ws + WS_KVX), g.N};
                pg8::gemm_phase<pg8::EpiBf16<0>, pg8::StaticOrder>(lds, g, S, E, cx.tid);
            }
        } break;
        case K_MLA: if (ENB(9)) {
            if (G == 256) {
                const int xcd = bid & 7, slot = bid >> 3, id = xcd * 4 + (slot >> 3);
                mla_unit(args, cx, lds, id * 8 + (slot & 7));
                mla_unit(args, cx, lds, 256 + 2 * bid);
                mla_unit(args, cx, lds, 256 + 2 * bid + 1);
            } else { for (int u = bid; u < 768; u += G) mla_unit(args, cx, lds, u); }
        } break;
        case K_DOWN: case K_OUTP: case K_FF2: if (ENB(10)) {
            pg8::Gemm g; pg8::EpiF32 E;
            if (kind == K_DOWN) {
                g = pg8::Gemm{(const bf16_t*)(ws + WS_H), (const bf16_t*)(ws + WS_WDOWN) + (size_t)i * NDOWN_PAD * D, T, 2 * NDOWN_PAD, D / 2, D, D / 2, NDOWN_PAD / 256, D / 2};
                E = pg8::EpiF32{(float*)(ws + WS_OUT), NDOWN_PAD, NDOWN_PAD / 256, DOWN_SPLIT};
            } else if (kind == K_OUTP) {
                const bf16_t* Wt = (l & 1) ? (const bf16_t*)(ws + WS_WO) + (size_t)i * D * D : (const bf16_t*)(ws + WS_WOUT) + (size_t)i * D * D;
                g = pg8::Gemm{(const bf16_t*)(ws + WS_MIX), Wt, T, 2 * D, D / 2, D, D / 2, 4, D / 2};
                E = pg8::EpiF32{(float*)(ws + WS_OUT), D, 4, OUT_SPLIT};
            } else {
                g = pg8::Gemm{(const bf16_t*)(ws + WS_U), (const bf16_t*)(ws + WS_WFF2) + (size_t)l * FF * D, T, 2 * D, FF / 2, FF, FF / 2, 4, FF / 2};
                E = pg8::EpiF32{(float*)(ws + WS_OUT), D, 4, OUT_SPLIT};
            }
            pg8::StaticOrder S; S.init(g.M, g.N, G, bid);
            pg8::gemm_phase<pg8::EpiF32, pg8::StaticOrder>(lds, g, S, E, cx.tid);
        } break;
        case K_FF1: if (ENB(12)) {
            pg8::Gemm g{(const bf16_t*)(ws + WS_H), (const bf16_t*)(ws + WS_WFF1) + (size_t)l * FF * D, T, FF, D, D, D, FF / 256, 0};
            pg8::StaticOrder S; S.init(T, FF, G, bid);
            pg8::EpiBf16<1> E{(bf16_t*)(ws + WS_U), FF};
            pg8::gemm_phase<pg8::EpiBf16<1>, pg8::StaticOrder>(lds, g, S, E, cx.tid);
        } break;
        case K_POST1: if (ENB(11)) {
            const float* MODL = (const float*)(ws + WS_MOD) + (size_t)l * 3 * 6144; const float* gN = (args.in[12] + cx.z) + (size_t)l * 4 * D;
            post_rows(args, cx, l == 0, MODL + 2 * D, gN + D, true, gN + 2 * D, MODL + 3 * D, MODL + 4 * D, rep + 1 < reps);
        } break;
        case K_POST2: if (ENB(14)) {
            const float* MODL = (const float*)(ws + WS_MOD) + (size_t)l * 3 * 6144; const float* gN = (args.in[12] + cx.z) + (size_t)l * 4 * D;
            const float* MODN = MODL + 3 * 6144; const float* gNn = gN + 4 * D;
            post_rows(args, cx, false, MODL + 5 * D, gN + 3 * D, l < 3, gNn, MODN, MODN + D, rep + 1 < reps);
        } break;
        default: break;
        }
        }
        if (p + 1 < hi) { if (hi < 0) cg::this_grid().sync(); else { XcdBarrier xb; xb.bar = (unsigned*)(args.ws + WS_CTL); xb.x = xb_xcc_id(); xb.st = (volatile LAS unsigned*)(lds + LDS_BYTES - 64); int tidb; MY_TID(tidb); for (int br = 0; br < BAR_REPS; ++br) xcd_barrier(xb, tidb); } }
    }
}

extern "C" void kernel_launch(void* const* d_in, const int* in_sizes, int n_in, void* d_out, int out_size, void* d_ws, size_t ws_size, hipStream_t stream) {
    static int grid = 0;
    if (grid == 0) {
        int dev = 0, cus = 0, per_cu = 0;
        hipGetDevice(&dev);
        hipDeviceGetAttribute(&cus, hipDeviceAttributeMultiprocessorCount, dev);
        hipFuncSetAttribute((const void*)mega_fwd, hipFuncAttributeMaxDynamicSharedMemorySize, LDS_BYTES);
        hipOccupancyMaxActiveBlocksPerMultiprocessor(&per_cu, (const void*)mega_fwd, NTHREADS, LDS_BYTES);
        if (per_cu < 1) { fprintf(stderr, "kernel_launch: occupancy query says %d blocks per CU\n", per_cu); per_cu = 1; }
        (void)hipGetLastError();
        grid = cus;
        if (ws_size < 256 * MiB) fprintf(stderr, "kernel_launch: workspace too small (%zu)\n", ws_size);
    }
    (void)hipMemsetAsync((char*)d_ws + WS_CTL, 0, CTL_BYTES, stream);
    Args a{};
    for (int i = 0; i < 29; ++i) a.in[i] = (const float*)d_in[i];
    a.out = (float*)d_out; a.ws = (unsigned char*)d_ws;
#if MK_ONE_LAUNCH
    a.ph_lo = 0; a.ph_hi = N_PHASES;
    void* kargs[] = {&a};
    hipError_t e = hipLaunchCooperativeKernel((const void*)mega_fwd, dim3(grid), dim3(NTHREADS), kargs, LDS_BYTES, stream);
    if (e != hipSuccess) fprintf(stderr, "cooperative launch failed: %s (grid %d)\n", hipGetErrorString(e), grid);
#else
    for (int p = 0; p < N_PHASES; ++p) {
        a.ph_lo = p; a.ph_hi = p + 1;
        hipLaunchKernelGGL(mega_fwd, dim3(grid), dim3(NTHREADS), LDS_BYTES, stream, a);
    }
#endif
}
```

```cpp
#include <hip/hip_runtime.h>
#include <hip/hip_cooperative_groups.h>
#include <cstdio>
#include <cstdint>
namespace cg = cooperative_groups;

#ifndef MK_ONE_LAUNCH
#define MK_ONE_LAUNCH 1
#endif

#define LAS __attribute__((address_space(3)))
#define GAS __attribute__((address_space(1)))
typedef unsigned short bf16_t;
typedef short bf16x8 __attribute__((ext_vector_type(8)));
typedef float f32x4 __attribute__((ext_vector_type(4)));
typedef float f32x2 __attribute__((ext_vector_type(2)));
typedef unsigned u32x4 __attribute__((ext_vector_type(4)));
typedef unsigned u32x2 __attribute__((ext_vector_type(2)));

constexpr int D = 1024, TP = 4096, TS = 2048, T = TP + TS, FF = 4096;
constexpr int NPROJ = 2336, NPROJ_PAD = 2560, NDOWN = 672, NDOWN_PAD = 768;
constexpr int C_QA = 0, C_KA = 256, C_VA = 512, C_GA = 1024, C_LO = 1536, C_QB = 1568, C_KB = 2080, C_VB = 2208;
constexpr float EPS = 1e-6f;
constexpr int NTHREADS = 512, NWAVES = 8;
constexpr int LDS_BYTES = 147456;

constexpr size_t O_X = 0, O_SF = 6291456, O_SB = 7340032, O_CK = 8388608, O_CV = 9437184, O_CKV = 10485760, O_CKR = 12582912;

constexpr size_t MiB = 1u << 20;
constexpr size_t WS_WFF1 = 0, WS_WFF2 = 32 * MiB, WS_WIN = 64 * MiB, WS_WOUT = 74 * MiB, WS_WDOWN = 78 * MiB, WS_WUQ = 81 * MiB,
                 WS_WUKV = 84 * MiB, WS_WO = 86 * MiB, WS_MOD = 90 * MiB, WS_TAB = 91 * MiB, WS_CSK = 92 * MiB, WS_CSV = 93 * MiB,
                 WS_H = 94 * MiB, WS_MIX = 106 * MiB, WS_OUT = 118 * MiB, WS_U = 166 * MiB, WS_PROJ = 214 * MiB, WS_CTL = 250 * MiB;
constexpr size_t CTL_BYTES = 16384;
constexpr size_t WS_LOC = WS_U, WS_DEC = WS_U + 24 * MiB;
constexpr size_t WS_Q = WS_U, WS_KVX = WS_U + 18 * MiB;
constexpr size_t WS_DOWN = WS_PROJ, WS_CQ = WS_PROJ + 18 * MiB, WS_CKV = WS_PROJ + 23 * MiB, WS_KR = WS_PROJ + 27 * MiB;
constexpr size_t OUT_SPLIT = (size_t)T * D;
constexpr size_t DOWN_SPLIT = (WS_DOWN - WS_OUT) / 4;

__device__ __forceinline__ unsigned f2bf(float f) { unsigned u = __builtin_bit_cast(unsigned, f); return (u + 0x7fffu + ((u >> 16) & 1u)) >> 16; }
__device__ __forceinline__ unsigned pk2(float lo, float hi) { return f2bf(lo) | (f2bf(hi) << 16); }
__device__ __forceinline__ float bf2f(unsigned short b) { return __builtin_bit_cast(float, (unsigned)b << 16); }
__device__ __forceinline__ float bflo(unsigned w) { return __builtin_bit_cast(float, w << 16); }
__device__ __forceinline__ float bfhi(unsigned w) { return __builtin_bit_cast(float, w & 0xffff0000u); }
__device__ __forceinline__ void unpack8(const u32x4 v, float* f) {
    f[0] = bflo(v.x); f[1] = bfhi(v.x); f[2] = bflo(v.y); f[3] = bfhi(v.y); f[4] = bflo(v.z); f[5] = bfhi(v.z); f[6] = bflo(v.w); f[7] = bfhi(v.w);
}
__device__ __forceinline__ u32x4 pack8(const float* f) { u32x4 o; o.x = pk2(f[0], f[1]); o.y = pk2(f[2], f[3]); o.z = pk2(f[4], f[5]); o.w = pk2(f[6], f[7]); return o; }
__device__ __forceinline__ float wave_sum(float v) {
#pragma unroll
    for (int o = 1; o < 64; o <<= 1) v += __shfl_xor(v, o);
    return v;
}
__device__ __forceinline__ float xor16_max(float x) { const unsigned u = __builtin_bit_cast(unsigned, x); auto r = __builtin_amdgcn_permlane16_swap(u, u, false, false); return fmaxf(__builtin_bit_cast(float, (unsigned)r[0]), __builtin_bit_cast(float, (unsigned)r[1])); }
__device__ __forceinline__ float xor32_max(float x) { const unsigned u = __builtin_bit_cast(unsigned, x); auto r = __builtin_amdgcn_permlane32_swap(u, u, false, false); return fmaxf(__builtin_bit_cast(float, (unsigned)r[0]), __builtin_bit_cast(float, (unsigned)r[1])); }
__device__ __forceinline__ float xor16_add(float x) { const unsigned u = __builtin_bit_cast(unsigned, x); auto r = __builtin_amdgcn_permlane16_swap(u, u, false, false); return __builtin_bit_cast(float, (unsigned)r[0]) + __builtin_bit_cast(float, (unsigned)r[1]); }
__device__ __forceinline__ float xor32_add(float x) { const unsigned u = __builtin_bit_cast(unsigned, x); auto r = __builtin_amdgcn_permlane32_swap(u, u, false, false); return __builtin_bit_cast(float, (unsigned)r[0]) + __builtin_bit_cast(float, (unsigned)r[1]); }
__device__ __forceinline__ unsigned cvtpk(float lo, float hi) { unsigned r; asm volatile("v_cvt_pk_bf16_f32 %0, %1, %2" : "=v"(r) : "v"(lo), "v"(hi)); return r; }
__device__ __forceinline__ float silu_f(float x) { return x / (1.f + __expf(-x)); }

namespace pg8 {
constexpr int BM = 256, BK = 64, HALF = 128, HTB = HALF * BK * 2, NXCD = 8, WGM = 8;
__host__ __device__ __forceinline__ int lds_byte(int r, int c) { const int st = (r >> 4) * 2 + (c >> 5), rr = r & 15, cc = c & 31, ob = rr * 64 + cc * 2; return st * 1024 + (ob ^ (((ob >> 9) & 1) << 5)); }
__host__ __device__ __forceinline__ void stage_rc(int b, int& R, int& C) { const int st = b / 1024, sb = b % 1024, swz = sb ^ (((sb >> 9) & 1) << 5); R = (st >> 1) * 16 + swz / 64; C = (st & 1) * 32 + (swz % 64) / 2; }
__host__ __device__ __forceinline__ int perm32(int rho) { const int n = rho >> 4, i = rho & 15; return 8 * (i >> 2) + 4 * n + (i & 3); }

struct Unit { int pm, pn; };
struct Gemm { const bf16_t* A; const bf16_t* Bt; int M, N, K, lda, ldb, npn, a_split; };

struct StaticOrder {
    int nM, nN, nwg, G, c;
    __device__ void init(int M, int N, int G_, int c_) { nM = M / BM; nN = N / BM; nwg = nM * nN; G = G_; c = c_; }
    __device__ bool next(int i, Unit& u) const {
        const long L = (long)i * G + c; if (L >= nwg) return false;
        int wgid = (int)L; { const int q = nwg / NXCD, r = nwg % NXCD, xcd = wgid % NXCD, off = wgid / NXCD; wgid = (xcd < r ? xcd * (q + 1) : r * (q + 1) + (xcd - r) * q) + off; }
        const int nig = WGM * nN, gid = wgid / nig, fm = gid * WGM, gsz = (nM - fm) < WGM ? (nM - fm) : WGM;
        u.pm = fm + ((wgid % nig) % gsz); u.pn = (wgid % nig) / gsz; return true;
    }
};

__device__ __forceinline__ unsigned cvt_pk_bf16(float lo, float hi) { unsigned r; asm volatile("v_cvt_pk_bf16_f32 %0, %1, %2" : "=v"(r) : "v"(lo), "v"(hi)); return r; }

template <int ACT  > struct EpiBf16 {
    static constexpr bool PERM = true;
    bf16_t* O; int ldc;
    __device__ __forceinline__ void operator()(const f32x4 (&acc)[2][2][4][2], const Unit& u, int wr, int wc, int fr, int fq) const {
        const int row0 = u.pm * BM + wr * 64 + fr, col0 = u.pn * BM + wc * 32 + 8 * fq;
#pragma unroll
        for (int ai = 0; ai < 2; ++ai)
#pragma unroll
            for (int m = 0; m < 4; ++m) { __builtin_amdgcn_sched_barrier(0); bf16_t* rowp = O + (size_t)(row0 + ai * HALF + m * 16) * ldc + col0;
#pragma unroll
                for (int bj = 0; bj < 2; ++bj) { f32x4 v0 = acc[ai][bj][m][0], v1 = acc[ai][bj][m][1];
                    if (ACT == 1) {
#pragma unroll
                        for (int j = 0; j < 4; ++j) { float a = fmaxf(v0[j], 0.f), b = fmaxf(v1[j], 0.f); v0[j] = a * a; v1[j] = b * b; } }
                    u32x4 w; w.x = cvt_pk_bf16(v0[0], v0[1]); w.y = cvt_pk_bf16(v0[2], v0[3]); w.z = cvt_pk_bf16(v1[0], v1[1]); w.w = cvt_pk_bf16(v1[2], v1[3]);
                    *(u32x4*)(rowp + bj * HALF) = w; } }
    }
};
struct EpiProj {
    static constexpr bool PERM = true;
    bf16_t* O; float* outp; int li;
    __device__ __forceinline__ void operator()(const f32x4 (&acc)[2][2][4][2], const Unit& u, int wr, int wc, int fr, int fq) const {
        const int row0 = u.pm * BM + wr * 64 + fr, col0 = u.pn * BM + wc * 32 + 8 * fq;
#pragma unroll
        for (int ai = 0; ai < 2; ++ai)
#pragma unroll
            for (int m = 0; m < 4; ++m) { __builtin_amdgcn_sched_barrier(0); const int row = row0 + ai * HALF + m * 16; bf16_t* rowp = O + (size_t)row * NPROJ_PAD + col0;
#pragma unroll
                for (int bj = 0; bj < 2; ++bj) { const f32x4 v0 = acc[ai][bj][m][0], v1 = acc[ai][bj][m][1];
                    u32x4 w; w.x = cvt_pk_bf16(v0[0], v0[1]); w.y = cvt_pk_bf16(v0[2], v0[3]); w.z = cvt_pk_bf16(v1[0], v1[1]); w.w = cvt_pk_bf16(v1[2], v1[3]);
                    *(u32x4*)(rowp + bj * HALF) = w;
                    const int col = col0 + bj * HALF;
                    if (row < TP && col >= C_KB && col < NPROJ) {
                        const int b = row >> 8, t = row & 255;
                        float* dst = outp + ((col < C_VB) ? (O_CK - C_KB) : (O_CV - C_VB)) + ((size_t)((b * 2 + li) * 256 + t)) * 128 + col;
                        *(f32x4*)dst = v0; *(f32x4*)(dst + 4) = v1; } } }
    }
};
struct EpiSplitBf16 {
    static constexpr bool PERM = true;
    bf16_t* O; int ldc; int npn; size_t split_stride;
    __device__ __forceinline__ void operator()(const f32x4 (&acc)[2][2][4][2], const Unit& u, int wr, int wc, int fr, int fq) const {
        const int s = u.pn / npn, pn = u.pn - s * npn;
        bf16_t* base = O + (size_t)s * split_stride;
        const int row0 = u.pm * BM + wr * 64 + fr, col0 = pn * BM + wc * 32 + 8 * fq;
#pragma unroll
        for (int ai = 0; ai < 2; ++ai)
#pragma unroll
            for (int m = 0; m < 4; ++m) { __builtin_amdgcn_sched_barrier(0); bf16_t* rowp = base + (size_t)(row0 + ai * HALF + m * 16) * ldc + col0;
#pragma unroll
                for (int bj = 0; bj < 2; ++bj) { const f32x4 v0 = acc[ai][bj][m][0], v1 = acc[ai][bj][m][1];
                    u32x4 w; w.x = cvt_pk_bf16(v0[0], v0[1]); w.y = cvt_pk_bf16(v0[2], v0[3]); w.z = cvt_pk_bf16(v1[0], v1[1]); w.w = cvt_pk_bf16(v1[2], v1[3]);
                    *(u32x4*)(rowp + bj * HALF) = w; } }
    }
};
struct EpiF32 {
    static constexpr bool PERM = true;
    float* O; int ldc; int npn; size_t split_stride;
    __device__ __forceinline__ void operator()(const f32x4 (&acc)[2][2][4][2], const Unit& u, int wr, int wc, int fr, int fq) const {
        const int s = u.pn / npn, pn = u.pn - s * npn;
        float* base = O + (size_t)s * split_stride;
        const int row0 = u.pm * BM + wr * 64 + fr, col0 = pn * BM + wc * 32 + 8 * fq;
#pragma unroll
        for (int ai = 0; ai < 2; ++ai)
#pragma unroll
            for (int m = 0; m < 4; ++m) { __builtin_amdgcn_sched_barrier(0); float* rowp = base + (size_t)(row0 + ai * HALF + m * 16) * ldc + col0;
#pragma unroll
                for (int bj = 0; bj < 2; ++bj) { *(f32x4*)(rowp + bj * HALF) = acc[ai][bj][m][0]; *(f32x4*)(rowp + bj * HALF + 4) = acc[ai][bj][m][1]; } }
    }
};

template <class Epi, class Sched>
__device__ __forceinline__ void gemm_phase(LAS unsigned char* lds, const Gemm g, const Sched& S, const Epi& E, const int tid) {
    const int wid = __builtin_amdgcn_readfirstlane(tid >> 6), lane = tid & 63, wr = wid >> 2, wc = wid & 3, fr = lane & 15, fq = lane >> 4;
    const int K = g.K, nt = K / BK;
    unsigned voffA[2], voffB[2];
#pragma unroll
    for (int i = 0; i < 2; ++i) { int R, C; stage_rc(tid * 16 + i * 8192, R, C); const int Rb = Epi::PERM ? ((R & ~31) + perm32(R & 31)) : R;
        voffA[i] = (unsigned)(R * g.lda + C) * 2u; voffB[i] = (unsigned)(Rb * g.ldb + C) * 2u; }
    const size_t kstep = (size_t)(BK * 2);
    const size_t hstepA = (size_t)HALF * g.lda * 2, hstepB = (size_t)HALF * g.ldb * 2;
    const size_t tstepA = 2 * hstepA, tstepB = 2 * hstepB;
    const unsigned ldsw = (unsigned)wid * 1024u;
    const int aoff = lds_byte(wr * 64 + fr, fq * 8), boff = lds_byte(wc * 32 + fr, fq * 8);
#define PG8_SA(b, h) (((b) * 2 + (h)) * HTB)
#define PG8_SB(b, h) ((4 + (b) * 2 + (h)) * HTB)
#define PG8_STAGE(bufoff, gbase, voff) do { _Pragma("unroll") for (int _i = 0; _i < 2; ++_i) \
        __builtin_amdgcn_global_load_lds((const unsigned*)((const char*)(gbase) + (voff)[_i]), (LAS unsigned*)(lds + (bufoff) + ldsw + _i * 8192), 16, 0, 0); } while (0)
#define PG8_LDA(dst, b, h) do { _Pragma("unroll") for (int m = 0; m < 4; ++m) _Pragma("unroll") for (int k = 0; k < 2; ++k) dst[m][k] = *(const LAS bf16x8*)(lds + PG8_SA(b, h) + aoff + m * 2048 + k * 1024); } while (0)
#define PG8_LDB(dst, b, h) do { _Pragma("unroll") for (int n = 0; n < 2; ++n) _Pragma("unroll") for (int k = 0; k < 2; ++k) dst[n][k] = *(const LAS bf16x8*)(lds + PG8_SB(b, h) + boff + n * 2048 + k * 1024); } while (0)
#define PG8_MMA(ai, bj, At, Bt) do { __builtin_amdgcn_s_setprio(1); _Pragma("unroll") for (int m = 0; m < 4; ++m) _Pragma("unroll") for (int n = 0; n < 2; ++n) _Pragma("unroll") for (int k = 0; k < 2; ++k) \
        acc[ai][bj][m][n] = __builtin_amdgcn_mfma_f32_16x16x32_bf16(Bt[n][k], At[m][k], acc[ai][bj][m][n], 0, 0, 0); __builtin_amdgcn_s_setprio(0); } while (0)
#define PG8_WAIT_V(n) asm volatile("s_waitcnt vmcnt(" #n ")" ::: "memory")
#define PG8_WAIT_L(n) asm volatile("s_waitcnt lgkmcnt(" #n ")" ::: "memory")
#define PG8_BAR __builtin_amdgcn_s_barrier()
#define PG8_SCHED __builtin_amdgcn_sched_barrier(0)
#define PG8_UA(u) ((const char*)g.A + (size_t)(u).pm * tstepA + (size_t)((u).pn / g.npn) * (size_t)g.a_split * 2)
#define PG8_UB(u) ((const char*)g.Bt + (size_t)(u).pn * tstepB)
    Unit cur, nxt; int ui = 0;
    if (!S.next(0, cur)) return;
    f32x4 acc[2][2][4][2];
#pragma unroll
    for (int a = 0; a < 2; ++a)
#pragma unroll
        for (int b = 0; b < 2; ++b)
#pragma unroll
            for (int m = 0; m < 4; ++m)
#pragma unroll
                for (int n = 0; n < 2; ++n) acc[a][b][m][n] = (f32x4){0.f, 0.f, 0.f, 0.f};
    bf16x8 At[4][2], B0[2][2], B1[2][2];
    const char* cA = PG8_UA(cur); const char* cB = PG8_UB(cur);
    PG8_STAGE(PG8_SB(0, 0), cB, voffB); PG8_STAGE(PG8_SB(0, 1), cB + hstepB, voffB); PG8_STAGE(PG8_SA(0, 0), cA, voffA); PG8_STAGE(PG8_SA(0, 1), cA + hstepA, voffA);
    if (wr == 1) PG8_BAR;
    PG8_WAIT_V(2); PG8_BAR;
    PG8_STAGE(PG8_SB(1, 0), cB + kstep, voffB); PG8_STAGE(PG8_SA(1, 0), cA + kstep, voffA); PG8_STAGE(PG8_SB(1, 1), cB + hstepB + kstep, voffB);
    PG8_WAIT_V(6); PG8_BAR;
    for (;;) {
        const bool has_next = S.next(ui + 1, nxt);
        const char* nA = has_next ? PG8_UA(nxt) : cA; const char* nB = has_next ? PG8_UB(nxt) : cB;
        for (int t = 0; t < nt; t += 2) {
            const bool last = (t == nt - 2);
            const char* a1 = cA + (size_t)(t + 1) * kstep;
            const char* a2 = last ? nA : cA + (size_t)(t + 2) * kstep; const char* b2 = last ? nB : cB + (size_t)(t + 2) * kstep;
            const char* a3 = a2 + kstep; const char* b3 = b2 + kstep;
            PG8_LDB(B0, 0, 0); PG8_LDB(B1, 0, 1); PG8_SCHED; PG8_LDA(At, 0, 0); PG8_STAGE(PG8_SA(1, 1), a1 + hstepA, voffA);
            PG8_WAIT_V(8); PG8_WAIT_L(0); PG8_BAR; PG8_MMA(0, 0, At, B0); PG8_MMA(0, 1, At, B1); PG8_BAR; PG8_SCHED;
            PG8_LDA(At, 0, 1); PG8_STAGE(PG8_SB(0, 0), b2, voffB); PG8_STAGE(PG8_SB(0, 1), b2 + hstepB, voffB); PG8_STAGE(PG8_SA(0, 0), a2, voffA);
            PG8_WAIT_V(8); PG8_WAIT_L(0); PG8_BAR; PG8_MMA(1, 0, At, B0); PG8_MMA(1, 1, At, B1); PG8_BAR; PG8_SCHED;
            PG8_LDB(B0, 1, 0); PG8_LDB(B1, 1, 1); PG8_SCHED; PG8_LDA(At, 1, 0); PG8_STAGE(PG8_SA(0, 1), a2 + hstepA, voffA);
            PG8_WAIT_V(8); PG8_WAIT_L(0); PG8_BAR; PG8_MMA(0, 0, At, B0); PG8_MMA(0, 1, At, B1); PG8_BAR; PG8_SCHED;
            PG8_LDA(At, 1, 1); PG8_STAGE(PG8_SB(1, 0), b3, voffB); PG8_STAGE(PG8_SB(1, 1), b3 + hstepB, voffB); PG8_STAGE(PG8_SA(1, 0), a3, voffA);
            PG8_WAIT_V(8); PG8_WAIT_L(0); PG8_BAR; PG8_MMA(1, 0, At, B0); PG8_MMA(1, 1, At, B1); PG8_BAR; PG8_SCHED;
        }
        if (wr == 0) PG8_BAR;
        E(acc, cur, wr, wc, fr, fq);
        if (!has_next) break;
#pragma unroll
        for (int a = 0; a < 2; ++a)
#pragma unroll
            for (int b = 0; b < 2; ++b)
#pragma unroll
                for (int m = 0; m < 4; ++m)
#pragma unroll
                    for (int n = 0; n < 2; ++n) acc[a][b][m][n] = (f32x4){0.f, 0.f, 0.f, 0.f};
        cur = nxt; cA = nA; cB = nB; ++ui;
        if (wr == 1) PG8_BAR;
    }
    PG8_WAIT_V(0);
    PG8_BAR;
#undef PG8_SA
#undef PG8_SB
#undef PG8_STAGE
#undef PG8_LDA
#undef PG8_LDB
#undef PG8_MMA
#undef PG8_WAIT_V
#undef PG8_WAIT_L
#undef PG8_BAR
#undef PG8_SCHED
#undef PG8_UA
#undef PG8_UB
}
}

struct Args { const float* in[29]; float* out; unsigned char* ws; int ph_lo, ph_hi; };
struct Ctx { unsigned char* ws; float* out; int z, tid, bid, G; };

#define MFMA16(a, b, c) __builtin_amdgcn_mfma_f32_16x16x32_bf16((a), (b), (c), 0, 0, 0)

__device__ __forceinline__ void transpose_item(const float* W, int K, int N, bf16_t* WT, int npad, int ksub, LAS float* scr, int item, int lane) {
    const int nblk = N / 32, kb = item / nblk, nb = item % nblk, k0 = 64 * kb, n0 = 32 * nb;
#pragma unroll 8
    for (int i = 0; i < 32; ++i) { const int kk = 2 * i + (lane >> 5); scr[kk * 33 + (lane & 31)] = W[(size_t)(k0 + kk) * N + n0 + (lane & 31)]; }
    asm volatile("s_waitcnt lgkmcnt(0)" ::: "memory");
    const int c = lane & 7;
    const int ks = k0 / ksub, kin = k0 - ks * ksub;
    bf16_t* dbase = WT + (size_t)ks * npad * ksub + kin + 8 * c;
#pragma unroll
    for (int j = 0; j < 4; ++j) { const int n = (lane >> 3) + 8 * j; const LAS float* s = scr + (8 * c) * 33 + n;
        u32x4 o; o.x = pk2(s[0 * 33], s[1 * 33]); o.y = pk2(s[2 * 33], s[3 * 33]); o.z = pk2(s[4 * 33], s[5 * 33]); o.w = pk2(s[6 * 33], s[7 * 33]);
        *(u32x4*)(dbase + (size_t)(n0 + n) * ksub) = o; }
    asm volatile("s_waitcnt lgkmcnt(0)" ::: "memory");
}

struct MatDesc { const float* W; bf16_t* WT; int K, N, npad, ksub, items; };
__device__ __forceinline__ MatDesc get_mat(const Args& a, const Ctx& cx, int mi) {
    MatDesc m; unsigned char* ws = cx.ws;
    if (mi < 4)       { m.W = (a.in[13] + cx.z) + (size_t)mi * D * FF; m.WT = (bf16_t*)(ws + WS_WFF1) + (size_t)mi * FF * D; m.K = D; m.N = FF; m.npad = FF; m.ksub = D; }
    else if (mi < 8)  { const int l = mi - 4; m.W = (a.in[14] + cx.z) + (size_t)l * FF * D; m.WT = (bf16_t*)(ws + WS_WFF2) + (size_t)l * FF * D; m.K = FF; m.N = D; m.npad = D; m.ksub = FF / 2; }
    else if (mi < 10) { const int i = mi - 8; m.W = (a.in[15] + cx.z) + (size_t)i * D * NPROJ; m.WT = (bf16_t*)(ws + WS_WIN) + (size_t)i * NPROJ_PAD * D; m.K = D; m.N = NPROJ; m.npad = NPROJ_PAD; m.ksub = D; }
    else if (mi < 12) { const int i = mi - 10; m.W = (a.in[22] + cx.z) + (size_t)i * D * D; m.WT = (bf16_t*)(ws + WS_WOUT) + (size_t)i * D * D; m.K = D; m.N = D; m.npad = D; m.ksub = D / 2; }
    else if (mi < 14) { const int i = mi - 12; m.W = (a.in[23] + cx.z) + (size_t)i * D * NDOWN; m.WT = (bf16_t*)(ws + WS_WDOWN) + (size_t)i * NDOWN_PAD * D; m.K = D; m.N = NDOWN; m.npad = NDOWN_PAD; m.ksub = D / 2; }
    else if (mi < 16) { const int i = mi - 14; m.W = (a.in[26] + cx.z) + (size_t)i * 384 * 1536; m.WT = (bf16_t*)(ws + WS_WUQ) + (size_t)i * 1536 * 384; m.K = 384; m.N = 1536; m.npad = 1536; m.ksub = 384; }
    else if (mi < 18) { const int i = mi - 16; m.W = (a.in[27] + cx.z) + (size_t)i * 256 * 2048; m.WT = (bf16_t*)(ws + WS_WUKV) + (size_t)i * 2048 * 256; m.K = 256; m.N = 2048; m.npad = 2048; m.ksub = 256; }
    else              { const int i = mi - 18; m.W = (a.in[28] + cx.z) + (size_t)i * D * D; m.WT = (bf16_t*)(ws + WS_WO) + (size_t)i * D * D; m.K = D; m.N = D; m.npad = D; m.ksub = D / 2; }
    m.items = (m.K / 64) * (m.N / 32);
    return m;
}

__device__ __forceinline__ void prologue(const Args& a, const Ctx& cx, LAS unsigned char* lds) {
    const int tid = cx.tid, lane = tid & 63, wave = tid >> 6, G = cx.G, bid = cx.bid;
    unsigned char* ws = cx.ws;
    {
        LAS float* sc = (LAS float*)lds;
        LAS float* red = (LAS float*)(lds + 12288);
        for (int i = tid; i < 3 * D; i += NTHREADS) { const int g = i >> 10, k = i & 1023; const float v = (g == 0) ? (a.in[9] + cx.z)[k] : (a.in[8] + cx.z)[(g - 1) * D + k]; sc[i] = silu_f(v); }
        __syncthreads();
        float* MOD = (float*)(ws + WS_MOD);
        for (int it = bid; it < 4 * 48; it += G) {
            const int l = it / 48, jb = it % 48, jq = tid & 31, kg = tid >> 5, j = jb * 128 + jq * 4;
            const float* wp = (a.in[10] + cx.z) + ((size_t)l * D + kg * 64) * 6144 + j;
            f32x4 a0 = {0.f, 0.f, 0.f, 0.f}, a1 = a0, a2 = a0;
#pragma unroll 8
            for (int k = 0; k < 64; ++k) { const f32x4 w = *(const f32x4*)(wp + (size_t)k * 6144); const int kk = kg * 64 + k;
                a0 += w * sc[kk]; a1 += w * sc[D + kk]; a2 += w * sc[2 * D + kk]; }
#pragma unroll
            for (int e = 0; e < 4; ++e) { red[(kg * 3 + 0) * 128 + jq * 4 + e] = a0[e]; red[(kg * 3 + 1) * 128 + jq * 4 + e] = a1[e]; red[(kg * 3 + 2) * 128 + jq * 4 + e] = a2[e]; }
            __syncthreads();
            if (tid < 384) { const int g = tid >> 7, jj = tid & 127; float s = 0.f;
#pragma unroll
                for (int q = 0; q < 16; ++q) s += red[(q * 3 + g) * 128 + jj];
                MOD[((size_t)l * 3 + g) * 6144 + jb * 128 + jj] = s + (a.in[11] + cx.z)[(size_t)l * 6144 + jb * 128 + jj]; }
            __syncthreads();
        }
    }
    __syncthreads();
    {
        LAS float* scr = (LAS float*)(lds + wave * 16384);
        const int gw = bid * NWAVES + wave, NGW = G * NWAVES;
        int base = 0;
        for (int mi = 0; mi < 20; ++mi) {
            const MatDesc m = get_mat(a, cx, mi);
            int first = (gw - base) % NGW; if (first < 0) first += NGW;
            for (int it = first; it < m.items; it += NGW) transpose_item(m.W, m.K, m.N, m.WT, m.npad, m.ksub, scr, it, lane);
            base += m.items;
        }
    }
    {
        const size_t gt = (size_t)bid * NTHREADS + tid, NGT = (size_t)G * NTHREADS;
        for (int i = 0; i < 2; ++i) {
            u32x4* z1 = (u32x4*)((bf16_t*)(ws + WS_WIN) + (size_t)i * NPROJ_PAD * D + (size_t)NPROJ * D);
            for (size_t x = gt; x < (size_t)(NPROJ_PAD - NPROJ) * D / 8; x += NGT) z1[x] = (u32x4){0u, 0u, 0u, 0u};
            for (int ks = 0; ks < 2; ++ks) {
                u32x4* z2 = (u32x4*)((bf16_t*)(ws + WS_WDOWN) + (size_t)i * NDOWN_PAD * D + (size_t)ks * NDOWN_PAD * (D / 2) + (size_t)NDOWN * (D / 2));
                for (size_t x = gt; x < (size_t)(NDOWN_PAD - NDOWN) * (D / 2) / 8; x += NGT) z2[x] = (u32x4){0u, 0u, 0u, 0u}; }
        }
        f32x2* tab64 = (f32x2*)(ws + WS_TAB); f32x2* tab32 = tab64 + 64 * 16;
        for (size_t x = gt; x < 64 * 16; x += NGT) { const int pos = (int)x >> 4, f = (int)x & 15; const float inv = powf(10000.f, -(float)f / 16.f); const float ang = (float)pos * inv; tab64[x] = (f32x2){cosf(ang), sinf(ang)}; }
        for (size_t x = gt; x < 64 * 8; x += NGT) { const int pos = (int)x >> 3, f = (int)x & 7; const float inv = powf(10000.f, -(float)f / 8.f); const float ang = (float)pos * inv; tab32[x] = (f32x2){cosf(ang), sinf(ang)}; }
        bf16_t* csk = (bf16_t*)(ws + WS_CSK); bf16_t* csv = (bf16_t*)(ws + WS_CSV);
        for (size_t x = gt; x < (size_t)2 * 2 * 512 * 128 / 4; x += NGT) {
            const size_t e = x * 4; const int b = (int)(e / (2 * 65536)), i = (int)(e / 65536) & 1; const size_t r = e % 65536;
            const size_t d = ((size_t)(i * 2 + b)) * 65536 + r;
            const f32x4 k = *(const f32x4*)((a.in[4] + cx.z) + e), v = *(const f32x4*)((a.in[5] + cx.z) + e);
            *(u32x2*)(csk + d) = (u32x2){pk2(k[0], k[1]), pk2(k[2], k[3])};
            *(u32x2*)(csv + d) = (u32x2){pk2(v[0], v[1]), pk2(v[2], v[3])};
        }
    }
}

__device__ __forceinline__ int mod_group(int r) { return r < TP ? 0 : 1 + ((r - TP) >> 10); }

__device__ __forceinline__ void pre_rows(const Args& a, const Ctx& cx, int l) {
    const int lane = cx.tid & 63, gw = cx.bid * NWAVES + (cx.tid >> 6), NGW = cx.G * NWAVES;
    const float* MOD = (const float*)(cx.ws + WS_MOD) + (size_t)l * 3 * 6144;
    const float* gA = (a.in[12] + cx.z) + (size_t)l * 4 * D;
    bf16_t* H = (bf16_t*)(cx.ws + WS_H);
    for (int r = gw; r < T; r += NGW) {
        const float* xr = (r < TP) ? (a.in[0] + cx.z) + (size_t)r * D : (a.in[1] + cx.z) + (size_t)(r - TP) * D;
        const float* m = MOD + (size_t)mod_group(r) * 6144;
        f32x4 v[4]; float s = 0.f;
#pragma unroll
        for (int j = 0; j < 4; ++j) { v[j] = *(const f32x4*)(xr + lane * 4 + 256 * j); s += v[j][0] * v[j][0] + v[j][1] * v[j][1] + v[j][2] * v[j][2] + v[j][3] * v[j][3]; }
        f32x4 vg[4], vsh[4], vsc[4];
#pragma unroll
        for (int j = 0; j < 4; ++j) { const int c = lane * 4 + 256 * j; vg[j] = *(const f32x4*)(gA + c); vsh[j] = *(const f32x4*)(m + c); vsc[j] = *(const f32x4*)(m + D + c); }
        const float rstd = rsqrtf(wave_sum(s) * (1.f / D) + EPS);
#pragma unroll
        for (int j = 0; j < 4; ++j) { const int c = lane * 4 + 256 * j;
            const f32x4 g = vg[j], sh = vsh[j], scl = vsc[j];
            const f32x4 h = v[j] * rstd * g * (scl + 1.f) + sh;
            *(u32x2*)(H + (size_t)r * D + c) = (u32x2){pk2(h[0], h[1]), pk2(h[2], h[3])}; }
    }
}

__device__ __forceinline__ void post_rows(const Args& a, const Ctx& cx, bool x_from_input, const float* gate_base  , const float* gB,
                                          bool has_next, const float* gC, const float* shift_base, const float* scale_base, bool dry) {
    constexpr int RB = 3;
    const int lane = cx.tid & 63, gw = cx.bid * NWAVES + (cx.tid >> 6), NGW = cx.G * NWAVES;
    const bf16_t* OUT = (const bf16_t*)(cx.ws + WS_OUT);
    bf16_t* H = dry ? (bf16_t*)(cx.ws + WS_U + 24 * MiB) : (bf16_t*)(cx.ws + WS_H);
    float* xout = dry ? (float*)(cx.ws + WS_U) : cx.out;
    for (int rb = gw * RB; rb < T; rb += NGW * RB) {
        f32x4 o[RB][4], x[RB][4]; float s[RB], s2[RB]; size_t mg[RB];
        const size_t mg0 = (size_t)mod_group(rb < T ? rb : T - 1) * 6144;
        f32x4 vgB[4], vgt[4];
#pragma unroll
        for (int j = 0; j < 4; ++j) { const int c = lane * 4 + 256 * j; vgB[j] = *(const f32x4*)(gB + c); vgt[j] = *(const f32x4*)(gate_base + mg0 + c); }
#pragma unroll
        for (int q = 0; q < RB; ++q) { const int r = (rb + q < T) ? rb + q : T - 1;
            const float* xr = x_from_input ? ((r < TP) ? (a.in[0] + cx.z) + (size_t)r * D : (a.in[1] + cx.z) + (size_t)(r - TP) * D) : cx.out + (size_t)r * D;
            mg[q] = (size_t)mod_group(r) * 6144;
#pragma unroll
            for (int j = 0; j < 4; ++j) { const int c = lane * 4 + 256 * j;
                { const u32x2 p0 = *(const u32x2*)(OUT + (size_t)r * D + c), p1 = *(const u32x2*)(OUT + OUT_SPLIT + (size_t)r * D + c);
                  o[q][j] = (f32x4){bflo(p0.x) + bflo(p1.x), bfhi(p0.x) + bfhi(p1.x), bflo(p0.y) + bflo(p1.y), bfhi(p0.y) + bfhi(p1.y)}; }
                x[q][j] = *(const f32x4*)(xr + c); } }
#pragma unroll
        for (int q = 0; q < RB; ++q) { float t = 0.f;
#pragma unroll
            for (int j = 0; j < 4; ++j) t += o[q][j][0] * o[q][j][0] + o[q][j][1] * o[q][j][1] + o[q][j][2] * o[q][j][2] + o[q][j][3] * o[q][j][3];
            s[q] = t; }
#pragma unroll
        for (int off = 1; off < 64; off <<= 1) {
#pragma unroll
            for (int q = 0; q < RB; ++q) s[q] += __shfl_xor(s[q], off); }
#pragma unroll
        for (int q = 0; q < RB; ++q) { const int r = rb + q; const float rstd = rsqrtf(s[q] * (1.f / D) + EPS); float t = 0.f;
            const bool same = (mg[q] == mg0);
#pragma unroll
            for (int j = 0; j < 4; ++j) { const int c = lane * 4 + 256 * j;
                const f32x4 gt = same ? vgt[j] : *(const f32x4*)(gate_base + mg[q] + c);
                x[q][j] = x[q][j] + gt * (o[q][j] * rstd * vgB[j]);
                if (r < T) *(f32x4*)(xout + (size_t)r * D + c) = x[q][j];
                t += x[q][j][0] * x[q][j][0] + x[q][j][1] * x[q][j][1] + x[q][j][2] * x[q][j][2] + x[q][j][3] * x[q][j][3]; }
            s2[q] = t; }
        if (has_next) {
            f32x4 vgC[4], vsh[4], vsc[4];
#pragma unroll
            for (int j = 0; j < 4; ++j) { const int c = lane * 4 + 256 * j; vgC[j] = *(const f32x4*)(gC + c); vsh[j] = *(const f32x4*)(shift_base + mg0 + c); vsc[j] = *(const f32x4*)(scale_base + mg0 + c); }
#pragma unroll
            for (int off = 1; off < 64; off <<= 1) {
#pragma unroll
                for (int q = 0; q < RB; ++q) s2[q] += __shfl_xor(s2[q], off); }
#pragma unroll
            for (int q = 0; q < RB; ++q) { const int r = rb + q; const float rstd2 = rsqrtf(s2[q] * (1.f / D) + EPS);
                const bool same = (mg[q] == mg0);
#pragma unroll
                for (int j = 0; j < 4; ++j) { const int c = lane * 4 + 256 * j;
                    const f32x4 sh = same ? vsh[j] : *(const f32x4*)(shift_base + mg[q] + c), scl = same ? vsc[j] : *(const f32x4*)(scale_base + mg[q] + c);
                    const f32x4 h = x[q][j] * rstd2 * vgC[j] * (scl + 1.f) + sh;
                    if (r < T) *(u32x2*)(H + (size_t)r * D + c) = (u32x2){pk2(h[0], h[1]), pk2(h[2], h[3])}; } }
        }
    }
}

__device__ __forceinline__ void mla_mid(const Args& a, const Ctx& cx, int i) {
    constexpr int RB = 3;
    const int lane = cx.tid & 63, gw = cx.bid * NWAVES + (cx.tid >> 6), NGW = cx.G * NWAVES;
    const float* DOWN = (const float*)(cx.ws + WS_OUT);
    bf16_t* CQ = (bf16_t*)(cx.ws + WS_CQ); bf16_t* CKV = (bf16_t*)(cx.ws + WS_CKV); bf16_t* KR = (bf16_t*)(cx.ws + WS_KR);
    const float* gq = (a.in[24] + cx.z) + (size_t)i * 384; const float* gkv = (a.in[25] + cx.z) + (size_t)i * 256;
    const f32x2* tab32 = (const f32x2*)(cx.ws + WS_TAB) + 64 * 16;
    for (int r = T + gw; r < T + 1024; r += NGW) {
        const int rr = r - T, b = rr >> 9, j = rr & 511;
        const float* src = (a.in[6] + cx.z) + ((size_t)((b * 2 + i) * 512 + j)) * 256;
        float v[4];
#pragma unroll
        for (int q = 0; q < 4; ++q) v[q] = src[lane + 64 * q];
        const float kr = (lane < 32) ? (a.in[7] + cx.z)[((size_t)((b * 2 + i) * 512 + j)) * 32 + lane] : 0.f;
#pragma unroll
        for (int q = 0; q < 4; ++q) CKV[(size_t)r * 256 + lane + 64 * q] = (bf16_t)f2bf(v[q]);
        if (lane < 32) KR[(size_t)r * 32 + lane] = (bf16_t)f2bf(kr);
    }
    for (int rb = gw * RB; rb < T; rb += NGW * RB) {
        float q[RB][6], kv[RB][4], kr[RB], ot[RB], sq[RB], sk[RB], vq[6], vk[4];
#pragma unroll
        for (int j = 0; j < 6; ++j) vq[j] = gq[lane + 64 * j];
#pragma unroll
        for (int j = 0; j < 4; ++j) vk[j] = gkv[lane + 64 * j];
#pragma unroll
        for (int u = 0; u < RB; ++u) { const int r = (rb + u < T) ? rb + u : T - 1; const float* dr = DOWN + (size_t)r * NDOWN_PAD;
#pragma unroll
            for (int j = 0; j < 6; ++j) q[u][j] = dr[lane + 64 * j] + dr[DOWN_SPLIT + lane + 64 * j];
#pragma unroll
            for (int j = 0; j < 4; ++j) kv[u][j] = dr[384 + lane + 64 * j] + dr[DOWN_SPLIT + 384 + lane + 64 * j];
            kr[u] = dr[640 + (lane & 31)] + dr[DOWN_SPLIT + 640 + (lane & 31)];
            ot[u] = dr[640 + ((lane & 31) ^ 8)] + dr[DOWN_SPLIT + 640 + ((lane & 31) ^ 8)]; }
#pragma unroll
        for (int u = 0; u < RB; ++u) { float s = 0.f, t = 0.f;
#pragma unroll
            for (int j = 0; j < 6; ++j) s += q[u][j] * q[u][j];
#pragma unroll
            for (int j = 0; j < 4; ++j) t += kv[u][j] * kv[u][j];
            sq[u] = s; sk[u] = t; }
#pragma unroll
        for (int off = 1; off < 64; off <<= 1) {
#pragma unroll
            for (int u = 0; u < RB; ++u) { sq[u] += __shfl_xor(sq[u], off); sk[u] += __shfl_xor(sk[u], off); } }
#pragma unroll
        for (int u = 0; u < RB; ++u) { const int r = rb + u; if (r >= T) continue;
            const float rq = rsqrtf(sq[u] * (1.f / 384.f) + EPS), rk = rsqrtf(sk[u] * (1.f / 256.f) + EPS);
#pragma unroll
            for (int j = 0; j < 6; ++j) CQ[(size_t)r * 384 + lane + 64 * j] = (bf16_t)f2bf(q[u][j] * rq * vq[j]);
#pragma unroll
            for (int j = 0; j < 4; ++j) { const float v = kv[u][j] * rk * vk[j]; CKV[(size_t)r * 256 + lane + 64 * j] = (bf16_t)f2bf(v);
                if (r < TP) { const int b = r >> 8, t = r & 255; cx.out[O_CKV + ((size_t)((b * 2 + i) * 256 + t)) * 256 + lane + 64 * j] = v; } }
            if (lane < 32) {
                if (r < TP) { const int b = r >> 8, t = r & 255; cx.out[O_CKR + ((size_t)((b * 2 + i) * 256 + t)) * 32 + lane] = kr[u]; KR[(size_t)r * 32 + lane] = (bf16_t)f2bf(kr[u]); }
                else {
                    const int t = (r - TP) & 1023, half = lane >> 4, p = (lane >> 3) & 1, f = lane & 7, pos = half ? (t & 63) : (t >> 6);
                    const f32x2 cs = tab32[pos * 8 + f];
                    const float v = p ? (ot[u] * cs[1] + kr[u] * cs[0]) : (kr[u] * cs[0] - ot[u] * cs[1]);
                    KR[(size_t)r * 32 + lane] = (bf16_t)f2bf(v);
                }
            }
        }
    }
}

struct KSeg { const bf16_t* K; int kstride; const bf16_t* K2; int k2stride; const bf16_t* V; int vstride; int k_lo, k_hi; int rope; int mask; };
struct AttnArgs { const bf16_t* Q; int qstride; int qpos0; int qrope  ; int nseg; KSeg seg0, seg1;
                  float m0, l0, scale; bf16_t* O; int ostride; const f32x2* tab64; const f32x2* tab32; };

__device__ __forceinline__ u32x4 rope8(const u32x4 own, const u32x4 partner, int p, const f32x2* tab) {
    float a[8], b[8], o[8]; unpack8(own, a); unpack8(partner, b);
#pragma unroll
    for (int e = 0; e < 8; ++e) { const f32x2 cs = tab[e]; o[e] = p ? (b[e] * cs[1] + a[e] * cs[0]) : (a[e] * cs[0] - b[e] * cs[1]); }
    return pack8(o);
}

template <int DQK>
__device__ __forceinline__ void attn_unit(LAS unsigned char* lds, const AttnArgs& A, const int tid) {
    constexpr int KT = 64;
    constexpr int QS = DQK + 8, VS = KT + 8, NCH = DQK / 8, NKS = DQK / 32, KCH = KT * NCH, KPT = (KCH + NTHREADS - 1) / NTHREADS, VPT = KT / 64, NT = KT / 16;
    LAS bf16_t* Qs = (LAS bf16_t*)lds;
    LAS bf16_t* Ks = Qs + 128 * QS;
    LAS bf16_t* VT = Ks + 2 * KT * QS;
    const int lane = tid & 63, w = tid >> 6, fr = lane & 15, fq = lane >> 4;
    const int n0 = (A.seg0.k_hi - A.seg0.k_lo) / KT, n1 = (A.nseg > 1) ? ((A.seg1.k_hi - A.seg1.k_lo) / KT) : 0, ntiles = n0 + n1;
    int kkey[KPT], kch[KPT];
#pragma unroll
    for (int i = 0; i < KPT; ++i) { const int c = tid + i * NTHREADS; kkey[i] = c / NCH; kch[i] = c % NCH; }
    const int vkey = tid & 63, vch = tid >> 6;
    u32x4 kr[KPT], kp[KPT], vr[VPT]; int pf_kt = 0, pf_rope = 0, pf_mask = 0;
#define ATT_PREFETCH(j) do { const bool s0_ = (j) < n0; const KSeg S = s0_ ? A.seg0 : A.seg1; const int kt = s0_ ? (A.seg0.k_lo + KT * (j)) : (A.seg1.k_lo + KT * ((j) - n0)); \
        _Pragma("unroll") for (int i = 0; i < KPT; ++i) if (tid + i * NTHREADS < KCH) { const int d0 = kch[i] * 8; \
            if (DQK == 96 && kch[i] >= 8) kr[i] = *(const u32x4*)(S.K2 + (size_t)(kt + kkey[i]) * S.k2stride + (d0 - 64)); \
            else { const bf16_t* src = S.K + (size_t)(kt + kkey[i]) * S.kstride; kr[i] = *(const u32x4*)(src + d0); if (DQK == 64 && S.rope) kp[i] = *(const u32x4*)(src + (d0 ^ 16)); } } \
        _Pragma("unroll") for (int i = 0; i < VPT; ++i) vr[i] = *(const u32x4*)(S.V + (size_t)(kt + vkey + 64 * i) * S.vstride + vch * 8); \
        pf_kt = kt; pf_rope = S.rope; pf_mask = S.mask; } while (0)
#define ATT_WRITE(buf) do { LAS bf16_t* Kb = Ks + (buf) * KT * QS; LAS bf16_t* Vb = VT + (buf) * 64 * VS; \
        _Pragma("unroll") for (int i = 0; i < KPT; ++i) if (tid + i * NTHREADS < KCH) { u32x4 v = kr[i]; \
            if (DQK == 64 && pf_rope) { const int t = pf_kt + kkey[i], ch = kch[i], half = ch >> 2, p = (ch >> 1) & 1, f0 = (ch & 1) * 8, pos = half ? (t & 63) : (t >> 6); v = rope8(v, kp[i], p, A.tab64 + pos * 16 + f0); } \
            *(LAS u32x4*)(Kb + kkey[i] * QS + kch[i] * 8) = v; } \
        _Pragma("unroll") for (int i = 0; i < VPT; ++i) { LAS bf16_t* dst = Vb + (vch * 8) * VS + vkey + 64 * i; const u32x4 v = vr[i]; \
          dst[0 * VS] = (bf16_t)(v.x & 0xffff); dst[1 * VS] = (bf16_t)(v.x >> 16); dst[2 * VS] = (bf16_t)(v.y & 0xffff); dst[3 * VS] = (bf16_t)(v.y >> 16); \
          dst[4 * VS] = (bf16_t)(v.z & 0xffff); dst[5 * VS] = (bf16_t)(v.z >> 16); dst[6 * VS] = (bf16_t)(v.w & 0xffff); dst[7 * VS] = (bf16_t)(v.w >> 16); } } while (0)
    ATT_PREFETCH(0);
    __syncthreads();
    for (int c = tid; c < 128 * NCH; c += NTHREADS) {
        const int qi = c / NCH, ch = c % NCH, d0 = ch * 8;
        const bf16_t* src = A.Q + (size_t)qi * A.qstride;
        u32x4 v = *(const u32x4*)(src + d0);
        const int t = A.qpos0 + qi;
        if (A.qrope == 1) { const int half = ch >> 2, p = (ch >> 1) & 1, f0 = (ch & 1) * 8, pos = half ? (t & 63) : (t >> 6);
            const u32x4 pv = *(const u32x4*)(src + (d0 ^ 16)); v = rope8(v, pv, p, A.tab64 + pos * 16 + f0); }
        else if (A.qrope == 2 && ch >= 8) { const int c2 = ch - 8, half = c2 >> 1, p = c2 & 1, pos = half ? (t & 63) : (t >> 6);
            const u32x4 pv = *(const u32x4*)(src + 64 + ((c2 ^ 1) * 8)); v = rope8(v, pv, p, A.tab32 + pos * 8); }
        *(LAS u32x4*)(Qs + qi * QS + d0) = v;
    }
    ATT_WRITE(0);
    int cur_kt = pf_kt, cur_mask = pf_mask;
    if (ntiles > 1) ATT_PREFETCH(1);
    __syncthreads();
    bf16x8 Qf[NKS];
#pragma unroll
    for (int ks = 0; ks < NKS; ++ks) Qf[ks] = *(const LAS bf16x8*)(Qs + (w * 16 + fr) * QS + ks * 32 + fq * 8);
    const float scl2 = A.scale * 1.4426950408889634f;
    float m = (A.m0 > -1e29f) ? A.m0 * 1.4426950408889634f : A.m0, l = (fq == 0) ? A.l0 : 0.f;
    f32x4 Oa[4];
#pragma unroll
    for (int dt = 0; dt < 4; ++dt) Oa[dt] = (f32x4){0.f, 0.f, 0.f, 0.f};
    const int qp = A.qpos0 + w * 16 + fr;
    for (int j = 0; j < ntiles; ++j) {
        const LAS bf16_t* Kb = Ks + (j & 1) * KT * QS; const LAS bf16_t* Vb = VT + (j & 1) * 64 * VS;
        f32x4 st[NT];
#pragma unroll
        for (int nt = 0; nt < NT; ++nt) { st[nt] = (f32x4){0.f, 0.f, 0.f, 0.f};
#pragma unroll
            for (int ks = 0; ks < NKS; ++ks) { const bf16x8 kf = *(const LAS bf16x8*)(Kb + (nt * 16 + fr) * QS + ks * 32 + fq * 8); st[nt] = MFMA16(kf, Qf[ks], st[nt]); } }
        float mx = -1e30f;
#pragma unroll
        for (int nt = 0; nt < NT; ++nt)
#pragma unroll
            for (int jj = 0; jj < 4; ++jj) { float sc = st[nt][jj] * scl2;
                if (cur_mask) { const int kpos = cur_kt + nt * 16 + fq * 4 + jj; const int dd = qp - kpos; if (dd > 128 || dd < -128) sc = -1e30f; }
                st[nt][jj] = sc; mx = fmaxf(mx, sc); }
        mx = xor16_max(mx); mx = xor32_max(mx);
        const float mn = fmaxf(m, mx), alpha = __builtin_amdgcn_exp2f(m - mn);
        float rs = 0.f;
#pragma unroll
        for (int nt = 0; nt < NT; ++nt)
#pragma unroll
            for (int jj = 0; jj < 4; ++jj) { const float pe = __builtin_amdgcn_exp2f(st[nt][jj] - mn); st[nt][jj] = pe; rs += pe; }
        l = l * alpha + rs; m = mn;
#pragma unroll
        for (int dt = 0; dt < 4; ++dt) Oa[dt] = Oa[dt] * alpha;
#pragma unroll
        for (int kk = 0; kk < KT / 32; ++kk) {
            u32x4 pb; pb.x = cvtpk(st[2 * kk][0], st[2 * kk][1]); pb.y = cvtpk(st[2 * kk][2], st[2 * kk][3]); pb.z = cvtpk(st[2 * kk + 1][0], st[2 * kk + 1][1]); pb.w = cvtpk(st[2 * kk + 1][2], st[2 * kk + 1][3]);
            const bf16x8 pf = __builtin_bit_cast(bf16x8, pb);
#pragma unroll
            for (int dt = 0; dt < 4; ++dt) {
                const LAS bf16_t* vp = Vb + (dt * 16 + fr) * VS + 32 * kk + fq * 4;
                const u32x2 v0 = *(const LAS u32x2*)vp, v1 = *(const LAS u32x2*)(vp + 16);
                const u32x4 vv = {v0.x, v0.y, v1.x, v1.y};
                Oa[dt] = MFMA16(__builtin_bit_cast(bf16x8, vv), pf, Oa[dt]);
            }
        }
        if (j + 1 < ntiles) { ATT_WRITE((j + 1) & 1); cur_kt = pf_kt; cur_mask = pf_mask; if (j + 2 < ntiles) ATT_PREFETCH(j + 2); }
        __syncthreads();
    }
#undef ATT_PREFETCH
#undef ATT_WRITE
    l = xor16_add(l); l = xor32_add(l);
    const float inv = 1.f / l;
    bf16_t* op = A.O + (size_t)(w * 16 + fr) * A.ostride + fq * 4;
#pragma unroll
    for (int dt = 0; dt < 4; ++dt) *(u32x2*)(op + dt * 16) = (u32x2){pk2(Oa[dt][0] * inv, Oa[dt][1] * inv), pk2(Oa[dt][2] * inv, Oa[dt][3] * inv)};
}

__device__ __forceinline__ void swa_unit(const Args& a, const Ctx& cx, LAS unsigned char* lds, int i, int u) {
    const bf16_t* PROJ = (const bf16_t*)(cx.ws + WS_PROJ); bf16_t* MIX = (bf16_t*)(cx.ws + WS_MIX);
    AttnArgs A;
    A.tab64 = (const f32x2*)(cx.ws + WS_TAB); A.tab32 = A.tab64 + 64 * 16;
    A.qstride = NPROJ_PAD; A.ostride = D; A.scale = 0.125f; A.l0 = 1.f;
    if (u < 128) {
        const int b = u >> 6, hq = (u >> 3) & 7, qt = u & 7, kv = hq >> 2, row0 = TP + b * 1024, q0 = qt * 128;
        A.Q = PROJ + (size_t)(row0 + q0) * NPROJ_PAD + C_QB + hq * 64; A.qpos0 = q0; A.qrope = 1; A.nseg = 2;
        A.m0 = (a.in[21] + cx.z)[i * 8 + hq];
        const bf16_t* csk = (const bf16_t*)(cx.ws + WS_CSK) + ((size_t)(i * 2 + b)) * 65536 + kv * 64;
        const bf16_t* csv = (const bf16_t*)(cx.ws + WS_CSV) + ((size_t)(i * 2 + b)) * 65536 + kv * 64;
        A.seg0 = KSeg{csk, 128, nullptr, 0, csv, 128, 0, 512, 0, 0};
        const int lo = q0 - 128 < 0 ? 0 : q0 - 128, hi = q0 + 256 > 1024 ? 1024 : q0 + 256;
        A.seg1 = KSeg{PROJ + (size_t)row0 * NPROJ_PAD + C_KB + kv * 64, NPROJ_PAD, nullptr, 0, PROJ + (size_t)row0 * NPROJ_PAD + C_VB + kv * 64, NPROJ_PAD, lo, hi, 1, 1};
        A.O = MIX + (size_t)(row0 + q0) * D + 512 + hq * 64;
    } else {
        const int v = u - 128, b = v >> 4, hq = (v >> 1) & 7, qt = v & 1, kv = hq >> 2, row0 = b * 256, q0 = qt * 128;
        A.Q = PROJ + (size_t)(row0 + q0) * NPROJ_PAD + C_QB + hq * 64; A.qpos0 = q0; A.qrope = 0; A.nseg = 1;
        A.m0 = (a.in[21] + cx.z)[i * 8 + hq];
        A.seg0 = KSeg{PROJ + (size_t)row0 * NPROJ_PAD + C_KB + kv * 64, NPROJ_PAD, nullptr, 0, PROJ + (size_t)row0 * NPROJ_PAD + C_VB + kv * 64, NPROJ_PAD, 0, 256, 0, 0};
        A.seg1 = A.seg0;
        A.O = MIX + (size_t)(row0 + q0) * D + 512 + hq * 64;
    }
    attn_unit<64>(lds, A, cx.tid);
}

__device__ __forceinline__ void mla_unit(const Args& a, const Ctx& cx, LAS unsigned char* lds, int u) {
    const bf16_t* Q = (const bf16_t*)(cx.ws + WS_Q); const bf16_t* KVX = (const bf16_t*)(cx.ws + WS_KVX); const bf16_t* KR = (const bf16_t*)(cx.ws + WS_KR);
    bf16_t* MIX = (bf16_t*)(cx.ws + WS_MIX);
    AttnArgs A;
    A.tab64 = (const f32x2*)(cx.ws + WS_TAB); A.tab32 = A.tab64 + 64 * 16;
    A.qstride = 1536; A.ostride = D; A.scale = 0.10206207261596577f; A.l0 = 0.f; A.m0 = -1e30f;
    if (u < 256) {
        const int b = u >> 7, h = (u >> 3) & 15, qt = u & 7, row0 = TP + b * 1024, q0 = qt * 128, crow0 = T + b * 512;
        A.Q = Q + (size_t)(row0 + q0) * 1536 + h * 96; A.qpos0 = q0; A.qrope = 2; A.nseg = 2;
        A.seg0 = KSeg{KVX + (size_t)crow0 * 2048 + h * 128, 2048, KR + (size_t)crow0 * 32, 32, KVX + (size_t)crow0 * 2048 + h * 128 + 64, 2048, 0, 512, 0, 0};
        A.seg1 = KSeg{KVX + (size_t)row0 * 2048 + h * 128, 2048, KR + (size_t)row0 * 32, 32, KVX + (size_t)row0 * 2048 + h * 128 + 64, 2048, 0, 1024, 0, 0};
        A.O = MIX + (size_t)(row0 + q0) * D + h * 64;
    } else {
        const int v = u - 256, b = v >> 5, h = (v >> 1) & 15, qt = v & 1, row0 = b * 256, q0 = qt * 128;
        A.Q = Q + (size_t)(row0 + q0) * 1536 + h * 96; A.qpos0 = q0; A.qrope = 0; A.nseg = 1;
        A.seg0 = KSeg{KVX + (size_t)row0 * 2048 + h * 128, 2048, KR + (size_t)row0 * 32, 32, KVX + (size_t)row0 * 2048 + h * 128 + 64, 2048, 0, 256, 0, 0};
        A.seg1 = A.seg0;
        A.O = MIX + (size_t)(row0 + q0) * D + h * 64;
    }
    attn_unit<96>(lds, A, cx.tid);
}

constexpr int GL_G = 0;
constexpr int GL_STF = 32768, GL_STB = 51200;
constexpr int GL_LO = 32768, GL_WF = 40960, GL_WB = 45056, GL_BF = 49152, GL_BB = 49408;
constexpr int GL_QF = 69632, GL_KF = 78848, GL_QB = 88064, GL_KB = 97280;
constexpr int GL_VT = 106496;
constexpr int GL_AF = 124928, GL_AB = 134144;

__device__ __forceinline__ void gla_gates(const Args& a, const Ctx& cx, LAS unsigned char* lds, int i, int tok0, int h) {
    const int tid = cx.tid;
    const bf16_t* PROJ = (const bf16_t*)(cx.ws + WS_PROJ);
    LAS float* LO = (LAS float*)(lds + GL_LO); LAS float* WF = (LAS float*)(lds + GL_WF); LAS float* WB = (LAS float*)(lds + GL_WB);
    LAS float* BF = (LAS float*)(lds + GL_BF); LAS float* BB = (LAS float*)(lds + GL_BB);
    LAS float* Gf = (LAS float*)(lds + GL_G); LAS float* Gb = Gf + 4096;
    { const int t = tid >> 3, j0 = (tid & 7) * 4; const u32x2 v = *(const u32x2*)(PROJ + (size_t)(tok0 + t) * NPROJ_PAD + C_LO + j0);
      LO[t * 32 + j0] = bflo(v.x); LO[t * 32 + j0 + 1] = bfhi(v.x); LO[t * 32 + j0 + 2] = bflo(v.y); LO[t * 32 + j0 + 3] = bfhi(v.y); }
    for (int x = tid; x < 1024; x += NTHREADS) { const int r = x >> 6, d = x & 63;
        WF[x] = (a.in[16] + cx.z)[((size_t)i * 16 + r) * 256 + h * 64 + d]; WB[x] = (a.in[18] + cx.z)[((size_t)i * 16 + r) * 256 + h * 64 + d]; }
    if (tid < 64) { BF[tid] = (a.in[17] + cx.z)[i * 256 + h * 64 + tid]; BB[tid] = (a.in[19] + cx.z)[i * 256 + h * 64 + tid]; }
    __syncthreads();
    { const int d = tid & 63, tg = tid >> 6;
      LAS float* SEG = (LAS float*)(lds + GL_LO + 8192 + 8192 + 1024);
      float wf[16], wb[16];
#pragma unroll
      for (int r = 0; r < 16; ++r) { wf[r] = WF[r * 64 + d]; wb[r] = WB[r * 64 + d]; }
      const float bfv = BF[d], bbv = BB[d];
      float gf[8], gb[8];
#pragma unroll
      for (int tt = 0; tt < 8; ++tt) { const int t = tg * 8 + tt; float xf = bfv, xb = bbv;
#pragma unroll
          for (int r = 0; r < 16; ++r) { xf += LO[t * 32 + r] * wf[r]; xb += LO[t * 32 + 16 + r] * wb[r]; }
          gf[tt] = (fminf(xf, 0.f) - log1pf(__expf(-fabsf(xf)))) * (1.f / 16.f); gb[tt] = (fminf(xb, 0.f) - log1pf(__expf(-fabsf(xb)))) * (1.f / 16.f); }
#pragma unroll
      for (int tt = 1; tt < 8; ++tt) gf[tt] += gf[tt - 1];
#pragma unroll
      for (int tt = 6; tt >= 0; --tt) gb[tt] += gb[tt + 1];
      SEG[tg * 64 + d] = gf[7]; SEG[512 + tg * 64 + d] = gb[0];
      __syncthreads();
      float offf = 0.f, offb = 0.f;
#pragma unroll
      for (int q = 0; q < 8; ++q) { const float a_ = SEG[q * 64 + d], b_ = SEG[512 + q * 64 + d]; offf += (q < tg) ? a_ : 0.f; offb += (q > tg) ? b_ : 0.f; }
#pragma unroll
      for (int tt = 0; tt < 8; ++tt) { const int t = tg * 8 + tt; Gf[t * 64 + d] = gf[tt] + offf; Gb[t * 64 + d] = gb[tt] + offb; } }
    __syncthreads();
}

__device__ __forceinline__ void gla_vt_load(const bf16_t* PROJ, int tok0, int h, const int tid, u32x4 (&v)[2]) {
    const int s = tid & 63, e0 = (tid >> 6) * 16;
    const bf16_t* src = PROJ + (size_t)(tok0 + s) * NPROJ_PAD + C_VA + h * 128 + e0;
    v[0] = *(const u32x4*)src; v[1] = *(const u32x4*)(src + 8);
}
__device__ __forceinline__ void gla_vt_store(LAS unsigned char* lds, const int tid, const u32x4 (&vv)[2]) {
    const int s = tid & 63, e0 = (tid >> 6) * 16;
    LAS bf16_t* VT = (LAS bf16_t*)(lds + GL_VT);
#pragma unroll
    for (int q = 0; q < 2; ++q) { const u32x4 v = vv[q]; LAS bf16_t* dst = VT + (e0 + q * 8) * 72 + s;
        dst[0 * 72] = (bf16_t)(v.x & 0xffff); dst[1 * 72] = (bf16_t)(v.x >> 16); dst[2 * 72] = (bf16_t)(v.y & 0xffff); dst[3 * 72] = (bf16_t)(v.y >> 16);
        dst[4 * 72] = (bf16_t)(v.z & 0xffff); dst[5 * 72] = (bf16_t)(v.z >> 16); dst[6 * 72] = (bf16_t)(v.w & 0xffff); dst[7 * 72] = (bf16_t)(v.w >> 16); }
}

__device__ __forceinline__ void gla_local_unit(const Args& a, const Ctx& cx, LAS unsigned char* lds, int i, int u) {
    const int cg_ = u >> 2, h = u & 3, tok0 = cg_ * 64, tid = cx.tid, lane = tid & 63, w = tid >> 6, fr = lane & 15, fq = lane >> 4;
    const bf16_t* PROJ = (const bf16_t*)(cx.ws + WS_PROJ);
    float* LOC = (float*)(cx.ws + WS_LOC); float* DEC = (float*)(cx.ws + WS_DEC);
    u32x4 vpre[2]; gla_vt_load(PROJ, tok0, h, tid, vpre);
    const u32x4 kpre = *(const u32x4*)(PROJ + (size_t)(tok0 + (tid >> 3)) * NPROJ_PAD + C_KA + h * 64 + (tid & 7) * 8);
    __syncthreads();
    gla_gates(a, cx, lds, i, tok0, h);
    LAS float* Gf = (LAS float*)(lds + GL_G); LAS float* Gb = Gf + 4096;
    LAS bf16_t* KTf = (LAS bf16_t*)(lds + GL_KF); LAS bf16_t* KTb = (LAS bf16_t*)(lds + GL_KB);
    LAS bf16_t* VT = (LAS bf16_t*)(lds + GL_VT);
    { const int s = tid >> 3, d0 = (tid & 7) * 8; const u32x4 kv = kpre;
      float k[8]; unpack8(kv, k);
#pragma unroll
      for (int e = 0; e < 8; ++e) { const int d = d0 + e;
          KTf[d * 72 + s] = (bf16_t)f2bf(k[e] * __expf(Gf[63 * 64 + d] - Gf[s * 64 + d]));
          KTb[d * 72 + s] = (bf16_t)f2bf(k[e] * __expf(Gb[d] - Gb[s * 64 + d])); } }
    gla_vt_store(lds, tid, vpre);
    if (tid < 128) { const int dir = tid >> 6, d = tid & 63; DEC[((size_t)(dir * 96 + cg_) * 4 + h) * 64 + d] = __expf(dir ? Gb[d] : Gf[63 * 64 + d]); }
    __syncthreads();
    const int dir = w >> 2, dtile = w & 3;
    const LAS bf16_t* KT = dir ? KTb : KTf;
    bf16x8 af[2];
#pragma unroll
    for (int ks = 0; ks < 2; ++ks) af[ks] = *(const LAS bf16x8*)(KT + (dtile * 16 + fr) * 72 + ks * 32 + fq * 8);
    float* dst = LOC + ((size_t)(dir * 96 + cg_) * 4 + h) * 8192;
#pragma unroll
    for (int et = 0; et < 8; ++et) { f32x4 acc = {0.f, 0.f, 0.f, 0.f};
#pragma unroll
        for (int ks = 0; ks < 2; ++ks) { const bf16x8 bfv = *(const LAS bf16x8*)(VT + (et * 16 + fr) * 72 + ks * 32 + fq * 8); acc = MFMA16(af[ks], bfv, acc); }
#pragma unroll
        for (int j = 0; j < 4; ++j) dst[(dtile * 16 + fq * 4 + j) * 128 + et * 16 + fr] = acc[j]; }
}

__device__ __forceinline__ void gla_out_unit(const Args& a, const Ctx& cx, LAS unsigned char* lds, int i, int u) {
    const int cg_ = u >> 2, h = u & 3, tok0 = cg_ * 64, tid = cx.tid, lane = tid & 63, w = tid >> 6, fr = lane & 15, fq = lane >> 4;
    const bf16_t* PROJ = (const bf16_t*)(cx.ws + WS_PROJ); bf16_t* MIX = (bf16_t*)(cx.ws + WS_MIX);
    const float* LOC = (const float*)(cx.ws + WS_LOC); const float* DEC = (const float*)(cx.ws + WS_DEC);
    u32x4 vpre[2]; gla_vt_load(PROJ, tok0, h, tid, vpre);
    const u32x4 qpre = *(const u32x4*)(PROJ + (size_t)(tok0 + (tid >> 3)) * NPROJ_PAD + C_QA + h * 64 + (tid & 7) * 8);
    const u32x4 kpre = *(const u32x4*)(PROJ + (size_t)(tok0 + (tid >> 3)) * NPROJ_PAD + C_KA + h * 64 + (tid & 7) * 8);
    const bf16_t* gpp = PROJ + (size_t)(tok0 + (tid >> 3)) * NPROJ_PAD + C_GA + h * 128 + (tid & 7) * 16;
    const u32x4 gpre0 = *(const u32x4*)gpp, gpre1 = *(const u32x4*)(gpp + 8);
    __syncthreads();
    gla_gates(a, cx, lds, i, tok0, h);
    LAS float* Gf = (LAS float*)(lds + GL_G); LAS float* Gb = Gf + 4096;
    const bool samp = cg_ >= 64;
    const int b = samp ? (cg_ - 64) >> 4 : cg_ >> 2, c = samp ? (cg_ - 64) & 15 : cg_ & 3, nc = samp ? 16 : 4, cbase = cg_ - c;
    {
        const int d = tid >> 3, e0 = (tid & 7) * 16;
        f32x4 Sf[4], Sb[4];
        if (samp) { const float* s0f = (a.in[2] + cx.z) + ((size_t)((b * 2 + i) * 4 + h)) * 8192 + d * 128 + e0; const float* s0b = (a.in[3] + cx.z) + ((size_t)((b * 2 + i) * 4 + h)) * 8192 + d * 128 + e0;
#pragma unroll
            for (int q = 0; q < 4; ++q) { Sf[q] = *(const f32x4*)(s0f + q * 4); Sb[q] = *(const f32x4*)(s0b + q * 4); } }
        else {
#pragma unroll
            for (int q = 0; q < 4; ++q) { Sf[q] = (f32x4){0.f, 0.f, 0.f, 0.f}; Sb[q] = Sf[q]; } }
        for (int j = 0; j < c; ++j) { const size_t ix = (size_t)(0 * 96 + cbase + j) * 4 + h; const float dec = DEC[ix * 64 + d]; const float* lp = LOC + ix * 8192 + d * 128 + e0;
#pragma unroll
            for (int q = 0; q < 4; ++q) Sf[q] = Sf[q] * dec + *(const f32x4*)(lp + q * 4); }
        for (int j = nc - 1; j > c; --j) { const size_t ix = (size_t)(1 * 96 + cbase + j) * 4 + h; const float dec = DEC[ix * 64 + d]; const float* lp = LOC + ix * 8192 + d * 128 + e0;
#pragma unroll
            for (int q = 0; q < 4; ++q) Sb[q] = Sb[q] * dec + *(const f32x4*)(lp + q * 4); }
        if (!samp) {
            if (c == nc - 1) { const size_t ix = (size_t)(0 * 96 + cg_) * 4 + h; const float dec = DEC[ix * 64 + d]; const float* lp = LOC + ix * 8192 + d * 128 + e0;
                float* o = cx.out + O_SF + ((size_t)((b * 2 + i) * 4 + h)) * 8192 + d * 128 + e0;
#pragma unroll
                for (int q = 0; q < 4; ++q) *(f32x4*)(o + q * 4) = Sf[q] * dec + *(const f32x4*)(lp + q * 4); }
            if (c == 0) { const size_t ix = (size_t)(1 * 96 + cg_) * 4 + h; const float dec = DEC[ix * 64 + d]; const float* lp = LOC + ix * 8192 + d * 128 + e0;
                float* o = cx.out + O_SB + ((size_t)((b * 2 + i) * 4 + h)) * 8192 + d * 128 + e0;
#pragma unroll
                for (int q = 0; q < 4; ++q) *(f32x4*)(o + q * 4) = Sb[q] * dec + *(const f32x4*)(lp + q * 4); }
        }
        LAS bf16_t* STf = (LAS bf16_t*)(lds + GL_STF); LAS bf16_t* STb = (LAS bf16_t*)(lds + GL_STB);
#pragma unroll
        for (int q = 0; q < 4; ++q)
#pragma unroll
            for (int e = 0; e < 4; ++e) { STf[(e0 + q * 4 + e) * 72 + d] = (bf16_t)f2bf(Sf[q][e]); STb[(e0 + q * 4 + e) * 72 + d] = (bf16_t)f2bf(Sb[q][e]); }
    }
    {
        const int t = tid >> 3, d0 = (tid & 7) * 8;
        const u32x4 qv = qpre, kv = kpre;
        float q[8], k[8], o1[8], o2[8], o3[8], o4[8]; unpack8(qv, q); unpack8(kv, k);
#pragma unroll
        for (int e = 0; e < 8; ++e) { const float gf = Gf[t * 64 + d0 + e], gb = Gb[t * 64 + d0 + e];
            o1[e] = q[e] * 0.125f * __expf(gf); o2[e] = k[e] * __expf(-gf); o3[e] = q[e] * 0.125f * __expf(gb); o4[e] = k[e] * __expf(-gb); }
        *(LAS u32x4*)((LAS bf16_t*)(lds + GL_QF) + t * 72 + d0) = pack8(o1);
        *(LAS u32x4*)((LAS bf16_t*)(lds + GL_KF) + t * 72 + d0) = pack8(o2);
        *(LAS u32x4*)((LAS bf16_t*)(lds + GL_QB) + t * 72 + d0) = pack8(o3);
        *(LAS u32x4*)((LAS bf16_t*)(lds + GL_KB) + t * 72 + d0) = pack8(o4);
    }
    gla_vt_store(lds, tid, vpre);
    __syncthreads();
    {
        const int dir = w >> 2, tt = w & 3;
        const LAS bf16_t* Qm = (const LAS bf16_t*)(lds + (dir ? GL_QB : GL_QF)); const LAS bf16_t* Km = (const LAS bf16_t*)(lds + (dir ? GL_KB : GL_KF));
        LAS bf16_t* AT = (LAS bf16_t*)(lds + (dir ? GL_AB : GL_AF));
        bf16x8 af[2];
#pragma unroll
        for (int ks = 0; ks < 2; ++ks) af[ks] = *(const LAS bf16x8*)(Qm + (tt * 16 + fr) * 72 + ks * 32 + fq * 8);
#pragma unroll
        for (int st = 0; st < 4; ++st) { f32x4 acc = {0.f, 0.f, 0.f, 0.f};
#pragma unroll
            for (int ks = 0; ks < 2; ++ks) { const bf16x8 bfv = *(const LAS bf16x8*)(Km + (st * 16 + fr) * 72 + ks * 32 + fq * 8); acc = MFMA16(af[ks], bfv, acc); }
#pragma unroll
            for (int j = 0; j < 4; ++j) { const int t = tt * 16 + fq * 4 + j, s = st * 16 + fr; const bool keep = dir ? (s >= t) : (s <= t);
                AT[t * 72 + s] = (bf16_t)f2bf(keep ? acc[j] : 0.f); } }
    }
    __syncthreads();
    {
        const int tt = w & 3, eg = w >> 2;
        LAS float* OS = (LAS float*)(lds + GL_G);
        const LAS bf16_t* VT = (const LAS bf16_t*)(lds + GL_VT);
        bf16x8 a1[2], a2[2], a3[2], a4[2];
#pragma unroll
        for (int ks = 0; ks < 2; ++ks) { const int off = (tt * 16 + fr) * 72 + ks * 32 + fq * 8;
            a1[ks] = *(const LAS bf16x8*)((const LAS bf16_t*)(lds + GL_QF) + off); a2[ks] = *(const LAS bf16x8*)((const LAS bf16_t*)(lds + GL_AF) + off);
            a3[ks] = *(const LAS bf16x8*)((const LAS bf16_t*)(lds + GL_QB) + off); a4[ks] = *(const LAS bf16x8*)((const LAS bf16_t*)(lds + GL_AB) + off); }
        f32x4 accs[4];
#pragma unroll
        for (int q = 0; q < 4; ++q) { const int et = eg * 4 + q; f32x4 acc = {0.f, 0.f, 0.f, 0.f};
#pragma unroll
            for (int ks = 0; ks < 2; ++ks) { const int off = (et * 16 + fr) * 72 + ks * 32 + fq * 8;
                const bf16x8 b1 = *(const LAS bf16x8*)((const LAS bf16_t*)(lds + GL_STF) + off), b2 = *(const LAS bf16x8*)(VT + off), b3 = *(const LAS bf16x8*)((const LAS bf16_t*)(lds + GL_STB) + off);
                acc = MFMA16(a1[ks], b1, acc); acc = MFMA16(a2[ks], b2, acc); acc = MFMA16(a3[ks], b3, acc); acc = MFMA16(a4[ks], b2, acc); }
            accs[q] = acc; }
#pragma unroll
        for (int q = 0; q < 4; ++q)
#pragma unroll
            for (int j = 0; j < 4; ++j) OS[(tt * 16 + fq * 4 + j) * 128 + (eg * 4 + q) * 16 + fr] = accs[q][j];
    }
    __syncthreads();
    {
        const int t = tid >> 3, e0 = (tid & 7) * 16;
        const LAS float* OS = (const LAS float*)(lds + GL_G);
        float o[16]; float ss = 0.f;
#pragma unroll
        for (int e = 0; e < 16; ++e) { o[e] = OS[t * 128 + e0 + e]; ss += o[e] * o[e]; }
        ss += __shfl_xor(ss, 1); ss += __shfl_xor(ss, 2); ss += __shfl_xor(ss, 4);
        const float rstd = rsqrtf(ss * (1.f / 128.f) + EPS);
        const float* gg = (a.in[20] + cx.z) + i * 128 + e0;
        float gt[16]; unpack8(gpre0, gt); unpack8(gpre1, gt + 8);
#pragma unroll
        for (int e = 0; e < 16; ++e) o[e] = o[e] * rstd * gg[e] * silu_f(gt[e]);
        bf16_t* op = MIX + (size_t)(tok0 + t) * D + h * 128 + e0;
        *(u32x4*)op = pack8(o); *(u32x4*)(op + 8) = pack8(o + 8);
    }
}


#define XB_TMO      128
#define XB_XCNT(j)  (256  + 64 * (j))
#define XB_XSUB(j)  (1280 + 64 * (j))
#define XB_XGEN(j)  (2304 + 64 * (j))
#define XB_TOP      3328
#define XB_TOPGEN   3392
#define XCD_BAR_WORDS 3456
#define XB_SPIN_CAP (1u << 18)
__device__ __forceinline__ unsigned xb_ld(unsigned* p)              { return __hip_atomic_load(p, __ATOMIC_RELAXED, __HIP_MEMORY_SCOPE_AGENT); }
__device__ __forceinline__ unsigned xb_add(unsigned* p, unsigned v) { return __hip_atomic_fetch_add(p, v, __ATOMIC_RELAXED, __HIP_MEMORY_SCOPE_AGENT); }
__device__ __forceinline__ unsigned xb_xcc_id() { return (unsigned)__builtin_amdgcn_s_getreg((3 << 11) | 20) & 0xFu; }
#define XB_SPIN(cond, bar) do { unsigned _sp = 0; while (cond) { __builtin_amdgcn_s_sleep(1); \
    if ((++_sp & 255u) == 0u) { if (xb_ld(&(bar)[XB_TMO])) break; if (_sp > XB_SPIN_CAP) { atomicAdd(&(bar)[XB_TMO], 1u); break; } } } } while (0)
struct XcdBarrier { unsigned* bar; unsigned x; volatile LAS unsigned* st; };
__device__ __forceinline__ XcdBarrier xcd_barrier_post(unsigned* bar, volatile LAS unsigned* st, const int tid) {
    XcdBarrier b; b.bar = bar; b.x = xb_xcc_id(); b.st = st;
    if (tid == 0) (void)xb_add(&bar[XB_XCNT(b.x)], 1u);
    return b;
}
__device__ __forceinline__ void xcd_barrier_complete(unsigned* bar, unsigned x, unsigned& nloc, unsigned& nx) {
    const unsigned G = gridDim.x * gridDim.y * gridDim.z;
    unsigned sum, cnt, mine, sp = 0u;
    for (;;) {
        sum = 0u; cnt = 0u; mine = 0u;
#pragma unroll
        for (unsigned j = 0; j < 16; ++j) { const unsigned c = xb_ld(&bar[XB_XCNT(j)]); sum += c; cnt += (c > 0u) ? 1u : 0u; mine = (j == x) ? c : mine; }
        if (sum == G) break;
        __builtin_amdgcn_s_sleep(1);
        if ((++sp & 255u) == 0u) { if (xb_ld(&bar[XB_TMO])) break; if (sp > XB_SPIN_CAP) { atomicAdd(&bar[XB_TMO], 1u); break; } }
    }
    nloc = mine > 0u ? mine : 1u; nx = cnt > 0u ? cnt : 1u;
}
__device__ __forceinline__ void xcd_barrier(const XcdBarrier& b, const int tid) {
    asm volatile("s_waitcnt vmcnt(0)" ::: "memory");
    __syncthreads();
    if (tid == 0) {
        unsigned* bar = b.bar;
        __builtin_amdgcn_s_waitcnt(0);
        unsigned nloc = b.st[0], nx = b.st[1];
        if (nloc == 0u) { xcd_barrier_complete(bar, b.x, nloc, nx); b.st[0] = nloc; b.st[1] = nx; }
        const unsigned old = xb_add(&bar[XB_XSUB(b.x)], 1u);
        const unsigned gen = old / nloc;
        if (old + 1u == (gen + 1u) * nloc) {
            __builtin_amdgcn_fence(__ATOMIC_RELEASE, "agent");
            asm volatile("s_waitcnt vmcnt(0)" ::: "memory");
            const unsigned og = xb_add(&bar[XB_TOP], 1u);
            const unsigned tg = og / nx;
            if (og + 1u == (tg + 1u) * nx) xb_add(&bar[XB_TOPGEN], 1u);
            else XB_SPIN(xb_ld(&bar[XB_TOPGEN]) == tg, bar);
            __builtin_amdgcn_fence(__ATOMIC_ACQUIRE, "agent");
            xb_add(&bar[XB_XGEN(b.x)], 1u);
            asm volatile("s_waitcnt vmcnt(0)" ::: "memory");
        } else {
            XB_SPIN(xb_ld(&bar[XB_XGEN(b.x)]) == gen, bar);
            __builtin_amdgcn_fence(__ATOMIC_ACQUIRE, "agent");
            asm volatile("s_waitcnt vmcnt(0)" ::: "memory");
        }
    }
    __syncthreads();
}

enum { K_PRO = 0, K_PRE, K_G1, K_A1, K_A2, K_DOWN, K_MID, K_UQKV, K_MLA, K_OUTP, K_POST1, K_FF1, K_FF2, K_POST2 };
constexpr int N_PHASES = 2 + 2 * 8 + 2 * 9;
#ifndef EN_MASK
#define EN_MASK 0xFFFFFFFFu
#endif
#define ENB(k) (((EN_MASK) >> (k)) & 1u)
#ifndef DUP_MASK
#define DUP_MASK 0u
#endif
#ifndef BAR_REPS
#define BAR_REPS 1
#endif

__global__ void __launch_bounds__(NTHREADS, 2) mega_fwd(Args args) {
    extern __shared__ __attribute__((aligned(16))) unsigned char lds_raw[];
    LAS unsigned char* lds = (LAS unsigned char*)lds_raw;
    const int lo = args.ph_lo, hi = args.ph_hi;
    const int wave_s = __builtin_amdgcn_readfirstlane((int)(threadIdx.x >> 6));
#define MY_TID(dst) do { int _l; asm volatile("v_mbcnt_lo_u32_b32 %0, -1, 0\n\tv_mbcnt_hi_u32_b32 %0, -1, %0" : "=v"(_l)); dst = wave_s * 64 + _l; } while (0)
    {
        int tid0; MY_TID(tid0);
        volatile LAS unsigned* bst = (volatile LAS unsigned*)(lds + LDS_BYTES - 64);
        if (tid0 < 2) bst[tid0] = 0u;
        __syncthreads();
        (void)xcd_barrier_post((unsigned*)(args.ws + WS_CTL), bst, tid0);
    }
    for (int p = lo; p < hi; ++p) {
        int kind, l;
        if (p == 0) { kind = K_PRO; l = 0; }
        else if (p == 1) { kind = K_PRE; l = 0; }
        else {
            const int q = p - 2, pair = q / 17, r = q - pair * 17;
            if (r < 8) { l = 2 * pair; kind = (r == 0) ? K_G1 : (r == 1) ? K_A1 : (r == 2) ? K_A2 : (r == 3) ? K_OUTP : (r == 4) ? K_POST1 : (r == 5) ? K_FF1 : (r == 6) ? K_FF2 : K_POST2; }
            else { const int r2 = r - 8; l = 2 * pair + 1; kind = (r2 == 0) ? K_DOWN : (r2 == 1) ? K_MID : (r2 == 2) ? K_UQKV : (r2 == 3) ? K_MLA : (r2 == 4) ? K_OUTP : (r2 == 5) ? K_POST1 : (r2 == 6) ? K_FF1 : (r2 == 7) ? K_FF2 : K_POST2; }
        }
        const int reps = ((DUP_MASK >> kind) & 1u) ? 2 : 1;
        for (int rep = 0; rep < reps; ++rep) {
        if (rep) __syncthreads();
        Ctx cx; cx.z = 0; MY_TID(cx.tid); cx.bid = blockIdx.x; cx.G = gridDim.x;
        asm volatile("" : "+s"(cx.z), "+s"(kind), "+s"(l), "+v"(cx.tid), "+s"(cx.bid), "+s"(cx.G));
        cx.ws = args.ws + cx.z; cx.out = args.out + cx.z;
        unsigned char* ws = cx.ws;
        const int i = l >> 1, G = cx.G, bid = cx.bid;
        switch (kind) {
        case K_PRO: if (ENB(0)) prologue(args, cx, lds); break;
        case K_PRE: if (ENB(1)) pre_rows(args, cx, 0); break;
        case K_G1: if (ENB(2)) {
            pg8::Gemm g{(const bf16_t*)(ws + WS_H), (const bf16_t*)(ws + WS_WIN) + (size_t)i * NPROJ_PAD * D, T, NPROJ_PAD, D, D, D, NPROJ_PAD / 256, 0};
            pg8::StaticOrder S; S.init(T, NPROJ_PAD, G, bid);
            pg8::EpiProj E{(bf16_t*)(ws + WS_PROJ), cx.out, i};
            pg8::gemm_phase<pg8::EpiProj, pg8::StaticOrder>(lds, g, S, E, cx.tid);
        } break;
        case K_A1:
            if (G == 256) {
                if (bid < 128) { if (ENB(3)) swa_unit(args, cx, lds, i, bid); if (ENB(4)) gla_local_unit(args, cx, lds, i, bid); }
                else { const int q = bid - 128; if (ENB(3)) { swa_unit(args, cx, lds, i, 128 + 2 * q); swa_unit(args, cx, lds, i, 128 + 2 * q + 1); }
                       if (ENB(4)) { gla_local_unit(args, cx, lds, i, 128 + 2 * q); gla_local_unit(args, cx, lds, i, 128 + 2 * q + 1); } }
            } else { for (int u = bid; u < 768; u += G) { if (u < 384) { if (ENB(3)) swa_unit(args, cx, lds, i, u); } else { if (ENB(4)) gla_local_unit(args, cx, lds, i, u - 384); } } }
            break;
        case K_A2:
            if (G == 256) {
                if (bid < 128) { if (ENB(5)) { gla_out_unit(args, cx, lds, i, 256 + bid); gla_out_unit(args, cx, lds, i, bid); } }
                else { if (ENB(5)) gla_out_unit(args, cx, lds, i, bid); }
            } else { for (int u = bid; u < 384; u += G) if (ENB(5)) gla_out_unit(args, cx, lds, i, u); }
            break;
        case K_MID: if (ENB(7)) mla_mid(args, cx, i); break;
        case K_UQKV: if (ENB(8)) {
            for (int s = 0; s < 2; ++s) {
                pg8::Gemm g;
                if (s == 0) g = pg8::Gemm{(const bf16_t*)(ws + WS_CQ), (const bf16_t*)(ws + WS_WUQ) + (size_t)i * 1536 * 384, T, 1536, 384, 384, 384, 6, 0};
                else        g = pg8::Gemm{(const bf16_t*)(ws + WS_CKV), (const bf16_t*)(ws + WS_WUKV) + (size_t)i * 2048 * 256, T + 1024, 2048, 256, 256, 256, 8, 0};
                pg8::StaticOrder S; S.init(g.M, g.N, G, (s == 0 || G != 256) ? bid : ((bid + 144) & 255));
                pg8::EpiBf16<0> E{s == 0 ? (bf16_t*)(ws + WS_Q) : (bf16_t*)(ws + WS_KVX), g.N};
                pg8::gemm_phase<pg8::EpiBf16<0>, pg8::StaticOrder>(lds, g, S, E, cx.tid);
            }
        } break;
        case K_MLA: if (ENB(9)) {
            if (G == 256) {
                const int xcd = bid & 7, slot = bid >> 3, id = xcd * 4 + (slot >> 3);
                mla_unit(args, cx, lds, id * 8 + (slot & 7));
                mla_unit(args, cx, lds, 256 + 2 * bid);
                mla_unit(args, cx, lds, 256 + 2 * bid + 1);
            } else { for (int u = bid; u < 768; u += G) mla_unit(args, cx, lds, u); }
        } break;
        case K_DOWN: if (ENB(10)) {
            pg8::Gemm g{(const bf16_t*)(ws + WS_H), (const bf16_t*)(ws + WS_WDOWN) + (size_t)i * NDOWN_PAD * D, T, 2 * NDOWN_PAD, D / 2, D, D / 2, NDOWN_PAD / 256, D / 2};
            pg8::EpiF32 E{(float*)(ws + WS_OUT), NDOWN_PAD, NDOWN_PAD / 256, DOWN_SPLIT};
            pg8::StaticOrder S; S.init(g.M, g.N, G, bid);
            pg8::gemm_phase<pg8::EpiF32, pg8::StaticOrder>(lds, g, S, E, cx.tid);
        } break;
        case K_OUTP: case K_FF2: if (ENB(10)) {
            pg8::Gemm g;
            if (kind == K_OUTP) {
                const bf16_t* Wt = (l & 1) ? (const bf16_t*)(ws + WS_WO) + (size_t)i * D * D : (const bf16_t*)(ws + WS_WOUT) + (size_t)i * D * D;
                g = pg8::Gemm{(const bf16_t*)(ws + WS_MIX), Wt, T, 2 * D, D / 2, D, D / 2, 4, D / 2};
            } else {
                g = pg8::Gemm{(const bf16_t*)(ws + WS_U), (const bf16_t*)(ws + WS_WFF2) + (size_t)l * FF * D, T, 2 * D, FF / 2, FF, FF / 2, 4, FF / 2};
            }
            pg8::EpiSplitBf16 E{(bf16_t*)(ws + WS_OUT), D, 4, OUT_SPLIT};
            pg8::StaticOrder S; S.init(g.M, g.N, G, bid);
            pg8::gemm_phase<pg8::EpiSplitBf16, pg8::StaticOrder>(lds, g, S, E, cx.tid);
        } break;
        case K_FF1: if (ENB(12)) {
            pg8::Gemm g{(const bf16_t*)(ws + WS_H), (const bf16_t*)(ws + WS_WFF1) + (size_t)l * FF * D, T, FF, D, D, D, FF / 256, 0};
            pg8::StaticOrder S; S.init(T, FF, G, bid);
            pg8::EpiBf16<1> E{(bf16_t*)(ws + WS_U), FF};
            pg8::gemm_phase<pg8::EpiBf16<1>, pg8::StaticOrder>(lds, g, S, E, cx.tid);
        } break;
        case K_POST1: if (ENB(11)) {
            const float* MODL = (const float*)(ws + WS_MOD) + (size_t)l * 3 * 6144; const float* gN = (args.in[12] + cx.z) + (size_t)l * 4 * D;
            post_rows(args, cx, l == 0, MODL + 2 * D, gN + D, true, gN + 2 * D, MODL + 3 * D, MODL + 4 * D, rep + 1 < reps);
        } break;
        case K_POST2: if (ENB(14)) {
            const float* MODL = (const float*)(ws + WS_MOD) + (size_t)l * 3 * 6144; const float* gN = (args.in[12] + cx.z) + (size_t)l * 4 * D;
            const float* MODN = MODL + 3 * 6144; const float* gNn = gN + 4 * D;
            post_rows(args, cx, false, MODL + 5 * D, gN + 3 * D, l < 3, gNn, MODN, MODN + D, rep + 1 < reps);
        } break;
        default: break;
        }
        }
        if (p + 1 < hi) { if (hi < 0) cg::this_grid().sync(); else { XcdBarrier xb; xb.bar = (unsigned*)(args.ws + WS_CTL); xb.x = xb_xcc_id(); xb.st = (volatile LAS unsigned*)(lds + LDS_BYTES - 64); int tidb; MY_TID(tidb); for (int br = 0; br < BAR_REPS; ++br) xcd_barrier(xb, tidb); } }
    }
}

extern "C" void kernel_launch(void* const* d_in, const int* in_sizes, int n_in, void* d_out, int out_size, void* d_ws, size_t ws_size, hipStream_t stream) {
    static int grid = 0;
    if (grid == 0) {
        int dev = 0, cus = 0, per_cu = 0;
        hipGetDevice(&dev);
        hipDeviceGetAttribute(&cus, hipDeviceAttributeMultiprocessorCount, dev);
        hipFuncSetAttribute((const void*)mega_fwd, hipFuncAttributeMaxDynamicSharedMemorySize, LDS_BYTES);
        hipOccupancyMaxActiveBlocksPerMultiprocessor(&per_cu, (const void*)mega_fwd, NTHREADS, LDS_BYTES);
        if (per_cu < 1) { fprintf(stderr, "kernel_launch: occupancy query says %d blocks per CU\n", per_cu); per_cu = 1; }
        (void)hipGetLastError();
        grid = cus;
        if (ws_size < 256 * MiB) fprintf(stderr, "kernel_launch: workspace too small (%zu)\n", ws_size);
    }
    (void)hipMemsetAsync((char*)d_ws + WS_CTL, 0, CTL_BYTES, stream);
    Args a{};
    for (int i = 0; i < 29; ++i) a.in[i] = (const float*)d_in[i];
    a.out = (float*)d_out; a.ws = (unsigned char*)d_ws;
#if MK_ONE_LAUNCH
    a.ph_lo = 0; a.ph_hi = N_PHASES;
    void* kargs[] = {&a};
    hipError_t e = hipLaunchCooperativeKernel((const void*)mega_fwd, dim3(grid), dim3(NTHREADS), kargs, LDS_BYTES, stream);
    if (e != hipSuccess) fprintf(stderr, "cooperative launch failed: %s (grid %d)\n", hipGetErrorString(e), grid);
#else
    for (int p = 0; p < N_PHASES; ++p) {
        a.ph_lo = p; a.ph_hi = p + 1;
        hipLaunchKernelGGL(mega_fwd, dim3(grid), dim3(NTHREADS), LDS_BYTES, stream, a);
    }
#endif
}
```

```cpp
#include <hip/hip_runtime.h>
#include <hip/hip_cooperative_groups.h>
#include <cstdio>
#include <cstdint>
namespace cg = cooperative_groups;

#ifndef MK_ONE_LAUNCH
#define MK_ONE_LAUNCH 1
#endif

#define LAS __attribute__((address_space(3)))
#define GAS __attribute__((address_space(1)))
typedef unsigned short bf16_t;
typedef short bf16x8 __attribute__((ext_vector_type(8)));
typedef float f32x4 __attribute__((ext_vector_type(4)));
typedef float f32x2 __attribute__((ext_vector_type(2)));
typedef unsigned u32x4 __attribute__((ext_vector_type(4)));
typedef unsigned u32x2 __attribute__((ext_vector_type(2)));

constexpr int D = 1024, TP = 4096, TS = 2048, T = TP + TS, FF = 4096;
constexpr int NPROJ = 2336, NPROJ_PAD = 2560, NDOWN = 672, NDOWN_PAD = 768;
constexpr int C_QA = 0, C_KA = 256, C_VA = 512, C_GA = 1024, C_LO = 1536, C_QB = 1568, C_KB = 2080, C_VB = 2208;
constexpr float EPS = 1e-6f;
constexpr int NTHREADS = 512, NWAVES = 8;
constexpr int LDS_BYTES = 147456;

constexpr size_t O_X = 0, O_SF = 6291456, O_SB = 7340032, O_CK = 8388608, O_CV = 9437184, O_CKV = 10485760, O_CKR = 12582912;

constexpr size_t MiB = 1u << 20;
constexpr size_t WS_WFF1 = 0, WS_WFF2 = 32 * MiB, WS_WIN = 64 * MiB, WS_WOUT = 74 * MiB, WS_WDOWN = 78 * MiB, WS_WUQ = 81 * MiB,
                 WS_WUKV = 84 * MiB, WS_WO = 86 * MiB, WS_MOD = 90 * MiB, WS_TAB = 91 * MiB, WS_CSK = 92 * MiB, WS_CSV = 93 * MiB,
                 WS_H = 94 * MiB, WS_MIX = 106 * MiB, WS_OUT = 118 * MiB, WS_U = 166 * MiB, WS_PROJ = 214 * MiB, WS_CTL = 250 * MiB;
constexpr size_t CTL_BYTES = 16384;
constexpr size_t WS_LOC = WS_U, WS_DEC = WS_U + 24 * MiB;
constexpr size_t WS_Q = WS_U, WS_KVX = WS_U + 18 * MiB;
constexpr size_t WS_DOWN = WS_PROJ, WS_CQ = WS_PROJ + 18 * MiB, WS_CKV = WS_PROJ + 23 * MiB, WS_KR = WS_PROJ + 27 * MiB;
constexpr size_t OUT_SPLIT = (size_t)T * D;
constexpr size_t DOWN_SPLIT = (WS_DOWN - WS_OUT) / 4;

__device__ __forceinline__ unsigned f2bf(float f) { unsigned u = __builtin_bit_cast(unsigned, f); return (u + 0x7fffu + ((u >> 16) & 1u)) >> 16; }
__device__ __forceinline__ unsigned pk2(float lo, float hi) { return f2bf(lo) | (f2bf(hi) << 16); }
__device__ __forceinline__ float bf2f(unsigned short b) { return __builtin_bit_cast(float, (unsigned)b << 16); }
__device__ __forceinline__ float bflo(unsigned w) { return __builtin_bit_cast(float, w << 16); }
__device__ __forceinline__ float bfhi(unsigned w) { return __builtin_bit_cast(float, w & 0xffff0000u); }
__device__ __forceinline__ void unpack8(const u32x4 v, float* f) {
    f[0] = bflo(v.x); f[1] = bfhi(v.x); f[2] = bflo(v.y); f[3] = bfhi(v.y); f[4] = bflo(v.z); f[5] = bfhi(v.z); f[6] = bflo(v.w); f[7] = bfhi(v.w);
}
__device__ __forceinline__ u32x4 pack8(const float* f) { u32x4 o; o.x = pk2(f[0], f[1]); o.y = pk2(f[2], f[3]); o.z = pk2(f[4], f[5]); o.w = pk2(f[6], f[7]); return o; }
__device__ __forceinline__ float wave_sum(float v) {
#pragma unroll
    for (int o = 1; o < 64; o <<= 1) v += __shfl_xor(v, o);
    return v;
}
__device__ __forceinline__ float xor16_max(float x) { const unsigned u = __builtin_bit_cast(unsigned, x); auto r = __builtin_amdgcn_permlane16_swap(u, u, false, false); return fmaxf(__builtin_bit_cast(float, (unsigned)r[0]), __builtin_bit_cast(float, (unsigned)r[1])); }
__device__ __forceinline__ float xor32_max(float x) { const unsigned u = __builtin_bit_cast(unsigned, x); auto r = __builtin_amdgcn_permlane32_swap(u, u, false, false); return fmaxf(__builtin_bit_cast(float, (unsigned)r[0]), __builtin_bit_cast(float, (unsigned)r[1])); }
__device__ __forceinline__ float xor16_add(float x) { const unsigned u = __builtin_bit_cast(unsigned, x); auto r = __builtin_amdgcn_permlane16_swap(u, u, false, false); return __builtin_bit_cast(float, (unsigned)r[0]) + __builtin_bit_cast(float, (unsigned)r[1]); }
__device__ __forceinline__ float xor32_add(float x) { const unsigned u = __builtin_bit_cast(unsigned, x); auto r = __builtin_amdgcn_permlane32_swap(u, u, false, false); return __builtin_bit_cast(float, (unsigned)r[0]) + __builtin_bit_cast(float, (unsigned)r[1]); }
__device__ __forceinline__ unsigned cvtpk(float lo, float hi) { unsigned r; asm volatile("v_cvt_pk_bf16_f32 %0, %1, %2" : "=v"(r) : "v"(lo), "v"(hi)); return r; }
__device__ __forceinline__ float silu_f(float x) { return x / (1.f + __expf(-x)); }

namespace pg8 {
constexpr int BM = 256, BK = 64, HALF = 128, HTB = HALF * BK * 2, NXCD = 8, WGM = 8;
__host__ __device__ __forceinline__ int lds_byte(int r, int c) { const int st = (r >> 4) * 2 + (c >> 5), rr = r & 15, cc = c & 31, ob = rr * 64 + cc * 2; return st * 1024 + (ob ^ (((ob >> 9) & 1) << 5)); }
__host__ __device__ __forceinline__ void stage_rc(int b, int& R, int& C) { const int st = b / 1024, sb = b % 1024, swz = sb ^ (((sb >> 9) & 1) << 5); R = (st >> 1) * 16 + swz / 64; C = (st & 1) * 32 + (swz % 64) / 2; }
__host__ __device__ __forceinline__ int perm32(int rho) { const int n = rho >> 4, i = rho & 15; return 8 * (i >> 2) + 4 * n + (i & 3); }

struct Unit { int pm, pn; };
struct Gemm { const bf16_t* A; const bf16_t* Bt; int M, N, K, lda, ldb, npn, a_split; };

struct StaticOrder {
    int nM, nN, nwg, G, c;
    __device__ void init(int M, int N, int G_, int c_) { nM = M / BM; nN = N / BM; nwg = nM * nN; G = G_; c = c_; }
    __device__ bool next(int i, Unit& u) const {
        const long L = (long)i * G + c; if (L >= nwg) return false;
        int wgid = (int)L; { const int q = nwg / NXCD, r = nwg % NXCD, xcd = wgid % NXCD, off = wgid / NXCD; wgid = (xcd < r ? xcd * (q + 1) : r * (q + 1) + (xcd - r) * q) + off; }
        const int nig = WGM * nN, gid = wgid / nig, fm = gid * WGM, gsz = (nM - fm) < WGM ? (nM - fm) : WGM;
        u.pm = fm + ((wgid % nig) % gsz); u.pn = (wgid % nig) / gsz; return true;
    }
};

__device__ __forceinline__ unsigned cvt_pk_bf16(float lo, float hi) { unsigned r; asm volatile("v_cvt_pk_bf16_f32 %0, %1, %2" : "=v"(r) : "v"(lo), "v"(hi)); return r; }

template <int ACT  > struct EpiBf16 {
    static constexpr bool PERM = true;
    bf16_t* O; int ldc;
    __device__ __forceinline__ void operator()(const f32x4 (&acc)[2][2][4][2], const Unit& u, int wr, int wc, int fr, int fq) const {
        const int row0 = u.pm * BM + wr * 64 + fr, col0 = u.pn * BM + wc * 32 + 8 * fq;
#pragma unroll
        for (int ai = 0; ai < 2; ++ai)
#pragma unroll
            for (int m = 0; m < 4; ++m) { __builtin_amdgcn_sched_barrier(0); bf16_t* rowp = O + (size_t)(row0 + ai * HALF + m * 16) * ldc + col0;
#pragma unroll
                for (int bj = 0; bj < 2; ++bj) { f32x4 v0 = acc[ai][bj][m][0], v1 = acc[ai][bj][m][1];
                    if (ACT == 1) {
#pragma unroll
                        for (int j = 0; j < 4; ++j) { float a = fmaxf(v0[j], 0.f), b = fmaxf(v1[j], 0.f); v0[j] = a * a; v1[j] = b * b; } }
                    u32x4 w; w.x = cvt_pk_bf16(v0[0], v0[1]); w.y = cvt_pk_bf16(v0[2], v0[3]); w.z = cvt_pk_bf16(v1[0], v1[1]); w.w = cvt_pk_bf16(v1[2], v1[3]);
                    *(u32x4*)(rowp + bj * HALF) = w; } }
    }
};
struct EpiProj {
    static constexpr bool PERM = true;
    bf16_t* O; float* outp; int li;
    __device__ __forceinline__ void operator()(const f32x4 (&acc)[2][2][4][2], const Unit& u, int wr, int wc, int fr, int fq) const {
        const int row0 = u.pm * BM + wr * 64 + fr, col0 = u.pn * BM + wc * 32 + 8 * fq;
#pragma unroll
        for (int ai = 0; ai < 2; ++ai)
#pragma unroll
            for (int m = 0; m < 4; ++m) { __builtin_amdgcn_sched_barrier(0); const int row = row0 + ai * HALF + m * 16; bf16_t* rowp = O + (size_t)row * NPROJ_PAD + col0;
#pragma unroll
                for (int bj = 0; bj < 2; ++bj) { const f32x4 v0 = acc[ai][bj][m][0], v1 = acc[ai][bj][m][1];
                    u32x4 w; w.x = cvt_pk_bf16(v0[0], v0[1]); w.y = cvt_pk_bf16(v0[2], v0[3]); w.z = cvt_pk_bf16(v1[0], v1[1]); w.w = cvt_pk_bf16(v1[2], v1[3]);
                    *(u32x4*)(rowp + bj * HALF) = w;
                    const int col = col0 + bj * HALF;
                    if (row < TP && col >= C_KB && col < NPROJ) {
                        const int b = row >> 8, t = row & 255;
                        float* dst = outp + ((col < C_VB) ? (O_CK - C_KB) : (O_CV - C_VB)) + ((size_t)((b * 2 + li) * 256 + t)) * 128 + col;
                        *(f32x4*)dst = v0; *(f32x4*)(dst + 4) = v1; } } }
    }
};
struct EpiSplitBf16 {
    static constexpr bool PERM = true;
    bf16_t* O; int ldc; int npn; size_t split_stride;
    __device__ __forceinline__ void operator()(const f32x4 (&acc)[2][2][4][2], const Unit& u, int wr, int wc, int fr, int fq) const {
        const int s = u.pn / npn, pn = u.pn - s * npn;
        bf16_t* base = O + (size_t)s * split_stride;
        const int row0 = u.pm * BM + wr * 64 + fr, col0 = pn * BM + wc * 32 + 8 * fq;
#pragma unroll
        for (int ai = 0; ai < 2; ++ai)
#pragma unroll
            for (int m = 0; m < 4; ++m) { __builtin_amdgcn_sched_barrier(0); bf16_t* rowp = base + (size_t)(row0 + ai * HALF + m * 16) * ldc + col0;
#pragma unroll
                for (int bj = 0; bj < 2; ++bj) { const f32x4 v0 = acc[ai][bj][m][0], v1 = acc[ai][bj][m][1];
                    u32x4 w; w.x = cvt_pk_bf16(v0[0], v0[1]); w.y = cvt_pk_bf16(v0[2], v0[3]); w.z = cvt_pk_bf16(v1[0], v1[1]); w.w = cvt_pk_bf16(v1[2], v1[3]);
                    *(u32x4*)(rowp + bj * HALF) = w; } }
    }
};
struct EpiF32 {
    static constexpr bool PERM = true;
    float* O; int ldc; int npn; size_t split_stride;
    __device__ __forceinline__ void operator()(const f32x4 (&acc)[2][2][4][2], const Unit& u, int wr, int wc, int fr, int fq) const {
        const int s = u.pn / npn, pn = u.pn - s * npn;
        float* base = O + (size_t)s * split_stride;
        const int row0 = u.pm * BM + wr * 64 + fr, col0 = pn * BM + wc * 32 + 8 * fq;
#pragma unroll
        for (int ai = 0; ai < 2; ++ai)
#pragma unroll
            for (int m = 0; m < 4; ++m) { __builtin_amdgcn_sched_barrier(0); float* rowp = base + (size_t)(row0 + ai * HALF + m * 16) * ldc + col0;
#pragma unroll
                for (int bj = 0; bj < 2; ++bj) { *(f32x4*)(rowp + bj * HALF) = acc[ai][bj][m][0]; *(f32x4*)(rowp + bj * HALF + 4) = acc[ai][bj][m][1]; } }
    }
};

template <class Epi, class Sched>
__device__ __forceinline__ void gemm_phase(LAS unsigned char* lds, const Gemm g, const Sched& S, const Epi& E, const int tid) {
    const int wid = __builtin_amdgcn_readfirstlane(tid >> 6), lane = tid & 63, wr = wid >> 2, wc = wid & 3, fr = lane & 15, fq = lane >> 4;
    const int K = g.K, nt = K / BK;
    unsigned voffA[2], voffB[2];
#pragma unroll
    for (int i = 0; i < 2; ++i) { int R, C; stage_rc(tid * 16 + i * 8192, R, C); const int Rb = Epi::PERM ? ((R & ~31) + perm32(R & 31)) : R;
        voffA[i] = (unsigned)(R * g.lda + C) * 2u; voffB[i] = (unsigned)(Rb * g.ldb + C) * 2u; }
    const size_t kstep = (size_t)(BK * 2);
    const size_t hstepA = (size_t)HALF * g.lda * 2, hstepB = (size_t)HALF * g.ldb * 2;
    const size_t tstepA = 2 * hstepA, tstepB = 2 * hstepB;
    const unsigned ldsw = (unsigned)wid * 1024u;
    const int aoff = lds_byte(wr * 64 + fr, fq * 8), boff = lds_byte(wc * 32 + fr, fq * 8);
#define PG8_SA(b, h) (((b) * 2 + (h)) * HTB)
#define PG8_SB(b, h) ((4 + (b) * 2 + (h)) * HTB)
#define PG8_STAGE(bufoff, gbase, voff) do { _Pragma("unroll") for (int _i = 0; _i < 2; ++_i) \
        __builtin_amdgcn_global_load_lds((const unsigned*)((const char*)(gbase) + (voff)[_i]), (LAS unsigned*)(lds + (bufoff) + ldsw + _i * 8192), 16, 0, 0); } while (0)
#define PG8_LDA(dst, b, h) do { _Pragma("unroll") for (int m = 0; m < 4; ++m) _Pragma("unroll") for (int k = 0; k < 2; ++k) dst[m][k] = *(const LAS bf16x8*)(lds + PG8_SA(b, h) + aoff + m * 2048 + k * 1024); } while (0)
#define PG8_LDB(dst, b, h) do { _Pragma("unroll") for (int n = 0; n < 2; ++n) _Pragma("unroll") for (int k = 0; k < 2; ++k) dst[n][k] = *(const LAS bf16x8*)(lds + PG8_SB(b, h) + boff + n * 2048 + k * 1024); } while (0)
#define PG8_MMA(ai, bj, At, Bt) do { __builtin_amdgcn_s_setprio(1); _Pragma("unroll") for (int m = 0; m < 4; ++m) _Pragma("unroll") for (int n = 0; n < 2; ++n) _Pragma("unroll") for (int k = 0; k < 2; ++k) \
        acc[ai][bj][m][n] = __builtin_amdgcn_mfma_f32_16x16x32_bf16(Bt[n][k], At[m][k], acc[ai][bj][m][n], 0, 0, 0); __builtin_amdgcn_s_setprio(0); } while (0)
#define PG8_WAIT_V(n) asm volatile("s_waitcnt vmcnt(" #n ")" ::: "memory")
#define PG8_WAIT_L(n) asm volatile("s_waitcnt lgkmcnt(" #n ")" ::: "memory")
#define PG8_BAR __builtin_amdgcn_s_barrier()
#define PG8_SCHED __builtin_amdgcn_sched_barrier(0)
#define PG8_UA(u) ((const char*)g.A + (size_t)(u).pm * tstepA + (size_t)((u).pn / g.npn) * (size_t)g.a_split * 2)
#define PG8_UB(u) ((const char*)g.Bt + (size_t)(u).pn * tstepB)
    Unit cur, nxt; int ui = 0;
    if (!S.next(0, cur)) return;
    f32x4 acc[2][2][4][2];
#pragma unroll
    for (int a = 0; a < 2; ++a)
#pragma unroll
        for (int b = 0; b < 2; ++b)
#pragma unroll
            for (int m = 0; m < 4; ++m)
#pragma unroll
                for (int n = 0; n < 2; ++n) acc[a][b][m][n] = (f32x4){0.f, 0.f, 0.f, 0.f};
    bf16x8 At[4][2], B0[2][2], B1[2][2];
    const char* cA = PG8_UA(cur); const char* cB = PG8_UB(cur);
    PG8_STAGE(PG8_SB(0, 0), cB, voffB); PG8_STAGE(PG8_SB(0, 1), cB + hstepB, voffB); PG8_STAGE(PG8_SA(0, 0), cA, voffA); PG8_STAGE(PG8_SA(0, 1), cA + hstepA, voffA);
    if (wr == 1) PG8_BAR;
    PG8_WAIT_V(2); PG8_BAR;
    PG8_STAGE(PG8_SB(1, 0), cB + kstep, voffB); PG8_STAGE(PG8_SA(1, 0), cA + kstep, voffA); PG8_STAGE(PG8_SB(1, 1), cB + hstepB + kstep, voffB);
    PG8_WAIT_V(6); PG8_BAR;
    for (;;) {
        const bool has_next = S.next(ui + 1, nxt);
        const char* nA = has_next ? PG8_UA(nxt) : cA; const char* nB = has_next ? PG8_UB(nxt) : cB;
        for (int t = 0; t < nt; t += 2) {
            const bool last = (t == nt - 2);
            const char* a1 = cA + (size_t)(t + 1) * kstep;
            const char* a2 = last ? nA : cA + (size_t)(t + 2) * kstep; const char* b2 = last ? nB : cB + (size_t)(t + 2) * kstep;
            const char* a3 = a2 + kstep; const char* b3 = b2 + kstep;
            PG8_LDB(B0, 0, 0); PG8_LDB(B1, 0, 1); PG8_SCHED; PG8_LDA(At, 0, 0); PG8_STAGE(PG8_SA(1, 1), a1 + hstepA, voffA);
            PG8_WAIT_V(8); PG8_WAIT_L(0); PG8_BAR; PG8_MMA(0, 0, At, B0); PG8_MMA(0, 1, At, B1); PG8_BAR; PG8_SCHED;
            PG8_LDA(At, 0, 1); PG8_STAGE(PG8_SB(0, 0), b2, voffB); PG8_STAGE(PG8_SB(0, 1), b2 + hstepB, voffB); PG8_STAGE(PG8_SA(0, 0), a2, voffA);
            PG8_WAIT_V(8); PG8_WAIT_L(0); PG8_BAR; PG8_MMA(1, 0, At, B0); PG8_MMA(1, 1, At, B1); PG8_BAR; PG8_SCHED;
            PG8_LDB(B0, 1, 0); PG8_LDB(B1, 1, 1); PG8_SCHED; PG8_LDA(At, 1, 0); PG8_STAGE(PG8_SA(0, 1), a2 + hstepA, voffA);
            PG8_WAIT_V(8); PG8_WAIT_L(0); PG8_BAR; PG8_MMA(0, 0, At, B0); PG8_MMA(0, 1, At, B1); PG8_BAR; PG8_SCHED;
            PG8_LDA(At, 1, 1); PG8_STAGE(PG8_SB(1, 0), b3, voffB); PG8_STAGE(PG8_SB(1, 1), b3 + hstepB, voffB); PG8_STAGE(PG8_SA(1, 0), a3, voffA);
            PG8_WAIT_V(8); PG8_WAIT_L(0); PG8_BAR; PG8_MMA(1, 0, At, B0); PG8_MMA(1, 1, At, B1); PG8_BAR; PG8_SCHED;
        }
        if (wr == 0) PG8_BAR;
        E(acc, cur, wr, wc, fr, fq);
        if (!has_next) break;
#pragma unroll
        for (int a = 0; a < 2; ++a)
#pragma unroll
            for (int b = 0; b < 2; ++b)
#pragma unroll
                for (int m = 0; m < 4; ++m)
#pragma unroll
                    for (int n = 0; n < 2; ++n) acc[a][b][m][n] = (f32x4){0.f, 0.f, 0.f, 0.f};
        cur = nxt; cA = nA; cB = nB; ++ui;
        if (wr == 1) PG8_BAR;
    }
    PG8_WAIT_V(0);
    PG8_BAR;
#undef PG8_SA
#undef PG8_SB
#undef PG8_STAGE
#undef PG8_LDA
#undef PG8_LDB
#undef PG8_MMA
#undef PG8_WAIT_V
#undef PG8_WAIT_L
#undef PG8_BAR
#undef PG8_SCHED
#undef PG8_UA
#undef PG8_UB
}
}

struct Args { const float* in[29]; float* out; unsigned char* ws; int ph_lo, ph_hi; };
struct Ctx { unsigned char* ws; float* out; int z, tid, bid, G; };

#define MFMA16(a, b, c) __builtin_amdgcn_mfma_f32_16x16x32_bf16((a), (b), (c), 0, 0, 0)

__device__ __forceinline__ void transpose_item(const float* W, int K, int N, bf16_t* WT, int npad, int ksub, LAS float* scr, int item, int lane) {
    const int nblk = N / 32, kb = item / nblk, nb = item % nblk, k0 = 64 * kb, n0 = 32 * nb;
#pragma unroll 8
    for (int i = 0; i < 32; ++i) { const int kk = 2 * i + (lane >> 5); scr[kk * 33 + (lane & 31)] = W[(size_t)(k0 + kk) * N + n0 + (lane & 31)]; }
    asm volatile("s_waitcnt lgkmcnt(0)" ::: "memory");
    const int c = lane & 7;
    const int ks = k0 / ksub, kin = k0 - ks * ksub;
    bf16_t* dbase = WT + (size_t)ks * npad * ksub + kin + 8 * c;
#pragma unroll
    for (int j = 0; j < 4; ++j) { const int n = (lane >> 3) + 8 * j; const LAS float* s = scr + (8 * c) * 33 + n;
        u32x4 o; o.x = pk2(s[0 * 33], s[1 * 33]); o.y = pk2(s[2 * 33], s[3 * 33]); o.z = pk2(s[4 * 33], s[5 * 33]); o.w = pk2(s[6 * 33], s[7 * 33]);
        *(u32x4*)(dbase + (size_t)(n0 + n) * ksub) = o; }
    asm volatile("s_waitcnt lgkmcnt(0)" ::: "memory");
}

struct MatDesc { const float* W; bf16_t* WT; int K, N, npad, ksub, items; };
__device__ __forceinline__ MatDesc get_mat(const Args& a, const Ctx& cx, int mi) {
    MatDesc m; unsigned char* ws = cx.ws;
    if (mi < 4)       { m.W = (a.in[13] + cx.z) + (size_t)mi * D * FF; m.WT = (bf16_t*)(ws + WS_WFF1) + (size_t)mi * FF * D; m.K = D; m.N = FF; m.npad = FF; m.ksub = D; }
    else if (mi < 8)  { const int l = mi - 4; m.W = (a.in[14] + cx.z) + (size_t)l * FF * D; m.WT = (bf16_t*)(ws + WS_WFF2) + (size_t)l * FF * D; m.K = FF; m.N = D; m.npad = D; m.ksub = FF / 2; }
    else if (mi < 10) { const int i = mi - 8; m.W = (a.in[15] + cx.z) + (size_t)i * D * NPROJ; m.WT = (bf16_t*)(ws + WS_WIN) + (size_t)i * NPROJ_PAD * D; m.K = D; m.N = NPROJ; m.npad = NPROJ_PAD; m.ksub = D; }
    else if (mi < 12) { const int i = mi - 10; m.W = (a.in[22] + cx.z) + (size_t)i * D * D; m.WT = (bf16_t*)(ws + WS_WOUT) + (size_t)i * D * D; m.K = D; m.N = D; m.npad = D; m.ksub = D / 2; }
    else if (mi < 14) { const int i = mi - 12; m.W = (a.in[23] + cx.z) + (size_t)i * D * NDOWN; m.WT = (bf16_t*)(ws + WS_WDOWN) + (size_t)i * NDOWN_PAD * D; m.K = D; m.N = NDOWN; m.npad = NDOWN_PAD; m.ksub = D / 2; }
    else if (mi < 16) { const int i = mi - 14; m.W = (a.in[26] + cx.z) + (size_t)i * 384 * 1536; m.WT = (bf16_t*)(ws + WS_WUQ) + (size_t)i * 1536 * 384; m.K = 384; m.N = 1536; m.npad = 1536; m.ksub = 384; }
    else if (mi < 18) { const int i = mi - 16; m.W = (a.in[27] + cx.z) + (size_t)i * 256 * 2048; m.WT = (bf16_t*)(ws + WS_WUKV) + (size_t)i * 2048 * 256; m.K = 256; m.N = 2048; m.npad = 2048; m.ksub = 256; }
    else              { const int i = mi - 18; m.W = (a.in[28] + cx.z) + (size_t)i * D * D; m.WT = (bf16_t*)(ws + WS_WO) + (size_t)i * D * D; m.K = D; m.N = D; m.npad = D; m.ksub = D / 2; }
    m.items = (m.K / 64) * (m.N / 32);
    return m;
}

__device__ __forceinline__ void prologue(const Args& a, const Ctx& cx, LAS unsigned char* lds) {
    const int tid = cx.tid, lane = tid & 63, wave = tid >> 6, G = cx.G, bid = cx.bid;
    unsigned char* ws = cx.ws;
    {
        LAS float* sc = (LAS float*)lds;
        LAS float* red = (LAS float*)(lds + 12288);
        for (int i = tid; i < 3 * D; i += NTHREADS) { const int g = i >> 10, k = i & 1023; const float v = (g == 0) ? (a.in[9] + cx.z)[k] : (a.in[8] + cx.z)[(g - 1) * D + k]; sc[i] = silu_f(v); }
        __syncthreads();
        float* MOD = (float*)(ws + WS_MOD);
        for (int it = bid; it < 4 * 48; it += G) {
            const int l = it / 48, jb = it % 48, jq = tid & 31, kg = tid >> 5, j = jb * 128 + jq * 4;
            const float* wp = (a.in[10] + cx.z) + ((size_t)l * D + kg * 64) * 6144 + j;
            f32x4 a0 = {0.f, 0.f, 0.f, 0.f}, a1 = a0, a2 = a0;
#pragma unroll 8
            for (int k = 0; k < 64; ++k) { const f32x4 w = *(const f32x4*)(wp + (size_t)k * 6144); const int kk = kg * 64 + k;
                a0 += w * sc[kk]; a1 += w * sc[D + kk]; a2 += w * sc[2 * D + kk]; }
#pragma unroll
            for (int e = 0; e < 4; ++e) { red[(kg * 3 + 0) * 128 + jq * 4 + e] = a0[e]; red[(kg * 3 + 1) * 128 + jq * 4 + e] = a1[e]; red[(kg * 3 + 2) * 128 + jq * 4 + e] = a2[e]; }
            __syncthreads();
            if (tid < 384) { const int g = tid >> 7, jj = tid & 127; float s = 0.f;
#pragma unroll
                for (int q = 0; q < 16; ++q) s += red[(q * 3 + g) * 128 + jj];
                MOD[((size_t)l * 3 + g) * 6144 + jb * 128 + jj] = s + (a.in[11] + cx.z)[(size_t)l * 6144 + jb * 128 + jj]; }
            __syncthreads();
        }
    }
    __syncthreads();
    {
        LAS float* scr = (LAS float*)(lds + wave * 16384);
        const int gw = bid * NWAVES + wave, NGW = G * NWAVES;
        int base = 0;
        for (int mi = 0; mi < 20; ++mi) {
            const MatDesc m = get_mat(a, cx, mi);
            int first = (gw - base) % NGW; if (first < 0) first += NGW;
            for (int it = first; it < m.items; it += NGW) transpose_item(m.W, m.K, m.N, m.WT, m.npad, m.ksub, scr, it, lane);
            base += m.items;
        }
    }
    {
        const size_t gt = (size_t)bid * NTHREADS + tid, NGT = (size_t)G * NTHREADS;
        for (int i = 0; i < 2; ++i) {
            u32x4* z1 = (u32x4*)((bf16_t*)(ws + WS_WIN) + (size_t)i * NPROJ_PAD * D + (size_t)NPROJ * D);
            for (size_t x = gt; x < (size_t)(NPROJ_PAD - NPROJ) * D / 8; x += NGT) z1[x] = (u32x4){0u, 0u, 0u, 0u};
            for (int ks = 0; ks < 2; ++ks) {
                u32x4* z2 = (u32x4*)((bf16_t*)(ws + WS_WDOWN) + (size_t)i * NDOWN_PAD * D + (size_t)ks * NDOWN_PAD * (D / 2) + (size_t)NDOWN * (D / 2));
                for (size_t x = gt; x < (size_t)(NDOWN_PAD - NDOWN) * (D / 2) / 8; x += NGT) z2[x] = (u32x4){0u, 0u, 0u, 0u}; }
        }
        f32x2* tab64 = (f32x2*)(ws + WS_TAB); f32x2* tab32 = tab64 + 64 * 16;
        for (size_t x = gt; x < 64 * 16; x += NGT) { const int pos = (int)x >> 4, f = (int)x & 15; const float inv = powf(10000.f, -(float)f / 16.f); const float ang = (float)pos * inv; tab64[x] = (f32x2){cosf(ang), sinf(ang)}; }
        for (size_t x = gt; x < 64 * 8; x += NGT) { const int pos = (int)x >> 3, f = (int)x & 7; const float inv = powf(10000.f, -(float)f / 8.f); const float ang = (float)pos * inv; tab32[x] = (f32x2){cosf(ang), sinf(ang)}; }
        bf16_t* csk = (bf16_t*)(ws + WS_CSK); bf16_t* csv = (bf16_t*)(ws + WS_CSV);
        for (size_t x = gt; x < (size_t)2 * 2 * 512 * 128 / 4; x += NGT) {
            const size_t e = x * 4; const int b = (int)(e / (2 * 65536)), i = (int)(e / 65536) & 1; const size_t r = e % 65536;
            const size_t d = ((size_t)(i * 2 + b)) * 65536 + r;
            const f32x4 k = *(const f32x4*)((a.in[4] + cx.z) + e), v = *(const f32x4*)((a.in[5] + cx.z) + e);
            *(u32x2*)(csk + d) = (u32x2){pk2(k[0], k[1]), pk2(k[2], k[3])};
            *(u32x2*)(csv + d) = (u32x2){pk2(v[0], v[1]), pk2(v[2], v[3])};
        }
    }
}

__device__ __forceinline__ int mod_group(int r) { return r < TP ? 0 : 1 + ((r - TP) >> 10); }

__device__ __forceinline__ void pre_rows(const Args& a, const Ctx& cx, int l) {
    const int lane = cx.tid & 63, gw = cx.bid * NWAVES + (cx.tid >> 6), NGW = cx.G * NWAVES;
    const float* MOD = (const float*)(cx.ws + WS_MOD) + (size_t)l * 3 * 6144;
    const float* gA = (a.in[12] + cx.z) + (size_t)l * 4 * D;
    bf16_t* H = (bf16_t*)(cx.ws + WS_H);
    for (int r = gw; r < T; r += NGW) {
        const float* xr = (r < TP) ? (a.in[0] + cx.z) + (size_t)r * D : (a.in[1] + cx.z) + (size_t)(r - TP) * D;
        const float* m = MOD + (size_t)mod_group(r) * 6144;
        f32x4 v[4]; float s = 0.f;
#pragma unroll
        for (int j = 0; j < 4; ++j) { v[j] = *(const f32x4*)(xr + lane * 4 + 256 * j); s += v[j][0] * v[j][0] + v[j][1] * v[j][1] + v[j][2] * v[j][2] + v[j][3] * v[j][3]; }
        f32x4 vg[4], vsh[4], vsc[4];
#pragma unroll
        for (int j = 0; j < 4; ++j) { const int c = lane * 4 + 256 * j; vg[j] = *(const f32x4*)(gA + c); vsh[j] = *(const f32x4*)(m + c); vsc[j] = *(const f32x4*)(m + D + c); }
        const float rstd = rsqrtf(wave_sum(s) * (1.f / D) + EPS);
#pragma unroll
        for (int j = 0; j < 4; ++j) { const int c = lane * 4 + 256 * j;
            const f32x4 g = vg[j], sh = vsh[j], scl = vsc[j];
            const f32x4 h = v[j] * rstd * g * (scl + 1.f) + sh;
            *(u32x2*)(H + (size_t)r * D + c) = (u32x2){pk2(h[0], h[1]), pk2(h[2], h[3])}; }
    }
}

__device__ __forceinline__ void post_rows(const Args& a, const Ctx& cx, bool x_from_input, const float* gate_base  , const float* gB,
                                          bool has_next, const float* gC, const float* shift_base, const float* scale_base, bool dry) {
    constexpr int RB = 3;
    const int lane = cx.tid & 63, gw = cx.bid * NWAVES + (cx.tid >> 6), NGW = cx.G * NWAVES;
    const bf16_t* OUT = (const bf16_t*)(cx.ws + WS_OUT);
    bf16_t* H = dry ? (bf16_t*)(cx.ws + WS_U + 24 * MiB) : (bf16_t*)(cx.ws + WS_H);
    float* xout = dry ? (float*)(cx.ws + WS_U) : cx.out;
    for (int rb = gw * RB; rb < T; rb += NGW * RB) {
        f32x4 o[RB][4], x[RB][4]; float s[RB], s2[RB]; size_t mg[RB];
        const size_t mg0 = (size_t)mod_group(rb < T ? rb : T - 1) * 6144;
        f32x4 vgB[4], vgt[4];
#pragma unroll
        for (int j = 0; j < 4; ++j) { const int c = lane * 4 + 256 * j; vgB[j] = *(const f32x4*)(gB + c); vgt[j] = *(const f32x4*)(gate_base + mg0 + c); }
#pragma unroll
        for (int q = 0; q < RB; ++q) { const int r = (rb + q < T) ? rb + q : T - 1;
            const float* xr = x_from_input ? ((r < TP) ? (a.in[0] + cx.z) + (size_t)r * D : (a.in[1] + cx.z) + (size_t)(r - TP) * D) : cx.out + (size_t)r * D;
            mg[q] = (size_t)mod_group(r) * 6144;
#pragma unroll
            for (int j = 0; j < 4; ++j) { const int c = lane * 4 + 256 * j;
                { const u32x2 p0 = *(const u32x2*)(OUT + (size_t)r * D + c), p1 = *(const u32x2*)(OUT + OUT_SPLIT + (size_t)r * D + c);
                  o[q][j] = (f32x4){bflo(p0.x) + bflo(p1.x), bfhi(p0.x) + bfhi(p1.x), bflo(p0.y) + bflo(p1.y), bfhi(p0.y) + bfhi(p1.y)}; }
                x[q][j] = *(const f32x4*)(xr + c); } }
#pragma unroll
        for (int q = 0; q < RB; ++q) { float t = 0.f;
#pragma unroll
            for (int j = 0; j < 4; ++j) t += o[q][j][0] * o[q][j][0] + o[q][j][1] * o[q][j][1] + o[q][j][2] * o[q][j][2] + o[q][j][3] * o[q][j][3];
            s[q] = t; }
#pragma unroll
        for (int off = 1; off < 64; off <<= 1) {
#pragma unroll
            for (int q = 0; q < RB; ++q) s[q] += __shfl_xor(s[q], off); }
#pragma unroll
        for (int q = 0; q < RB; ++q) { const int r = rb + q; const float rstd = rsqrtf(s[q] * (1.f / D) + EPS); float t = 0.f;
            const bool same = (mg[q] == mg0);
#pragma unroll
            for (int j = 0; j < 4; ++j) { const int c = lane * 4 + 256 * j;
                const f32x4 gt = same ? vgt[j] : *(const f32x4*)(gate_base + mg[q] + c);
                x[q][j] = x[q][j] + gt * (o[q][j] * rstd * vgB[j]);
                if (r < T) *(f32x4*)(xout + (size_t)r * D + c) = x[q][j];
                t += x[q][j][0] * x[q][j][0] + x[q][j][1] * x[q][j][1] + x[q][j][2] * x[q][j][2] + x[q][j][3] * x[q][j][3]; }
            s2[q] = t; }
        if (has_next) {
            f32x4 vgC[4], vsh[4], vsc[4];
#pragma unroll
            for (int j = 0; j < 4; ++j) { const int c = lane * 4 + 256 * j; vgC[j] = *(const f32x4*)(gC + c); vsh[j] = *(const f32x4*)(shift_base + mg0 + c); vsc[j] = *(const f32x4*)(scale_base + mg0 + c); }
#pragma unroll
            for (int off = 1; off < 64; off <<= 1) {
#pragma unroll
                for (int q = 0; q < RB; ++q) s2[q] += __shfl_xor(s2[q], off); }
#pragma unroll
            for (int q = 0; q < RB; ++q) { const int r = rb + q; const float rstd2 = rsqrtf(s2[q] * (1.f / D) + EPS);
                const bool same = (mg[q] == mg0);
#pragma unroll
                for (int j = 0; j < 4; ++j) { const int c = lane * 4 + 256 * j;
                    const f32x4 sh = same ? vsh[j] : *(const f32x4*)(shift_base + mg[q] + c), scl = same ? vsc[j] : *(const f32x4*)(scale_base + mg[q] + c);
                    const f32x4 h = x[q][j] * rstd2 * vgC[j] * (scl + 1.f) + sh;
                    if (r < T) *(u32x2*)(H + (size_t)r * D + c) = (u32x2){pk2(h[0], h[1]), pk2(h[2], h[3])}; } }
        }
    }
}

__device__ __forceinline__ void mla_mid(const Args& a, const Ctx& cx, int i) {
    constexpr int RB = 3;
    const int lane = cx.tid & 63, gw = cx.bid * NWAVES + (cx.tid >> 6), NGW = cx.G * NWAVES;
    const float* DOWN = (const float*)(cx.ws + WS_OUT);
    bf16_t* CQ = (bf16_t*)(cx.ws + WS_CQ); bf16_t* CKV = (bf16_t*)(cx.ws + WS_CKV); bf16_t* KR = (bf16_t*)(cx.ws + WS_KR);
    const float* gq = (a.in[24] + cx.z) + (size_t)i * 384; const float* gkv = (a.in[25] + cx.z) + (size_t)i * 256;
    const f32x2* tab32 = (const f32x2*)(cx.ws + WS_TAB) + 64 * 16;
    for (int r = T + gw; r < T + 1024; r += NGW) {
        const int rr = r - T, b = rr >> 9, j = rr & 511;
        const float* src = (a.in[6] + cx.z) + ((size_t)((b * 2 + i) * 512 + j)) * 256;
        float v[4];
#pragma unroll
        for (int q = 0; q < 4; ++q) v[q] = src[lane + 64 * q];
        const float kr = (lane < 32) ? (a.in[7] + cx.z)[((size_t)((b * 2 + i) * 512 + j)) * 32 + lane] : 0.f;
#pragma unroll
        for (int q = 0; q < 4; ++q) CKV[(size_t)r * 256 + lane + 64 * q] = (bf16_t)f2bf(v[q]);
        if (lane < 32) KR[(size_t)r * 32 + lane] = (bf16_t)f2bf(kr);
    }
    for (int rb = gw * RB; rb < T; rb += NGW * RB) {
        float q[RB][6], kv[RB][4], kr[RB], ot[RB], sq[RB], sk[RB], vq[6], vk[4];
#pragma unroll
        for (int j = 0; j < 6; ++j) vq[j] = gq[lane + 64 * j];
#pragma unroll
        for (int j = 0; j < 4; ++j) vk[j] = gkv[lane + 64 * j];
#pragma unroll
        for (int u = 0; u < RB; ++u) { const int r = (rb + u < T) ? rb + u : T - 1; const float* dr = DOWN + (size_t)r * NDOWN_PAD;
#pragma unroll
            for (int j = 0; j < 6; ++j) q[u][j] = dr[lane + 64 * j] + dr[DOWN_SPLIT + lane + 64 * j];
#pragma unroll
            for (int j = 0; j < 4; ++j) kv[u][j] = dr[384 + lane + 64 * j] + dr[DOWN_SPLIT + 384 + lane + 64 * j];
            kr[u] = dr[640 + (lane & 31)] + dr[DOWN_SPLIT + 640 + (lane & 31)];
            ot[u] = dr[640 + ((lane & 31) ^ 8)] + dr[DOWN_SPLIT + 640 + ((lane & 31) ^ 8)]; }
#pragma unroll
        for (int u = 0; u < RB; ++u) { float s = 0.f, t = 0.f;
#pragma unroll
            for (int j = 0; j < 6; ++j) s += q[u][j] * q[u][j];
#pragma unroll
            for (int j = 0; j < 4; ++j) t += kv[u][j] * kv[u][j];
            sq[u] = s; sk[u] = t; }
#pragma unroll
        for (int off = 1; off < 64; off <<= 1) {
#pragma unroll
            for (int u = 0; u < RB; ++u) { sq[u] += __shfl_xor(sq[u], off); sk[u] += __shfl_xor(sk[u], off); } }
#pragma unroll
        for (int u = 0; u < RB; ++u) { const int r = rb + u; if (r >= T) continue;
            const float rq = rsqrtf(sq[u] * (1.f / 384.f) + EPS), rk = rsqrtf(sk[u] * (1.f / 256.f) + EPS);
#pragma unroll
            for (int j = 0; j < 6; ++j) CQ[(size_t)r * 384 + lane + 64 * j] = (bf16_t)f2bf(q[u][j] * rq * vq[j]);
#pragma unroll
            for (int j = 0; j < 4; ++j) { const float v = kv[u][j] * rk * vk[j]; CKV[(size_t)r * 256 + lane + 64 * j] = (bf16_t)f2bf(v);
                if (r < TP) { const int b = r >> 8, t = r & 255; cx.out[O_CKV + ((size_t)((b * 2 + i) * 256 + t)) * 256 + lane + 64 * j] = v; } }
            if (lane < 32) {
                if (r < TP) { const int b = r >> 8, t = r & 255; cx.out[O_CKR + ((size_t)((b * 2 + i) * 256 + t)) * 32 + lane] = kr[u]; KR[(size_t)r * 32 + lane] = (bf16_t)f2bf(kr[u]); }
                else {
                    const int t = (r - TP) & 1023, half = lane >> 4, p = (lane >> 3) & 1, f = lane & 7, pos = half ? (t & 63) : (t >> 6);
                    const f32x2 cs = tab32[pos * 8 + f];
                    const float v = p ? (ot[u] * cs[1] + kr[u] * cs[0]) : (kr[u] * cs[0] - ot[u] * cs[1]);
                    KR[(size_t)r * 32 + lane] = (bf16_t)f2bf(v);
                }
            }
        }
    }
}

struct KSeg { const bf16_t* K; int kstride; const bf16_t* K2; int k2stride; const bf16_t* V; int vstride; int k_lo, k_hi; int rope; int mask; };
struct AttnArgs { const bf16_t* Q; int qstride; int qpos0; int qrope  ; int nseg; KSeg seg0, seg1;
                  float m0, l0, scale; bf16_t* O; int ostride; const f32x2* tab64; const f32x2* tab32; };

__device__ __forceinline__ u32x4 rope8(const u32x4 own, const u32x4 partner, int p, const f32x2* tab) {
    float a[8], b[8], o[8]; unpack8(own, a); unpack8(partner, b);
#pragma unroll
    for (int e = 0; e < 8; ++e) { const f32x2 cs = tab[e]; o[e] = p ? (b[e] * cs[1] + a[e] * cs[0]) : (a[e] * cs[0] - b[e] * cs[1]); }
    return pack8(o);
}

template <int DQK>
__device__ __forceinline__ void attn_unit(LAS unsigned char* lds, const AttnArgs& A, const int tid) {
    constexpr int KT = 64;
    constexpr int QS = DQK + 8, VS = KT + 8, NCH = DQK / 8, NKS = DQK / 32, KCH = KT * NCH, KPT = (KCH + NTHREADS - 1) / NTHREADS, VPT = KT / 64, NT = KT / 16;
    LAS bf16_t* Qs = (LAS bf16_t*)lds;
    LAS bf16_t* Ks = Qs + 128 * QS;
    LAS bf16_t* VT = Ks + 2 * KT * QS;
    const int lane = tid & 63, w = tid >> 6, fr = lane & 15, fq = lane >> 4;
    const int n0 = (A.seg0.k_hi - A.seg0.k_lo) / KT, n1 = (A.nseg > 1) ? ((A.seg1.k_hi - A.seg1.k_lo) / KT) : 0, ntiles = n0 + n1;
    int kkey[KPT], kch[KPT];
#pragma unroll
    for (int i = 0; i < KPT; ++i) { const int c = tid + i * NTHREADS; kkey[i] = c / NCH; kch[i] = c % NCH; }
    const int vkey = tid & 63, vch = tid >> 6;
    u32x4 kr[KPT], kp[KPT], vr[VPT]; int pf_kt = 0, pf_rope = 0, pf_mask = 0;
#define ATT_PREFETCH(j) do { const bool s0_ = (j) < n0; const KSeg S = s0_ ? A.seg0 : A.seg1; const int kt = s0_ ? (A.seg0.k_lo + KT * (j)) : (A.seg1.k_lo + KT * ((j) - n0)); \
        _Pragma("unroll") for (int i = 0; i < KPT; ++i) if (tid + i * NTHREADS < KCH) { const int d0 = kch[i] * 8; \
            if (DQK == 96 && kch[i] >= 8) kr[i] = *(const u32x4*)(S.K2 + (size_t)(kt + kkey[i]) * S.k2stride + (d0 - 64)); \
            else { const bf16_t* src = S.K + (size_t)(kt + kkey[i]) * S.kstride; kr[i] = *(const u32x4*)(src + d0); if (DQK == 64 && S.rope) kp[i] = *(const u32x4*)(src + (d0 ^ 16)); } } \
        _Pragma("unroll") for (int i = 0; i < VPT; ++i) vr[i] = *(const u32x4*)(S.V + (size_t)(kt + vkey + 64 * i) * S.vstride + vch * 8); \
        pf_kt = kt; pf_rope = S.rope; pf_mask = S.mask; } while (0)
#define ATT_WRITE(buf) do { LAS bf16_t* Kb = Ks + (buf) * KT * QS; LAS bf16_t* Vb = VT + (buf) * 64 * VS; \
        _Pragma("unroll") for (int i = 0; i < KPT; ++i) if (tid + i * NTHREADS < KCH) { u32x4 v = kr[i]; \
            if (DQK == 64 && pf_rope) { const int t = pf_kt + kkey[i], ch = kch[i], half = ch >> 2, p = (ch >> 1) & 1, f0 = (ch & 1) * 8, pos = half ? (t & 63) : (t >> 6); v = rope8(v, kp[i], p, A.tab64 + pos * 16 + f0); } \
            *(LAS u32x4*)(Kb + kkey[i] * QS + kch[i] * 8) = v; } \
        _Pragma("unroll") for (int i = 0; i < VPT; ++i) { LAS bf16_t* dst = Vb + (vch * 8) * VS + vkey + 64 * i; const u32x4 v = vr[i]; \
          dst[0 * VS] = (bf16_t)(v.x & 0xffff); dst[1 * VS] = (bf16_t)(v.x >> 16); dst[2 * VS] = (bf16_t)(v.y & 0xffff); dst[3 * VS] = (bf16_t)(v.y >> 16); \
          dst[4 * VS] = (bf16_t)(v.z & 0xffff); dst[5 * VS] = (bf16_t)(v.z >> 16); dst[6 * VS] = (bf16_t)(v.w & 0xffff); dst[7 * VS] = (bf16_t)(v.w >> 16); } } while (0)
    ATT_PREFETCH(0);
    __syncthreads();
    for (int c = tid; c < 128 * NCH; c += NTHREADS) {
        const int qi = c / NCH, ch = c % NCH, d0 = ch * 8;
        const bf16_t* src = A.Q + (size_t)qi * A.qstride;
        u32x4 v = *(const u32x4*)(src + d0);
        const int t = A.qpos0 + qi;
        if (A.qrope == 1) { const int half = ch >> 2, p = (ch >> 1) & 1, f0 = (ch & 1) * 8, pos = half ? (t & 63) : (t >> 6);
            const u32x4 pv = *(const u32x4*)(src + (d0 ^ 16)); v = rope8(v, pv, p, A.tab64 + pos * 16 + f0); }
        else if (A.qrope == 2 && ch >= 8) { const int c2 = ch - 8, half = c2 >> 1, p = c2 & 1, pos = half ? (t & 63) : (t >> 6);
            const u32x4 pv = *(const u32x4*)(src + 64 + ((c2 ^ 1) * 8)); v = rope8(v, pv, p, A.tab32 + pos * 8); }
        *(LAS u32x4*)(Qs + qi * QS + d0) = v;
    }
    ATT_WRITE(0);
    int cur_kt = pf_kt, cur_mask = pf_mask;
    if (ntiles > 1) ATT_PREFETCH(1);
    __syncthreads();
    bf16x8 Qf[NKS];
#pragma unroll
    for (int ks = 0; ks < NKS; ++ks) Qf[ks] = *(const LAS bf16x8*)(Qs + (w * 16 + fr) * QS + ks * 32 + fq * 8);
    const float scl2 = A.scale * 1.4426950408889634f;
    float m = (A.m0 > -1e29f) ? A.m0 * 1.4426950408889634f : A.m0, l = (fq == 0) ? A.l0 : 0.f;
    f32x4 Oa[4];
#pragma unroll
    for (int dt = 0; dt < 4; ++dt) Oa[dt] = (f32x4){0.f, 0.f, 0.f, 0.f};
    const int qp = A.qpos0 + w * 16 + fr;
    for (int j = 0; j < ntiles; ++j) {
        const LAS bf16_t* Kb = Ks + (j & 1) * KT * QS; const LAS bf16_t* Vb = VT + (j & 1) * 64 * VS;
        f32x4 st[NT];
#pragma unroll
        for (int nt = 0; nt < NT; ++nt) { st[nt] = (f32x4){0.f, 0.f, 0.f, 0.f};
#pragma unroll
            for (int ks = 0; ks < NKS; ++ks) { const bf16x8 kf = *(const LAS bf16x8*)(Kb + (nt * 16 + fr) * QS + ks * 32 + fq * 8); st[nt] = MFMA16(kf, Qf[ks], st[nt]); } }
        float mx = -1e30f;
#pragma unroll
        for (int nt = 0; nt < NT; ++nt)
#pragma unroll
            for (int jj = 0; jj < 4; ++jj) { float sc = st[nt][jj] * scl2;
                if (cur_mask) { const int kpos = cur_kt + nt * 16 + fq * 4 + jj; const int dd = qp - kpos; if (dd > 128 || dd < -128) sc = -1e30f; }
                st[nt][jj] = sc; mx = fmaxf(mx, sc); }
        mx = xor16_max(mx); mx = xor32_max(mx);
        const float mn = fmaxf(m, mx), alpha = __builtin_amdgcn_exp2f(m - mn);
        float rs = 0.f;
#pragma unroll
        for (int nt = 0; nt < NT; ++nt)
#pragma unroll
            for (int jj = 0; jj < 4; ++jj) { const float pe = __builtin_amdgcn_exp2f(st[nt][jj] - mn); st[nt][jj] = pe; rs += pe; }
        l = l * alpha + rs; m = mn;
#pragma unroll
        for (int dt = 0; dt < 4; ++dt) Oa[dt] = Oa[dt] * alpha;
#pragma unroll
        for (int kk = 0; kk < KT / 32; ++kk) {
            u32x4 pb; pb.x = cvtpk(st[2 * kk][0], st[2 * kk][1]); pb.y = cvtpk(st[2 * kk][2], st[2 * kk][3]); pb.z = cvtpk(st[2 * kk + 1][0], st[2 * kk + 1][1]); pb.w = cvtpk(st[2 * kk + 1][2], st[2 * kk + 1][3]);
            const bf16x8 pf = __builtin_bit_cast(bf16x8, pb);
#pragma unroll
            for (int dt = 0; dt < 4; ++dt) {
                const LAS bf16_t* vp = Vb + (dt * 16 + fr) * VS + 32 * kk + fq * 4;
                const u32x2 v0 = *(const LAS u32x2*)vp, v1 = *(const LAS u32x2*)(vp + 16);
                const u32x4 vv = {v0.x, v0.y, v1.x, v1.y};
                Oa[dt] = MFMA16(__builtin_bit_cast(bf16x8, vv), pf, Oa[dt]);
            }
        }
        if (j + 1 < ntiles) { ATT_WRITE((j + 1) & 1); cur_kt = pf_kt; cur_mask = pf_mask; if (j + 2 < ntiles) ATT_PREFETCH(j + 2); }
        __syncthreads();
    }
#undef ATT_PREFETCH
#undef ATT_WRITE
    l = xor16_add(l); l = xor32_add(l);
    const float inv = 1.f / l;
    bf16_t* op = A.O + (size_t)(w * 16 + fr) * A.ostride + fq * 4;
#pragma unroll
    for (int dt = 0; dt < 4; ++dt) *(u32x2*)(op + dt * 16) = (u32x2){pk2(Oa[dt][0] * inv, Oa[dt][1] * inv), pk2(Oa[dt][2] * inv, Oa[dt][3] * inv)};
}

__device__ __forceinline__ void swa_unit(const Args& a, const Ctx& cx, LAS unsigned char* lds, int i, int u) {
    const bf16_t* PROJ = (const bf16_t*)(cx.ws + WS_PROJ); bf16_t* MIX = (bf16_t*)(cx.ws + WS_MIX);
    AttnArgs A;
    A.tab64 = (const f32x2*)(cx.ws + WS_TAB); A.tab32 = A.tab64 + 64 * 16;
    A.qstride = NPROJ_PAD; A.ostride = D; A.scale = 0.125f; A.l0 = 1.f;
    if (u < 128) {
        const int b = u >> 6, hq = (u >> 3) & 7, qt = u & 7, kv = hq >> 2, row0 = TP + b * 1024, q0 = qt * 128;
        A.Q = PROJ + (size_t)(row0 + q0) * NPROJ_PAD + C_QB + hq * 64; A.qpos0 = q0; A.qrope = 1; A.nseg = 2;
        A.m0 = (a.in[21] + cx.z)[i * 8 + hq];
        const bf16_t* csk = (const bf16_t*)(cx.ws + WS_CSK) + ((size_t)(i * 2 + b)) * 65536 + kv * 64;
        const bf16_t* csv = (const bf16_t*)(cx.ws + WS_CSV) + ((size_t)(i * 2 + b)) * 65536 + kv * 64;
        A.seg0 = KSeg{csk, 128, nullptr, 0, csv, 128, 0, 512, 0, 0};
        const int lo = q0 - 128 < 0 ? 0 : q0 - 128, hi = q0 + 256 > 1024 ? 1024 : q0 + 256;
        A.seg1 = KSeg{PROJ + (size_t)row0 * NPROJ_PAD + C_KB + kv * 64, NPROJ_PAD, nullptr, 0, PROJ + (size_t)row0 * NPROJ_PAD + C_VB + kv * 64, NPROJ_PAD, lo, hi, 1, 1};
        A.O = MIX + (size_t)(row0 + q0) * D + 512 + hq * 64;
    } else {
        const int v = u - 128, b = v >> 4, hq = (v >> 1) & 7, qt = v & 1, kv = hq >> 2, row0 = b * 256, q0 = qt * 128;
        A.Q = PROJ + (size_t)(row0 + q0) * NPROJ_PAD + C_QB + hq * 64; A.qpos0 = q0; A.qrope = 0; A.nseg = 1;
        A.m0 = (a.in[21] + cx.z)[i * 8 + hq];
        A.seg0 = KSeg{PROJ + (size_t)row0 * NPROJ_PAD + C_KB + kv * 64, NPROJ_PAD, nullptr, 0, PROJ + (size_t)row0 * NPROJ_PAD + C_VB + kv * 64, NPROJ_PAD, 0, 256, 0, 0};
        A.seg1 = A.seg0;
        A.O = MIX + (size_t)(row0 + q0) * D + 512 + hq * 64;
    }
    attn_unit<64>(lds, A, cx.tid);
}

__device__ __forceinline__ void mla_unit(const Args& a, const Ctx& cx, LAS unsigned char* lds, int u) {
    const bf16_t* Q = (const bf16_t*)(cx.ws + WS_Q); const bf16_t* KVX = (const bf16_t*)(cx.ws + WS_KVX); const bf16_t* KR = (const bf16_t*)(cx.ws + WS_KR);
    bf16_t* MIX = (bf16_t*)(cx.ws + WS_MIX);
    AttnArgs A;
    A.tab64 = (const f32x2*)(cx.ws + WS_TAB); A.tab32 = A.tab64 + 64 * 16;
    A.qstride = 1536; A.ostride = D; A.scale = 0.10206207261596577f; A.l0 = 0.f; A.m0 = -1e30f;
    if (u < 256) {
        const int b = u >> 7, h = (u >> 3) & 15, qt = u & 7, row0 = TP + b * 1024, q0 = qt * 128, crow0 = T + b * 512;
        A.Q = Q + (size_t)(row0 + q0) * 1536 + h * 96; A.qpos0 = q0; A.qrope = 2; A.nseg = 2;
        A.seg0 = KSeg{KVX + (size_t)crow0 * 2048 + h * 128, 2048, KR + (size_t)crow0 * 32, 32, KVX + (size_t)crow0 * 2048 + h * 128 + 64, 2048, 0, 512, 0, 0};
        A.seg1 = KSeg{KVX + (size_t)row0 * 2048 + h * 128, 2048, KR + (size_t)row0 * 32, 32, KVX + (size_t)row0 * 2048 + h * 128 + 64, 2048, 0, 1024, 0, 0};
        A.O = MIX + (size_t)(row0 + q0) * D + h * 64;
    } else {
        const int v = u - 256, b = v >> 5, h = (v >> 1) & 15, qt = v & 1, row0 = b * 256, q0 = qt * 128;
        A.Q = Q + (size_t)(row0 + q0) * 1536 + h * 96; A.qpos0 = q0; A.qrope = 0; A.nseg = 1;
        A.seg0 = KSeg{KVX + (size_t)row0 * 2048 + h * 128, 2048, KR + (size_t)row0 * 32, 32, KVX + (size_t)row0 * 2048 + h * 128 + 64, 2048, 0, 256, 0, 0};
        A.seg1 = A.seg0;
        A.O = MIX + (size_t)(row0 + q0) * D + h * 64;
    }
    attn_unit<96>(lds, A, cx.tid);
}

constexpr int GL_G = 0;
constexpr int GL_STF = 32768, GL_STB = 51200;
constexpr int GL_LO = 32768, GL_WF = 40960, GL_WB = 45056, GL_BF = 49152, GL_BB = 49408;
constexpr int GL_QF = 69632, GL_KF = 78848, GL_QB = 88064, GL_KB = 97280;
constexpr int GL_VT = 106496;
constexpr int GL_AF = 124928, GL_AB = 134144;

__device__ __forceinline__ void gla_gates(const Args& a, const Ctx& cx, LAS unsigned char* lds, int i, int tok0, int h) {
    const int tid = cx.tid;
    const bf16_t* PROJ = (const bf16_t*)(cx.ws + WS_PROJ);
    LAS float* LO = (LAS float*)(lds + GL_LO); LAS float* WF = (LAS float*)(lds + GL_WF); LAS float* WB = (LAS float*)(lds + GL_WB);
    LAS float* BF = (LAS float*)(lds + GL_BF); LAS float* BB = (LAS float*)(lds + GL_BB);
    LAS float* Gf = (LAS float*)(lds + GL_G); LAS float* Gb = Gf + 4096;
    { const int t = tid >> 3, j0 = (tid & 7) * 4; const u32x2 v = *(const u32x2*)(PROJ + (size_t)(tok0 + t) * NPROJ_PAD + C_LO + j0);
      LO[t * 32 + j0] = bflo(v.x); LO[t * 32 + j0 + 1] = bfhi(v.x); LO[t * 32 + j0 + 2] = bflo(v.y); LO[t * 32 + j0 + 3] = bfhi(v.y); }
    for (int x = tid; x < 1024; x += NTHREADS) { const int r = x >> 6, d = x & 63;
        WF[x] = (a.in[16] + cx.z)[((size_t)i * 16 + r) * 256 + h * 64 + d]; WB[x] = (a.in[18] + cx.z)[((size_t)i * 16 + r) * 256 + h * 64 + d]; }
    if (tid < 64) { BF[tid] = (a.in[17] + cx.z)[i * 256 + h * 64 + tid]; BB[tid] = (a.in[19] + cx.z)[i * 256 + h * 64 + tid]; }
    __syncthreads();
    { const int d = tid & 63, tg = tid >> 6;
      LAS float* SEG = (LAS float*)(lds + GL_LO + 8192 + 8192 + 1024);
      float wf[16], wb[16];
#pragma unroll
      for (int r = 0; r < 16; ++r) { wf[r] = WF[r * 64 + d]; wb[r] = WB[r * 64 + d]; }
      const float bfv = BF[d], bbv = BB[d];
      float gf[8], gb[8];
#pragma unroll
      for (int tt = 0; tt < 8; ++tt) { const int t = tg * 8 + tt; float xf = bfv, xb = bbv;
#pragma unroll
          for (int r = 0; r < 16; ++r) { xf += LO[t * 32 + r] * wf[r]; xb += LO[t * 32 + 16 + r] * wb[r]; }
          gf[tt] = (fminf(xf, 0.f) - log1pf(__expf(-fabsf(xf)))) * (1.f / 16.f); gb[tt] = (fminf(xb, 0.f) - log1pf(__expf(-fabsf(xb)))) * (1.f / 16.f); }
#pragma unroll
      for (int tt = 1; tt < 8; ++tt) gf[tt] += gf[tt - 1];
#pragma unroll
      for (int tt = 6; tt >= 0; --tt) gb[tt] += gb[tt + 1];
      SEG[tg * 64 + d] = gf[7]; SEG[512 + tg * 64 + d] = gb[0];
      __syncthreads();
      float offf = 0.f, offb = 0.f;
#pragma unroll
      for (int q = 0; q < 8; ++q) { const float a_ = SEG[q * 64 + d], b_ = SEG[512 + q * 64 + d]; offf += (q < tg) ? a_ : 0.f; offb += (q > tg) ? b_ : 0.f; }
#pragma unroll
      for (int tt = 0; tt < 8; ++tt) { const int t = tg * 8 + tt; Gf[t * 64 + d] = gf[tt] + offf; Gb[t * 64 + d] = gb[tt] + offb; } }
    __syncthreads();
}

__device__ __forceinline__ void gla_vt_load(const bf16_t* PROJ, int tok0, int h, const int tid, u32x4 (&v)[2]) {
    const int s = tid & 63, e0 = (tid >> 6) * 16;
    const bf16_t* src = PROJ + (size_t)(tok0 + s) * NPROJ_PAD + C_VA + h * 128 + e0;
    v[0] = *(const u32x4*)src; v[1] = *(const u32x4*)(src + 8);
}
__device__ __forceinline__ void gla_vt_store(LAS unsigned char* lds, const int tid, const u32x4 (&vv)[2]) {
    const int s = tid & 63, e0 = (tid >> 6) * 16;
    LAS bf16_t* VT = (LAS bf16_t*)(lds + GL_VT);
#pragma unroll
    for (int q = 0; q < 2; ++q) { const u32x4 v = vv[q]; LAS bf16_t* dst = VT + (e0 + q * 8) * 72 + s;
        dst[0 * 72] = (bf16_t)(v.x & 0xffff); dst[1 * 72] = (bf16_t)(v.x >> 16); dst[2 * 72] = (bf16_t)(v.y & 0xffff); dst[3 * 72] = (bf16_t)(v.y >> 16);
        dst[4 * 72] = (bf16_t)(v.z & 0xffff); dst[5 * 72] = (bf16_t)(v.z >> 16); dst[6 * 72] = (bf16_t)(v.w & 0xffff); dst[7 * 72] = (bf16_t)(v.w >> 16); }
}

__device__ __forceinline__ void gla_local_unit(const Args& a, const Ctx& cx, LAS unsigned char* lds, int i, int u) {
    const int cg_ = u >> 2, h = u & 3, tok0 = cg_ * 64, tid = cx.tid, lane = tid & 63, w = tid >> 6, fr = lane & 15, fq = lane >> 4;
    const bf16_t* PROJ = (const bf16_t*)(cx.ws + WS_PROJ);
    float* LOC = (float*)(cx.ws + WS_LOC); float* DEC = (float*)(cx.ws + WS_DEC);
    u32x4 vpre[2]; gla_vt_load(PROJ, tok0, h, tid, vpre);
    const u32x4 kpre = *(const u32x4*)(PROJ + (size_t)(tok0 + (tid >> 3)) * NPROJ_PAD + C_KA + h * 64 + (tid & 7) * 8);
    __syncthreads();
    gla_gates(a, cx, lds, i, tok0, h);
    LAS float* Gf = (LAS float*)(lds + GL_G); LAS float* Gb = Gf + 4096;
    LAS bf16_t* KTf = (LAS bf16_t*)(lds + GL_KF); LAS bf16_t* KTb = (LAS bf16_t*)(lds + GL_KB);
    LAS bf16_t* VT = (LAS bf16_t*)(lds + GL_VT);
    { const int s = tid >> 3, d0 = (tid & 7) * 8; const u32x4 kv = kpre;
      float k[8]; unpack8(kv, k);
#pragma unroll
      for (int e = 0; e < 8; ++e) { const int d = d0 + e;
          KTf[d * 72 + s] = (bf16_t)f2bf(k[e] * __expf(Gf[63 * 64 + d] - Gf[s * 64 + d]));
          KTb[d * 72 + s] = (bf16_t)f2bf(k[e] * __expf(Gb[d] - Gb[s * 64 + d])); } }
    gla_vt_store(lds, tid, vpre);
    if (tid < 128) { const int dir = tid >> 6, d = tid & 63; DEC[((size_t)(dir * 96 + cg_) * 4 + h) * 64 + d] = __expf(dir ? Gb[d] : Gf[63 * 64 + d]); }
    __syncthreads();
    const int dir = w >> 2, dtile = w & 3;
    const LAS bf16_t* KT = dir ? KTb : KTf;
    bf16x8 af[2];
#pragma unroll
    for (int ks = 0; ks < 2; ++ks) af[ks] = *(const LAS bf16x8*)(KT + (dtile * 16 + fr) * 72 + ks * 32 + fq * 8);
    float* dst = LOC + ((size_t)(dir * 96 + cg_) * 4 + h) * 8192;
#pragma unroll
    for (int et = 0; et < 8; ++et) { f32x4 acc = {0.f, 0.f, 0.f, 0.f};
#pragma unroll
        for (int ks = 0; ks < 2; ++ks) { const bf16x8 bfv = *(const LAS bf16x8*)(VT + (et * 16 + fr) * 72 + ks * 32 + fq * 8); acc = MFMA16(af[ks], bfv, acc); }
#pragma unroll
        for (int j = 0; j < 4; ++j) dst[(dtile * 16 + fq * 4 + j) * 128 + et * 16 + fr] = acc[j]; }
}

__device__ __forceinline__ void gla_out_unit(const Args& a, const Ctx& cx, LAS unsigned char* lds, int i, int u) {
    const int cg_ = u >> 2, h = u & 3, tok0 = cg_ * 64, tid = cx.tid, lane = tid & 63, w = tid >> 6, fr = lane & 15, fq = lane >> 4;
    const bf16_t* PROJ = (const bf16_t*)(cx.ws + WS_PROJ); bf16_t* MIX = (bf16_t*)(cx.ws + WS_MIX);
    const float* LOC = (const float*)(cx.ws + WS_LOC); const float* DEC = (const float*)(cx.ws + WS_DEC);
    u32x4 vpre[2]; gla_vt_load(PROJ, tok0, h, tid, vpre);
    const u32x4 qpre = *(const u32x4*)(PROJ + (size_t)(tok0 + (tid >> 3)) * NPROJ_PAD + C_QA + h * 64 + (tid & 7) * 8);
    const u32x4 kpre = *(const u32x4*)(PROJ + (size_t)(tok0 + (tid >> 3)) * NPROJ_PAD + C_KA + h * 64 + (tid & 7) * 8);
    const bf16_t* gpp = PROJ + (size_t)(tok0 + (tid >> 3)) * NPROJ_PAD + C_GA + h * 128 + (tid & 7) * 16;
    const u32x4 gpre0 = *(const u32x4*)gpp, gpre1 = *(const u32x4*)(gpp + 8);
    __syncthreads();
    gla_gates(a, cx, lds, i, tok0, h);
    LAS float* Gf = (LAS float*)(lds + GL_G); LAS float* Gb = Gf + 4096;
    const bool samp = cg_ >= 64;
    const int b = samp ? (cg_ - 64) >> 4 : cg_ >> 2, c = samp ? (cg_ - 64) & 15 : cg_ & 3, nc = samp ? 16 : 4, cbase = cg_ - c;
    {
        const int d = tid >> 3, e0 = (tid & 7) * 16;
        f32x4 Sf[4], Sb[4];
        if (samp) { const float* s0f = (a.in[2] + cx.z) + ((size_t)((b * 2 + i) * 4 + h)) * 8192 + d * 128 + e0; const float* s0b = (a.in[3] + cx.z) + ((size_t)((b * 2 + i) * 4 + h)) * 8192 + d * 128 + e0;
#pragma unroll
            for (int q = 0; q < 4; ++q) { Sf[q] = *(const f32x4*)(s0f + q * 4); Sb[q] = *(const f32x4*)(s0b + q * 4); } }
        else {
#pragma unroll
            for (int q = 0; q < 4; ++q) { Sf[q] = (f32x4){0.f, 0.f, 0.f, 0.f}; Sb[q] = Sf[q]; } }
        for (int j = 0; j < c; ++j) { const size_t ix = (size_t)(0 * 96 + cbase + j) * 4 + h; const float dec = DEC[ix * 64 + d]; const float* lp = LOC + ix * 8192 + d * 128 + e0;
#pragma unroll
            for (int q = 0; q < 4; ++q) Sf[q] = Sf[q] * dec + *(const f32x4*)(lp + q * 4); }
        for (int j = nc - 1; j > c; --j) { const size_t ix = (size_t)(1 * 96 + cbase + j) * 4 + h; const float dec = DEC[ix * 64 + d]; const float* lp = LOC + ix * 8192 + d * 128 + e0;
#pragma unroll
            for (int q = 0; q < 4; ++q) Sb[q] = Sb[q] * dec + *(const f32x4*)(lp + q * 4); }
        if (!samp) {
            if (c == nc - 1) { const size_t ix = (size_t)(0 * 96 + cg_) * 4 + h; const float dec = DEC[ix * 64 + d]; const float* lp = LOC + ix * 8192 + d * 128 + e0;
                float* o = cx.out + O_SF + ((size_t)((b * 2 + i) * 4 + h)) * 8192 + d * 128 + e0;
#pragma unroll
                for (int q = 0; q < 4; ++q) *(f32x4*)(o + q * 4) = Sf[q] * dec + *(const f32x4*)(lp + q * 4); }
            if (c == 0) { const size_t ix = (size_t)(1 * 96 + cg_) * 4 + h; const float dec = DEC[ix * 64 + d]; const float* lp = LOC + ix * 8192 + d * 128 + e0;
                float* o = cx.out + O_SB + ((size_t)((b * 2 + i) * 4 + h)) * 8192 + d * 128 + e0;
#pragma unroll
                for (int q = 0; q < 4; ++q) *(f32x4*)(o + q * 4) = Sb[q] * dec + *(const f32x4*)(lp + q * 4); }
        }
        LAS bf16_t* STf = (LAS bf16_t*)(lds + GL_STF); LAS bf16_t* STb = (LAS bf16_t*)(lds + GL_STB);
#pragma unroll
        for (int q = 0; q < 4; ++q)
#pragma unroll
            for (int e = 0; e < 4; ++e) { STf[(e0 + q * 4 + e) * 72 + d] = (bf16_t)f2bf(Sf[q][e]); STb[(e0 + q * 4 + e) * 72 + d] = (bf16_t)f2bf(Sb[q][e]); }
    }
    {
        const int t = tid >> 3, d0 = (tid & 7) * 8;
        const u32x4 qv = qpre, kv = kpre;
        float q[8], k[8], o1[8], o2[8], o3[8], o4[8]; unpack8(qv, q); unpack8(kv, k);
#pragma unroll
        for (int e = 0; e < 8; ++e) { const float gf = Gf[t * 64 + d0 + e], gb = Gb[t * 64 + d0 + e];
            o1[e] = q[e] * 0.125f * __expf(gf); o2[e] = k[e] * __expf(-gf); o3[e] = q[e] * 0.125f * __expf(gb); o4[e] = k[e] * __expf(-gb); }
        *(LAS u32x4*)((LAS bf16_t*)(lds + GL_QF) + t * 72 + d0) = pack8(o1);
        *(LAS u32x4*)((LAS bf16_t*)(lds + GL_KF) + t * 72 + d0) = pack8(o2);
        *(LAS u32x4*)((LAS bf16_t*)(lds + GL_QB) + t * 72 + d0) = pack8(o3);
        *(LAS u32x4*)((LAS bf16_t*)(lds + GL_KB) + t * 72 + d0) = pack8(o4);
    }
    gla_vt_store(lds, tid, vpre);
    __syncthreads();
    {
        const int dir = w >> 2, tt = w & 3;
        const LAS bf16_t* Qm = (const LAS bf16_t*)(lds + (dir ? GL_QB : GL_QF)); const LAS bf16_t* Km = (const LAS bf16_t*)(lds + (dir ? GL_KB : GL_KF));
        LAS bf16_t* AT = (LAS bf16_t*)(lds + (dir ? GL_AB : GL_AF));
        bf16x8 af[2];
#pragma unroll
        for (int ks = 0; ks < 2; ++ks) af[ks] = *(const LAS bf16x8*)(Qm + (tt * 16 + fr) * 72 + ks * 32 + fq * 8);
#pragma unroll
        for (int st = 0; st < 4; ++st) { f32x4 acc = {0.f, 0.f, 0.f, 0.f};
#pragma unroll
            for (int ks = 0; ks < 2; ++ks) { const bf16x8 bfv = *(const LAS bf16x8*)(Km + (st * 16 + fr) * 72 + ks * 32 + fq * 8); acc = MFMA16(af[ks], bfv, acc); }
#pragma unroll
            for (int j = 0; j < 4; ++j) { const int t = tt * 16 + fq * 4 + j, s = st * 16 + fr; const bool keep = dir ? (s >= t) : (s <= t);
                AT[t * 72 + s] = (bf16_t)f2bf(keep ? acc[j] : 0.f); } }
    }
    __syncthreads();
    {
        const int tt = w & 3, eg = w >> 2;
        LAS float* OS = (LAS float*)(lds + GL_G);
        const LAS bf16_t* VT = (const LAS bf16_t*)(lds + GL_VT);
        bf16x8 a1[2], a2[2], a3[2], a4[2];
#pragma unroll
        for (int ks = 0; ks < 2; ++ks) { const int off = (tt * 16 + fr) * 72 + ks * 32 + fq * 8;
            a1[ks] = *(const LAS bf16x8*)((const LAS bf16_t*)(lds + GL_QF) + off); a2[ks] = *(const LAS bf16x8*)((const LAS bf16_t*)(lds + GL_AF) + off);
            a3[ks] = *(const LAS bf16x8*)((const LAS bf16_t*)(lds + GL_QB) + off); a4[ks] = *(const LAS bf16x8*)((const LAS bf16_t*)(lds + GL_AB) + off); }
        f32x4 accs[4];
#pragma unroll
        for (int q = 0; q < 4; ++q) { const int et = eg * 4 + q; f32x4 acc = {0.f, 0.f, 0.f, 0.f};
#pragma unroll
            for (int ks = 0; ks < 2; ++ks) { const int off = (et * 16 + fr) * 72 + ks * 32 + fq * 8;
                const bf16x8 b1 = *(const LAS bf16x8*)((const LAS bf16_t*)(lds + GL_STF) + off), b2 = *(const LAS bf16x8*)(VT + off), b3 = *(const LAS bf16x8*)((const LAS bf16_t*)(lds + GL_STB) + off);
                acc = MFMA16(a1[ks], b1, acc); acc = MFMA16(a2[ks], b2, acc); acc = MFMA16(a3[ks], b3, acc); acc = MFMA16(a4[ks], b2, acc); }
            accs[q] = acc; }
#pragma unroll
        for (int q = 0; q < 4; ++q)
#pragma unroll
            for (int j = 0; j < 4; ++j) OS[(tt * 16 + fq * 4 + j) * 128 + (eg * 4 + q) * 16 + fr] = accs[q][j];
    }
    __syncthreads();
    {
        const int t = tid >> 3, e0 = (tid & 7) * 16;
        const LAS float* OS = (const LAS float*)(lds + GL_G);
        float o[16]; float ss = 0.f;
#pragma unroll
        for (int e = 0; e < 16; ++e) { o[e] = OS[t * 128 + e0 + e]; ss += o[e] * o[e]; }
        ss += __shfl_xor(ss, 1); ss += __shfl_xor(ss, 2); ss += __shfl_xor(ss, 4);
        const float rstd = rsqrtf(ss * (1.f / 128.f) + EPS);
        const float* gg = (a.in[20] + cx.z) + i * 128 + e0;
        float gt[16]; unpack8(gpre0, gt); unpack8(gpre1, gt + 8);
#pragma unroll
        for (int e = 0; e < 16; ++e) o[e] = o[e] * rstd * gg[e] * silu_f(gt[e]);
        bf16_t* op = MIX + (size_t)(tok0 + t) * D + h * 128 + e0;
        *(u32x4*)op = pack8(o); *(u32x4*)(op + 8) = pack8(o + 8);
    }
}


#define XB_TMO      128
#define XB_XCNT(j)  (256  + 64 * (j))
#define XB_XSUB(j)  (1280 + 64 * (j))
#define XB_XGEN(j)  (2304 + 64 * (j))
#define XB_TOP      3328
#define XB_TOPGEN   3392
#define XCD_BAR_WORDS 3456
#define XB_SPIN_CAP (1u << 18)
__device__ __forceinline__ unsigned xb_ld(unsigned* p)              { return __hip_atomic_load(p, __ATOMIC_RELAXED, __HIP_MEMORY_SCOPE_AGENT); }
__device__ __forceinline__ unsigned xb_add(unsigned* p, unsigned v) { return __hip_atomic_fetch_add(p, v, __ATOMIC_RELAXED, __HIP_MEMORY_SCOPE_AGENT); }
__device__ __forceinline__ unsigned xb_xcc_id() { return (unsigned)__builtin_amdgcn_s_getreg((3 << 11) | 20) & 0xFu; }
#define XB_SPIN(cond, bar) do { unsigned _sp = 0; while (cond) { __builtin_amdgcn_s_sleep(1); \
    if ((++_sp & 255u) == 0u) { if (xb_ld(&(bar)[XB_TMO])) break; if (_sp > XB_SPIN_CAP) { atomicAdd(&(bar)[XB_TMO], 1u); break; } } } } while (0)
struct XcdBarrier { unsigned* bar; unsigned x; volatile LAS unsigned* st; };
__device__ __forceinline__ XcdBarrier xcd_barrier_post(unsigned* bar, volatile LAS unsigned* st, const int tid) {
    XcdBarrier b; b.bar = bar; b.x = xb_xcc_id(); b.st = st;
    if (tid == 0) (void)xb_add(&bar[XB_XCNT(b.x)], 1u);
    return b;
}
__device__ __forceinline__ void xcd_barrier_complete(unsigned* bar, unsigned x, unsigned& nloc, unsigned& nx) {
    const unsigned G = gridDim.x * gridDim.y * gridDim.z;
    unsigned sum, cnt, mine, sp = 0u;
    for (;;) {
        sum = 0u; cnt = 0u; mine = 0u;
#pragma unroll
        for (unsigned j = 0; j < 16; ++j) { const unsigned c = xb_ld(&bar[XB_XCNT(j)]); sum += c; cnt += (c > 0u) ? 1u : 0u; mine = (j == x) ? c : mine; }
        if (sum == G) break;
        __builtin_amdgcn_s_sleep(1);
        if ((++sp & 255u) == 0u) { if (xb_ld(&bar[XB_TMO])) break; if (sp > XB_SPIN_CAP) { atomicAdd(&bar[XB_TMO], 1u); break; } }
    }
    nloc = mine > 0u ? mine : 1u; nx = cnt > 0u ? cnt : 1u;
}
__device__ __forceinline__ void xcd_barrier(const XcdBarrier& b, const int tid) {
    asm volatile("s_waitcnt vmcnt(0)" ::: "memory");
    __syncthreads();
    if (tid == 0) {
        unsigned* bar = b.bar;
        __builtin_amdgcn_s_waitcnt(0);
        unsigned nloc = b.st[0], nx = b.st[1];
        if (nloc == 0u) { xcd_barrier_complete(bar, b.x, nloc, nx); b.st[0] = nloc; b.st[1] = nx; }
        const unsigned old = xb_add(&bar[XB_XSUB(b.x)], 1u);
        const unsigned gen = old / nloc;
        if (old + 1u == (gen + 1u) * nloc) {
            __builtin_amdgcn_fence(__ATOMIC_RELEASE, "agent");
            asm volatile("s_waitcnt vmcnt(0)" ::: "memory");
            const unsigned og = xb_add(&bar[XB_TOP], 1u);
            const unsigned tg = og / nx;
            if (og + 1u == (tg + 1u) * nx) xb_add(&bar[XB_TOPGEN], 1u);
            else XB_SPIN(xb_ld(&bar[XB_TOPGEN]) == tg, bar);
            __builtin_amdgcn_fence(__ATOMIC_ACQUIRE, "agent");
            asm volatile("s_waitcnt vmcnt(0)" ::: "memory");
        } else {
            XB_SPIN(xb_ld(&bar[XB_TOPGEN]) == gen, bar);
            __builtin_amdgcn_fence(__ATOMIC_ACQUIRE, "agent");
            asm volatile("s_waitcnt vmcnt(0)" ::: "memory");
        }
    }
    __syncthreads();
}

enum { K_PRO = 0, K_PRE, K_G1, K_A1, K_A2, K_DOWN, K_MID, K_UQKV, K_MLA, K_OUTP, K_POST1, K_FF1, K_FF2, K_POST2 };
constexpr int N_PHASES = 2 + 2 * 8 + 2 * 9;
#ifndef EN_MASK
#define EN_MASK 0xFFFFFFFFu
#endif
#define ENB(k) (((EN_MASK) >> (k)) & 1u)
#ifndef DUP_MASK
#define DUP_MASK 0u
#endif
#ifndef BAR_REPS
#define BAR_REPS 1
#endif

__global__ void __launch_bounds__(NTHREADS, 2) mega_fwd(Args args) {
    extern __shared__ __attribute__((aligned(16))) unsigned char lds_raw[];
    LAS unsigned char* lds = (LAS unsigned char*)lds_raw;
    const int lo = args.ph_lo, hi = args.ph_hi;
    const int wave_s = __builtin_amdgcn_readfirstlane((int)(threadIdx.x >> 6));
#define MY_TID(dst) do { int _l; asm volatile("v_mbcnt_lo_u32_b32 %0, -1, 0\n\tv_mbcnt_hi_u32_b32 %0, -1, %0" : "=v"(_l)); dst = wave_s * 64 + _l; } while (0)
    {
        int tid0; MY_TID(tid0);
        volatile LAS unsigned* bst = (volatile LAS unsigned*)(lds + LDS_BYTES - 64);
        if (tid0 < 2) bst[tid0] = 0u;
        __syncthreads();
        (void)xcd_barrier_post((unsigned*)(args.ws + WS_CTL), bst, tid0);
    }
    for (int p = lo; p < hi; ++p) {
        int kind, l;
        if (p == 0) { kind = K_PRO; l = 0; }
        else if (p == 1) { kind = K_PRE; l = 0; }
        else {
            const int q = p - 2, pair = q / 17, r = q - pair * 17;
            if (r < 8) { l = 2 * pair; kind = (r == 0) ? K_G1 : (r == 1) ? K_A1 : (r == 2) ? K_A2 : (r == 3) ? K_OUTP : (r == 4) ? K_POST1 : (r == 5) ? K_FF1 : (r == 6) ? K_FF2 : K_POST2; }
            else { const int r2 = r - 8; l = 2 * pair + 1; kind = (r2 == 0) ? K_DOWN : (r2 == 1) ? K_MID : (r2 == 2) ? K_UQKV : (r2 == 3) ? K_MLA : (r2 == 4) ? K_OUTP : (r2 == 5) ? K_POST1 : (r2 == 6) ? K_FF1 : (r2 == 7) ? K_FF2 : K_POST2; }
        }
        const int reps = ((DUP_MASK >> kind) & 1u) ? 2 : 1;
        for (int rep = 0; rep < reps; ++rep) {
        if (rep) __syncthreads();
        Ctx cx; cx.z = 0; MY_TID(cx.tid); cx.bid = blockIdx.x; cx.G = gridDim.x;
        asm volatile("" : "+s"(cx.z), "+s"(kind), "+s"(l), "+v"(cx.tid), "+s"(cx.bid), "+s"(cx.G));
        cx.ws = args.ws + cx.z; cx.out = args.out + cx.z;
        unsigned char* ws = cx.ws;
        const int i = l >> 1, G = cx.G, bid = cx.bid;
        switch (kind) {
        case K_PRO: if (ENB(0)) prologue(args, cx, lds); break;
        case K_PRE: if (ENB(1)) pre_rows(args, cx, 0); break;
        case K_G1: if (ENB(2)) {
            pg8::Gemm g{(const bf16_t*)(ws + WS_H), (const bf16_t*)(ws + WS_WIN) + (size_t)i * NPROJ_PAD * D, T, NPROJ_PAD, D, D, D, NPROJ_PAD / 256, 0};
            pg8::StaticOrder S; S.init(T, NPROJ_PAD, G, bid);
            pg8::EpiProj E{(bf16_t*)(ws + WS_PROJ), cx.out, i};
            pg8::gemm_phase<pg8::EpiProj, pg8::StaticOrder>(lds, g, S, E, cx.tid);
        } break;
        case K_A1:
            if (G == 256) {
                if (bid < 128) { if (ENB(3)) swa_unit(args, cx, lds, i, bid); if (ENB(4)) gla_local_unit(args, cx, lds, i, bid); }
                else { const int q = bid - 128; if (ENB(3)) { swa_unit(args, cx, lds, i, 128 + 2 * q); swa_unit(args, cx, lds, i, 128 + 2 * q + 1); }
                       if (ENB(4)) { gla_local_unit(args, cx, lds, i, 128 + 2 * q); gla_local_unit(args, cx, lds, i, 128 + 2 * q + 1); } }
            } else { for (int u = bid; u < 768; u += G) { if (u < 384) { if (ENB(3)) swa_unit(args, cx, lds, i, u); } else { if (ENB(4)) gla_local_unit(args, cx, lds, i, u - 384); } } }
            break;
        case K_A2:
            if (G == 256) {
                if (bid < 128) { if (ENB(5)) { gla_out_unit(args, cx, lds, i, 256 + bid); gla_out_unit(args, cx, lds, i, bid); } }
                else { if (ENB(5)) gla_out_unit(args, cx, lds, i, bid); }
            } else { for (int u = bid; u < 384; u += G) if (ENB(5)) gla_out_unit(args, cx, lds, i, u); }
            break;
        case K_MID: if (ENB(7)) mla_mid(args, cx, i); break;
        case K_UQKV: if (ENB(8)) {
            for (int s = 0; s < 2; ++s) {
                pg8::Gemm g;
                if (s == 0) g = pg8::Gemm{(const bf16_t*)(ws + WS_CQ), (const bf16_t*)(ws + WS_WUQ) + (size_t)i * 1536 * 384, T, 1536, 384, 384, 384, 6, 0};
                else        g = pg8::Gemm{(const bf16_t*)(ws + WS_CKV), (const bf16_t*)(ws + WS_WUKV) + (size_t)i * 2048 * 256, T + 1024, 2048, 256, 256, 256, 8, 0};
                pg8::StaticOrder S; S.init(g.M, g.N, G, (s == 0 || G != 256) ? bid : ((bid + 144) & 255));
                pg8::EpiBf16<0> E{s == 0 ? (bf16_t*)(ws + WS_Q) : (bf16_t*)(ws + WS_KVX), g.N};
                pg8::gemm_phase<pg8::EpiBf16<0>, pg8::StaticOrder>(lds, g, S, E, cx.tid);
            }
        } break;
        case K_MLA: if (ENB(9)) {
            if (G == 256) {
                const int xcd = bid & 7, slot = bid >> 3, id = xcd * 4 + (slot >> 3);
                mla_unit(args, cx, lds, id * 8 + (slot & 7));
                mla_unit(args, cx, lds, 256 + 2 * bid);
                mla_unit(args, cx, lds, 256 + 2 * bid + 1);
            } else { for (int u = bid; u < 768; u += G) mla_unit(args, cx, lds, u); }
        } break;
        case K_DOWN: if (ENB(10)) {
            pg8::Gemm g{(const bf16_t*)(ws + WS_H), (const bf16_t*)(ws + WS_WDOWN) + (size_t)i * NDOWN_PAD * D, T, 2 * NDOWN_PAD, D / 2, D, D / 2, NDOWN_PAD / 256, D / 2};
            pg8::EpiF32 E{(float*)(ws + WS_OUT), NDOWN_PAD, NDOWN_PAD / 256, DOWN_SPLIT};
            pg8::StaticOrder S; S.init(g.M, g.N, G, bid);
            pg8::gemm_phase<pg8::EpiF32, pg8::StaticOrder>(lds, g, S, E, cx.tid);
        } break;
        case K_OUTP: case K_FF2: if (ENB(10)) {
            pg8::Gemm g;
            if (kind == K_OUTP) {
                const bf16_t* Wt = (l & 1) ? (const bf16_t*)(ws + WS_WO) + (size_t)i * D * D : (const bf16_t*)(ws + WS_WOUT) + (size_t)i * D * D;
                g = pg8::Gemm{(const bf16_t*)(ws + WS_MIX), Wt, T, 2 * D, D / 2, D, D / 2, 4, D / 2};
            } else {
                g = pg8::Gemm{(const bf16_t*)(ws + WS_U), (const bf16_t*)(ws + WS_WFF2) + (size_t)l * FF * D, T, 2 * D, FF / 2, FF, FF / 2, 4, FF / 2};
            }
            pg8::EpiSplitBf16 E{(bf16_t*)(ws + WS_OUT), D, 4, OUT_SPLIT};
            pg8::StaticOrder S; S.init(g.M, g.N, G, bid);
            pg8::gemm_phase<pg8::EpiSplitBf16, pg8::StaticOrder>(lds, g, S, E, cx.tid);
        } break;
        case K_FF1: if (ENB(12)) {
            pg8::Gemm g{(const bf16_t*)(ws + WS_H), (const bf16_t*)(ws + WS_WFF1) + (size_t)l * FF * D, T, FF, D, D, D, FF / 256, 0};
            pg8::StaticOrder S; S.init(T, FF, G, bid);
            pg8::EpiBf16<1> E{(bf16_t*)(ws + WS_U), FF};
            pg8::gemm_phase<pg8::EpiBf16<1>, pg8::StaticOrder>(lds, g, S, E, cx.tid);
        } break;
        case K_POST1: if (ENB(11)) {
            const float* MODL = (const float*)(ws + WS_MOD) + (size_t)l * 3 * 6144; const float* gN = (args.in[12] + cx.z) + (size_t)l * 4 * D;
            post_rows(args, cx, l == 0, MODL + 2 * D, gN + D, true, gN + 2 * D, MODL + 3 * D, MODL + 4 * D, rep + 1 < reps);
        } break;
        case K_POST2: if (ENB(14)) {
            const float* MODL = (const float*)(ws + WS_MOD) + (size_t)l * 3 * 6144; const float* gN = (args.in[12] + cx.z) + (size_t)l * 4 * D;
            const float* MODN = MODL + 3 * 6144; const float* gNn = gN + 4 * D;
            post_rows(args, cx, false, MODL + 5 * D, gN + 3 * D, l < 3, gNn, MODN, MODN + D, rep + 1 < reps);
        } break;
        default: break;
        }
        }
        if (p + 1 < hi) { if (hi < 0) cg::this_grid().sync(); else { XcdBarrier xb; xb.bar = (unsigned*)(args.ws + WS_CTL); xb.x = xb_xcc_id(); xb.st = (volatile LAS unsigned*)(lds + LDS_BYTES - 64); int tidb; MY_TID(tidb); for (int br = 0; br < BAR_REPS; ++br) xcd_barrier(xb, tidb); } }
    }
}

extern "C" void kernel_launch(void* const* d_in, const int* in_sizes, int n_in, void* d_out, int out_size, void* d_ws, size_t ws_size, hipStream_t stream) {
    static int grid = 0;
    if (grid == 0) {
        int dev = 0, cus = 0, per_cu = 0;
        hipGetDevice(&dev);
        hipDeviceGetAttribute(&cus, hipDeviceAttributeMultiprocessorCount, dev);
        hipFuncSetAttribute((const void*)mega_fwd, hipFuncAttributeMaxDynamicSharedMemorySize, LDS_BYTES);
        hipOccupancyMaxActiveBlocksPerMultiprocessor(&per_cu, (const void*)mega_fwd, NTHREADS, LDS_BYTES);
        if (per_cu < 1) { fprintf(stderr, "kernel_launch: occupancy query says %d blocks per CU\n", per_cu); per_cu = 1; }
        (void)hipGetLastError();
        grid = cus;
        if (ws_size < 256 * MiB) fprintf(stderr, "kernel_launch: workspace too small (%zu)\n", ws_size);
    }
    (void)hipMemsetAsync((char*)d_ws + WS_CTL, 0, CTL_BYTES, stream);
    Args a{};
    for (int i = 0; i < 29; ++i) a.in[i] = (const float*)d_in[i];
    a.out = (float*)d_out; a.ws = (unsigned char*)d_ws;
#if MK_ONE_LAUNCH
    a.ph_lo = 0; a.ph_hi = N_PHASES;
    void* kargs[] = {&a};
    hipError_t e = hipLaunchCooperativeKernel((const void*)mega_fwd, dim3(grid), dim3(NTHREADS), kargs, LDS_BYTES, stream);
    if (e != hipSuccess) fprintf(stderr, "cooperative launch failed: %s (grid %d)\n", hipGetErrorString(e), grid);
#else
    for (int p = 0; p < N_PHASES; ++p) {
        a.ph_lo = p; a.ph_hi = p + 1;
        hipLaunchKernelGGL(mega_fwd, dim3(grid), dim3(NTHREADS), LDS_BYTES, stream, a);
    }
#endif
}
```

```cpp
#include <hip/hip_runtime.h>
#include <hip/hip_cooperative_groups.h>
#include <cstdio>
#include <cstdint>
namespace cg = cooperative_groups;

#ifndef MK_ONE_LAUNCH
#define MK_ONE_LAUNCH 1
#endif

#define LAS __attribute__((address_space(3)))
#define GAS __attribute__((address_space(1)))
typedef unsigned short bf16_t;
typedef short bf16x8 __attribute__((ext_vector_type(8)));
typedef float f32x4 __attribute__((ext_vector_type(4)));
typedef float f32x2 __attribute__((ext_vector_type(2)));
typedef unsigned u32x4 __attribute__((ext_vector_type(4)));
typedef unsigned u32x2 __attribute__((ext_vector_type(2)));

constexpr int D = 1024, TP = 4096, TS = 2048, T = TP + TS, FF = 4096;
constexpr int NPROJ = 2336, NPROJ_PAD = 2560, NDOWN = 672, NDOWN_PAD = 768;
constexpr int C_QA = 0, C_KA = 256, C_VA = 512, C_GA = 1024, C_LO = 1536, C_QB = 1568, C_KB = 2080, C_VB = 2208;
constexpr float EPS = 1e-6f;
constexpr int NTHREADS = 512, NWAVES = 8;
constexpr int LDS_BYTES = 147456;

constexpr size_t O_X = 0, O_SF = 6291456, O_SB = 7340032, O_CK = 8388608, O_CV = 9437184, O_CKV = 10485760, O_CKR = 12582912;

constexpr size_t MiB = 1u << 20;
constexpr size_t WS_WFF1 = 0, WS_WFF2 = 32 * MiB, WS_WIN = 64 * MiB, WS_WOUT = 74 * MiB, WS_WDOWN = 78 * MiB, WS_WUQ = 81 * MiB,
                 WS_WUKV = 84 * MiB, WS_WO = 86 * MiB, WS_MOD = 90 * MiB, WS_TAB = 91 * MiB, WS_CSK = 92 * MiB, WS_CSV = 93 * MiB,
                 WS_H = 94 * MiB, WS_MIX = 106 * MiB, WS_OUT = 118 * MiB, WS_U = 166 * MiB, WS_PROJ = 214 * MiB, WS_CTL = 250 * MiB;
constexpr size_t CTL_BYTES = 16384;
constexpr size_t WS_LOC = WS_U, WS_DEC = WS_U + 24 * MiB;
constexpr size_t WS_Q = WS_U, WS_KVX = WS_U + 18 * MiB;
constexpr size_t WS_DOWN = WS_PROJ, WS_CQ = WS_PROJ + 18 * MiB, WS_CKV = WS_PROJ + 23 * MiB, WS_KR = WS_PROJ + 27 * MiB;
constexpr size_t OUT_SPLIT = (size_t)T * D;
constexpr size_t DOWN_SPLIT = (WS_DOWN - WS_OUT) / 4;

__device__ __forceinline__ unsigned f2bf(float f) { unsigned u = __builtin_bit_cast(unsigned, f); return (u + 0x7fffu + ((u >> 16) & 1u)) >> 16; }
__device__ __forceinline__ unsigned pk2(float lo, float hi) { return f2bf(lo) | (f2bf(hi) << 16); }
__device__ __forceinline__ float bf2f(unsigned short b) { return __builtin_bit_cast(float, (unsigned)b << 16); }
__device__ __forceinline__ float bflo(unsigned w) { return __builtin_bit_cast(float, w << 16); }
__device__ __forceinline__ float bfhi(unsigned w) { return __builtin_bit_cast(float, w & 0xffff0000u); }
__device__ __forceinline__ void unpack8(const u32x4 v, float* f) {
    f[0] = bflo(v.x); f[1] = bfhi(v.x); f[2] = bflo(v.y); f[3] = bfhi(v.y); f[4] = bflo(v.z); f[5] = bfhi(v.z); f[6] = bflo(v.w); f[7] = bfhi(v.w);
}
__device__ __forceinline__ u32x4 pack8(const float* f) { u32x4 o; o.x = pk2(f[0], f[1]); o.y = pk2(f[2], f[3]); o.z = pk2(f[4], f[5]); o.w = pk2(f[6], f[7]); return o; }
__device__ __forceinline__ float wave_sum(float v) {
#pragma unroll
    for (int o = 1; o < 64; o <<= 1) v += __shfl_xor(v, o);
    return v;
}
__device__ __forceinline__ float xor16_max(float x) { const unsigned u = __builtin_bit_cast(unsigned, x); auto r = __builtin_amdgcn_permlane16_swap(u, u, false, false); return fmaxf(__builtin_bit_cast(float, (unsigned)r[0]), __builtin_bit_cast(float, (unsigned)r[1])); }
__device__ __forceinline__ float xor32_max(float x) { const unsigned u = __builtin_bit_cast(unsigned, x); auto r = __builtin_amdgcn_permlane32_swap(u, u, false, false); return fmaxf(__builtin_bit_cast(float, (unsigned)r[0]), __builtin_bit_cast(float, (unsigned)r[1])); }
__device__ __forceinline__ float xor16_add(float x) { const unsigned u = __builtin_bit_cast(unsigned, x); auto r = __builtin_amdgcn_permlane16_swap(u, u, false, false); return __builtin_bit_cast(float, (unsigned)r[0]) + __builtin_bit_cast(float, (unsigned)r[1]); }
__device__ __forceinline__ float xor32_add(float x) { const unsigned u = __builtin_bit_cast(unsigned, x); auto r = __builtin_amdgcn_permlane32_swap(u, u, false, false); return __builtin_bit_cast(float, (unsigned)r[0]) + __builtin_bit_cast(float, (unsigned)r[1]); }
__device__ __forceinline__ unsigned cvtpk(float lo, float hi) { unsigned r; asm volatile("v_cvt_pk_bf16_f32 %0, %1, %2" : "=v"(r) : "v"(lo), "v"(hi)); return r; }
__device__ __forceinline__ float silu_f(float x) { return x / (1.f + __expf(-x)); }

namespace pg8 {
constexpr int BM = 256, BK = 64, HALF = 128, HTB = HALF * BK * 2, NXCD = 8, WGM = 8;
__host__ __device__ __forceinline__ int lds_byte(int r, int c) { const int st = (r >> 4) * 2 + (c >> 5), rr = r & 15, cc = c & 31, ob = rr * 64 + cc * 2; return st * 1024 + (ob ^ (((ob >> 9) & 1) << 5)); }
__host__ __device__ __forceinline__ void stage_rc(int b, int& R, int& C) { const int st = b / 1024, sb = b % 1024, swz = sb ^ (((sb >> 9) & 1) << 5); R = (st >> 1) * 16 + swz / 64; C = (st & 1) * 32 + (swz % 64) / 2; }
__host__ __device__ __forceinline__ int perm32(int rho) { const int n = rho >> 4, i = rho & 15; return 8 * (i >> 2) + 4 * n + (i & 3); }

struct Unit { int pm, pn; };
struct Gemm { const bf16_t* A; const bf16_t* Bt; int M, N, K, lda, ldb, npn, a_split; };

struct StaticOrder {
    int nM, nN, nwg, G, c;
    __device__ void init(int M, int N, int G_, int c_) { nM = M / BM; nN = N / BM; nwg = nM * nN; G = G_; c = c_; }
    __device__ bool next(int i, Unit& u) const {
        const long L = (long)i * G + c; if (L >= nwg) return false;
        int wgid = (int)L; { const int q = nwg / NXCD, r = nwg % NXCD, xcd = wgid % NXCD, off = wgid / NXCD; wgid = (xcd < r ? xcd * (q + 1) : r * (q + 1) + (xcd - r) * q) + off; }
        const int nig = WGM * nN, gid = wgid / nig, fm = gid * WGM, gsz = (nM - fm) < WGM ? (nM - fm) : WGM;
        u.pm = fm + ((wgid % nig) % gsz); u.pn = (wgid % nig) / gsz; return true;
    }
};

__device__ __forceinline__ unsigned cvt_pk_bf16(float lo, float hi) { unsigned r; asm volatile("v_cvt_pk_bf16_f32 %0, %1, %2" : "=v"(r) : "v"(lo), "v"(hi)); return r; }

template <int ACT  > struct EpiBf16 {
    static constexpr bool PERM = true;
    bf16_t* O; int ldc;
    __device__ __forceinline__ void operator()(const f32x4 (&acc)[2][2][4][2], const Unit& u, int wr, int wc, int fr, int fq) const {
        const int row0 = u.pm * BM + wr * 64 + fr, col0 = u.pn * BM + wc * 32 + 8 * fq;
#pragma unroll
        for (int ai = 0; ai < 2; ++ai)
#pragma unroll
            for (int m = 0; m < 4; ++m) { __builtin_amdgcn_sched_barrier(0); bf16_t* rowp = O + (size_t)(row0 + ai * HALF + m * 16) * ldc + col0;
#pragma unroll
                for (int bj = 0; bj < 2; ++bj) { f32x4 v0 = acc[ai][bj][m][0], v1 = acc[ai][bj][m][1];
                    if (ACT == 1) {
#pragma unroll
                        for (int j = 0; j < 4; ++j) { float a = fmaxf(v0[j], 0.f), b = fmaxf(v1[j], 0.f); v0[j] = a * a; v1[j] = b * b; } }
                    u32x4 w; w.x = cvt_pk_bf16(v0[0], v0[1]); w.y = cvt_pk_bf16(v0[2], v0[3]); w.z = cvt_pk_bf16(v1[0], v1[1]); w.w = cvt_pk_bf16(v1[2], v1[3]);
                    *(u32x4*)(rowp + bj * HALF) = w; } }
    }
};
struct EpiProj {
    static constexpr bool PERM = true;
    bf16_t* O; float* outp; int li;
    __device__ __forceinline__ void operator()(const f32x4 (&acc)[2][2][4][2], const Unit& u, int wr, int wc, int fr, int fq) const {
        const int row0 = u.pm * BM + wr * 64 + fr, col0 = u.pn * BM + wc * 32 + 8 * fq;
#pragma unroll
        for (int ai = 0; ai < 2; ++ai)
#pragma unroll
            for (int m = 0; m < 4; ++m) { __builtin_amdgcn_sched_barrier(0); const int row = row0 + ai * HALF + m * 16; bf16_t* rowp = O + (size_t)row * NPROJ_PAD + col0;
#pragma unroll
                for (int bj = 0; bj < 2; ++bj) { const f32x4 v0 = acc[ai][bj][m][0], v1 = acc[ai][bj][m][1];
                    u32x4 w; w.x = cvt_pk_bf16(v0[0], v0[1]); w.y = cvt_pk_bf16(v0[2], v0[3]); w.z = cvt_pk_bf16(v1[0], v1[1]); w.w = cvt_pk_bf16(v1[2], v1[3]);
                    *(u32x4*)(rowp + bj * HALF) = w;
                    const int col = col0 + bj * HALF;
                    if (row < TP && col >= C_KB && col < NPROJ) {
                        const int b = row >> 8, t = row & 255;
                        float* dst = outp + ((col < C_VB) ? (O_CK - C_KB) : (O_CV - C_VB)) + ((size_t)((b * 2 + li) * 256 + t)) * 128 + col;
                        *(f32x4*)dst = v0; *(f32x4*)(dst + 4) = v1; } } }
    }
};
struct EpiSplitBf16 {
    static constexpr bool PERM = true;
    bf16_t* O; int ldc; int npn; size_t split_stride;
    __device__ __forceinline__ void operator()(const f32x4 (&acc)[2][2][4][2], const Unit& u, int wr, int wc, int fr, int fq) const {
        const int s = u.pn / npn, pn = u.pn - s * npn;
        bf16_t* base = O + (size_t)s * split_stride;
        const int row0 = u.pm * BM + wr * 64 + fr, col0 = pn * BM + wc * 32 + 8 * fq;
#pragma unroll
        for (int ai = 0; ai < 2; ++ai)
#pragma unroll
            for (int m = 0; m < 4; ++m) { __builtin_amdgcn_sched_barrier(0); bf16_t* rowp = base + (size_t)(row0 + ai * HALF + m * 16) * ldc + col0;
#pragma unroll
                for (int bj = 0; bj < 2; ++bj) { const f32x4 v0 = acc[ai][bj][m][0], v1 = acc[ai][bj][m][1];
                    u32x4 w; w.x = cvt_pk_bf16(v0[0], v0[1]); w.y = cvt_pk_bf16(v0[2], v0[3]); w.z = cvt_pk_bf16(v1[0], v1[1]); w.w = cvt_pk_bf16(v1[2], v1[3]);
                    *(u32x4*)(rowp + bj * HALF) = w; } }
    }
};
struct EpiF32 {
    static constexpr bool PERM = true;
    float* O; int ldc; int npn; size_t split_stride;
    __device__ __forceinline__ void operator()(const f32x4 (&acc)[2][2][4][2], const Unit& u, int wr, int wc, int fr, int fq) const {
        const int s = u.pn / npn, pn = u.pn - s * npn;
        float* base = O + (size_t)s * split_stride;
        const int row0 = u.pm * BM + wr * 64 + fr, col0 = pn * BM + wc * 32 + 8 * fq;
#pragma unroll
        for (int ai = 0; ai < 2; ++ai)
#pragma unroll
            for (int m = 0; m < 4; ++m) { __builtin_amdgcn_sched_barrier(0); float* rowp = base + (size_t)(row0 + ai * HALF + m * 16) * ldc + col0;
#pragma unroll
                for (int bj = 0; bj < 2; ++bj) { *(f32x4*)(rowp + bj * HALF) = acc[ai][bj][m][0]; *(f32x4*)(rowp + bj * HALF + 4) = acc[ai][bj][m][1]; } }
    }
};

template <class Epi, class Sched>
__device__ __forceinline__ void gemm_phase(LAS unsigned char* lds, const Gemm g, const Sched& S, const Epi& E, const int tid) {
    const int wid = __builtin_amdgcn_readfirstlane(tid >> 6), lane = tid & 63, wr = wid >> 2, wc = wid & 3, fr = lane & 15, fq = lane >> 4;
    const int K = g.K, nt = K / BK;
    unsigned voffA[2], voffB[2];
#pragma unroll
    for (int i = 0; i < 2; ++i) { int R, C; stage_rc(tid * 16 + i * 8192, R, C); const int Rb = Epi::PERM ? ((R & ~31) + perm32(R & 31)) : R;
        voffA[i] = (unsigned)(R * g.lda + C) * 2u; voffB[i] = (unsigned)(Rb * g.ldb + C) * 2u; }
    const size_t kstep = (size_t)(BK * 2);
    const size_t hstepA = (size_t)HALF * g.lda * 2, hstepB = (size_t)HALF * g.ldb * 2;
    const size_t tstepA = 2 * hstepA, tstepB = 2 * hstepB;
    const unsigned ldsw = (unsigned)wid * 1024u;
    const int aoff = lds_byte(wr * 64 + fr, fq * 8), boff = lds_byte(wc * 32 + fr, fq * 8);
#define PG8_SA(b, h) (((b) * 2 + (h)) * HTB)
#define PG8_SB(b, h) ((4 + (b) * 2 + (h)) * HTB)
#define PG8_STAGE(bufoff, gbase, voff) do { _Pragma("unroll") for (int _i = 0; _i < 2; ++_i) \
        __builtin_amdgcn_global_load_lds((const unsigned*)((const char*)(gbase) + (voff)[_i]), (LAS unsigned*)(lds + (bufoff) + ldsw + _i * 8192), 16, 0, 0); } while (0)
#define PG8_LDA(dst, b, h) do { _Pragma("unroll") for (int m = 0; m < 4; ++m) _Pragma("unroll") for (int k = 0; k < 2; ++k) dst[m][k] = *(const LAS bf16x8*)(lds + PG8_SA(b, h) + aoff + m * 2048 + k * 1024); } while (0)
#define PG8_LDB(dst, b, h) do { _Pragma("unroll") for (int n = 0; n < 2; ++n) _Pragma("unroll") for (int k = 0; k < 2; ++k) dst[n][k] = *(const LAS bf16x8*)(lds + PG8_SB(b, h) + boff + n * 2048 + k * 1024); } while (0)
#define PG8_MMA(ai, bj, At, Bt) do { __builtin_amdgcn_s_setprio(1); _Pragma("unroll") for (int m = 0; m < 4; ++m) _Pragma("unroll") for (int n = 0; n < 2; ++n) _Pragma("unroll") for (int k = 0; k < 2; ++k) \
        acc[ai][bj][m][n] = __builtin_amdgcn_mfma_f32_16x16x32_bf16(Bt[n][k], At[m][k], acc[ai][bj][m][n], 0, 0, 0); __builtin_amdgcn_s_setprio(0); } while (0)
#define PG8_WAIT_V(n) asm volatile("s_waitcnt vmcnt(" #n ")" ::: "memory")
#define PG8_WAIT_L(n) asm volatile("s_waitcnt lgkmcnt(" #n ")" ::: "memory")
#define PG8_BAR __builtin_amdgcn_s_barrier()
#define PG8_SCHED __builtin_amdgcn_sched_barrier(0)
#define PG8_UA(u) ((const char*)g.A + (size_t)(u).pm * tstepA + (size_t)((u).pn / g.npn) * (size_t)g.a_split * 2)
#define PG8_UB(u) ((const char*)g.Bt + (size_t)(u).pn * tstepB)
    Unit cur, nxt; int ui = 0;
    if (!S.next(0, cur)) return;
    f32x4 acc[2][2][4][2];
#pragma unroll
    for (int a = 0; a < 2; ++a)
#pragma unroll
        for (int b = 0; b < 2; ++b)
#pragma unroll
            for (int m = 0; m < 4; ++m)
#pragma unroll
                for (int n = 0; n < 2; ++n) acc[a][b][m][n] = (f32x4){0.f, 0.f, 0.f, 0.f};
    bf16x8 At[4][2], B0[2][2], B1[2][2];
    const char* cA = PG8_UA(cur); const char* cB = PG8_UB(cur);
    PG8_STAGE(PG8_SB(0, 0), cB, voffB); PG8_STAGE(PG8_SB(0, 1), cB + hstepB, voffB); PG8_STAGE(PG8_SA(0, 0), cA, voffA); PG8_STAGE(PG8_SA(0, 1), cA + hstepA, voffA);
    if (wr == 1) PG8_BAR;
    PG8_WAIT_V(2); PG8_BAR;
    PG8_STAGE(PG8_SB(1, 0), cB + kstep, voffB); PG8_STAGE(PG8_SA(1, 0), cA + kstep, voffA); PG8_STAGE(PG8_SB(1, 1), cB + hstepB + kstep, voffB);
    PG8_WAIT_V(6); PG8_BAR;
    for (;;) {
        const bool has_next = S.next(ui + 1, nxt);
        const char* nA = has_next ? PG8_UA(nxt) : cA; const char* nB = has_next ? PG8_UB(nxt) : cB;
        for (int t = 0; t < nt; t += 2) {
            const bool last = (t == nt - 2);
            const char* a1 = cA + (size_t)(t + 1) * kstep;
            const char* a2 = last ? nA : cA + (size_t)(t + 2) * kstep; const char* b2 = last ? nB : cB + (size_t)(t + 2) * kstep;
            const char* a3 = a2 + kstep; const char* b3 = b2 + kstep;
            PG8_LDB(B0, 0, 0); PG8_LDB(B1, 0, 1); PG8_SCHED; PG8_LDA(At, 0, 0); PG8_STAGE(PG8_SA(1, 1), a1 + hstepA, voffA);
            PG8_WAIT_V(8); PG8_WAIT_L(0); PG8_BAR; PG8_MMA(0, 0, At, B0); PG8_MMA(0, 1, At, B1); PG8_BAR; PG8_SCHED;
            PG8_LDA(At, 0, 1); PG8_STAGE(PG8_SB(0, 0), b2, voffB); PG8_STAGE(PG8_SB(0, 1), b2 + hstepB, voffB); PG8_STAGE(PG8_SA(0, 0), a2, voffA);
            PG8_WAIT_V(8); PG8_WAIT_L(0); PG8_BAR; PG8_MMA(1, 0, At, B0); PG8_MMA(1, 1, At, B1); PG8_BAR; PG8_SCHED;
            PG8_LDB(B0, 1, 0); PG8_LDB(B1, 1, 1); PG8_SCHED; PG8_LDA(At, 1, 0); PG8_STAGE(PG8_SA(0, 1), a2 + hstepA, voffA);
            PG8_WAIT_V(8); PG8_WAIT_L(0); PG8_BAR; PG8_MMA(0, 0, At, B0); PG8_MMA(0, 1, At, B1); PG8_BAR; PG8_SCHED;
            PG8_LDA(At, 1, 1); PG8_STAGE(PG8_SB(1, 0), b3, voffB); PG8_STAGE(PG8_SB(1, 1), b3 + hstepB, voffB); PG8_STAGE(PG8_SA(1, 0), a3, voffA);
            PG8_WAIT_V(8); PG8_WAIT_L(0); PG8_BAR; PG8_MMA(1, 0, At, B0); PG8_MMA(1, 1, At, B1); PG8_BAR; PG8_SCHED;
        }
        if (wr == 0) PG8_BAR;
        E(acc, cur, wr, wc, fr, fq);
        if (!has_next) break;
#pragma unroll
        for (int a = 0; a < 2; ++a)
#pragma unroll
            for (int b = 0; b < 2; ++b)
#pragma unroll
                for (int m = 0; m < 4; ++m)
#pragma unroll
                    for (int n = 0; n < 2; ++n) acc[a][b][m][n] = (f32x4){0.f, 0.f, 0.f, 0.f};
        cur = nxt; cA = nA; cB = nB; ++ui;
        if (wr == 1) PG8_BAR;
    }
    PG8_WAIT_V(0);
    PG8_BAR;
#undef PG8_SA
#undef PG8_SB
#undef PG8_STAGE
#undef PG8_LDA
#undef PG8_LDB
#undef PG8_MMA
#undef PG8_WAIT_V
#undef PG8_WAIT_L
#undef PG8_BAR
#undef PG8_SCHED
#undef PG8_UA
#undef PG8_UB
}
}

struct Args { const float* in[29]; float* out; unsigned char* ws; int ph_lo, ph_hi; };
struct Ctx { unsigned char* ws; float* out; int z, tid, bid, G; };

#define MFMA16(a, b, c) __builtin_amdgcn_mfma_f32_16x16x32_bf16((a), (b), (c), 0, 0, 0)

__device__ __forceinline__ void transpose_load(const float* W, int N, int item, int lane, float (&wv)[32]) {
    const int nblk = N / 32, kb = item / nblk, nb = item % nblk, k0 = 64 * kb, n0 = 32 * nb;
#pragma unroll
    for (int i = 0; i < 32; ++i) { const int kk = 2 * i + (lane >> 5); wv[i] = W[(size_t)(k0 + kk) * N + n0 + (lane & 31)]; }
}
__device__ __forceinline__ void transpose_finish(int N, bf16_t* WT, int npad, int ksub, LAS float* scr, int item, int lane, const float (&wv)[32]) {
    const int nblk = N / 32, kb = item / nblk, nb = item % nblk, k0 = 64 * kb, n0 = 32 * nb;
#pragma unroll
    for (int i = 0; i < 32; ++i) { const int kk = 2 * i + (lane >> 5); scr[kk * 33 + (lane & 31)] = wv[i]; }
    asm volatile("s_waitcnt lgkmcnt(0)" ::: "memory");
    const int c = lane & 7;
    const int ks = k0 / ksub, kin = k0 - ks * ksub;
    bf16_t* dbase = WT + (size_t)ks * npad * ksub + kin + 8 * c;
#pragma unroll
    for (int j = 0; j < 4; ++j) { const int n = (lane >> 3) + 8 * j; const LAS float* s = scr + (8 * c) * 33 + n;
        u32x4 o; o.x = pk2(s[0 * 33], s[1 * 33]); o.y = pk2(s[2 * 33], s[3 * 33]); o.z = pk2(s[4 * 33], s[5 * 33]); o.w = pk2(s[6 * 33], s[7 * 33]);
        *(u32x4*)(dbase + (size_t)(n0 + n) * ksub) = o; }
    asm volatile("s_waitcnt lgkmcnt(0)" ::: "memory");
}

struct MatDesc { const float* W; bf16_t* WT; int K, N, npad, ksub, items; };
__device__ __forceinline__ MatDesc get_mat(const Args& a, const Ctx& cx, int mi) {
    MatDesc m; unsigned char* ws = cx.ws;
    if (mi < 4)       { m.W = (a.in[13] + cx.z) + (size_t)mi * D * FF; m.WT = (bf16_t*)(ws + WS_WFF1) + (size_t)mi * FF * D; m.K = D; m.N = FF; m.npad = FF; m.ksub = D; }
    else if (mi < 8)  { const int l = mi - 4; m.W = (a.in[14] + cx.z) + (size_t)l * FF * D; m.WT = (bf16_t*)(ws + WS_WFF2) + (size_t)l * FF * D; m.K = FF; m.N = D; m.npad = D; m.ksub = FF / 2; }
    else if (mi < 10) { const int i = mi - 8; m.W = (a.in[15] + cx.z) + (size_t)i * D * NPROJ; m.WT = (bf16_t*)(ws + WS_WIN) + (size_t)i * NPROJ_PAD * D; m.K = D; m.N = NPROJ; m.npad = NPROJ_PAD; m.ksub = D; }
    else if (mi < 12) { const int i = mi - 10; m.W = (a.in[22] + cx.z) + (size_t)i * D * D; m.WT = (bf16_t*)(ws + WS_WOUT) + (size_t)i * D * D; m.K = D; m.N = D; m.npad = D; m.ksub = D / 2; }
    else if (mi < 14) { const int i = mi - 12; m.W = (a.in[23] + cx.z) + (size_t)i * D * NDOWN; m.WT = (bf16_t*)(ws + WS_WDOWN) + (size_t)i * NDOWN_PAD * D; m.K = D; m.N = NDOWN; m.npad = NDOWN_PAD; m.ksub = D / 2; }
    else if (mi < 16) { const int i = mi - 14; m.W = (a.in[26] + cx.z) + (size_t)i * 384 * 1536; m.WT = (bf16_t*)(ws + WS_WUQ) + (size_t)i * 1536 * 384; m.K = 384; m.N = 1536; m.npad = 1536; m.ksub = 384; }
    else if (mi < 18) { const int i = mi - 16; m.W = (a.in[27] + cx.z) + (size_t)i * 256 * 2048; m.WT = (bf16_t*)(ws + WS_WUKV) + (size_t)i * 2048 * 256; m.K = 256; m.N = 2048; m.npad = 2048; m.ksub = 256; }
    else              { const int i = mi - 18; m.W = (a.in[28] + cx.z) + (size_t)i * D * D; m.WT = (bf16_t*)(ws + WS_WO) + (size_t)i * D * D; m.K = D; m.N = D; m.npad = D; m.ksub = D / 2; }
    m.items = (m.K / 64) * (m.N / 32);
    return m;
}

__device__ __forceinline__ void prologue(const Args& a, const Ctx& cx, LAS unsigned char* lds) {
    const int tid = cx.tid, lane = tid & 63, wave = tid >> 6, G = cx.G, bid = cx.bid;
    unsigned char* ws = cx.ws;
    {
        LAS float* sc = (LAS float*)lds;
        LAS float* red = (LAS float*)(lds + 12288);
        for (int i = tid; i < 3 * D; i += NTHREADS) { const int g = i >> 10, k = i & 1023; const float v = (g == 0) ? (a.in[9] + cx.z)[k] : (a.in[8] + cx.z)[(g - 1) * D + k]; sc[i] = silu_f(v); }
        __syncthreads();
        float* MOD = (float*)(ws + WS_MOD);
        for (int it = bid; it < 4 * 48; it += G) {
            const int l = it / 48, jb = it % 48, jq = tid & 31, kg = tid >> 5, j = jb * 128 + jq * 4;
            const float* wp = (a.in[10] + cx.z) + ((size_t)l * D + kg * 64) * 6144 + j;
            f32x4 a0 = {0.f, 0.f, 0.f, 0.f}, a1 = a0, a2 = a0;
#pragma unroll 32
            for (int k = 0; k < 64; ++k) { const f32x4 w = *(const f32x4*)(wp + (size_t)k * 6144); const int kk = kg * 64 + k;
                a0 += w * sc[kk]; a1 += w * sc[D + kk]; a2 += w * sc[2 * D + kk]; }
#pragma unroll
            for (int e = 0; e < 4; ++e) { red[(kg * 3 + 0) * 128 + jq * 4 + e] = a0[e]; red[(kg * 3 + 1) * 128 + jq * 4 + e] = a1[e]; red[(kg * 3 + 2) * 128 + jq * 4 + e] = a2[e]; }
            __syncthreads();
            if (tid < 384) { const int g = tid >> 7, jj = tid & 127; float s = 0.f;
#pragma unroll
                for (int q = 0; q < 16; ++q) s += red[(q * 3 + g) * 128 + jj];
                MOD[((size_t)l * 3 + g) * 6144 + jb * 128 + jj] = s + (a.in[11] + cx.z)[(size_t)l * 6144 + jb * 128 + jj]; }
            __syncthreads();
        }
    }
    __syncthreads();
    {
        LAS float* scr = (LAS float*)(lds + wave * 16384);
        const int gw = bid * NWAVES + wave, NGW = G * NWAVES;
        int mi = 0, base = 0;
        MatDesc m = get_mat(a, cx, 0);
        int g = gw;
        while (mi < 20 && g - base >= m.items) { base += m.items; ++mi; if (mi < 20) m = get_mat(a, cx, mi); }
        float wv[32];
        if (mi < 20) transpose_load(m.W, m.N, g - base, lane, wv);
        while (mi < 20) {
            const MatDesc mc = m; const int itc = g - base;
            g += NGW;
            while (mi < 20 && g - base >= m.items) { base += m.items; ++mi; if (mi < 20) m = get_mat(a, cx, mi); }
            float wn[32];
            if (mi < 20) transpose_load(m.W, m.N, g - base, lane, wn);
            transpose_finish(mc.N, mc.WT, mc.npad, mc.ksub, scr, itc, lane, wv);
#pragma unroll
            for (int i = 0; i < 32; ++i) wv[i] = wn[i];
        }
    }
    {
        const size_t gt = (size_t)bid * NTHREADS + tid, NGT = (size_t)G * NTHREADS;
        for (int i = 0; i < 2; ++i) {
            u32x4* z1 = (u32x4*)((bf16_t*)(ws + WS_WIN) + (size_t)i * NPROJ_PAD * D + (size_t)NPROJ * D);
            for (size_t x = gt; x < (size_t)(NPROJ_PAD - NPROJ) * D / 8; x += NGT) z1[x] = (u32x4){0u, 0u, 0u, 0u};
            for (int ks = 0; ks < 2; ++ks) {
                u32x4* z2 = (u32x4*)((bf16_t*)(ws + WS_WDOWN) + (size_t)i * NDOWN_PAD * D + (size_t)ks * NDOWN_PAD * (D / 2) + (size_t)NDOWN * (D / 2));
                for (size_t x = gt; x < (size_t)(NDOWN_PAD - NDOWN) * (D / 2) / 8; x += NGT) z2[x] = (u32x4){0u, 0u, 0u, 0u}; }
        }
        f32x2* tab64 = (f32x2*)(ws + WS_TAB); f32x2* tab32 = tab64 + 64 * 16;
        for (size_t x = gt; x < 64 * 16; x += NGT) { const int pos = (int)x >> 4, f = (int)x & 15; const float inv = powf(10000.f, -(float)f / 16.f); const float ang = (float)pos * inv; tab64[x] = (f32x2){cosf(ang), sinf(ang)}; }
        for (size_t x = gt; x < 64 * 8; x += NGT) { const int pos = (int)x >> 3, f = (int)x & 7; const float inv = powf(10000.f, -(float)f / 8.f); const float ang = (float)pos * inv; tab32[x] = (f32x2){cosf(ang), sinf(ang)}; }
        bf16_t* csk = (bf16_t*)(ws + WS_CSK); bf16_t* csv = (bf16_t*)(ws + WS_CSV);
        for (size_t x = gt; x < (size_t)2 * 2 * 512 * 128 / 4; x += NGT) {
            const size_t e = x * 4; const int b = (int)(e / (2 * 65536)), i = (int)(e / 65536) & 1; const size_t r = e % 65536;
            const size_t d = ((size_t)(i * 2 + b)) * 65536 + r;
            const f32x4 k = *(const f32x4*)((a.in[4] + cx.z) + e), v = *(const f32x4*)((a.in[5] + cx.z) + e);
            *(u32x2*)(csk + d) = (u32x2){pk2(k[0], k[1]), pk2(k[2], k[3])};
            *(u32x2*)(csv + d) = (u32x2){pk2(v[0], v[1]), pk2(v[2], v[3])};
        }
    }
}

__device__ __forceinline__ int mod_group(int r) { return r < TP ? 0 : 1 + ((r - TP) >> 10); }

__device__ __forceinline__ void pre_rows(const Args& a, const Ctx& cx, int l) {
    const int lane = cx.tid & 63, gw = cx.bid * NWAVES + (cx.tid >> 6), NGW = cx.G * NWAVES;
    const float* MOD = (const float*)(cx.ws + WS_MOD) + (size_t)l * 3 * 6144;
    const float* gA = (a.in[12] + cx.z) + (size_t)l * 4 * D;
    bf16_t* H = (bf16_t*)(cx.ws + WS_H);
    for (int r = gw; r < T; r += NGW) {
        const float* xr = (r < TP) ? (a.in[0] + cx.z) + (size_t)r * D : (a.in[1] + cx.z) + (size_t)(r - TP) * D;
        const float* m = MOD + (size_t)mod_group(r) * 6144;
        f32x4 v[4]; float s = 0.f;
#pragma unroll
        for (int j = 0; j < 4; ++j) { v[j] = *(const f32x4*)(xr + lane * 4 + 256 * j); s += v[j][0] * v[j][0] + v[j][1] * v[j][1] + v[j][2] * v[j][2] + v[j][3] * v[j][3]; }
        f32x4 vg[4], vsh[4], vsc[4];
#pragma unroll
        for (int j = 0; j < 4; ++j) { const int c = lane * 4 + 256 * j; vg[j] = *(const f32x4*)(gA + c); vsh[j] = *(const f32x4*)(m + c); vsc[j] = *(const f32x4*)(m + D + c); }
        const float rstd = rsqrtf(wave_sum(s) * (1.f / D) + EPS);
#pragma unroll
        for (int j = 0; j < 4; ++j) { const int c = lane * 4 + 256 * j;
            const f32x4 g = vg[j], sh = vsh[j], scl = vsc[j];
            const f32x4 h = v[j] * rstd * g * (scl + 1.f) + sh;
            *(u32x2*)(H + (size_t)r * D + c) = (u32x2){pk2(h[0], h[1]), pk2(h[2], h[3])}; }
    }
}

__device__ __forceinline__ void post_rows(const Args& a, const Ctx& cx, bool x_from_input, const float* gate_base  , const float* gB,
                                          bool has_next, const float* gC, const float* shift_base, const float* scale_base, bool dry) {
    constexpr int RB = 3;
    const int lane = cx.tid & 63, gw = cx.bid * NWAVES + (cx.tid >> 6), NGW = cx.G * NWAVES;
    const bf16_t* OUT = (const bf16_t*)(cx.ws + WS_OUT);
    bf16_t* H = dry ? (bf16_t*)(cx.ws + WS_U + 24 * MiB) : (bf16_t*)(cx.ws + WS_H);
    float* xout = dry ? (float*)(cx.ws + WS_U) : cx.out;
    for (int rb = gw * RB; rb < T; rb += NGW * RB) {
        f32x4 o[RB][4], x[RB][4]; float s[RB], s2[RB]; size_t mg[RB];
        const size_t mg0 = (size_t)mod_group(rb < T ? rb : T - 1) * 6144;
        f32x4 vgB[4], vgt[4];
#pragma unroll
        for (int j = 0; j < 4; ++j) { const int c = lane * 4 + 256 * j; vgB[j] = *(const f32x4*)(gB + c); vgt[j] = *(const f32x4*)(gate_base + mg0 + c); }
#pragma unroll
        for (int q = 0; q < RB; ++q) { const int r = (rb + q < T) ? rb + q : T - 1;
            const float* xr = x_from_input ? ((r < TP) ? (a.in[0] + cx.z) + (size_t)r * D : (a.in[1] + cx.z) + (size_t)(r - TP) * D) : cx.out + (size_t)r * D;
            mg[q] = (size_t)mod_group(r) * 6144;
#pragma unroll
            for (int j = 0; j < 4; ++j) { const int c = lane * 4 + 256 * j;
                { const u32x2 p0 = *(const u32x2*)(OUT + (size_t)r * D + c), p1 = *(const u32x2*)(OUT + OUT_SPLIT + (size_t)r * D + c);
                  o[q][j] = (f32x4){bflo(p0.x) + bflo(p1.x), bfhi(p0.x) + bfhi(p1.x), bflo(p0.y) + bflo(p1.y), bfhi(p0.y) + bfhi(p1.y)}; }
                x[q][j] = *(const f32x4*)(xr + c); } }
#pragma unroll
        for (int q = 0; q < RB; ++q) { float t = 0.f;
#pragma unroll
            for (int j = 0; j < 4; ++j) t += o[q][j][0] * o[q][j][0] + o[q][j][1] * o[q][j][1] + o[q][j][2] * o[q][j][2] + o[q][j][3] * o[q][j][3];
            s[q] = t; }
#pragma unroll
        for (int off = 1; off < 64; off <<= 1) {
#pragma unroll
            for (int q = 0; q < RB; ++q) s[q] += __shfl_xor(s[q], off); }
#pragma unroll
        for (int q = 0; q < RB; ++q) { const int r = rb + q; const float rstd = rsqrtf(s[q] * (1.f / D) + EPS); float t = 0.f;
            const bool same = (mg[q] == mg0);
#pragma unroll
            for (int j = 0; j < 4; ++j) { const int c = lane * 4 + 256 * j;
                const f32x4 gt = same ? vgt[j] : *(const f32x4*)(gate_base + mg[q] + c);
                x[q][j] = x[q][j] + gt * (o[q][j] * rstd * vgB[j]);
                if (r < T) *(f32x4*)(xout + (size_t)r * D + c) = x[q][j];
                t += x[q][j][0] * x[q][j][0] + x[q][j][1] * x[q][j][1] + x[q][j][2] * x[q][j][2] + x[q][j][3] * x[q][j][3]; }
            s2[q] = t; }
        if (has_next) {
            f32x4 vgC[4], vsh[4], vsc[4];
#pragma unroll
            for (int j = 0; j < 4; ++j) { const int c = lane * 4 + 256 * j; vgC[j] = *(const f32x4*)(gC + c); vsh[j] = *(const f32x4*)(shift_base + mg0 + c); vsc[j] = *(const f32x4*)(scale_base + mg0 + c); }
#pragma unroll
            for (int off = 1; off < 64; off <<= 1) {
#pragma unroll
                for (int q = 0; q < RB; ++q) s2[q] += __shfl_xor(s2[q], off); }
#pragma unroll
            for (int q = 0; q < RB; ++q) { const int r = rb + q; const float rstd2 = rsqrtf(s2[q] * (1.f / D) + EPS);
                const bool same = (mg[q] == mg0);
#pragma unroll
                for (int j = 0; j < 4; ++j) { const int c = lane * 4 + 256 * j;
                    const f32x4 sh = same ? vsh[j] : *(const f32x4*)(shift_base + mg[q] + c), scl = same ? vsc[j] : *(const f32x4*)(scale_base + mg[q] + c);
                    const f32x4 h = x[q][j] * rstd2 * vgC[j] * (scl + 1.f) + sh;
                    if (r < T) *(u32x2*)(H + (size_t)r * D + c) = (u32x2){pk2(h[0], h[1]), pk2(h[2], h[3])}; } }
        }
    }
}

__device__ __forceinline__ void mla_mid(const Args& a, const Ctx& cx, int i) {
    constexpr int RB = 3;
    const int lane = cx.tid & 63, gw = cx.bid * NWAVES + (cx.tid >> 6), NGW = cx.G * NWAVES;
    const float* DOWN = (const float*)(cx.ws + WS_OUT);
    bf16_t* CQ = (bf16_t*)(cx.ws + WS_CQ); bf16_t* CKV = (bf16_t*)(cx.ws + WS_CKV); bf16_t* KR = (bf16_t*)(cx.ws + WS_KR);
    const float* gq = (a.in[24] + cx.z) + (size_t)i * 384; const float* gkv = (a.in[25] + cx.z) + (size_t)i * 256;
    const f32x2* tab32 = (const f32x2*)(cx.ws + WS_TAB) + 64 * 16;
    for (int r = T + gw; r < T + 1024; r += NGW) {
        const int rr = r - T, b = rr >> 9, j = rr & 511;
        const float* src = (a.in[6] + cx.z) + ((size_t)((b * 2 + i) * 512 + j)) * 256;
        float v[4];
#pragma unroll
        for (int q = 0; q < 4; ++q) v[q] = src[lane + 64 * q];
        const float kr = (lane < 32) ? (a.in[7] + cx.z)[((size_t)((b * 2 + i) * 512 + j)) * 32 + lane] : 0.f;
#pragma unroll
        for (int q = 0; q < 4; ++q) CKV[(size_t)r * 256 + lane + 64 * q] = (bf16_t)f2bf(v[q]);
        if (lane < 32) KR[(size_t)r * 32 + lane] = (bf16_t)f2bf(kr);
    }
    for (int rb = gw * RB; rb < T; rb += NGW * RB) {
        float q[RB][6], kv[RB][4], kr[RB], ot[RB], sq[RB], sk[RB], vq[6], vk[4];
#pragma unroll
        for (int j = 0; j < 6; ++j) vq[j] = gq[lane + 64 * j];
#pragma unroll
        for (int j = 0; j < 4; ++j) vk[j] = gkv[lane + 64 * j];
#pragma unroll
        for (int u = 0; u < RB; ++u) { const int r = (rb + u < T) ? rb + u : T - 1; const float* dr = DOWN + (size_t)r * NDOWN_PAD;
#pragma unroll
            for (int j = 0; j < 6; ++j) q[u][j] = dr[lane + 64 * j] + dr[DOWN_SPLIT + lane + 64 * j];
#pragma unroll
            for (int j = 0; j < 4; ++j) kv[u][j] = dr[384 + lane + 64 * j] + dr[DOWN_SPLIT + 384 + lane + 64 * j];
            kr[u] = dr[640 + (lane & 31)] + dr[DOWN_SPLIT + 640 + (lane & 31)];
            ot[u] = dr[640 + ((lane & 31) ^ 8)] + dr[DOWN_SPLIT + 640 + ((lane & 31) ^ 8)]; }
#pragma unroll
        for (int u = 0; u < RB; ++u) { float s = 0.f, t = 0.f;
#pragma unroll
            for (int j = 0; j < 6; ++j) s += q[u][j] * q[u][j];
#pragma unroll
            for (int j = 0; j < 4; ++j) t += kv[u][j] * kv[u][j];
            sq[u] = s; sk[u] = t; }
#pragma unroll
        for (int off = 1; off < 64; off <<= 1) {
#pragma unroll
            for (int u = 0; u < RB; ++u) { sq[u] += __shfl_xor(sq[u], off); sk[u] += __shfl_xor(sk[u], off); } }
#pragma unroll
        for (int u = 0; u < RB; ++u) { const int r = rb + u; if (r >= T) continue;
            const float rq = rsqrtf(sq[u] * (1.f / 384.f) + EPS), rk = rsqrtf(sk[u] * (1.f / 256.f) + EPS);
#pragma unroll
            for (int j = 0; j < 6; ++j) CQ[(size_t)r * 384 + lane + 64 * j] = (bf16_t)f2bf(q[u][j] * rq * vq[j]);
#pragma unroll
            for (int j = 0; j < 4; ++j) { const float v = kv[u][j] * rk * vk[j]; CKV[(size_t)r * 256 + lane + 64 * j] = (bf16_t)f2bf(v);
                if (r < TP) { const int b = r >> 8, t = r & 255; cx.out[O_CKV + ((size_t)((b * 2 + i) * 256 + t)) * 256 + lane + 64 * j] = v; } }
            if (lane < 32) {
                if (r < TP) { const int b = r >> 8, t = r & 255; cx.out[O_CKR + ((size_t)((b * 2 + i) * 256 + t)) * 32 + lane] = kr[u]; KR[(size_t)r * 32 + lane] = (bf16_t)f2bf(kr[u]); }
                else {
                    const int t = (r - TP) & 1023, half = lane >> 4, p = (lane >> 3) & 1, f = lane & 7, pos = half ? (t & 63) : (t >> 6);
                    const f32x2 cs = tab32[pos * 8 + f];
                    const float v = p ? (ot[u] * cs[1] + kr[u] * cs[0]) : (kr[u] * cs[0] - ot[u] * cs[1]);
                    KR[(size_t)r * 32 + lane] = (bf16_t)f2bf(v);
                }
            }
        }
    }
}

struct KSeg { const bf16_t* K; int kstride; const bf16_t* K2; const bf16_t* V; int vstride; int k_lo, k_hi; int flags  ; };
struct AttnArgs { const bf16_t* Q; int qstride; int qpos0; int qrope  ; int nseg; KSeg seg0, seg1;
                  float m0, l0, scale; bf16_t* O; int ostride; const f32x2* tab64; };

__device__ __forceinline__ u32x4 rope8l(const u32x4 own, const u32x4 partner, int p, const LAS f32x2* tab) {
    float a[8], b[8], o[8]; unpack8(own, a); unpack8(partner, b);
#pragma unroll
    for (int e = 0; e < 8; ++e) { const f32x2 cs = tab[e]; o[e] = p ? (b[e] * cs[1] + a[e] * cs[0]) : (a[e] * cs[0] - b[e] * cs[1]); }
    return pack8(o);
}
__device__ __forceinline__ u32x4 rope8(const u32x4 own, const u32x4 partner, int p, const f32x2* tab) {
    float a[8], b[8], o[8]; unpack8(own, a); unpack8(partner, b);
#pragma unroll
    for (int e = 0; e < 8; ++e) { const f32x2 cs = tab[e]; o[e] = p ? (b[e] * cs[1] + a[e] * cs[0]) : (a[e] * cs[0] - b[e] * cs[1]); }
    return pack8(o);
}

template <int DQK, int QG>
__device__ __forceinline__ void attn_unit(LAS unsigned char* lds, const AttnArgs& A, const int tid) {
    constexpr int KT = 64;
    constexpr int QS = DQK + 8, VS = KT + 8, NCH = DQK / 8, NKS = DQK / 32, KCH = KT * NCH, KPT = (KCH + NTHREADS - 1) / NTHREADS, VPT = KT / 64, NT = KT / 16, NQ = 128 * QG;
    LAS bf16_t* Qs = (LAS bf16_t*)lds;
    LAS bf16_t* Ks = Qs + NQ * QS;
    LAS bf16_t* VT = Ks + 2 * KT * QS;
    LAS f32x2* TB = (LAS f32x2*)(VT + 2 * 64 * VS);
    const int lane = tid & 63, w = tid >> 6, fr = lane & 15, fq = lane >> 4;
    const int n0 = (A.seg0.k_hi - A.seg0.k_lo) / KT, n1 = (A.nseg > 1) ? ((A.seg1.k_hi - A.seg1.k_lo) / KT) : 0, ntiles = n0 + n1;
    int kkey[KPT], kch[KPT];
#pragma unroll
    for (int i = 0; i < KPT; ++i) { const int c = tid + i * NTHREADS; kkey[i] = c / NCH; kch[i] = c % NCH; }
    const int vkey = tid & 63, vch = tid >> 6;
    u32x4 kr[KPT], kp[KPT], vr[VPT]; int pf_kt = 0, pf_rope = 0, pf_mask = 0;
#define ATT_PREFETCH(j) do { const bool s0_ = (j) < n0; const KSeg S = s0_ ? A.seg0 : A.seg1; const int kt = s0_ ? (A.seg0.k_lo + KT * (j)) : (A.seg1.k_lo + KT * ((j) - n0)); \
        _Pragma("unroll") for (int i = 0; i < KPT; ++i) if (tid + i * NTHREADS < KCH) { const int d0 = kch[i] * 8; \
            if (DQK == 96 && kch[i] >= 8) kr[i] = *(const u32x4*)(S.K2 + (size_t)(kt + kkey[i]) * 32 + (d0 - 64)); \
            else { const bf16_t* src = S.K + (size_t)(kt + kkey[i]) * S.kstride; kr[i] = *(const u32x4*)(src + d0); if (DQK == 64 && (S.flags & 1)) kp[i] = *(const u32x4*)(src + (d0 ^ 16)); } } \
        _Pragma("unroll") for (int i = 0; i < VPT; ++i) vr[i] = *(const u32x4*)(S.V + (size_t)(kt + vkey + 64 * i) * S.vstride + vch * 8); \
        pf_kt = kt; pf_rope = S.flags & 1; pf_mask = S.flags & 2; } while (0)
#define ATT_WRITE(buf) do { LAS bf16_t* Kb = Ks + (buf) * KT * QS; LAS bf16_t* Vb = VT + (buf) * 64 * VS; \
        _Pragma("unroll") for (int i = 0; i < KPT; ++i) if (tid + i * NTHREADS < KCH) { u32x4 v = kr[i]; \
            if (DQK == 64 && pf_rope) { const int t = pf_kt + kkey[i], ch = kch[i], half = ch >> 2, p = (ch >> 1) & 1, f0 = (ch & 1) * 8, pos = half ? (t & 63) : (t >> 6); v = rope8l(v, kp[i], p, TB + pos * 16 + f0); } \
            *(LAS u32x4*)(Kb + kkey[i] * QS + kch[i] * 8) = v; } \
        _Pragma("unroll") for (int i = 0; i < VPT; ++i) { LAS bf16_t* dst = Vb + (vch * 8) * VS + vkey + 64 * i; const u32x4 v = vr[i]; \
          dst[0 * VS] = (bf16_t)(v.x & 0xffff); dst[1 * VS] = (bf16_t)(v.x >> 16); dst[2 * VS] = (bf16_t)(v.y & 0xffff); dst[3 * VS] = (bf16_t)(v.y >> 16); \
          dst[4 * VS] = (bf16_t)(v.z & 0xffff); dst[5 * VS] = (bf16_t)(v.z >> 16); dst[6 * VS] = (bf16_t)(v.w & 0xffff); dst[7 * VS] = (bf16_t)(v.w >> 16); } } while (0)
    ATT_PREFETCH(0);
    if (DQK == 64 && A.qrope == 1) { for (int x = tid; x < 64 * 16; x += NTHREADS) TB[x] = A.tab64[x]; }
    __syncthreads();
    for (int c = tid; c < NQ * NCH; c += NTHREADS) {
        const int qi = c / NCH, ch = c % NCH, d0 = ch * 8;
        const bf16_t* src = A.Q + (size_t)qi * A.qstride;
        u32x4 v = *(const u32x4*)(src + d0);
        const int t = A.qpos0 + qi;
        if (A.qrope == 1) { const int half = ch >> 2, p = (ch >> 1) & 1, f0 = (ch & 1) * 8, pos = half ? (t & 63) : (t >> 6);
            const u32x4 pv = *(const u32x4*)(src + (d0 ^ 16)); v = rope8(v, pv, p, A.tab64 + pos * 16 + f0); }
        else if (A.qrope == 2 && ch >= 8) { const int c2 = ch - 8, half = c2 >> 1, p = c2 & 1, pos = half ? (t & 63) : (t >> 6);
            const u32x4 pv = *(const u32x4*)(src + 64 + ((c2 ^ 1) * 8)); v = rope8(v, pv, p, A.tab64 + 64 * 16 + pos * 8); }
        *(LAS u32x4*)(Qs + qi * QS + d0) = v;
    }
    ATT_WRITE(0);
    int cur_kt = pf_kt, cur_mask = pf_mask;
    if (ntiles > 1) ATT_PREFETCH(1);
    __syncthreads();
    bf16x8 Qf[QG][NKS];
#pragma unroll
    for (int g = 0; g < QG; ++g)
#pragma unroll
        for (int ks = 0; ks < NKS; ++ks) Qf[g][ks] = *(const LAS bf16x8*)(Qs + (g * 128 + w * 16 + fr) * QS + ks * 32 + fq * 8);
    const float scl2 = A.scale * 1.4426950408889634f;
    float m[QG], l[QG];
    f32x4 Oa[QG][4];
#pragma unroll
    for (int g = 0; g < QG; ++g) { m[g] = (A.m0 > -1e29f) ? A.m0 * 1.4426950408889634f : A.m0; l[g] = (fq == 0) ? A.l0 : 0.f;
#pragma unroll
        for (int dt = 0; dt < 4; ++dt) Oa[g][dt] = (f32x4){0.f, 0.f, 0.f, 0.f}; }
    for (int j = 0; j < ntiles; ++j) {
        const LAS bf16_t* Kb = Ks + (j & 1) * KT * QS; const LAS bf16_t* Vb = VT + (j & 1) * 64 * VS;
        f32x4 st[QG][NT];
#pragma unroll
        for (int nt = 0; nt < NT; ++nt) {
#pragma unroll
            for (int g = 0; g < QG; ++g) st[g][nt] = (f32x4){0.f, 0.f, 0.f, 0.f};
#pragma unroll
            for (int ks = 0; ks < NKS; ++ks) { const bf16x8 kf = *(const LAS bf16x8*)(Kb + (nt * 16 + fr) * QS + ks * 32 + fq * 8);
#pragma unroll
                for (int g = 0; g < QG; ++g) st[g][nt] = MFMA16(kf, Qf[g][ks], st[g][nt]); } }
        bf16x8 pf[QG][KT / 32];
#pragma unroll
        for (int g = 0; g < QG; ++g) {
            const int qp = A.qpos0 + g * 128 + w * 16 + fr;
            float mx = -1e30f;
#pragma unroll
            for (int nt = 0; nt < NT; ++nt)
#pragma unroll
                for (int jj = 0; jj < 4; ++jj) { float sc = st[g][nt][jj] * scl2;
                    if (cur_mask) { const int kpos = cur_kt + nt * 16 + fq * 4 + jj; const int dd = qp - kpos; if (dd > 128 || dd < -128) sc = -1e30f; }
                    st[g][nt][jj] = sc; mx = fmaxf(mx, sc); }
            mx = xor16_max(mx); mx = xor32_max(mx);
            const float mn = fmaxf(m[g], mx), alpha = __builtin_amdgcn_exp2f(m[g] - mn);
            float rs = 0.f;
#pragma unroll
            for (int nt = 0; nt < NT; ++nt)
#pragma unroll
                for (int jj = 0; jj < 4; ++jj) { const float pe = __builtin_amdgcn_exp2f(st[g][nt][jj] - mn); st[g][nt][jj] = pe; rs += pe; }
            l[g] = l[g] * alpha + rs; m[g] = mn;
#pragma unroll
            for (int dt = 0; dt < 4; ++dt) Oa[g][dt] = Oa[g][dt] * alpha;
#pragma unroll
            for (int kk = 0; kk < KT / 32; ++kk) {
                u32x4 pb; pb.x = cvtpk(st[g][2 * kk][0], st[g][2 * kk][1]); pb.y = cvtpk(st[g][2 * kk][2], st[g][2 * kk][3]); pb.z = cvtpk(st[g][2 * kk + 1][0], st[g][2 * kk + 1][1]); pb.w = cvtpk(st[g][2 * kk + 1][2], st[g][2 * kk + 1][3]);
                pf[g][kk] = __builtin_bit_cast(bf16x8, pb); }
        }
#pragma unroll
        for (int kk = 0; kk < KT / 32; ++kk)
#pragma unroll
            for (int dt = 0; dt < 4; ++dt) {
                const LAS bf16_t* vp = Vb + (dt * 16 + fr) * VS + 32 * kk + fq * 4;
                const u32x2 v0 = *(const LAS u32x2*)vp, v1 = *(const LAS u32x2*)(vp + 16);
                const u32x4 vv = {v0.x, v0.y, v1.x, v1.y};
#pragma unroll
                for (int g = 0; g < QG; ++g) Oa[g][dt] = MFMA16(__builtin_bit_cast(bf16x8, vv), pf[g][kk], Oa[g][dt]);
            }
        if (j + 1 < ntiles) { ATT_WRITE((j + 1) & 1); cur_kt = pf_kt; cur_mask = pf_mask; if (j + 2 < ntiles) ATT_PREFETCH(j + 2); }
        __syncthreads();
    }
#undef ATT_PREFETCH
#undef ATT_WRITE
#pragma unroll
    for (int g = 0; g < QG; ++g) {
        float lg = xor16_add(l[g]); lg = xor32_add(lg);
        const float inv = 1.f / lg;
        bf16_t* op = A.O + (size_t)(g * 128 + w * 16 + fr) * A.ostride + fq * 4;
#pragma unroll
        for (int dt = 0; dt < 4; ++dt) *(u32x2*)(op + dt * 16) = (u32x2){pk2(Oa[g][dt][0] * inv, Oa[g][dt][1] * inv), pk2(Oa[g][dt][2] * inv, Oa[g][dt][3] * inv)};
    }
}

__device__ __forceinline__ void swa_unit(const Args& a, const Ctx& cx, LAS unsigned char* lds, int i, int u) {
    const bf16_t* PROJ = (const bf16_t*)(cx.ws + WS_PROJ); bf16_t* MIX = (bf16_t*)(cx.ws + WS_MIX);
    AttnArgs A;
    A.tab64 = (const f32x2*)(cx.ws + WS_TAB);
    A.qstride = NPROJ_PAD; A.ostride = D; A.scale = 0.125f; A.l0 = 1.f;
    int npass, rowq, hq;
    if (u < 128) {
        const int b = u >> 6, qt = u & 7, row0 = TP + b * 1024, q0 = qt * 128; hq = (u >> 3) & 7; const int kv = hq >> 2;
        A.qpos0 = q0; A.qrope = 1; A.nseg = 2; npass = 1; rowq = row0 + q0;
        const bf16_t* csk = (const bf16_t*)(cx.ws + WS_CSK) + ((size_t)(i * 2 + b)) * 65536 + kv * 64;
        const bf16_t* csv = (const bf16_t*)(cx.ws + WS_CSV) + ((size_t)(i * 2 + b)) * 65536 + kv * 64;
        A.seg0 = KSeg{csk, 128, nullptr, csv, 128, 0, 512, 0};
        const int lo = q0 - 128 < 0 ? 0 : q0 - 128, hi = q0 + 256 > 1024 ? 1024 : q0 + 256;
        A.seg1 = KSeg{PROJ + (size_t)row0 * NPROJ_PAD + C_KB + kv * 64, NPROJ_PAD, nullptr, PROJ + (size_t)row0 * NPROJ_PAD + C_VB + kv * 64, NPROJ_PAD, lo, hi, 3};
    } else {
        const int v = u - 128, b = v >> 3, row0 = b * 256; hq = v & 7; const int kv = hq >> 2;
        A.qpos0 = 0; A.qrope = 0; A.nseg = 1; npass = 2; rowq = row0;
        A.seg0 = KSeg{PROJ + (size_t)row0 * NPROJ_PAD + C_KB + kv * 64, NPROJ_PAD, nullptr, PROJ + (size_t)row0 * NPROJ_PAD + C_VB + kv * 64, NPROJ_PAD, 0, 256, 0};
        A.seg1 = A.seg0;
    }
    A.m0 = (a.in[21] + cx.z)[i * 8 + hq];
    for (int ps = 0; ps < npass; ++ps) {
        A.Q = PROJ + (size_t)(rowq + ps * 128) * NPROJ_PAD + C_QB + hq * 64;
        A.O = MIX + (size_t)(rowq + ps * 128) * D + 512 + hq * 64;
        if (ps) A.qpos0 += 128;
        attn_unit<64, 1>(lds, A, cx.tid);
    }
}

__device__ __forceinline__ void mla_unit(const Args& a, const Ctx& cx, LAS unsigned char* lds, int u) {
    const bf16_t* Q = (const bf16_t*)(cx.ws + WS_Q); const bf16_t* KVX = (const bf16_t*)(cx.ws + WS_KVX); const bf16_t* KR = (const bf16_t*)(cx.ws + WS_KR);
    bf16_t* MIX = (bf16_t*)(cx.ws + WS_MIX);
    AttnArgs A;
    A.tab64 = (const f32x2*)(cx.ws + WS_TAB);
    A.qstride = 1536; A.ostride = D; A.scale = 0.10206207261596577f; A.l0 = 0.f; A.m0 = -1e30f;
    if (u < 256) {
        const int b = u >> 7, h = (u >> 3) & 15, qt = u & 7, row0 = TP + b * 1024, q0 = qt * 128, crow0 = T + b * 512;
        A.Q = Q + (size_t)(row0 + q0) * 1536 + h * 96; A.qpos0 = q0; A.qrope = 2; A.nseg = 2;
        A.seg0 = KSeg{KVX + (size_t)crow0 * 2048 + h * 128, 2048, KR + (size_t)crow0 * 32, KVX + (size_t)crow0 * 2048 + h * 128 + 64, 2048, 0, 512, 0};
        A.seg1 = KSeg{KVX + (size_t)row0 * 2048 + h * 128, 2048, KR + (size_t)row0 * 32, KVX + (size_t)row0 * 2048 + h * 128 + 64, 2048, 0, 1024, 0};
        A.O = MIX + (size_t)(row0 + q0) * D + h * 64;
        attn_unit<96, 1>(lds, A, cx.tid);
    } else {
        const int v = u - 256, b = v >> 4, h = v & 15, row0 = b * 256;
        A.Q = Q + (size_t)row0 * 1536 + h * 96; A.qpos0 = 0; A.qrope = 0; A.nseg = 1;
        A.seg0 = KSeg{KVX + (size_t)row0 * 2048 + h * 128, 2048, KR + (size_t)row0 * 32, KVX + (size_t)row0 * 2048 + h * 128 + 64, 2048, 0, 256, 0};
        A.seg1 = A.seg0;
        A.O = MIX + (size_t)row0 * D + h * 64;
        attn_unit<96, 2>(lds, A, cx.tid);
    }
}

constexpr int GL_G = 0;
constexpr int GL_STF = 32768, GL_STB = 51200;
constexpr int GL_LO = 32768, GL_WF = 40960, GL_WB = 45056, GL_BF = 49152, GL_BB = 49408;
constexpr int GL_QF = 69632, GL_KF = 78848, GL_QB = 88064, GL_KB = 97280;
constexpr int GL_VT = 106496;
constexpr int GL_AF = 124928, GL_AB = 134144;

__device__ __forceinline__ void gla_gates(const Args& a, const Ctx& cx, LAS unsigned char* lds, int i, int tok0, int h) {
    const int tid = cx.tid;
    const bf16_t* PROJ = (const bf16_t*)(cx.ws + WS_PROJ);
    LAS float* LO = (LAS float*)(lds + GL_LO); LAS float* WF = (LAS float*)(lds + GL_WF); LAS float* WB = (LAS float*)(lds + GL_WB);
    LAS float* BF = (LAS float*)(lds + GL_BF); LAS float* BB = (LAS float*)(lds + GL_BB);
    LAS float* Gf = (LAS float*)(lds + GL_G); LAS float* Gb = Gf + 4096;
    { const int t = tid >> 3, j0 = (tid & 7) * 4; const u32x2 v = *(const u32x2*)(PROJ + (size_t)(tok0 + t) * NPROJ_PAD + C_LO + j0);
      LO[t * 32 + j0] = bflo(v.x); LO[t * 32 + j0 + 1] = bfhi(v.x); LO[t * 32 + j0 + 2] = bflo(v.y); LO[t * 32 + j0 + 3] = bfhi(v.y); }
    for (int x = tid; x < 1024; x += NTHREADS) { const int r = x >> 6, d = x & 63;
        WF[x] = (a.in[16] + cx.z)[((size_t)i * 16 + r) * 256 + h * 64 + d]; WB[x] = (a.in[18] + cx.z)[((size_t)i * 16 + r) * 256 + h * 64 + d]; }
    if (tid < 64) { BF[tid] = (a.in[17] + cx.z)[i * 256 + h * 64 + tid]; BB[tid] = (a.in[19] + cx.z)[i * 256 + h * 64 + tid]; }
    __syncthreads();
    { const int d = tid & 63, tg = tid >> 6;
      LAS float* SEG = (LAS float*)(lds + GL_LO + 8192 + 8192 + 1024);
      float wf[16], wb[16];
#pragma unroll
      for (int r = 0; r < 16; ++r) { wf[r] = WF[r * 64 + d]; wb[r] = WB[r * 64 + d]; }
      const float bfv = BF[d], bbv = BB[d];
      float gf[8], gb[8];
#pragma unroll
      for (int tt = 0; tt < 8; ++tt) { const int t = tg * 8 + tt; float xf = bfv, xb = bbv;
#pragma unroll
          for (int r = 0; r < 16; ++r) { xf += LO[t * 32 + r] * wf[r]; xb += LO[t * 32 + 16 + r] * wb[r]; }
          gf[tt] = (fminf(xf, 0.f) - log1pf(__expf(-fabsf(xf)))) * (1.f / 16.f); gb[tt] = (fminf(xb, 0.f) - log1pf(__expf(-fabsf(xb)))) * (1.f / 16.f); }
#pragma unroll
      for (int tt = 1; tt < 8; ++tt) gf[tt] += gf[tt - 1];
#pragma unroll
      for (int tt = 6; tt >= 0; --tt) gb[tt] += gb[tt + 1];
      SEG[tg * 64 + d] = gf[7]; SEG[512 + tg * 64 + d] = gb[0];
      __syncthreads();
      float offf = 0.f, offb = 0.f;
#pragma unroll
      for (int q = 0; q < 8; ++q) { const float a_ = SEG[q * 64 + d], b_ = SEG[512 + q * 64 + d]; offf += (q < tg) ? a_ : 0.f; offb += (q > tg) ? b_ : 0.f; }
#pragma unroll
      for (int tt = 0; tt < 8; ++tt) { const int t = tg * 8 + tt; Gf[t * 64 + d] = gf[tt] + offf; Gb[t * 64 + d] = gb[tt] + offb; } }
    __syncthreads();
}

__device__ __forceinline__ void gla_vt_load(const bf16_t* PROJ, int tok0, int h, const int tid, u32x4 (&v)[2]) {
    const int s = tid & 63, e0 = (tid >> 6) * 16;
    const bf16_t* src = PROJ + (size_t)(tok0 + s) * NPROJ_PAD + C_VA + h * 128 + e0;
    v[0] = *(const u32x4*)src; v[1] = *(const u32x4*)(src + 8);
}
__device__ __forceinline__ void gla_vt_store(LAS unsigned char* lds, const int tid, const u32x4 (&vv)[2]) {
    const int s = tid & 63, e0 = (tid >> 6) * 16;
    LAS bf16_t* VT = (LAS bf16_t*)(lds + GL_VT);
#pragma unroll
    for (int q = 0; q < 2; ++q) { const u32x4 v = vv[q]; LAS bf16_t* dst = VT + (e0 + q * 8) * 72 + s;
        dst[0 * 72] = (bf16_t)(v.x & 0xffff); dst[1 * 72] = (bf16_t)(v.x >> 16); dst[2 * 72] = (bf16_t)(v.y & 0xffff); dst[3 * 72] = (bf16_t)(v.y >> 16);
        dst[4 * 72] = (bf16_t)(v.z & 0xffff); dst[5 * 72] = (bf16_t)(v.z >> 16); dst[6 * 72] = (bf16_t)(v.w & 0xffff); dst[7 * 72] = (bf16_t)(v.w >> 16); }
}

__device__ __forceinline__ void gla_local_unit(const Args& a, const Ctx& cx, LAS unsigned char* lds, int i, int u) {
    const int cg_ = u >> 2, h = u & 3, tok0 = cg_ * 64, tid = cx.tid, lane = tid & 63, w = tid >> 6, fr = lane & 15, fq = lane >> 4;
    const bf16_t* PROJ = (const bf16_t*)(cx.ws + WS_PROJ);
    float* LOC = (float*)(cx.ws + WS_LOC); float* DEC = (float*)(cx.ws + WS_DEC);
    u32x4 vpre[2]; gla_vt_load(PROJ, tok0, h, tid, vpre);
    const u32x4 kpre = *(const u32x4*)(PROJ + (size_t)(tok0 + (tid >> 3)) * NPROJ_PAD + C_KA + h * 64 + (tid & 7) * 8);
    __syncthreads();
    gla_gates(a, cx, lds, i, tok0, h);
    LAS float* Gf = (LAS float*)(lds + GL_G); LAS float* Gb = Gf + 4096;
    LAS bf16_t* KTf = (LAS bf16_t*)(lds + GL_KF); LAS bf16_t* KTb = (LAS bf16_t*)(lds + GL_KB);
    LAS bf16_t* VT = (LAS bf16_t*)(lds + GL_VT);
    { const int s = tid >> 3, d0 = (tid & 7) * 8; const u32x4 kv = kpre;
      float k[8]; unpack8(kv, k);
#pragma unroll
      for (int e = 0; e < 8; ++e) { const int d = d0 + e;
          KTf[d * 72 + s] = (bf16_t)f2bf(k[e] * __expf(Gf[63 * 64 + d] - Gf[s * 64 + d]));
          KTb[d * 72 + s] = (bf16_t)f2bf(k[e] * __expf(Gb[d] - Gb[s * 64 + d])); } }
    gla_vt_store(lds, tid, vpre);
    if (tid < 128) { const int dir = tid >> 6, d = tid & 63; DEC[((size_t)(dir * 96 + cg_) * 4 + h) * 64 + d] = __expf(dir ? Gb[d] : Gf[63 * 64 + d]); }
    __syncthreads();
    const int dir = w >> 2, dtile = w & 3;
    const LAS bf16_t* KT = dir ? KTb : KTf;
    bf16x8 af[2];
#pragma unroll
    for (int ks = 0; ks < 2; ++ks) af[ks] = *(const LAS bf16x8*)(KT + (dtile * 16 + fr) * 72 + ks * 32 + fq * 8);
    float* dst = LOC + ((size_t)(dir * 96 + cg_) * 4 + h) * 8192;
#pragma unroll
    for (int et = 0; et < 8; ++et) { f32x4 acc = {0.f, 0.f, 0.f, 0.f};
#pragma unroll
        for (int ks = 0; ks < 2; ++ks) { const bf16x8 bfv = *(const LAS bf16x8*)(VT + (et * 16 + fr) * 72 + ks * 32 + fq * 8); acc = MFMA16(af[ks], bfv, acc); }
#pragma unroll
        for (int j = 0; j < 4; ++j) dst[(dtile * 16 + fq * 4 + j) * 128 + et * 16 + fr] = acc[j]; }
}

__device__ __forceinline__ void gla_out_unit(const Args& a, const Ctx& cx, LAS unsigned char* lds, int i, int u) {
    const int cg_ = u >> 2, h = u & 3, tok0 = cg_ * 64, tid = cx.tid, lane = tid & 63, w = tid >> 6, fr = lane & 15, fq = lane >> 4;
    const bf16_t* PROJ = (const bf16_t*)(cx.ws + WS_PROJ); bf16_t* MIX = (bf16_t*)(cx.ws + WS_MIX);
    const float* LOC = (const float*)(cx.ws + WS_LOC); const float* DEC = (const float*)(cx.ws + WS_DEC);
    u32x4 vpre[2]; gla_vt_load(PROJ, tok0, h, tid, vpre);
    const u32x4 qpre = *(const u32x4*)(PROJ + (size_t)(tok0 + (tid >> 3)) * NPROJ_PAD + C_QA + h * 64 + (tid & 7) * 8);
    const u32x4 kpre = *(const u32x4*)(PROJ + (size_t)(tok0 + (tid >> 3)) * NPROJ_PAD + C_KA + h * 64 + (tid & 7) * 8);
    const bf16_t* gpp = PROJ + (size_t)(tok0 + (tid >> 3)) * NPROJ_PAD + C_GA + h * 128 + (tid & 7) * 16;
    const u32x4 gpre0 = *(const u32x4*)gpp, gpre1 = *(const u32x4*)(gpp + 8);
    __syncthreads();
    gla_gates(a, cx, lds, i, tok0, h);
    LAS float* Gf = (LAS float*)(lds + GL_G); LAS float* Gb = Gf + 4096;
    const bool samp = cg_ >= 64;
    const int b = samp ? (cg_ - 64) >> 4 : cg_ >> 2, c = samp ? (cg_ - 64) & 15 : cg_ & 3, nc = samp ? 16 : 4, cbase = cg_ - c;
    {
        const int d = tid >> 3, e0 = (tid & 7) * 16;
        f32x4 Sf[4], Sb[4];
        if (samp) { const float* s0f = (a.in[2] + cx.z) + ((size_t)((b * 2 + i) * 4 + h)) * 8192 + d * 128 + e0; const float* s0b = (a.in[3] + cx.z) + ((size_t)((b * 2 + i) * 4 + h)) * 8192 + d * 128 + e0;
#pragma unroll
            for (int q = 0; q < 4; ++q) { Sf[q] = *(const f32x4*)(s0f + q * 4); Sb[q] = *(const f32x4*)(s0b + q * 4); } }
        else {
#pragma unroll
            for (int q = 0; q < 4; ++q) { Sf[q] = (f32x4){0.f, 0.f, 0.f, 0.f}; Sb[q] = Sf[q]; } }
        for (int j = 0; j < c; ++j) { const size_t ix = (size_t)(0 * 96 + cbase + j) * 4 + h; const float dec = DEC[ix * 64 + d]; const float* lp = LOC + ix * 8192 + d * 128 + e0;
#pragma unroll
            for (int q = 0; q < 4; ++q) Sf[q] = Sf[q] * dec + *(const f32x4*)(lp + q * 4); }
        for (int j = nc - 1; j > c; --j) { const size_t ix = (size_t)(1 * 96 + cbase + j) * 4 + h; const float dec = DEC[ix * 64 + d]; const float* lp = LOC + ix * 8192 + d * 128 + e0;
#pragma unroll
            for (int q = 0; q < 4; ++q) Sb[q] = Sb[q] * dec + *(const f32x4*)(lp + q * 4); }
        if (!samp) {
            if (c == nc - 1) { const size_t ix = (size_t)(0 * 96 + cg_) * 4 + h; const float dec = DEC[ix * 64 + d]; const float* lp = LOC + ix * 8192 + d * 128 + e0;
                float* o = cx.out + O_SF + ((size_t)((b * 2 + i) * 4 + h)) * 8192 + d * 128 + e0;
#pragma unroll
                for (int q = 0; q < 4; ++q) *(f32x4*)(o + q * 4) = Sf[q] * dec + *(const f32x4*)(lp + q * 4); }
            if (c == 0) { const size_t ix = (size_t)(1 * 96 + cg_) * 4 + h; const float dec = DEC[ix * 64 + d]; const float* lp = LOC + ix * 8192 + d * 128 + e0;
                float* o = cx.out + O_SB + ((size_t)((b * 2 + i) * 4 + h)) * 8192 + d * 128 + e0;
#pragma unroll
                for (int q = 0; q < 4; ++q) *(f32x4*)(o + q * 4) = Sb[q] * dec + *(const f32x4*)(lp + q * 4); }
        }
        LAS bf16_t* STf = (LAS bf16_t*)(lds + GL_STF); LAS bf16_t* STb = (LAS bf16_t*)(lds + GL_STB);
#pragma unroll
        for (int q = 0; q < 4; ++q)
#pragma unroll
            for (int e = 0; e < 4; ++e) { STf[(e0 + q * 4 + e) * 72 + d] = (bf16_t)f2bf(Sf[q][e]); STb[(e0 + q * 4 + e) * 72 + d] = (bf16_t)f2bf(Sb[q][e]); }
    }
    {
        const int t = tid >> 3, d0 = (tid & 7) * 8;
        const u32x4 qv = qpre, kv = kpre;
        float q[8], k[8], o1[8], o2[8], o3[8], o4[8]; unpack8(qv, q); unpack8(kv, k);
#pragma unroll
        for (int e = 0; e < 8; ++e) { const float gf = Gf[t * 64 + d0 + e], gb = Gb[t * 64 + d0 + e];
            o1[e] = q[e] * 0.125f * __expf(gf); o2[e] = k[e] * __expf(-gf); o3[e] = q[e] * 0.125f * __expf(gb); o4[e] = k[e] * __expf(-gb); }
        *(LAS u32x4*)((LAS bf16_t*)(lds + GL_QF) + t * 72 + d0) = pack8(o1);
        *(LAS u32x4*)((LAS bf16_t*)(lds + GL_KF) + t * 72 + d0) = pack8(o2);
        *(LAS u32x4*)((LAS bf16_t*)(lds + GL_QB) + t * 72 + d0) = pack8(o3);
        *(LAS u32x4*)((LAS bf16_t*)(lds + GL_KB) + t * 72 + d0) = pack8(o4);
    }
    gla_vt_store(lds, tid, vpre);
    __syncthreads();
    {
        const int dir = w >> 2, tt = w & 3;
        const LAS bf16_t* Qm = (const LAS bf16_t*)(lds + (dir ? GL_QB : GL_QF)); const LAS bf16_t* Km = (const LAS bf16_t*)(lds + (dir ? GL_KB : GL_KF));
        LAS bf16_t* AT = (LAS bf16_t*)(lds + (dir ? GL_AB : GL_AF));
        bf16x8 af[2];
#pragma unroll
        for (int ks = 0; ks < 2; ++ks) af[ks] = *(const LAS bf16x8*)(Qm + (tt * 16 + fr) * 72 + ks * 32 + fq * 8);
#pragma unroll
        for (int st = 0; st < 4; ++st) { f32x4 acc = {0.f, 0.f, 0.f, 0.f};
#pragma unroll
            for (int ks = 0; ks < 2; ++ks) { const bf16x8 bfv = *(const LAS bf16x8*)(Km + (st * 16 + fr) * 72 + ks * 32 + fq * 8); acc = MFMA16(af[ks], bfv, acc); }
#pragma unroll
            for (int j = 0; j < 4; ++j) { const int t = tt * 16 + fq * 4 + j, s = st * 16 + fr; const bool keep = dir ? (s >= t) : (s <= t);
                AT[t * 72 + s] = (bf16_t)f2bf(keep ? acc[j] : 0.f); } }
    }
    __syncthreads();
    {
        const int tt = w & 3, eg = w >> 2;
        LAS float* OS = (LAS float*)(lds + GL_G);
        const LAS bf16_t* VT = (const LAS bf16_t*)(lds + GL_VT);
        bf16x8 a1[2], a2[2], a3[2], a4[2];
#pragma unroll
        for (int ks = 0; ks < 2; ++ks) { const int off = (tt * 16 + fr) * 72 + ks * 32 + fq * 8;
            a1[ks] = *(const LAS bf16x8*)((const LAS bf16_t*)(lds + GL_QF) + off); a2[ks] = *(const LAS bf16x8*)((const LAS bf16_t*)(lds + GL_AF) + off);
            a3[ks] = *(const LAS bf16x8*)((const LAS bf16_t*)(lds + GL_QB) + off); a4[ks] = *(const LAS bf16x8*)((const LAS bf16_t*)(lds + GL_AB) + off); }
        f32x4 accs[4];
#pragma unroll
        for (int q = 0; q < 4; ++q) { const int et = eg * 4 + q; f32x4 acc = {0.f, 0.f, 0.f, 0.f};
#pragma unroll
            for (int ks = 0; ks < 2; ++ks) { const int off = (et * 16 + fr) * 72 + ks * 32 + fq * 8;
                const bf16x8 b1 = *(const LAS bf16x8*)((const LAS bf16_t*)(lds + GL_STF) + off), b2 = *(const LAS bf16x8*)(VT + off), b3 = *(const LAS bf16x8*)((const LAS bf16_t*)(lds + GL_STB) + off);
                acc = MFMA16(a1[ks], b1, acc); acc = MFMA16(a2[ks], b2, acc); acc = MFMA16(a3[ks], b3, acc); acc = MFMA16(a4[ks], b2, acc); }
            accs[q] = acc; }
#pragma unroll
        for (int q = 0; q < 4; ++q)
#pragma unroll
            for (int j = 0; j < 4; ++j) OS[(tt * 16 + fq * 4 + j) * 128 + (eg * 4 + q) * 16 + fr] = accs[q][j];
    }
    __syncthreads();
    {
        const int t = tid >> 3, e0 = (tid & 7) * 16;
        const LAS float* OS = (const LAS float*)(lds + GL_G);
        float o[16]; float ss = 0.f;
#pragma unroll
        for (int e = 0; e < 16; ++e) { o[e] = OS[t * 128 + e0 + e]; ss += o[e] * o[e]; }
        ss += __shfl_xor(ss, 1); ss += __shfl_xor(ss, 2); ss += __shfl_xor(ss, 4);
        const float rstd = rsqrtf(ss * (1.f / 128.f) + EPS);
        const float* gg = (a.in[20] + cx.z) + i * 128 + e0;
        float gt[16]; unpack8(gpre0, gt); unpack8(gpre1, gt + 8);
#pragma unroll
        for (int e = 0; e < 16; ++e) o[e] = o[e] * rstd * gg[e] * silu_f(gt[e]);
        bf16_t* op = MIX + (size_t)(tok0 + t) * D + h * 128 + e0;
        *(u32x4*)op = pack8(o); *(u32x4*)(op + 8) = pack8(o + 8);
    }
}


#define XB_TMO      128
#define XB_XCNT(j)  (256  + 64 * (j))
#define XB_XSUB(j)  (1280 + 64 * (j))
#define XB_XGEN(j)  (2304 + 64 * (j))
#define XB_TOP      3328
#define XB_TOPGEN   3392
#define XCD_BAR_WORDS 3456
#define XB_SPIN_CAP (1u << 18)
__device__ __forceinline__ unsigned xb_ld(unsigned* p)              { return __hip_atomic_load(p, __ATOMIC_RELAXED, __HIP_MEMORY_SCOPE_AGENT); }
__device__ __forceinline__ unsigned xb_add(unsigned* p, unsigned v) { return __hip_atomic_fetch_add(p, v, __ATOMIC_RELAXED, __HIP_MEMORY_SCOPE_AGENT); }
__device__ __forceinline__ unsigned xb_xcc_id() { return (unsigned)__builtin_amdgcn_s_getreg((3 << 11) | 20) & 0xFu; }
#define XB_SPIN(cond, bar) do { unsigned _sp = 0; while (cond) { __builtin_amdgcn_s_sleep(1); \
    if ((++_sp & 255u) == 0u) { if (xb_ld(&(bar)[XB_TMO])) break; if (_sp > XB_SPIN_CAP) { atomicAdd(&(bar)[XB_TMO], 1u); break; } } } } while (0)
struct XcdBarrier { unsigned* bar; unsigned x; volatile LAS unsigned* st; };
__device__ __forceinline__ XcdBarrier xcd_barrier_post(unsigned* bar, volatile LAS unsigned* st, const int tid) {
    XcdBarrier b; b.bar = bar; b.x = xb_xcc_id(); b.st = st;
    if (tid == 0) (void)xb_add(&bar[XB_XCNT(b.x)], 1u);
    return b;
}
__device__ __forceinline__ void xcd_barrier_complete(unsigned* bar, unsigned x, unsigned& nloc, unsigned& nx) {
    const unsigned G = gridDim.x * gridDim.y * gridDim.z;
    unsigned sum, cnt, mine, sp = 0u;
    for (;;) {
        sum = 0u; cnt = 0u; mine = 0u;
#pragma unroll
        for (unsigned j = 0; j < 16; ++j) { const unsigned c = xb_ld(&bar[XB_XCNT(j)]); sum += c; cnt += (c > 0u) ? 1u : 0u; mine = (j == x) ? c : mine; }
        if (sum == G) break;
        __builtin_amdgcn_s_sleep(1);
        if ((++sp & 255u) == 0u) { if (xb_ld(&bar[XB_TMO])) break; if (sp > XB_SPIN_CAP) { atomicAdd(&bar[XB_TMO], 1u); break; } }
    }
    nloc = mine > 0u ? mine : 1u; nx = cnt > 0u ? cnt : 1u;
}
__device__ __forceinline__ void xcd_barrier(const XcdBarrier& b, const int tid) {
    asm volatile("s_waitcnt vmcnt(0)" ::: "memory");
    __syncthreads();
    if (tid == 0) {
        unsigned* bar = b.bar;
        __builtin_amdgcn_s_waitcnt(0);
        unsigned nloc = b.st[0], nx = b.st[1];
        if (nloc == 0u) { xcd_barrier_complete(bar, b.x, nloc, nx); b.st[0] = nloc; b.st[1] = nx; }
        const unsigned old = xb_add(&bar[XB_XSUB(b.x)], 1u);
        const unsigned gen = old / nloc;
        if (old + 1u == (gen + 1u) * nloc) {
            __builtin_amdgcn_fence(__ATOMIC_RELEASE, "agent");
            asm volatile("s_waitcnt vmcnt(0)" ::: "memory");
            const unsigned og = xb_add(&bar[XB_TOP], 1u);
            const unsigned tg = og / nx;
            if (og + 1u == (tg + 1u) * nx) xb_add(&bar[XB_TOPGEN], 1u);
            else XB_SPIN(xb_ld(&bar[XB_TOPGEN]) == tg, bar);
            __builtin_amdgcn_fence(__ATOMIC_ACQUIRE, "agent");
            asm volatile("s_waitcnt vmcnt(0)" ::: "memory");
        } else {
            XB_SPIN(xb_ld(&bar[XB_TOPGEN]) == gen, bar);
            __builtin_amdgcn_fence(__ATOMIC_ACQUIRE, "agent");
            asm volatile("s_waitcnt vmcnt(0)" ::: "memory");
        }
    }
    __syncthreads();
}

enum { K_PRO = 0, K_PRE, K_G1, K_A1, K_A2, K_DOWN, K_MID, K_UQKV, K_MLA, K_OUTP, K_POST1, K_FF1, K_FF2, K_POST2 };
constexpr int N_PHASES = 2 + 2 * 8 + 2 * 9;
#ifndef EN_MASK
#define EN_MASK 0xFFFFFFFFu
#endif
#define ENB(k) (((EN_MASK) >> (k)) & 1u)
#ifndef DUP_MASK
#define DUP_MASK 0u
#endif
#ifndef BAR_REPS
#define BAR_REPS 1
#endif

__global__ void __launch_bounds__(NTHREADS, 2) mega_fwd(Args args) {
    extern __shared__ __attribute__((aligned(16))) unsigned char lds_raw[];
    LAS unsigned char* lds = (LAS unsigned char*)lds_raw;
    const int lo = args.ph_lo, hi = args.ph_hi;
    const int wave_s = __builtin_amdgcn_readfirstlane((int)(threadIdx.x >> 6));
#define MY_TID(dst) do { int _l; asm volatile("v_mbcnt_lo_u32_b32 %0, -1, 0\n\tv_mbcnt_hi_u32_b32 %0, -1, %0" : "=v"(_l)); dst = wave_s * 64 + _l; } while (0)
    {
        int tid0; MY_TID(tid0);
        volatile LAS unsigned* bst = (volatile LAS unsigned*)(lds + LDS_BYTES - 64);
        if (tid0 < 2) bst[tid0] = 0u;
        __syncthreads();
        (void)xcd_barrier_post((unsigned*)(args.ws + WS_CTL), bst, tid0);
    }
    for (int p = lo; p < hi; ++p) {
        int kind, l;
        if (p == 0) { kind = K_PRO; l = 0; }
        else if (p == 1) { kind = K_PRE; l = 0; }
        else {
            const int q = p - 2, pair = q / 17, r = q - pair * 17;
            if (r < 8) { l = 2 * pair; kind = (r == 0) ? K_G1 : (r == 1) ? K_A1 : (r == 2) ? K_A2 : (r == 3) ? K_OUTP : (r == 4) ? K_POST1 : (r == 5) ? K_FF1 : (r == 6) ? K_FF2 : K_POST2; }
            else { const int r2 = r - 8; l = 2 * pair + 1; kind = (r2 == 0) ? K_DOWN : (r2 == 1) ? K_MID : (r2 == 2) ? K_UQKV : (r2 == 3) ? K_MLA : (r2 == 4) ? K_OUTP : (r2 == 5) ? K_POST1 : (r2 == 6) ? K_FF1 : (r2 == 7) ? K_FF2 : K_POST2; }
        }
        const int reps = ((DUP_MASK >> kind) & 1u) ? 2 : 1;
        for (int rep = 0; rep < reps; ++rep) {
        if (rep) __syncthreads();
        Ctx cx; cx.z = 0; MY_TID(cx.tid); cx.bid = blockIdx.x; cx.G = gridDim.x;
        asm volatile("" : "+s"(cx.z), "+s"(kind), "+s"(l), "+v"(cx.tid), "+s"(cx.bid), "+s"(cx.G));
        cx.ws = args.ws + cx.z; cx.out = args.out + cx.z;
        unsigned char* ws = cx.ws;
        const int i = l >> 1, G = cx.G, bid = cx.bid;
        switch (kind) {
        case K_PRO: if (ENB(0)) prologue(args, cx, lds); break;
        case K_PRE: if (ENB(1)) pre_rows(args, cx, 0); break;
        case K_G1: if (ENB(2)) {
            pg8::Gemm g{(const bf16_t*)(ws + WS_H), (const bf16_t*)(ws + WS_WIN) + (size_t)i * NPROJ_PAD * D, T, NPROJ_PAD, D, D, D, NPROJ_PAD / 256, 0};
            pg8::StaticOrder S; S.init(T, NPROJ_PAD, G, bid);
            pg8::EpiProj E{(bf16_t*)(ws + WS_PROJ), cx.out, i};
            pg8::gemm_phase<pg8::EpiProj, pg8::StaticOrder>(lds, g, S, E, cx.tid);
        } break;
        case K_A1:
            if (G == 256) {
                if (bid < 128) { if (ENB(3)) swa_unit(args, cx, lds, i, bid); if (ENB(4)) gla_local_unit(args, cx, lds, i, bid); }
                else { const int q = bid - 128; if (ENB(3)) swa_unit(args, cx, lds, i, 128 + q);
                       if (ENB(4)) { gla_local_unit(args, cx, lds, i, 128 + 2 * q); gla_local_unit(args, cx, lds, i, 128 + 2 * q + 1); } }
            } else { for (int u = bid; u < 640; u += G) { if (u < 256) { if (ENB(3)) swa_unit(args, cx, lds, i, u); } else { if (ENB(4)) gla_local_unit(args, cx, lds, i, u - 256); } } }
            break;
        case K_A2:
            if (G == 256) {
                if (bid < 128) { if (ENB(5)) { gla_out_unit(args, cx, lds, i, 256 + bid); gla_out_unit(args, cx, lds, i, bid); } }
                else { if (ENB(5)) gla_out_unit(args, cx, lds, i, bid); }
            } else { for (int u = bid; u < 384; u += G) if (ENB(5)) gla_out_unit(args, cx, lds, i, u); }
            break;
        case K_MID: if (ENB(7)) mla_mid(args, cx, i); break;
        case K_UQKV: if (ENB(8)) {
            for (int s = 0; s < 2; ++s) {
                pg8::Gemm g;
                if (s == 0) g = pg8::Gemm{(const bf16_t*)(ws + WS_CQ), (const bf16_t*)(ws + WS_WUQ) + (size_t)i * 1536 * 384, T, 1536, 384, 384, 384, 6, 0};
                else        g = pg8::Gemm{(const bf16_t*)(ws + WS_CKV), (const bf16_t*)(ws + WS_WUKV) + (size_t)i * 2048 * 256, T + 1024, 2048, 256, 256, 256, 8, 0};
                pg8::StaticOrder S; S.init(g.M, g.N, G, (s == 0 || G != 256) ? bid : ((bid + 144) & 255));
                pg8::EpiBf16<0> E{s == 0 ? (bf16_t*)(ws + WS_Q) : (bf16_t*)(ws + WS_KVX), g.N};
                pg8::gemm_phase<pg8::EpiBf16<0>, pg8::StaticOrder>(lds, g, S, E, cx.tid);
            }
        } break;
        case K_MLA: if (ENB(9)) {
            if (G == 256) {
                const int xcd = bid & 7, slot = bid >> 3, id = xcd * 4 + (slot >> 3);
                mla_unit(args, cx, lds, id * 8 + (slot & 7));
                mla_unit(args, cx, lds, 256 + bid);
            } else { for (int u = bid; u < 512; u += G) mla_unit(args, cx, lds, u); }
        } break;
        case K_DOWN: if (ENB(10)) {
            pg8::Gemm g{(const bf16_t*)(ws + WS_H), (const bf16_t*)(ws + WS_WDOWN) + (size_t)i * NDOWN_PAD * D, T, 2 * NDOWN_PAD, D / 2, D, D / 2, NDOWN_PAD / 256, D / 2};
            pg8::EpiF32 E{(float*)(ws + WS_OUT), NDOWN_PAD, NDOWN_PAD / 256, DOWN_SPLIT};
            pg8::StaticOrder S; S.init(g.M, g.N, G, bid);
            pg8::gemm_phase<pg8::EpiF32, pg8::StaticOrder>(lds, g, S, E, cx.tid);
        } break;
        case K_OUTP: case K_FF2: if (ENB(10)) {
            pg8::Gemm g;
            if (kind == K_OUTP) {
                const bf16_t* Wt = (l & 1) ? (const bf16_t*)(ws + WS_WO) + (size_t)i * D * D : (const bf16_t*)(ws + WS_WOUT) + (size_t)i * D * D;
                g = pg8::Gemm{(const bf16_t*)(ws + WS_MIX), Wt, T, 2 * D, D / 2, D, D / 2, 4, D / 2};
            } else {
                g = pg8::Gemm{(const bf16_t*)(ws + WS_U), (const bf16_t*)(ws + WS_WFF2) + (size_t)l * FF * D, T, 2 * D, FF / 2, FF, FF / 2, 4, FF / 2};
            }
            pg8::EpiSplitBf16 E{(bf16_t*)(ws + WS_OUT), D, 4, OUT_SPLIT};
            pg8::StaticOrder S; S.init(g.M, g.N, G, bid);
            pg8::gemm_phase<pg8::EpiSplitBf16, pg8::StaticOrder>(lds, g, S, E, cx.tid);
        } break;
        case K_FF1: if (ENB(12)) {
            pg8::Gemm g{(const bf16_t*)(ws + WS_H), (const bf16_t*)(ws + WS_WFF1) + (size_t)l * FF * D, T, FF, D, D, D, FF / 256, 0};
            pg8::StaticOrder S; S.init(T, FF, G, bid);
            pg8::EpiBf16<1> E{(bf16_t*)(ws + WS_U), FF};
            pg8::gemm_phase<pg8::EpiBf16<1>, pg8::StaticOrder>(lds, g, S, E, cx.tid);
        } break;
        case K_POST1: if (ENB(11)) {
            const float* MODL = (const float*)(ws + WS_MOD) + (size_t)l * 3 * 6144; const float* gN = (args.in[12] + cx.z) + (size_t)l * 4 * D;
            post_rows(args, cx, l == 0, MODL + 2 * D, gN + D, true, gN + 2 * D, MODL + 3 * D, MODL + 4 * D, rep + 1 < reps);
        } break;
        case K_POST2: if (ENB(14)) {
            const float* MODL = (const float*)(ws + WS_MOD) + (size_t)l * 3 * 6144; const float* gN = (args.in[12] + cx.z) + (size_t)l * 4 * D;
            const float* MODN = MODL + 3 * 6144; const float* gNn = gN + 4 * D;
            post_rows(args, cx, false, MODL + 5 * D, gN + 3 * D, l < 3, gNn, MODN, MODN + D, rep + 1 < reps);
        } break;
        default: break;
        }
        }
        if (p + 1 < hi) { if (hi < 0) cg::this_grid().sync(); else { XcdBarrier xb; xb.bar = (unsigned*)(args.ws + WS_CTL); xb.x = xb_xcc_id(); xb.st = (volatile LAS unsigned*)(lds + LDS_BYTES - 64); int tidb; MY_TID(tidb); for (int br = 0; br < BAR_REPS; ++br) xcd_barrier(xb, tidb); } }
    }
}

extern "C" void kernel_launch(void* const* d_in, const int* in_sizes, int n_in, void* d_out, int out_size, void* d_ws, size_t ws_size, hipStream_t stream) {
    static int grid = 0;
    if (grid == 0) {
        int dev = 0, cus = 0, per_cu = 0;
        hipGetDevice(&dev);
        hipDeviceGetAttribute(&cus, hipDeviceAttributeMultiprocessorCount, dev);
        hipFuncSetAttribute((const void*)mega_fwd, hipFuncAttributeMaxDynamicSharedMemorySize, LDS_BYTES);
        hipOccupancyMaxActiveBlocksPerMultiprocessor(&per_cu, (const void*)mega_fwd, NTHREADS, LDS_BYTES);
        if (per_cu < 1) { fprintf(stderr, "kernel_launch: occupancy query says %d blocks per CU\n", per_cu); per_cu = 1; }
        (void)hipGetLastError();
        grid = cus;
        if (ws_size < 256 * MiB) fprintf(stderr, "kernel_launch: workspace too small (%zu)\n", ws_size);
    }
    (void)hipMemsetAsync((char*)d_ws + WS_CTL, 0, CTL_BYTES, stream);
    Args a{};
    for (int i = 0; i < 29; ++i) a.in[i] = (const float*)d_in[i];
    a.out = (float*)d_out; a.ws = (unsigned char*)d_ws;
#if MK_ONE_LAUNCH
    a.ph_lo = 0; a.ph_hi = N_PHASES;
    void* kargs[] = {&a};
    hipError_t e = hipLaunchCooperativeKernel((const void*)mega_fwd, dim3(grid), dim3(NTHREADS), kargs, LDS_BYTES, stream);
    if (e != hipSuccess) fprintf(stderr, "cooperative launch failed: %s (grid %d)\n", hipGetErrorString(e), grid);
#else
    for (int p = 0; p < N_PHASES; ++p) {
        a.ph_lo = p; a.ph_hi = p + 1;
        hipLaunchKernelGGL(mega_fwd, dim3(grid), dim3(NTHREADS), LDS_BYTES, stream, a);
    }
#endif
}
```

```cpp
#include <hip/hip_runtime.h>
#include <hip/hip_cooperative_groups.h>
#include <cstdio>
#include <cstdint>
namespace cg = cooperative_groups;

#ifndef MK_ONE_LAUNCH
#define MK_ONE_LAUNCH 1
#endif

#define LAS __attribute__((address_space(3)))
#define GAS __attribute__((address_space(1)))
typedef unsigned short bf16_t;
typedef short bf16x8 __attribute__((ext_vector_type(8)));
typedef float f32x4 __attribute__((ext_vector_type(4)));
typedef float f32x2 __attribute__((ext_vector_type(2)));
typedef unsigned u32x4 __attribute__((ext_vector_type(4)));
typedef unsigned u32x2 __attribute__((ext_vector_type(2)));

constexpr int D = 1024, TP = 4096, TS = 2048, T = TP + TS, FF = 4096;
constexpr int NPROJ = 2336, NPROJ_PAD = 2560, NDOWN = 672, NDOWN_PAD = 768;
constexpr int C_QA = 0, C_KA = 256, C_VA = 512, C_GA = 1024, C_LO = 1536, C_QB = 1568, C_KB = 2080, C_VB = 2208;
constexpr float EPS = 1e-6f;
constexpr int NTHREADS = 512, NWAVES = 8;
constexpr int LDS_BYTES = 147456;

constexpr size_t O_X = 0, O_SF = 6291456, O_SB = 7340032, O_CK = 8388608, O_CV = 9437184, O_CKV = 10485760, O_CKR = 12582912;

constexpr size_t MiB = 1u << 20;
constexpr size_t WS_WFF1 = 0, WS_WFF2 = 32 * MiB, WS_WIN = 64 * MiB, WS_WOUT = 74 * MiB, WS_WDOWN = 78 * MiB, WS_WUQ = 81 * MiB,
                 WS_WUKV = 84 * MiB, WS_WO = 86 * MiB, WS_MOD = 90 * MiB, WS_TAB = 91 * MiB, WS_CSK = 92 * MiB, WS_CSV = 93 * MiB,
                 WS_H = 94 * MiB, WS_MIX = 106 * MiB, WS_OUT = 118 * MiB, WS_U = 166 * MiB, WS_PROJ = 214 * MiB, WS_CTL = 250 * MiB;
constexpr size_t CTL_BYTES = 16384;
constexpr size_t WS_LOC = WS_U, WS_DEC = WS_U + 24 * MiB;
constexpr size_t WS_Q = WS_U, WS_KVX = WS_U + 18 * MiB;
constexpr size_t WS_DOWN = WS_PROJ, WS_CQ = WS_PROJ + 18 * MiB, WS_CKV = WS_PROJ + 23 * MiB, WS_KR = WS_PROJ + 27 * MiB;
constexpr size_t OUT_SPLIT = (size_t)T * D;
constexpr size_t DOWN_SPLIT = (WS_DOWN - WS_OUT) / 4;

__device__ __forceinline__ unsigned f2bf(float f) { unsigned u = __builtin_bit_cast(unsigned, f); return (u + 0x7fffu + ((u >> 16) & 1u)) >> 16; }
__device__ __forceinline__ unsigned pk2(float lo, float hi) { return f2bf(lo) | (f2bf(hi) << 16); }
__device__ __forceinline__ float bf2f(unsigned short b) { return __builtin_bit_cast(float, (unsigned)b << 16); }
__device__ __forceinline__ float bflo(unsigned w) { return __builtin_bit_cast(float, w << 16); }
__device__ __forceinline__ float bfhi(unsigned w) { return __builtin_bit_cast(float, w & 0xffff0000u); }
__device__ __forceinline__ void unpack8(const u32x4 v, float* f) {
    f[0] = bflo(v.x); f[1] = bfhi(v.x); f[2] = bflo(v.y); f[3] = bfhi(v.y); f[4] = bflo(v.z); f[5] = bfhi(v.z); f[6] = bflo(v.w); f[7] = bfhi(v.w);
}
__device__ __forceinline__ u32x4 pack8(const float* f) { u32x4 o; o.x = pk2(f[0], f[1]); o.y = pk2(f[2], f[3]); o.z = pk2(f[4], f[5]); o.w = pk2(f[6], f[7]); return o; }
__device__ __forceinline__ float wave_sum(float v) {
#pragma unroll
    for (int o = 1; o < 64; o <<= 1) v += __shfl_xor(v, o);
    return v;
}
__device__ __forceinline__ float xor16_max(float x) { const unsigned u = __builtin_bit_cast(unsigned, x); auto r = __builtin_amdgcn_permlane16_swap(u, u, false, false); return fmaxf(__builtin_bit_cast(float, (unsigned)r[0]), __builtin_bit_cast(float, (unsigned)r[1])); }
__device__ __forceinline__ float xor32_max(float x) { const unsigned u = __builtin_bit_cast(unsigned, x); auto r = __builtin_amdgcn_permlane32_swap(u, u, false, false); return fmaxf(__builtin_bit_cast(float, (unsigned)r[0]), __builtin_bit_cast(float, (unsigned)r[1])); }
__device__ __forceinline__ float xor16_add(float x) { const unsigned u = __builtin_bit_cast(unsigned, x); auto r = __builtin_amdgcn_permlane16_swap(u, u, false, false); return __builtin_bit_cast(float, (unsigned)r[0]) + __builtin_bit_cast(float, (unsigned)r[1]); }
__device__ __forceinline__ float xor32_add(float x) { const unsigned u = __builtin_bit_cast(unsigned, x); auto r = __builtin_amdgcn_permlane32_swap(u, u, false, false); return __builtin_bit_cast(float, (unsigned)r[0]) + __builtin_bit_cast(float, (unsigned)r[1]); }
__device__ __forceinline__ unsigned cvtpk(float lo, float hi) { unsigned r; asm volatile("v_cvt_pk_bf16_f32 %0, %1, %2" : "=v"(r) : "v"(lo), "v"(hi)); return r; }
__device__ __forceinline__ float silu_f(float x) { return x / (1.f + __expf(-x)); }

namespace pg8 {
constexpr int BM = 256, BK = 64, HALF = 128, HTB = HALF * BK * 2, NXCD = 8, WGM = 8;
__host__ __device__ __forceinline__ int lds_byte(int r, int c) { const int st = (r >> 4) * 2 + (c >> 5), rr = r & 15, cc = c & 31, ob = rr * 64 + cc * 2; return st * 1024 + (ob ^ (((ob >> 9) & 1) << 5)); }
__host__ __device__ __forceinline__ void stage_rc(int b, int& R, int& C) { const int st = b / 1024, sb = b % 1024, swz = sb ^ (((sb >> 9) & 1) << 5); R = (st >> 1) * 16 + swz / 64; C = (st & 1) * 32 + (swz % 64) / 2; }
__host__ __device__ __forceinline__ int perm32(int rho) { const int n = rho >> 4, i = rho & 15; return 8 * (i >> 2) + 4 * n + (i & 3); }

struct Unit { int pm, pn; };
struct Gemm { const bf16_t* A; const bf16_t* Bt; int M, N, K, lda, ldb, npn, a_split; };

struct StaticOrder {
    int nM, nN, nwg, G, c;
    __device__ void init(int M, int N, int G_, int c_) { nM = M / BM; nN = N / BM; nwg = nM * nN; G = G_; c = c_; }
    __device__ bool next(int i, Unit& u) const {
        const long L = (long)i * G + c; if (L >= nwg) return false;
        int wgid = (int)L; { const int q = nwg / NXCD, r = nwg % NXCD, xcd = wgid % NXCD, off = wgid / NXCD; wgid = (xcd < r ? xcd * (q + 1) : r * (q + 1) + (xcd - r) * q) + off; }
        const int nig = WGM * nN, gid = wgid / nig, fm = gid * WGM, gsz = (nM - fm) < WGM ? (nM - fm) : WGM;
        u.pm = fm + ((wgid % nig) % gsz); u.pn = (wgid % nig) / gsz; return true;
    }
};

__device__ __forceinline__ unsigned cvt_pk_bf16(float lo, float hi) { unsigned r; asm volatile("v_cvt_pk_bf16_f32 %0, %1, %2" : "=v"(r) : "v"(lo), "v"(hi)); return r; }

template <int ACT  > struct EpiBf16 {
    static constexpr bool PERM = true;
    bf16_t* O; int ldc;
    __device__ __forceinline__ void operator()(const f32x4 (&acc)[2][2][4][2], const Unit& u, int wr, int wc, int fr, int fq) const {
        const int row0 = u.pm * BM + wr * 64 + fr, col0 = u.pn * BM + wc * 32 + 8 * fq;
#pragma unroll
        for (int ai = 0; ai < 2; ++ai)
#pragma unroll
            for (int m = 0; m < 4; ++m) { __builtin_amdgcn_sched_barrier(0); bf16_t* rowp = O + (size_t)(row0 + ai * HALF + m * 16) * ldc + col0;
#pragma unroll
                for (int bj = 0; bj < 2; ++bj) { f32x4 v0 = acc[ai][bj][m][0], v1 = acc[ai][bj][m][1];
                    if (ACT == 1) {
#pragma unroll
                        for (int j = 0; j < 4; ++j) { float a = fmaxf(v0[j], 0.f), b = fmaxf(v1[j], 0.f); v0[j] = a * a; v1[j] = b * b; } }
                    u32x4 w; w.x = cvt_pk_bf16(v0[0], v0[1]); w.y = cvt_pk_bf16(v0[2], v0[3]); w.z = cvt_pk_bf16(v1[0], v1[1]); w.w = cvt_pk_bf16(v1[2], v1[3]);
                    *(u32x4*)(rowp + bj * HALF) = w; } }
    }
};
struct EpiProj {
    static constexpr bool PERM = true;
    bf16_t* O; float* outp; int li;
    __device__ __forceinline__ void operator()(const f32x4 (&acc)[2][2][4][2], const Unit& u, int wr, int wc, int fr, int fq) const {
        const int row0 = u.pm * BM + wr * 64 + fr, col0 = u.pn * BM + wc * 32 + 8 * fq;
#pragma unroll
        for (int ai = 0; ai < 2; ++ai)
#pragma unroll
            for (int m = 0; m < 4; ++m) { __builtin_amdgcn_sched_barrier(0); const int row = row0 + ai * HALF + m * 16; bf16_t* rowp = O + (size_t)row * NPROJ_PAD + col0;
#pragma unroll
                for (int bj = 0; bj < 2; ++bj) { const f32x4 v0 = acc[ai][bj][m][0], v1 = acc[ai][bj][m][1];
                    u32x4 w; w.x = cvt_pk_bf16(v0[0], v0[1]); w.y = cvt_pk_bf16(v0[2], v0[3]); w.z = cvt_pk_bf16(v1[0], v1[1]); w.w = cvt_pk_bf16(v1[2], v1[3]);
                    *(u32x4*)(rowp + bj * HALF) = w;
                    const int col = col0 + bj * HALF;
                    if (row < TP && col >= C_KB && col < NPROJ) {
                        const int b = row >> 8, t = row & 255;
                        float* dst = outp + ((col < C_VB) ? (O_CK - C_KB) : (O_CV - C_VB)) + ((size_t)((b * 2 + li) * 256 + t)) * 128 + col;
                        *(f32x4*)dst = v0; *(f32x4*)(dst + 4) = v1; } } }
    }
};
struct EpiSplitBf16 {
    static constexpr bool PERM = true;
    bf16_t* O; int ldc; int npn; size_t split_stride;
    __device__ __forceinline__ void operator()(const f32x4 (&acc)[2][2][4][2], const Unit& u, int wr, int wc, int fr, int fq) const {
        const int s = u.pn / npn, pn = u.pn - s * npn;
        bf16_t* base = O + (size_t)s * split_stride;
        const int row0 = u.pm * BM + wr * 64 + fr, col0 = pn * BM + wc * 32 + 8 * fq;
#pragma unroll
        for (int ai = 0; ai < 2; ++ai)
#pragma unroll
            for (int m = 0; m < 4; ++m) { __builtin_amdgcn_sched_barrier(0); bf16_t* rowp = base + (size_t)(row0 + ai * HALF + m * 16) * ldc + col0;
#pragma unroll
                for (int bj = 0; bj < 2; ++bj) { const f32x4 v0 = acc[ai][bj][m][0], v1 = acc[ai][bj][m][1];
                    u32x4 w; w.x = cvt_pk_bf16(v0[0], v0[1]); w.y = cvt_pk_bf16(v0[2], v0[3]); w.z = cvt_pk_bf16(v1[0], v1[1]); w.w = cvt_pk_bf16(v1[2], v1[3]);
                    *(u32x4*)(rowp + bj * HALF) = w; } }
    }
};
struct EpiF32 {
    static constexpr bool PERM = true;
    float* O; int ldc; int npn; size_t split_stride;
    __device__ __forceinline__ void operator()(const f32x4 (&acc)[2][2][4][2], const Unit& u, int wr, int wc, int fr, int fq) const {
        const int s = u.pn / npn, pn = u.pn - s * npn;
        float* base = O + (size_t)s * split_stride;
        const int row0 = u.pm * BM + wr * 64 + fr, col0 = pn * BM + wc * 32 + 8 * fq;
#pragma unroll
        for (int ai = 0; ai < 2; ++ai)
#pragma unroll
            for (int m = 0; m < 4; ++m) { __builtin_amdgcn_sched_barrier(0); float* rowp = base + (size_t)(row0 + ai * HALF + m * 16) * ldc + col0;
#pragma unroll
                for (int bj = 0; bj < 2; ++bj) { *(f32x4*)(rowp + bj * HALF) = acc[ai][bj][m][0]; *(f32x4*)(rowp + bj * HALF + 4) = acc[ai][bj][m][1]; } }
    }
};

template <class Epi, class Sched>
__device__ __forceinline__ void gemm_phase(LAS unsigned char* lds, const Gemm g, const Sched& S, const Epi& E, const int tid) {
    const int wid = __builtin_amdgcn_readfirstlane(tid >> 6), lane = tid & 63, wr = wid >> 2, wc = wid & 3, fr = lane & 15, fq = lane >> 4;
    const int K = g.K, nt = K / BK;
    unsigned voffA[2], voffB[2];
#pragma unroll
    for (int i = 0; i < 2; ++i) { int R, C; stage_rc(tid * 16 + i * 8192, R, C); const int Rb = Epi::PERM ? ((R & ~31) + perm32(R & 31)) : R;
        voffA[i] = (unsigned)(R * g.lda + C) * 2u; voffB[i] = (unsigned)(Rb * g.ldb + C) * 2u; }
    const size_t kstep = (size_t)(BK * 2);
    const size_t hstepA = (size_t)HALF * g.lda * 2, hstepB = (size_t)HALF * g.ldb * 2;
    const size_t tstepA = 2 * hstepA, tstepB = 2 * hstepB;
    const unsigned ldsw = (unsigned)wid * 1024u;
    const int aoff = lds_byte(wr * 64 + fr, fq * 8), boff = lds_byte(wc * 32 + fr, fq * 8);
#define PG8_SA(b, h) (((b) * 2 + (h)) * HTB)
#define PG8_SB(b, h) ((4 + (b) * 2 + (h)) * HTB)
#define PG8_STAGE(bufoff, gbase, voff) do { _Pragma("unroll") for (int _i = 0; _i < 2; ++_i) \
        __builtin_amdgcn_global_load_lds((const unsigned*)((const char*)(gbase) + (voff)[_i]), (LAS unsigned*)(lds + (bufoff) + ldsw + _i * 8192), 16, 0, 0); } while (0)
#define PG8_LDA(dst, b, h) do { _Pragma("unroll") for (int m = 0; m < 4; ++m) _Pragma("unroll") for (int k = 0; k < 2; ++k) dst[m][k] = *(const LAS bf16x8*)(lds + PG8_SA(b, h) + aoff + m * 2048 + k * 1024); } while (0)
#define PG8_LDB(dst, b, h) do { _Pragma("unroll") for (int n = 0; n < 2; ++n) _Pragma("unroll") for (int k = 0; k < 2; ++k) dst[n][k] = *(const LAS bf16x8*)(lds + PG8_SB(b, h) + boff + n * 2048 + k * 1024); } while (0)
#define PG8_MMA(ai, bj, At, Bt) do { __builtin_amdgcn_s_setprio(1); _Pragma("unroll") for (int m = 0; m < 4; ++m) _Pragma("unroll") for (int n = 0; n < 2; ++n) _Pragma("unroll") for (int k = 0; k < 2; ++k) \
        acc[ai][bj][m][n] = __builtin_amdgcn_mfma_f32_16x16x32_bf16(Bt[n][k], At[m][k], acc[ai][bj][m][n], 0, 0, 0); __builtin_amdgcn_s_setprio(0); } while (0)
#define PG8_WAIT_V(n) asm volatile("s_waitcnt vmcnt(" #n ")" ::: "memory")
#define PG8_WAIT_L(n) asm volatile("s_waitcnt lgkmcnt(" #n ")" ::: "memory")
#define PG8_BAR __builtin_amdgcn_s_barrier()
#define PG8_SCHED __builtin_amdgcn_sched_barrier(0)
#define PG8_UA(u) ((const char*)g.A + (size_t)(u).pm * tstepA + (size_t)((u).pn / g.npn) * (size_t)g.a_split * 2)
#define PG8_UB(u) ((const char*)g.Bt + (size_t)(u).pn * tstepB)
    Unit cur, nxt; int ui = 0;
    if (!S.next(0, cur)) return;
    f32x4 acc[2][2][4][2];
#pragma unroll
    for (int a = 0; a < 2; ++a)
#pragma unroll
        for (int b = 0; b < 2; ++b)
#pragma unroll
            for (int m = 0; m < 4; ++m)
#pragma unroll
                for (int n = 0; n < 2; ++n) acc[a][b][m][n] = (f32x4){0.f, 0.f, 0.f, 0.f};
    bf16x8 At[4][2], B0[2][2], B1[2][2];
    const char* cA = PG8_UA(cur); const char* cB = PG8_UB(cur);
    PG8_STAGE(PG8_SB(0, 0), cB, voffB); PG8_STAGE(PG8_SB(0, 1), cB + hstepB, voffB); PG8_STAGE(PG8_SA(0, 0), cA, voffA); PG8_STAGE(PG8_SA(0, 1), cA + hstepA, voffA);
    if (wr == 1) PG8_BAR;
    PG8_WAIT_V(2); PG8_BAR;
    PG8_STAGE(PG8_SB(1, 0), cB + kstep, voffB); PG8_STAGE(PG8_SA(1, 0), cA + kstep, voffA); PG8_STAGE(PG8_SB(1, 1), cB + hstepB + kstep, voffB);
    PG8_WAIT_V(6); PG8_BAR;
    for (;;) {
        const bool has_next = S.next(ui + 1, nxt);
        const char* nA = has_next ? PG8_UA(nxt) : cA; const char* nB = has_next ? PG8_UB(nxt) : cB;
        for (int t = 0; t < nt; t += 2) {
            const bool last = (t == nt - 2);
            const char* a1 = cA + (size_t)(t + 1) * kstep;
            const char* a2 = last ? nA : cA + (size_t)(t + 2) * kstep; const char* b2 = last ? nB : cB + (size_t)(t + 2) * kstep;
            const char* a3 = a2 + kstep; const char* b3 = b2 + kstep;
            PG8_LDB(B0, 0, 0); PG8_LDB(B1, 0, 1); PG8_SCHED; PG8_LDA(At, 0, 0); PG8_STAGE(PG8_SA(1, 1), a1 + hstepA, voffA);
            PG8_WAIT_V(8); PG8_WAIT_L(0); PG8_BAR; PG8_MMA(0, 0, At, B0); PG8_MMA(0, 1, At, B1); PG8_BAR; PG8_SCHED;
            PG8_LDA(At, 0, 1); PG8_STAGE(PG8_SB(0, 0), b2, voffB); PG8_STAGE(PG8_SB(0, 1), b2 + hstepB, voffB); PG8_STAGE(PG8_SA(0, 0), a2, voffA);
            PG8_WAIT_V(8); PG8_WAIT_L(0); PG8_BAR; PG8_MMA(1, 0, At, B0); PG8_MMA(1, 1, At, B1); PG8_BAR; PG8_SCHED;
            PG8_LDB(B0, 1, 0); PG8_LDB(B1, 1, 1); PG8_SCHED; PG8_LDA(At, 1, 0); PG8_STAGE(PG8_SA(0, 1), a2 + hstepA, voffA);
            PG8_WAIT_V(8); PG8_WAIT_L(0); PG8_BAR; PG8_MMA(0, 0, At, B0); PG8_MMA(0, 1, At, B1); PG8_BAR; PG8_SCHED;
            PG8_LDA(At, 1, 1); PG8_STAGE(PG8_SB(1, 0), b3, voffB); PG8_STAGE(PG8_SB(1, 1), b3 + hstepB, voffB); PG8_STAGE(PG8_SA(1, 0), a3, voffA);
            PG8_WAIT_V(8); PG8_WAIT_L(0); PG8_BAR; PG8_MMA(1, 0, At, B0); PG8_MMA(1, 1, At, B1); PG8_BAR; PG8_SCHED;
        }
        if (wr == 0) PG8_BAR;
        E(acc, cur, wr, wc, fr, fq);
        if (!has_next) break;
#pragma unroll
        for (int a = 0; a < 2; ++a)
#pragma unroll
            for (int b = 0; b < 2; ++b)
#pragma unroll
                for (int m = 0; m < 4; ++m)
#pragma unroll
                    for (int n = 0; n < 2; ++n) acc[a][b][m][n] = (f32x4){0.f, 0.f, 0.f, 0.f};
        cur = nxt; cA = nA; cB = nB; ++ui;
        if (wr == 1) PG8_BAR;
    }
    PG8_WAIT_V(0);
    PG8_BAR;
#undef PG8_SA
#undef PG8_SB
#undef PG8_STAGE
#undef PG8_LDA
#undef PG8_LDB
#undef PG8_MMA
#undef PG8_WAIT_V
#undef PG8_WAIT_L
#undef PG8_BAR
#undef PG8_SCHED
#undef PG8_UA
#undef PG8_UB
}
}

struct Args { const float* in[29]; float* out; unsigned char* ws; int ph_lo, ph_hi; };
struct Ctx { unsigned char* ws; float* out; int z, tid, bid, G; };

#define MFMA16(a, b, c) __builtin_amdgcn_mfma_f32_16x16x32_bf16((a), (b), (c), 0, 0, 0)

__device__ __forceinline__ void transpose_load(const float* W, int N, int item, int lane, float (&wv)[32]) {
    const int nblk = N / 32, kb = item / nblk, nb = item % nblk, k0 = 64 * kb, n0 = 32 * nb;
#pragma unroll
    for (int i = 0; i < 32; ++i) { const int kk = 2 * i + (lane >> 5); wv[i] = W[(size_t)(k0 + kk) * N + n0 + (lane & 31)]; }
}
__device__ __forceinline__ void transpose_finish(int N, bf16_t* WT, int npad, int ksub, LAS float* scr, int item, int lane, const float (&wv)[32]) {
    const int nblk = N / 32, kb = item / nblk, nb = item % nblk, k0 = 64 * kb, n0 = 32 * nb;
#pragma unroll
    for (int i = 0; i < 32; ++i) { const int kk = 2 * i + (lane >> 5); scr[kk * 33 + (lane & 31)] = wv[i]; }
    asm volatile("s_waitcnt lgkmcnt(0)" ::: "memory");
    const int c = lane & 7;
    const int ks = k0 / ksub, kin = k0 - ks * ksub;
    bf16_t* dbase = WT + (size_t)ks * npad * ksub + kin + 8 * c;
#pragma unroll
    for (int j = 0; j < 4; ++j) { const int n = (lane >> 3) + 8 * j; const LAS float* s = scr + (8 * c) * 33 + n;
        u32x4 o; o.x = pk2(s[0 * 33], s[1 * 33]); o.y = pk2(s[2 * 33], s[3 * 33]); o.z = pk2(s[4 * 33], s[5 * 33]); o.w = pk2(s[6 * 33], s[7 * 33]);
        *(u32x4*)(dbase + (size_t)(n0 + n) * ksub) = o; }
    asm volatile("s_waitcnt lgkmcnt(0)" ::: "memory");
}

struct MatDesc { const float* W; bf16_t* WT; int K, N, npad, ksub, items; };
__device__ __forceinline__ MatDesc get_mat(const Args& a, const Ctx& cx, int mi) {
    MatDesc m; unsigned char* ws = cx.ws;
    if (mi < 4)       { m.W = (a.in[13] + cx.z) + (size_t)mi * D * FF; m.WT = (bf16_t*)(ws + WS_WFF1) + (size_t)mi * FF * D; m.K = D; m.N = FF; m.npad = FF; m.ksub = D; }
    else if (mi < 8)  { const int l = mi - 4; m.W = (a.in[14] + cx.z) + (size_t)l * FF * D; m.WT = (bf16_t*)(ws + WS_WFF2) + (size_t)l * FF * D; m.K = FF; m.N = D; m.npad = D; m.ksub = FF / 2; }
    else if (mi < 10) { const int i = mi - 8; m.W = (a.in[15] + cx.z) + (size_t)i * D * NPROJ; m.WT = (bf16_t*)(ws + WS_WIN) + (size_t)i * NPROJ_PAD * D; m.K = D; m.N = NPROJ; m.npad = NPROJ_PAD; m.ksub = D; }
    else if (mi < 12) { const int i = mi - 10; m.W = (a.in[22] + cx.z) + (size_t)i * D * D; m.WT = (bf16_t*)(ws + WS_WOUT) + (size_t)i * D * D; m.K = D; m.N = D; m.npad = D; m.ksub = D / 2; }
    else if (mi < 14) { const int i = mi - 12; m.W = (a.in[23] + cx.z) + (size_t)i * D * NDOWN; m.WT = (bf16_t*)(ws + WS_WDOWN) + (size_t)i * NDOWN_PAD * D; m.K = D; m.N = NDOWN; m.npad = NDOWN_PAD; m.ksub = D / 2; }
    else if (mi < 16) { const int i = mi - 14; m.W = (a.in[26] + cx.z) + (size_t)i * 384 * 1536; m.WT = (bf16_t*)(ws + WS_WUQ) + (size_t)i * 1536 * 384; m.K = 384; m.N = 1536; m.npad = 1536; m.ksub = 384; }
    else if (mi < 18) { const int i = mi - 16; m.W = (a.in[27] + cx.z) + (size_t)i * 256 * 2048; m.WT = (bf16_t*)(ws + WS_WUKV) + (size_t)i * 2048 * 256; m.K = 256; m.N = 2048; m.npad = 2048; m.ksub = 256; }
    else              { const int i = mi - 18; m.W = (a.in[28] + cx.z) + (size_t)i * D * D; m.WT = (bf16_t*)(ws + WS_WO) + (size_t)i * D * D; m.K = D; m.N = D; m.npad = D; m.ksub = D / 2; }
    m.items = (m.K / 64) * (m.N / 32);
    return m;
}

__device__ __forceinline__ void prologue(const Args& a, const Ctx& cx, LAS unsigned char* lds) {
    const int tid = cx.tid, lane = tid & 63, wave = tid >> 6, G = cx.G, bid = cx.bid;
    unsigned char* ws = cx.ws;
    {
        LAS float* sc = (LAS float*)lds;
        LAS float* red = (LAS float*)(lds + 12288);
        for (int i = tid; i < 3 * D; i += NTHREADS) { const int g = i >> 10, k = i & 1023; const float v = (g == 0) ? (a.in[9] + cx.z)[k] : (a.in[8] + cx.z)[(g - 1) * D + k]; sc[i] = silu_f(v); }
        __syncthreads();
        float* MOD = (float*)(ws + WS_MOD);
        for (int it = bid; it < 4 * 48; it += G) {
            const int l = it / 48, jb = it % 48, jq = tid & 31, kg = tid >> 5, j = jb * 128 + jq * 4;
            const float* wp = (a.in[10] + cx.z) + ((size_t)l * D + kg * 64) * 6144 + j;
            f32x4 a0 = {0.f, 0.f, 0.f, 0.f}, a1 = a0, a2 = a0;
#pragma unroll 32
            for (int k = 0; k < 64; ++k) { const f32x4 w = *(const f32x4*)(wp + (size_t)k * 6144); const int kk = kg * 64 + k;
                a0 += w * sc[kk]; a1 += w * sc[D + kk]; a2 += w * sc[2 * D + kk]; }
#pragma unroll
            for (int e = 0; e < 4; ++e) { red[(kg * 3 + 0) * 128 + jq * 4 + e] = a0[e]; red[(kg * 3 + 1) * 128 + jq * 4 + e] = a1[e]; red[(kg * 3 + 2) * 128 + jq * 4 + e] = a2[e]; }
            __syncthreads();
            if (tid < 384) { const int g = tid >> 7, jj = tid & 127; float s = 0.f;
#pragma unroll
                for (int q = 0; q < 16; ++q) s += red[(q * 3 + g) * 128 + jj];
                MOD[((size_t)l * 3 + g) * 6144 + jb * 128 + jj] = s + (a.in[11] + cx.z)[(size_t)l * 6144 + jb * 128 + jj]; }
            __syncthreads();
        }
    }
    __syncthreads();
    {
        LAS float* scr = (LAS float*)(lds + wave * 16384);
        const int gw = bid * NWAVES + wave, NGW = G * NWAVES;
        int mi = 0, base = 0;
        MatDesc m = get_mat(a, cx, 0);
        int g = gw;
        while (mi < 20 && g - base >= m.items) { base += m.items; ++mi; if (mi < 20) m = get_mat(a, cx, mi); }
        float wv[32];
        if (mi < 20) transpose_load(m.W, m.N, g - base, lane, wv);
        while (mi < 20) {
            const MatDesc mc = m; const int itc = g - base;
            g += NGW;
            while (mi < 20 && g - base >= m.items) { base += m.items; ++mi; if (mi < 20) m = get_mat(a, cx, mi); }
            float wn[32];
            if (mi < 20) transpose_load(m.W, m.N, g - base, lane, wn);
            transpose_finish(mc.N, mc.WT, mc.npad, mc.ksub, scr, itc, lane, wv);
#pragma unroll
            for (int i = 0; i < 32; ++i) wv[i] = wn[i];
        }
    }
    {
        const size_t gt = (size_t)bid * NTHREADS + tid, NGT = (size_t)G * NTHREADS;
        for (int i = 0; i < 2; ++i) {
            u32x4* z1 = (u32x4*)((bf16_t*)(ws + WS_WIN) + (size_t)i * NPROJ_PAD * D + (size_t)NPROJ * D);
            for (size_t x = gt; x < (size_t)(NPROJ_PAD - NPROJ) * D / 8; x += NGT) z1[x] = (u32x4){0u, 0u, 0u, 0u};
            for (int ks = 0; ks < 2; ++ks) {
                u32x4* z2 = (u32x4*)((bf16_t*)(ws + WS_WDOWN) + (size_t)i * NDOWN_PAD * D + (size_t)ks * NDOWN_PAD * (D / 2) + (size_t)NDOWN * (D / 2));
                for (size_t x = gt; x < (size_t)(NDOWN_PAD - NDOWN) * (D / 2) / 8; x += NGT) z2[x] = (u32x4){0u, 0u, 0u, 0u}; }
        }
        f32x2* tab64 = (f32x2*)(ws + WS_TAB); f32x2* tab32 = tab64 + 64 * 16;
        for (size_t x = gt; x < 64 * 16; x += NGT) { const int pos = (int)x >> 4, f = (int)x & 15; const float inv = powf(10000.f, -(float)f / 16.f); const float ang = (float)pos * inv; tab64[x] = (f32x2){cosf(ang), sinf(ang)}; }
        for (size_t x = gt; x < 64 * 8; x += NGT) { const int pos = (int)x >> 3, f = (int)x & 7; const float inv = powf(10000.f, -(float)f / 8.f); const float ang = (float)pos * inv; tab32[x] = (f32x2){cosf(ang), sinf(ang)}; }
        bf16_t* csk = (bf16_t*)(ws + WS_CSK); bf16_t* csv = (bf16_t*)(ws + WS_CSV);
        for (size_t x = gt; x < (size_t)2 * 2 * 512 * 128 / 4; x += NGT) {
            const size_t e = x * 4; const int b = (int)(e / (2 * 65536)), i = (int)(e / 65536) & 1; const size_t r = e % 65536;
            const size_t d = ((size_t)(i * 2 + b)) * 65536 + r;
            const f32x4 k = *(const f32x4*)((a.in[4] + cx.z) + e), v = *(const f32x4*)((a.in[5] + cx.z) + e);
            *(u32x2*)(csk + d) = (u32x2){pk2(k[0], k[1]), pk2(k[2], k[3])};
            *(u32x2*)(csv + d) = (u32x2){pk2(v[0], v[1]), pk2(v[2], v[3])};
        }
    }
}

__device__ __forceinline__ int mod_group(int r) { return r < TP ? 0 : 1 + ((r - TP) >> 10); }

__device__ __forceinline__ void pre_rows(const Args& a, const Ctx& cx, int l) {
    constexpr int RB = 3;
    const int lane = cx.tid & 63, gw = cx.bid * NWAVES + (cx.tid >> 6), NGW = cx.G * NWAVES;
    const float* MOD = (const float*)(cx.ws + WS_MOD) + (size_t)l * 3 * 6144;
    const float* gA = (a.in[12] + cx.z) + (size_t)l * 4 * D;
    bf16_t* H = (bf16_t*)(cx.ws + WS_H);
    for (int rb = gw * RB; rb < T; rb += NGW * RB) {
        f32x4 v[RB][4], vg[4]; float s[RB];
#pragma unroll
        for (int j = 0; j < 4; ++j) vg[j] = *(const f32x4*)(gA + lane * 4 + 256 * j);
#pragma unroll
        for (int q = 0; q < RB; ++q) { const int r = (rb + q < T) ? rb + q : T - 1;
            const float* xr = (r < TP) ? (a.in[0] + cx.z) + (size_t)r * D : (a.in[1] + cx.z) + (size_t)(r - TP) * D;
            float t = 0.f;
#pragma unroll
            for (int j = 0; j < 4; ++j) { v[q][j] = *(const f32x4*)(xr + lane * 4 + 256 * j); t += v[q][j][0] * v[q][j][0] + v[q][j][1] * v[q][j][1] + v[q][j][2] * v[q][j][2] + v[q][j][3] * v[q][j][3]; }
            s[q] = t; }
#pragma unroll
        for (int off = 1; off < 64; off <<= 1) {
#pragma unroll
            for (int q = 0; q < RB; ++q) s[q] += __shfl_xor(s[q], off); }
#pragma unroll
        for (int q = 0; q < RB; ++q) { const int r = rb + q; if (r >= T) continue;
            const float rstd = rsqrtf(s[q] * (1.f / D) + EPS);
            const float* m = MOD + (size_t)mod_group(r) * 6144;
#pragma unroll
            for (int j = 0; j < 4; ++j) { const int c = lane * 4 + 256 * j;
                const f32x4 sh = *(const f32x4*)(m + c), scl = *(const f32x4*)(m + D + c);
                const f32x4 h = v[q][j] * rstd * vg[j] * (scl + 1.f) + sh;
                *(u32x2*)(H + (size_t)r * D + c) = (u32x2){pk2(h[0], h[1]), pk2(h[2], h[3])}; } }
    }
}

__device__ __forceinline__ void post_rows(const Args& a, const Ctx& cx, bool x_from_input, const float* gate_base  , const float* gB,
                                          bool has_next, const float* gC, const float* shift_base, const float* scale_base, bool dry) {
    constexpr int RB = 3;
    const int lane = cx.tid & 63, gw = cx.bid * NWAVES + (cx.tid >> 6), NGW = cx.G * NWAVES;
    const bf16_t* OUT = (const bf16_t*)(cx.ws + WS_OUT);
    bf16_t* H = dry ? (bf16_t*)(cx.ws + WS_U + 24 * MiB) : (bf16_t*)(cx.ws + WS_H);
    float* xout = dry ? (float*)(cx.ws + WS_U) : cx.out;
    for (int rb = gw * RB; rb < T; rb += NGW * RB) {
        f32x4 o[RB][4], x[RB][4]; float s[RB], s2[RB]; size_t mg[RB];
        const size_t mg0 = (size_t)mod_group(rb < T ? rb : T - 1) * 6144;
        f32x4 vgB[4], vgt[4];
#pragma unroll
        for (int j = 0; j < 4; ++j) { const int c = lane * 4 + 256 * j; vgB[j] = *(const f32x4*)(gB + c); vgt[j] = *(const f32x4*)(gate_base + mg0 + c); }
#pragma unroll
        for (int q = 0; q < RB; ++q) { const int r = (rb + q < T) ? rb + q : T - 1;
            const float* xr = x_from_input ? ((r < TP) ? (a.in[0] + cx.z) + (size_t)r * D : (a.in[1] + cx.z) + (size_t)(r - TP) * D) : cx.out + (size_t)r * D;
            mg[q] = (size_t)mod_group(r) * 6144;
#pragma unroll
            for (int j = 0; j < 4; ++j) { const int c = lane * 4 + 256 * j;
                { const u32x2 p0 = *(const u32x2*)(OUT + (size_t)r * D + c), p1 = *(const u32x2*)(OUT + OUT_SPLIT + (size_t)r * D + c);
                  o[q][j] = (f32x4){bflo(p0.x) + bflo(p1.x), bfhi(p0.x) + bfhi(p1.x), bflo(p0.y) + bflo(p1.y), bfhi(p0.y) + bfhi(p1.y)}; }
                x[q][j] = *(const f32x4*)(xr + c); } }
#pragma unroll
        for (int q = 0; q < RB; ++q) { float t = 0.f;
#pragma unroll
            for (int j = 0; j < 4; ++j) t += o[q][j][0] * o[q][j][0] + o[q][j][1] * o[q][j][1] + o[q][j][2] * o[q][j][2] + o[q][j][3] * o[q][j][3];
            s[q] = t; }
#pragma unroll
        for (int off = 1; off < 64; off <<= 1) {
#pragma unroll
            for (int q = 0; q < RB; ++q) s[q] += __shfl_xor(s[q], off); }
#pragma unroll
        for (int q = 0; q < RB; ++q) { const int r = rb + q; const float rstd = rsqrtf(s[q] * (1.f / D) + EPS); float t = 0.f;
            const bool same = (mg[q] == mg0);
#pragma unroll
            for (int j = 0; j < 4; ++j) { const int c = lane * 4 + 256 * j;
                const f32x4 gt = same ? vgt[j] : *(const f32x4*)(gate_base + mg[q] + c);
                x[q][j] = x[q][j] + gt * (o[q][j] * rstd * vgB[j]);
                if (r < T) *(f32x4*)(xout + (size_t)r * D + c) = x[q][j];
                t += x[q][j][0] * x[q][j][0] + x[q][j][1] * x[q][j][1] + x[q][j][2] * x[q][j][2] + x[q][j][3] * x[q][j][3]; }
            s2[q] = t; }
        if (has_next) {
            f32x4 vgC[4], vsh[4], vsc[4];
#pragma unroll
            for (int j = 0; j < 4; ++j) { const int c = lane * 4 + 256 * j; vgC[j] = *(const f32x4*)(gC + c); vsh[j] = *(const f32x4*)(shift_base + mg0 + c); vsc[j] = *(const f32x4*)(scale_base + mg0 + c); }
#pragma unroll
            for (int off = 1; off < 64; off <<= 1) {
#pragma unroll
                for (int q = 0; q < RB; ++q) s2[q] += __shfl_xor(s2[q], off); }
#pragma unroll
            for (int q = 0; q < RB; ++q) { const int r = rb + q; const float rstd2 = rsqrtf(s2[q] * (1.f / D) + EPS);
                const bool same = (mg[q] == mg0);
#pragma unroll
                for (int j = 0; j < 4; ++j) { const int c = lane * 4 + 256 * j;
                    const f32x4 sh = same ? vsh[j] : *(const f32x4*)(shift_base + mg[q] + c), scl = same ? vsc[j] : *(const f32x4*)(scale_base + mg[q] + c);
                    const f32x4 h = x[q][j] * rstd2 * vgC[j] * (scl + 1.f) + sh;
                    if (r < T) *(u32x2*)(H + (size_t)r * D + c) = (u32x2){pk2(h[0], h[1]), pk2(h[2], h[3])}; } }
        }
    }
}

__device__ __forceinline__ void mla_mid(const Args& a, const Ctx& cx, int i) {
    constexpr int RB = 3;
    const int lane = cx.tid & 63, gw = cx.bid * NWAVES + (cx.tid >> 6), NGW = cx.G * NWAVES;
    const float* DOWN = (const float*)(cx.ws + WS_OUT);
    bf16_t* CQ = (bf16_t*)(cx.ws + WS_CQ); bf16_t* CKV = (bf16_t*)(cx.ws + WS_CKV); bf16_t* KR = (bf16_t*)(cx.ws + WS_KR);
    const float* gq = (a.in[24] + cx.z) + (size_t)i * 384; const float* gkv = (a.in[25] + cx.z) + (size_t)i * 256;
    const f32x2* tab32 = (const f32x2*)(cx.ws + WS_TAB) + 64 * 16;
    for (int r = T + gw; r < T + 1024; r += NGW) {
        const int rr = r - T, b = rr >> 9, j = rr & 511;
        const float* src = (a.in[6] + cx.z) + ((size_t)((b * 2 + i) * 512 + j)) * 256;
        float v[4];
#pragma unroll
        for (int q = 0; q < 4; ++q) v[q] = src[lane + 64 * q];
        const float kr = (lane < 32) ? (a.in[7] + cx.z)[((size_t)((b * 2 + i) * 512 + j)) * 32 + lane] : 0.f;
#pragma unroll
        for (int q = 0; q < 4; ++q) CKV[(size_t)r * 256 + lane + 64 * q] = (bf16_t)f2bf(v[q]);
        if (lane < 32) KR[(size_t)r * 32 + lane] = (bf16_t)f2bf(kr);
    }
    for (int rb = gw * RB; rb < T; rb += NGW * RB) {
        float q[RB][6], kv[RB][4], kr[RB], ot[RB], sq[RB], sk[RB], vq[6], vk[4];
#pragma unroll
        for (int j = 0; j < 6; ++j) vq[j] = gq[lane + 64 * j];
#pragma unroll
        for (int j = 0; j < 4; ++j) vk[j] = gkv[lane + 64 * j];
#pragma unroll
        for (int u = 0; u < RB; ++u) { const int r = (rb + u < T) ? rb + u : T - 1; const float* dr = DOWN + (size_t)r * NDOWN_PAD;
#pragma unroll
            for (int j = 0; j < 6; ++j) q[u][j] = dr[lane + 64 * j] + dr[DOWN_SPLIT + lane + 64 * j];
#pragma unroll
            for (int j = 0; j < 4; ++j) kv[u][j] = dr[384 + lane + 64 * j] + dr[DOWN_SPLIT + 384 + lane + 64 * j];
            kr[u] = dr[640 + (lane & 31)] + dr[DOWN_SPLIT + 640 + (lane & 31)];
            ot[u] = dr[640 + ((lane & 31) ^ 8)] + dr[DOWN_SPLIT + 640 + ((lane & 31) ^ 8)]; }
#pragma unroll
        for (int u = 0; u < RB; ++u) { float s = 0.f, t = 0.f;
#pragma unroll
            for (int j = 0; j < 6; ++j) s += q[u][j] * q[u][j];
#pragma unroll
            for (int j = 0; j < 4; ++j) t += kv[u][j] * kv[u][j];
            sq[u] = s; sk[u] = t; }
#pragma unroll
        for (int off = 1; off < 64; off <<= 1) {
#pragma unroll
            for (int u = 0; u < RB; ++u) { sq[u] += __shfl_xor(sq[u], off); sk[u] += __shfl_xor(sk[u], off); } }
#pragma unroll
        for (int u = 0; u < RB; ++u) { const int r = rb + u; if (r >= T) continue;
            const float rq = rsqrtf(sq[u] * (1.f / 384.f) + EPS), rk = rsqrtf(sk[u] * (1.f / 256.f) + EPS);
#pragma unroll
            for (int j = 0; j < 6; ++j) CQ[(size_t)r * 384 + lane + 64 * j] = (bf16_t)f2bf(q[u][j] * rq * vq[j]);
#pragma unroll
            for (int j = 0; j < 4; ++j) { const float v = kv[u][j] * rk * vk[j]; CKV[(size_t)r * 256 + lane + 64 * j] = (bf16_t)f2bf(v);
                if (r < TP) { const int b = r >> 8, t = r & 255; cx.out[O_CKV + ((size_t)((b * 2 + i) * 256 + t)) * 256 + lane + 64 * j] = v; } }
            if (lane < 32) {
                if (r < TP) { const int b = r >> 8, t = r & 255; cx.out[O_CKR + ((size_t)((b * 2 + i) * 256 + t)) * 32 + lane] = kr[u]; KR[(size_t)r * 32 + lane] = (bf16_t)f2bf(kr[u]); }
                else {
                    const int t = (r - TP) & 1023, half = lane >> 4, p = (lane >> 3) & 1, f = lane & 7, pos = half ? (t & 63) : (t >> 6);
                    const f32x2 cs = tab32[pos * 8 + f];
                    const float v = p ? (ot[u] * cs[1] + kr[u] * cs[0]) : (kr[u] * cs[0] - ot[u] * cs[1]);
                    KR[(size_t)r * 32 + lane] = (bf16_t)f2bf(v);
                }
            }
        }
    }
}

struct KSeg { const bf16_t* K; int kstride; const bf16_t* K2; const bf16_t* V; int vstride; int k_lo, k_hi; int flags  ; };
struct AttnArgs { const bf16_t* Q; int qstride; int qpos0; int qrope  ; int nseg; KSeg seg0, seg1;
                  float m0, l0, scale; bf16_t* O; int ostride; const f32x2* tab64; };

__device__ __forceinline__ u32x4 rope8l(const u32x4 own, const u32x4 partner, int p, const LAS f32x2* tab) {
    float a[8], b[8], o[8]; unpack8(own, a); unpack8(partner, b);
#pragma unroll
    for (int e = 0; e < 8; ++e) { const f32x2 cs = tab[e]; o[e] = p ? (b[e] * cs[1] + a[e] * cs[0]) : (a[e] * cs[0] - b[e] * cs[1]); }
    return pack8(o);
}
__device__ __forceinline__ u32x4 rope8(const u32x4 own, const u32x4 partner, int p, const f32x2* tab) {
    float a[8], b[8], o[8]; unpack8(own, a); unpack8(partner, b);
#pragma unroll
    for (int e = 0; e < 8; ++e) { const f32x2 cs = tab[e]; o[e] = p ? (b[e] * cs[1] + a[e] * cs[0]) : (a[e] * cs[0] - b[e] * cs[1]); }
    return pack8(o);
}

template <int DQK, int QG>
__device__ __forceinline__ void attn_unit(LAS unsigned char* lds, const AttnArgs& A, const int tid) {
    constexpr int KT = 64;
    constexpr int QS = DQK + 8, VS = KT + 8, NCH = DQK / 8, NKS = DQK / 32, KCH = KT * NCH, KPT = (KCH + NTHREADS - 1) / NTHREADS, VPT = KT / 64, NT = KT / 16, NQ = 128 * QG;
    LAS bf16_t* Qs = (LAS bf16_t*)lds;
    LAS bf16_t* Ks = Qs + NQ * QS;
    LAS bf16_t* VT = Ks + 2 * KT * QS;
    LAS f32x2* TB = (LAS f32x2*)(VT + 2 * 64 * VS);
    const int lane = tid & 63, w = tid >> 6, fr = lane & 15, fq = lane >> 4;
    const int n0 = (A.seg0.k_hi - A.seg0.k_lo) / KT, n1 = (A.nseg > 1) ? ((A.seg1.k_hi - A.seg1.k_lo) / KT) : 0, ntiles = n0 + n1;
    int kkey[KPT], kch[KPT];
#pragma unroll
    for (int i = 0; i < KPT; ++i) { const int c = tid + i * NTHREADS; kkey[i] = c / NCH; kch[i] = c % NCH; }
    const int vkey = tid & 63, vch = tid >> 6;
    u32x4 kr[KPT], kp[KPT], vr[VPT]; int pf_kt = 0, pf_rope = 0, pf_mask = 0;
#define ATT_PREFETCH(j) do { const bool s0_ = (j) < n0; const KSeg S = s0_ ? A.seg0 : A.seg1; const int kt = s0_ ? (A.seg0.k_lo + KT * (j)) : (A.seg1.k_lo + KT * ((j) - n0)); \
        _Pragma("unroll") for (int i = 0; i < KPT; ++i) if (tid + i * NTHREADS < KCH) { const int d0 = kch[i] * 8; \
            if (DQK == 96 && kch[i] >= 8) kr[i] = *(const u32x4*)(S.K2 + (size_t)(kt + kkey[i]) * 32 + (d0 - 64)); \
            else { const bf16_t* src = S.K + (size_t)(kt + kkey[i]) * S.kstride; kr[i] = *(const u32x4*)(src + d0); if (DQK == 64 && (S.flags & 1)) kp[i] = *(const u32x4*)(src + (d0 ^ 16)); } } \
        _Pragma("unroll") for (int i = 0; i < VPT; ++i) vr[i] = *(const u32x4*)(S.V + (size_t)(kt + vkey + 64 * i) * S.vstride + vch * 8); \
        pf_kt = kt; pf_rope = S.flags & 1; pf_mask = S.flags & 2; } while (0)
#define ATT_WRITE(buf) do { LAS bf16_t* Kb = Ks + (buf) * KT * QS; LAS bf16_t* Vb = VT + (buf) * 64 * VS; \
        _Pragma("unroll") for (int i = 0; i < KPT; ++i) if (tid + i * NTHREADS < KCH) { u32x4 v = kr[i]; \
            if (DQK == 64 && pf_rope) { const int t = pf_kt + kkey[i], ch = kch[i], half = ch >> 2, p = (ch >> 1) & 1, f0 = (ch & 1) * 8, pos = half ? (t & 63) : (t >> 6); v = rope8l(v, kp[i], p, TB + pos * 16 + f0); } \
            *(LAS u32x4*)(Kb + kkey[i] * QS + kch[i] * 8) = v; } \
        _Pragma("unroll") for (int i = 0; i < VPT; ++i) { LAS bf16_t* dst = Vb + (vch * 8) * VS + vkey + 64 * i; const u32x4 v = vr[i]; \
          dst[0 * VS] = (bf16_t)(v.x & 0xffff); dst[1 * VS] = (bf16_t)(v.x >> 16); dst[2 * VS] = (bf16_t)(v.y & 0xffff); dst[3 * VS] = (bf16_t)(v.y >> 16); \
          dst[4 * VS] = (bf16_t)(v.z & 0xffff); dst[5 * VS] = (bf16_t)(v.z >> 16); dst[6 * VS] = (bf16_t)(v.w & 0xffff); dst[7 * VS] = (bf16_t)(v.w >> 16); } } while (0)
    ATT_PREFETCH(0);
    if (A.qrope) { for (int x = tid; x < 64 * 24; x += NTHREADS) TB[x] = A.tab64[x]; }
    __syncthreads();
    if constexpr (QG > 1) {
        for (int c = tid; c < NQ * NCH; c += NTHREADS) { const int qi = c / NCH, ch = c % NCH; *(LAS u32x4*)(Qs + qi * QS + ch * 8) = *(const u32x4*)(A.Q + (size_t)qi * A.qstride + ch * 8); }
    } else {
        constexpr int NQC = NQ * NCH / NTHREADS;
        u32x4 qv[NQC], qw[NQC];
#pragma unroll
        for (int i = 0; i < NQC; ++i) { const int c = tid + i * NTHREADS, qi = c / NCH, ch = c % NCH, d0 = ch * 8;
            const bf16_t* src = A.Q + (size_t)qi * A.qstride;
            qv[i] = *(const u32x4*)(src + d0);
            if (QG == 1 && A.qrope == 1) qw[i] = *(const u32x4*)(src + (d0 ^ 16));
            else if (QG == 1 && A.qrope == 2 && ch >= 8) qw[i] = *(const u32x4*)(src + 64 + (((ch - 8) ^ 1) * 8)); }
#pragma unroll
        for (int i = 0; i < NQC; ++i) { const int c = tid + i * NTHREADS, qi = c / NCH, ch = c % NCH, d0 = ch * 8, t = A.qpos0 + qi;
            u32x4 v = qv[i];
            if (QG == 1 && A.qrope == 1) { const int half = ch >> 2, p = (ch >> 1) & 1, f0 = (ch & 1) * 8, pos = half ? (t & 63) : (t >> 6); v = rope8l(v, qw[i], p, TB + pos * 16 + f0); }
            else if (QG == 1 && A.qrope == 2 && ch >= 8) { const int c2 = ch - 8, half = c2 >> 1, p = c2 & 1, pos = half ? (t & 63) : (t >> 6); v = rope8l(v, qw[i], p, TB + 64 * 16 + pos * 8); }
            *(LAS u32x4*)(Qs + qi * QS + d0) = v; }
    }
    ATT_WRITE(0);
    int cur_kt = pf_kt, cur_mask = pf_mask;
    if (ntiles > 1) ATT_PREFETCH(1);
    __syncthreads();
    bf16x8 Qf[QG][NKS];
#pragma unroll
    for (int g = 0; g < QG; ++g)
#pragma unroll
        for (int ks = 0; ks < NKS; ++ks) Qf[g][ks] = *(const LAS bf16x8*)(Qs + (g * 128 + w * 16 + fr) * QS + ks * 32 + fq * 8);
    const float scl2 = A.scale * 1.4426950408889634f;
    float m[QG], l[QG];
    f32x4 Oa[QG][4];
#pragma unroll
    for (int g = 0; g < QG; ++g) { m[g] = (A.m0 > -1e29f) ? A.m0 * 1.4426950408889634f : A.m0; l[g] = (fq == 0) ? A.l0 : 0.f;
#pragma unroll
        for (int dt = 0; dt < 4; ++dt) Oa[g][dt] = (f32x4){0.f, 0.f, 0.f, 0.f}; }
    for (int j = 0; j < ntiles; ++j) {
        const LAS bf16_t* Kb = Ks + (j & 1) * KT * QS; const LAS bf16_t* Vb = VT + (j & 1) * 64 * VS;
        f32x4 st[QG][NT];
#pragma unroll
        for (int nt = 0; nt < NT; ++nt) {
#pragma unroll
            for (int g = 0; g < QG; ++g) st[g][nt] = (f32x4){0.f, 0.f, 0.f, 0.f};
#pragma unroll
            for (int ks = 0; ks < NKS; ++ks) { const bf16x8 kf = *(const LAS bf16x8*)(Kb + (nt * 16 + fr) * QS + ks * 32 + fq * 8);
#pragma unroll
                for (int g = 0; g < QG; ++g) st[g][nt] = MFMA16(kf, Qf[g][ks], st[g][nt]); } }
        if (QG > 1) __builtin_amdgcn_sched_barrier(0);
        bf16x8 pf[QG][KT / 32];
#pragma unroll
        for (int g = 0; g < QG; ++g) {
            const int qp = A.qpos0 + g * 128 + w * 16 + fr;
            float mx = -1e30f;
#pragma unroll
            for (int nt = 0; nt < NT; ++nt)
#pragma unroll
                for (int jj = 0; jj < 4; ++jj) { float sc = st[g][nt][jj] * scl2;
                    if (cur_mask) { const int kpos = cur_kt + nt * 16 + fq * 4 + jj; const int dd = qp - kpos; if (dd > 128 || dd < -128) sc = -1e30f; }
                    st[g][nt][jj] = sc; mx = fmaxf(mx, sc); }
            mx = xor16_max(mx); mx = xor32_max(mx);
            const float mn = fmaxf(m[g], mx), alpha = __builtin_amdgcn_exp2f(m[g] - mn);
            float rs = 0.f;
#pragma unroll
            for (int nt = 0; nt < NT; ++nt)
#pragma unroll
                for (int jj = 0; jj < 4; ++jj) { const float pe = __builtin_amdgcn_exp2f(st[g][nt][jj] - mn); st[g][nt][jj] = pe; rs += pe; }
            l[g] = l[g] * alpha + rs; m[g] = mn;
#pragma unroll
            for (int dt = 0; dt < 4; ++dt) Oa[g][dt] = Oa[g][dt] * alpha;
#pragma unroll
            for (int kk = 0; kk < KT / 32; ++kk) {
                u32x4 pb; pb.x = cvtpk(st[g][2 * kk][0], st[g][2 * kk][1]); pb.y = cvtpk(st[g][2 * kk][2], st[g][2 * kk][3]); pb.z = cvtpk(st[g][2 * kk + 1][0], st[g][2 * kk + 1][1]); pb.w = cvtpk(st[g][2 * kk + 1][2], st[g][2 * kk + 1][3]);
                pf[g][kk] = __builtin_bit_cast(bf16x8, pb); }
        }
        if (QG > 1) __builtin_amdgcn_sched_barrier(0);
#pragma unroll
        for (int kk = 0; kk < KT / 32; ++kk)
#pragma unroll
            for (int dt = 0; dt < 4; ++dt) {
                const LAS bf16_t* vp = Vb + (dt * 16 + fr) * VS + 32 * kk + fq * 4;
                const u32x2 v0 = *(const LAS u32x2*)vp, v1 = *(const LAS u32x2*)(vp + 16);
                const u32x4 vv = {v0.x, v0.y, v1.x, v1.y};
#pragma unroll
                for (int g = 0; g < QG; ++g) Oa[g][dt] = MFMA16(__builtin_bit_cast(bf16x8, vv), pf[g][kk], Oa[g][dt]);
            }
        if (j + 1 < ntiles) { ATT_WRITE((j + 1) & 1); cur_kt = pf_kt; cur_mask = pf_mask; if (j + 2 < ntiles) ATT_PREFETCH(j + 2); }
        __syncthreads();
    }
#undef ATT_PREFETCH
#undef ATT_WRITE
#pragma unroll
    for (int g = 0; g < QG; ++g) {
        float lg = xor16_add(l[g]); lg = xor32_add(lg);
        const float inv = 1.f / lg;
        bf16_t* op = A.O + (size_t)(g * 128 + w * 16 + fr) * A.ostride + fq * 4;
#pragma unroll
        for (int dt = 0; dt < 4; ++dt) *(u32x2*)(op + dt * 16) = (u32x2){pk2(Oa[g][dt][0] * inv, Oa[g][dt][1] * inv), pk2(Oa[g][dt][2] * inv, Oa[g][dt][3] * inv)};
    }
}

__device__ __forceinline__ void swa_unit(const Args& a, const Ctx& cx, LAS unsigned char* lds, int i, int u) {
    const bf16_t* PROJ = (const bf16_t*)(cx.ws + WS_PROJ); bf16_t* MIX = (bf16_t*)(cx.ws + WS_MIX);
    AttnArgs A;
    A.tab64 = (const f32x2*)(cx.ws + WS_TAB);
    A.qstride = NPROJ_PAD; A.ostride = D; A.scale = 0.125f; A.l0 = 1.f;
    int npass, rowq, hq;
    if (u < 128) {
        const int b = u >> 6, qt = u & 7, row0 = TP + b * 1024, q0 = qt * 128; hq = (u >> 3) & 7; const int kv = hq >> 2;
        A.qpos0 = q0; A.qrope = 1; A.nseg = 2; npass = 1; rowq = row0 + q0;
        const bf16_t* csk = (const bf16_t*)(cx.ws + WS_CSK) + ((size_t)(i * 2 + b)) * 65536 + kv * 64;
        const bf16_t* csv = (const bf16_t*)(cx.ws + WS_CSV) + ((size_t)(i * 2 + b)) * 65536 + kv * 64;
        A.seg0 = KSeg{csk, 128, nullptr, csv, 128, 0, 512, 0};
        const int lo = q0 - 128 < 0 ? 0 : q0 - 128, hi = q0 + 256 > 1024 ? 1024 : q0 + 256;
        A.seg1 = KSeg{PROJ + (size_t)row0 * NPROJ_PAD + C_KB + kv * 64, NPROJ_PAD, nullptr, PROJ + (size_t)row0 * NPROJ_PAD + C_VB + kv * 64, NPROJ_PAD, lo, hi, 3};
    } else {
        const int v = u - 128, b = v >> 3, row0 = b * 256; hq = v & 7; const int kv = hq >> 2;
        A.qpos0 = 0; A.qrope = 0; A.nseg = 1; npass = 2; rowq = row0;
        A.seg0 = KSeg{PROJ + (size_t)row0 * NPROJ_PAD + C_KB + kv * 64, NPROJ_PAD, nullptr, PROJ + (size_t)row0 * NPROJ_PAD + C_VB + kv * 64, NPROJ_PAD, 0, 256, 0};
        A.seg1 = A.seg0;
    }
    A.m0 = (a.in[21] + cx.z)[i * 8 + hq];
    for (int ps = 0; ps < npass; ++ps) {
        A.Q = PROJ + (size_t)(rowq + ps * 128) * NPROJ_PAD + C_QB + hq * 64;
        A.O = MIX + (size_t)(rowq + ps * 128) * D + 512 + hq * 64;
        if (ps) A.qpos0 += 128;
        attn_unit<64, 1>(lds, A, cx.tid);
    }
}

__device__ __forceinline__ void mla_unit(const Args& a, const Ctx& cx, LAS unsigned char* lds, int u) {
    const bf16_t* Q = (const bf16_t*)(cx.ws + WS_Q); const bf16_t* KVX = (const bf16_t*)(cx.ws + WS_KVX); const bf16_t* KR = (const bf16_t*)(cx.ws + WS_KR);
    bf16_t* MIX = (bf16_t*)(cx.ws + WS_MIX);
    AttnArgs A;
    A.tab64 = (const f32x2*)(cx.ws + WS_TAB);
    A.qstride = 1536; A.ostride = D; A.scale = 0.10206207261596577f; A.l0 = 0.f; A.m0 = -1e30f;
    if (u < 256) {
        const int b = u >> 7, h = (u >> 3) & 15, qt = u & 7, row0 = TP + b * 1024, q0 = qt * 128, crow0 = T + b * 512;
        A.Q = Q + (size_t)(row0 + q0) * 1536 + h * 96; A.qpos0 = q0; A.qrope = 2; A.nseg = 2;
        A.seg0 = KSeg{KVX + (size_t)crow0 * 2048 + h * 128, 2048, KR + (size_t)crow0 * 32, KVX + (size_t)crow0 * 2048 + h * 128 + 64, 2048, 0, 512, 0};
        A.seg1 = KSeg{KVX + (size_t)row0 * 2048 + h * 128, 2048, KR + (size_t)row0 * 32, KVX + (size_t)row0 * 2048 + h * 128 + 64, 2048, 0, 1024, 0};
        A.O = MIX + (size_t)(row0 + q0) * D + h * 64;
        attn_unit<96, 1>(lds, A, cx.tid);
    } else {
        const int v = u - 256, b = v >> 4, h = v & 15, row0 = b * 256;
        A.Q = Q + (size_t)row0 * 1536 + h * 96; A.qpos0 = 0; A.qrope = 0; A.nseg = 1;
        A.seg0 = KSeg{KVX + (size_t)row0 * 2048 + h * 128, 2048, KR + (size_t)row0 * 32, KVX + (size_t)row0 * 2048 + h * 128 + 64, 2048, 0, 256, 0};
        A.seg1 = A.seg0;
        A.O = MIX + (size_t)row0 * D + h * 64;
        attn_unit<96, 2>(lds, A, cx.tid);
    }
}

constexpr int GL_G = 0;
constexpr int GL_STF = 32768, GL_STB = 51200;
constexpr int GL_LO = 32768, GL_WF = 40960, GL_WB = 45056, GL_BF = 49152, GL_BB = 49408;
constexpr int GL_QF = 69632, GL_KF = 78848, GL_QB = 88064, GL_KB = 97280;
constexpr int GL_VT = 106496;
constexpr int GL_AF = 124928, GL_AB = 134144;

__device__ __forceinline__ void gla_gates(const Args& a, const Ctx& cx, LAS unsigned char* lds, int i, int tok0, int h) {
    const int tid = cx.tid;
    const bf16_t* PROJ = (const bf16_t*)(cx.ws + WS_PROJ);
    LAS float* LO = (LAS float*)(lds + GL_LO); LAS float* WF = (LAS float*)(lds + GL_WF); LAS float* WB = (LAS float*)(lds + GL_WB);
    LAS float* BF = (LAS float*)(lds + GL_BF); LAS float* BB = (LAS float*)(lds + GL_BB);
    LAS float* Gf = (LAS float*)(lds + GL_G); LAS float* Gb = Gf + 4096;
    { const int t = tid >> 3, j0 = (tid & 7) * 4; const u32x2 v = *(const u32x2*)(PROJ + (size_t)(tok0 + t) * NPROJ_PAD + C_LO + j0);
      LO[t * 32 + j0] = bflo(v.x); LO[t * 32 + j0 + 1] = bfhi(v.x); LO[t * 32 + j0 + 2] = bflo(v.y); LO[t * 32 + j0 + 3] = bfhi(v.y); }
    for (int x = tid; x < 1024; x += NTHREADS) { const int r = x >> 6, d = x & 63;
        WF[x] = (a.in[16] + cx.z)[((size_t)i * 16 + r) * 256 + h * 64 + d]; WB[x] = (a.in[18] + cx.z)[((size_t)i * 16 + r) * 256 + h * 64 + d]; }
    if (tid < 64) { BF[tid] = (a.in[17] + cx.z)[i * 256 + h * 64 + tid]; BB[tid] = (a.in[19] + cx.z)[i * 256 + h * 64 + tid]; }
    __syncthreads();
    { const int d = tid & 63, tg = tid >> 6;
      LAS float* SEG = (LAS float*)(lds + GL_LO + 8192 + 8192 + 1024);
      float wf[16], wb[16];
#pragma unroll
      for (int r = 0; r < 16; ++r) { wf[r] = WF[r * 64 + d]; wb[r] = WB[r * 64 + d]; }
      const float bfv = BF[d], bbv = BB[d];
      float gf[8], gb[8];
#pragma unroll
      for (int tt = 0; tt < 8; ++tt) { const int t = tg * 8 + tt; float xf = bfv, xb = bbv;
#pragma unroll
          for (int r = 0; r < 16; ++r) { xf += LO[t * 32 + r] * wf[r]; xb += LO[t * 32 + 16 + r] * wb[r]; }
          gf[tt] = (fminf(xf, 0.f) - log1pf(__expf(-fabsf(xf)))) * (1.f / 16.f); gb[tt] = (fminf(xb, 0.f) - log1pf(__expf(-fabsf(xb)))) * (1.f / 16.f); }
#pragma unroll
      for (int tt = 1; tt < 8; ++tt) gf[tt] += gf[tt - 1];
#pragma unroll
      for (int tt = 6; tt >= 0; --tt) gb[tt] += gb[tt + 1];
      SEG[tg * 64 + d] = gf[7]; SEG[512 + tg * 64 + d] = gb[0];
      __syncthreads();
      float offf = 0.f, offb = 0.f;
#pragma unroll
      for (int q = 0; q < 8; ++q) { const float a_ = SEG[q * 64 + d], b_ = SEG[512 + q * 64 + d]; offf += (q < tg) ? a_ : 0.f; offb += (q > tg) ? b_ : 0.f; }
#pragma unroll
      for (int tt = 0; tt < 8; ++tt) { const int t = tg * 8 + tt; Gf[t * 64 + d] = gf[tt] + offf; Gb[t * 64 + d] = gb[tt] + offb; } }
    __syncthreads();
}

__device__ __forceinline__ void gla_vt_load(const bf16_t* PROJ, int tok0, int h, const int tid, u32x4 (&v)[2]) {
    const int s = tid & 63, e0 = (tid >> 6) * 16;
    const bf16_t* src = PROJ + (size_t)(tok0 + s) * NPROJ_PAD + C_VA + h * 128 + e0;
    v[0] = *(const u32x4*)src; v[1] = *(const u32x4*)(src + 8);
}
__device__ __forceinline__ void gla_vt_store(LAS unsigned char* lds, const int tid, const u32x4 (&vv)[2]) {
    const int s = tid & 63, e0 = (tid >> 6) * 16;
    LAS bf16_t* VT = (LAS bf16_t*)(lds + GL_VT);
#pragma unroll
    for (int q = 0; q < 2; ++q) { const u32x4 v = vv[q]; LAS bf16_t* dst = VT + (e0 + q * 8) * 72 + s;
        dst[0 * 72] = (bf16_t)(v.x & 0xffff); dst[1 * 72] = (bf16_t)(v.x >> 16); dst[2 * 72] = (bf16_t)(v.y & 0xffff); dst[3 * 72] = (bf16_t)(v.y >> 16);
        dst[4 * 72] = (bf16_t)(v.z & 0xffff); dst[5 * 72] = (bf16_t)(v.z >> 16); dst[6 * 72] = (bf16_t)(v.w & 0xffff); dst[7 * 72] = (bf16_t)(v.w >> 16); }
}

__device__ __forceinline__ void gla_local_unit(const Args& a, const Ctx& cx, LAS unsigned char* lds, int i, int u) {
    const int cg_ = u >> 2, h = u & 3, tok0 = cg_ * 64, tid = cx.tid, lane = tid & 63, w = tid >> 6, fr = lane & 15, fq = lane >> 4;
    const bf16_t* PROJ = (const bf16_t*)(cx.ws + WS_PROJ);
    float* LOC = (float*)(cx.ws + WS_LOC); float* DEC = (float*)(cx.ws + WS_DEC);
    u32x4 vpre[2]; gla_vt_load(PROJ, tok0, h, tid, vpre);
    const u32x4 kpre = *(const u32x4*)(PROJ + (size_t)(tok0 + (tid >> 3)) * NPROJ_PAD + C_KA + h * 64 + (tid & 7) * 8);
    __syncthreads();
    gla_gates(a, cx, lds, i, tok0, h);
    LAS float* Gf = (LAS float*)(lds + GL_G); LAS float* Gb = Gf + 4096;
    LAS bf16_t* KTf = (LAS bf16_t*)(lds + GL_KF); LAS bf16_t* KTb = (LAS bf16_t*)(lds + GL_KB);
    LAS bf16_t* VT = (LAS bf16_t*)(lds + GL_VT);
    { const int s = tid >> 3, d0 = (tid & 7) * 8; const u32x4 kv = kpre;
      float k[8]; unpack8(kv, k);
#pragma unroll
      for (int e = 0; e < 8; ++e) { const int d = d0 + e;
          KTf[d * 72 + s] = (bf16_t)f2bf(k[e] * __expf(Gf[63 * 64 + d] - Gf[s * 64 + d]));
          KTb[d * 72 + s] = (bf16_t)f2bf(k[e] * __expf(Gb[d] - Gb[s * 64 + d])); } }
    gla_vt_store(lds, tid, vpre);
    if (tid < 128) { const int dir = tid >> 6, d = tid & 63; DEC[((size_t)(dir * 96 + cg_) * 4 + h) * 64 + d] = __expf(dir ? Gb[d] : Gf[63 * 64 + d]); }
    __syncthreads();
    const int dir = w >> 2, dtile = w & 3;
    const LAS bf16_t* KT = dir ? KTb : KTf;
    bf16x8 af[2];
#pragma unroll
    for (int ks = 0; ks < 2; ++ks) af[ks] = *(const LAS bf16x8*)(KT + (dtile * 16 + fr) * 72 + ks * 32 + fq * 8);
    float* dst = LOC + ((size_t)(dir * 96 + cg_) * 4 + h) * 8192;
#pragma unroll
    for (int et = 0; et < 8; ++et) { f32x4 acc = {0.f, 0.f, 0.f, 0.f};
#pragma unroll
        for (int ks = 0; ks < 2; ++ks) { const bf16x8 bfv = *(const LAS bf16x8*)(VT + (et * 16 + fr) * 72 + ks * 32 + fq * 8); acc = MFMA16(af[ks], bfv, acc); }
#pragma unroll
        for (int j = 0; j < 4; ++j) dst[(dtile * 16 + fq * 4 + j) * 128 + et * 16 + fr] = acc[j]; }
}

__device__ __forceinline__ void gla_out_unit(const Args& a, const Ctx& cx, LAS unsigned char* lds, int i, int u) {
    const int cg_ = u >> 2, h = u & 3, tok0 = cg_ * 64, tid = cx.tid, lane = tid & 63, w = tid >> 6, fr = lane & 15, fq = lane >> 4;
    const bf16_t* PROJ = (const bf16_t*)(cx.ws + WS_PROJ); bf16_t* MIX = (bf16_t*)(cx.ws + WS_MIX);
    const float* LOC = (const float*)(cx.ws + WS_LOC); const float* DEC = (const float*)(cx.ws + WS_DEC);
    u32x4 vpre[2]; gla_vt_load(PROJ, tok0, h, tid, vpre);
    const u32x4 qpre = *(const u32x4*)(PROJ + (size_t)(tok0 + (tid >> 3)) * NPROJ_PAD + C_QA + h * 64 + (tid & 7) * 8);
    const u32x4 kpre = *(const u32x4*)(PROJ + (size_t)(tok0 + (tid >> 3)) * NPROJ_PAD + C_KA + h * 64 + (tid & 7) * 8);
    const bf16_t* gpp = PROJ + (size_t)(tok0 + (tid >> 3)) * NPROJ_PAD + C_GA + h * 128 + (tid & 7) * 16;
    const u32x4 gpre0 = *(const u32x4*)gpp, gpre1 = *(const u32x4*)(gpp + 8);
    f32x4 ggp[4];
    { const float* ggq = (a.in[20] + cx.z) + i * 128 + (tid & 7) * 16;
#pragma unroll
      for (int q = 0; q < 4; ++q) ggp[q] = *(const f32x4*)(ggq + q * 4); }
    const bool fin_f = (cg_ < 64) && ((cg_ & 3) == 3), fin_b = (cg_ < 64) && ((cg_ & 3) == 0);
    f32x4 finl[4]; float find = 0.f;
    if (fin_f || fin_b) { const size_t ix = (size_t)((fin_f ? 0 : 1) * 96 + cg_) * 4 + h; find = DEC[ix * 64 + (tid >> 3)]; const float* lp = LOC + ix * 8192 + (tid >> 3) * 128 + (tid & 7) * 16;
#pragma unroll
        for (int q = 0; q < 4; ++q) finl[q] = *(const f32x4*)(lp + q * 4); }
    __syncthreads();
    gla_gates(a, cx, lds, i, tok0, h);
    LAS float* Gf = (LAS float*)(lds + GL_G); LAS float* Gb = Gf + 4096;
    const bool samp = cg_ >= 64;
    const int b = samp ? (cg_ - 64) >> 4 : cg_ >> 2, c = samp ? (cg_ - 64) & 15 : cg_ & 3, nc = samp ? 16 : 4, cbase = cg_ - c;
    {
        const int d = tid >> 3, e0 = (tid & 7) * 16;
        f32x4 Sf[4], Sb[4];
        if (samp) { const float* s0f = (a.in[2] + cx.z) + ((size_t)((b * 2 + i) * 4 + h)) * 8192 + d * 128 + e0; const float* s0b = (a.in[3] + cx.z) + ((size_t)((b * 2 + i) * 4 + h)) * 8192 + d * 128 + e0;
#pragma unroll
            for (int q = 0; q < 4; ++q) { Sf[q] = *(const f32x4*)(s0f + q * 4); Sb[q] = *(const f32x4*)(s0b + q * 4); } }
        else {
#pragma unroll
            for (int q = 0; q < 4; ++q) { Sf[q] = (f32x4){0.f, 0.f, 0.f, 0.f}; Sb[q] = Sf[q]; } }
        for (int j = 0; j < c; ++j) { const size_t ix = (size_t)(0 * 96 + cbase + j) * 4 + h; const float dec = DEC[ix * 64 + d]; const float* lp = LOC + ix * 8192 + d * 128 + e0;
#pragma unroll
            for (int q = 0; q < 4; ++q) Sf[q] = Sf[q] * dec + *(const f32x4*)(lp + q * 4); }
        for (int j = nc - 1; j > c; --j) { const size_t ix = (size_t)(1 * 96 + cbase + j) * 4 + h; const float dec = DEC[ix * 64 + d]; const float* lp = LOC + ix * 8192 + d * 128 + e0;
#pragma unroll
            for (int q = 0; q < 4; ++q) Sb[q] = Sb[q] * dec + *(const f32x4*)(lp + q * 4); }
        if (fin_f) { float* o = cx.out + O_SF + ((size_t)((b * 2 + i) * 4 + h)) * 8192 + d * 128 + e0;
#pragma unroll
            for (int q = 0; q < 4; ++q) *(f32x4*)(o + q * 4) = Sf[q] * find + finl[q]; }
        if (fin_b) { float* o = cx.out + O_SB + ((size_t)((b * 2 + i) * 4 + h)) * 8192 + d * 128 + e0;
#pragma unroll
            for (int q = 0; q < 4; ++q) *(f32x4*)(o + q * 4) = Sb[q] * find + finl[q]; }
        LAS bf16_t* STf = (LAS bf16_t*)(lds + GL_STF); LAS bf16_t* STb = (LAS bf16_t*)(lds + GL_STB);
#pragma unroll
        for (int q = 0; q < 4; ++q)
#pragma unroll
            for (int e = 0; e < 4; ++e) { STf[(e0 + q * 4 + e) * 72 + d] = (bf16_t)f2bf(Sf[q][e]); STb[(e0 + q * 4 + e) * 72 + d] = (bf16_t)f2bf(Sb[q][e]); }
    }
    {
        const int t = tid >> 3, d0 = (tid & 7) * 8;
        const u32x4 qv = qpre, kv = kpre;
        float q[8], k[8], o1[8], o2[8], o3[8], o4[8]; unpack8(qv, q); unpack8(kv, k);
#pragma unroll
        for (int e = 0; e < 8; ++e) { const float gf = Gf[t * 64 + d0 + e], gb = Gb[t * 64 + d0 + e];
            o1[e] = q[e] * 0.125f * __expf(gf); o2[e] = k[e] * __expf(-gf); o3[e] = q[e] * 0.125f * __expf(gb); o4[e] = k[e] * __expf(-gb); }
        *(LAS u32x4*)((LAS bf16_t*)(lds + GL_QF) + t * 72 + d0) = pack8(o1);
        *(LAS u32x4*)((LAS bf16_t*)(lds + GL_KF) + t * 72 + d0) = pack8(o2);
        *(LAS u32x4*)((LAS bf16_t*)(lds + GL_QB) + t * 72 + d0) = pack8(o3);
        *(LAS u32x4*)((LAS bf16_t*)(lds + GL_KB) + t * 72 + d0) = pack8(o4);
    }
    gla_vt_store(lds, tid, vpre);
    __syncthreads();
    {
        const int dir = w >> 2, tt = w & 3;
        const LAS bf16_t* Qm = (const LAS bf16_t*)(lds + (dir ? GL_QB : GL_QF)); const LAS bf16_t* Km = (const LAS bf16_t*)(lds + (dir ? GL_KB : GL_KF));
        LAS bf16_t* AT = (LAS bf16_t*)(lds + (dir ? GL_AB : GL_AF));
        bf16x8 af[2];
#pragma unroll
        for (int ks = 0; ks < 2; ++ks) af[ks] = *(const LAS bf16x8*)(Qm + (tt * 16 + fr) * 72 + ks * 32 + fq * 8);
#pragma unroll
        for (int st = 0; st < 4; ++st) { f32x4 acc = {0.f, 0.f, 0.f, 0.f};
#pragma unroll
            for (int ks = 0; ks < 2; ++ks) { const bf16x8 bfv = *(const LAS bf16x8*)(Km + (st * 16 + fr) * 72 + ks * 32 + fq * 8); acc = MFMA16(af[ks], bfv, acc); }
#pragma unroll
            for (int j = 0; j < 4; ++j) { const int t = tt * 16 + fq * 4 + j, s = st * 16 + fr; const bool keep = dir ? (s >= t) : (s <= t);
                AT[t * 72 + s] = (bf16_t)f2bf(keep ? acc[j] : 0.f); } }
    }
    __syncthreads();
    {
        const int tt = w & 3, eg = w >> 2;
        LAS float* OS = (LAS float*)(lds + GL_G);
        const LAS bf16_t* VT = (const LAS bf16_t*)(lds + GL_VT);
        bf16x8 a1[2], a2[2], a3[2], a4[2];
#pragma unroll
        for (int ks = 0; ks < 2; ++ks) { const int off = (tt * 16 + fr) * 72 + ks * 32 + fq * 8;
            a1[ks] = *(const LAS bf16x8*)((const LAS bf16_t*)(lds + GL_QF) + off); a2[ks] = *(const LAS bf16x8*)((const LAS bf16_t*)(lds + GL_AF) + off);
            a3[ks] = *(const LAS bf16x8*)((const LAS bf16_t*)(lds + GL_QB) + off); a4[ks] = *(const LAS bf16x8*)((const LAS bf16_t*)(lds + GL_AB) + off); }
        f32x4 accs[4];
#pragma unroll
        for (int q = 0; q < 4; ++q) { const int et = eg * 4 + q; f32x4 acc = {0.f, 0.f, 0.f, 0.f};
#pragma unroll
            for (int ks = 0; ks < 2; ++ks) { const int off = (et * 16 + fr) * 72 + ks * 32 + fq * 8;
                const bf16x8 b1 = *(const LAS bf16x8*)((const LAS bf16_t*)(lds + GL_STF) + off), b2 = *(const LAS bf16x8*)(VT + off), b3 = *(const LAS bf16x8*)((const LAS bf16_t*)(lds + GL_STB) + off);
                acc = MFMA16(a1[ks], b1, acc); acc = MFMA16(a2[ks], b2, acc); acc = MFMA16(a3[ks], b3, acc); acc = MFMA16(a4[ks], b2, acc); }
            accs[q] = acc; }
#pragma unroll
        for (int q = 0; q < 4; ++q)
#pragma unroll
            for (int j = 0; j < 4; ++j) OS[(tt * 16 + fq * 4 + j) * 128 + (eg * 4 + q) * 16 + fr] = accs[q][j];
    }
    __syncthreads();
    {
        const int t = tid >> 3, e0 = (tid & 7) * 16;
        const LAS float* OS = (const LAS float*)(lds + GL_G);
        float o[16]; float ss = 0.f;
#pragma unroll
        for (int e = 0; e < 16; ++e) { o[e] = OS[t * 128 + e0 + e]; ss += o[e] * o[e]; }
        ss += __shfl_xor(ss, 1); ss += __shfl_xor(ss, 2); ss += __shfl_xor(ss, 4);
        const float rstd = rsqrtf(ss * (1.f / 128.f) + EPS);
        float gt[16]; unpack8(gpre0, gt); unpack8(gpre1, gt + 8);
#pragma unroll
        for (int e = 0; e < 16; ++e) o[e] = o[e] * rstd * ggp[e >> 2][e & 3] * silu_f(gt[e]);
        bf16_t* op = MIX + (size_t)(tok0 + t) * D + h * 128 + e0;
        *(u32x4*)op = pack8(o); *(u32x4*)(op + 8) = pack8(o + 8);
    }
}


#define XB_TMO      128
#define XB_XCNT(j)  (256  + 64 * (j))
#define XB_XSUB(j)  (1280 + 64 * (j))
#define XB_XGEN(j)  (2304 + 64 * (j))
#define XB_TOP      3328
#define XB_TOPGEN   3392
#define XCD_BAR_WORDS 3456
#define XB_SPIN_CAP (1u << 18)
__device__ __forceinline__ unsigned xb_ld(unsigned* p)              { return __hip_atomic_load(p, __ATOMIC_RELAXED, __HIP_MEMORY_SCOPE_AGENT); }
__device__ __forceinline__ unsigned xb_add(unsigned* p, unsigned v) { return __hip_atomic_fetch_add(p, v, __ATOMIC_RELAXED, __HIP_MEMORY_SCOPE_AGENT); }
__device__ __forceinline__ unsigned xb_xcc_id() { return (unsigned)__builtin_amdgcn_s_getreg((3 << 11) | 20) & 0xFu; }
#define XB_SPIN(cond, bar) do { unsigned _sp = 0; while (cond) { __builtin_amdgcn_s_sleep(1); \
    if ((++_sp & 255u) == 0u) { if (xb_ld(&(bar)[XB_TMO])) break; if (_sp > XB_SPIN_CAP) { atomicAdd(&(bar)[XB_TMO], 1u); break; } } } } while (0)
struct XcdBarrier { unsigned* bar; unsigned x; volatile LAS unsigned* st; };
__device__ __forceinline__ XcdBarrier xcd_barrier_post(unsigned* bar, volatile LAS unsigned* st, const int tid) {
    XcdBarrier b; b.bar = bar; b.x = xb_xcc_id(); b.st = st;
    if (tid == 0) (void)xb_add(&bar[XB_XCNT(b.x)], 1u);
    return b;
}
__device__ __forceinline__ void xcd_barrier_complete(unsigned* bar, unsigned x, unsigned& nloc, unsigned& nx) {
    const unsigned G = gridDim.x * gridDim.y * gridDim.z;
    unsigned sum, cnt, mine, sp = 0u;
    for (;;) {
        sum = 0u; cnt = 0u; mine = 0u;
#pragma unroll
        for (unsigned j = 0; j < 16; ++j) { const unsigned c = xb_ld(&bar[XB_XCNT(j)]); sum += c; cnt += (c > 0u) ? 1u : 0u; mine = (j == x) ? c : mine; }
        if (sum == G) break;
        __builtin_amdgcn_s_sleep(1);
        if ((++sp & 255u) == 0u) { if (xb_ld(&bar[XB_TMO])) break; if (sp > XB_SPIN_CAP) { atomicAdd(&bar[XB_TMO], 1u); break; } }
    }
    nloc = mine > 0u ? mine : 1u; nx = cnt > 0u ? cnt : 1u;
}
__device__ __forceinline__ void xcd_barrier(const XcdBarrier& b, const int tid) {
    asm volatile("s_waitcnt vmcnt(0)" ::: "memory");
    __syncthreads();
    if (tid == 0) {
        unsigned* bar = b.bar;
        __builtin_amdgcn_s_waitcnt(0);
        unsigned nloc = b.st[0], nx = b.st[1];
        if (nloc == 0u) { xcd_barrier_complete(bar, b.x, nloc, nx); b.st[0] = nloc; b.st[1] = nx; }
        const unsigned old = xb_add(&bar[XB_XSUB(b.x)], 1u);
        const unsigned gen = old / nloc;
        if (old + 1u == (gen + 1u) * nloc) {
            __builtin_amdgcn_fence(__ATOMIC_RELEASE, "agent");
            asm volatile("s_waitcnt vmcnt(0)" ::: "memory");
            const unsigned og = xb_add(&bar[XB_TOP], 1u);
            const unsigned tg = og / nx;
            if (og + 1u == (tg + 1u) * nx) xb_add(&bar[XB_TOPGEN], 1u);
            else XB_SPIN(xb_ld(&bar[XB_TOPGEN]) == tg, bar);
            __builtin_amdgcn_fence(__ATOMIC_ACQUIRE, "agent");
            asm volatile("s_waitcnt vmcnt(0)" ::: "memory");
        } else {
            XB_SPIN(xb_ld(&bar[XB_TOPGEN]) == gen, bar);
            __builtin_amdgcn_fence(__ATOMIC_ACQUIRE, "agent");
            asm volatile("s_waitcnt vmcnt(0)" ::: "memory");
        }
    }
    __syncthreads();
}

enum { K_PRO = 0, K_PRE, K_G1, K_A1, K_A2, K_DOWN, K_MID, K_UQKV, K_MLA, K_OUTP, K_POST1, K_FF1, K_FF2, K_POST2 };
constexpr int N_PHASES = 2 + 2 * 8 + 2 * 9;
#ifndef EN_MASK
#define EN_MASK 0xFFFFFFFFu
#endif
#define ENB(k) (((EN_MASK) >> (k)) & 1u)
#ifndef DUP_MASK
#define DUP_MASK 0u
#endif
#ifndef BAR_REPS
#define BAR_REPS 1
#endif

__global__ void __launch_bounds__(NTHREADS, 2) mega_fwd(Args args) {
    extern __shared__ __attribute__((aligned(16))) unsigned char lds_raw[];
    LAS unsigned char* lds = (LAS unsigned char*)lds_raw;
    const int lo = args.ph_lo, hi = args.ph_hi;
    const int wave_s = __builtin_amdgcn_readfirstlane((int)(threadIdx.x >> 6));
#define MY_TID(dst) do { int _l; asm volatile("v_mbcnt_lo_u32_b32 %0, -1, 0\n\tv_mbcnt_hi_u32_b32 %0, -1, %0" : "=v"(_l)); dst = wave_s * 64 + _l; } while (0)
    {
        int tid0; MY_TID(tid0);
        volatile LAS unsigned* bst = (volatile LAS unsigned*)(lds + LDS_BYTES - 64);
        if (tid0 < 2) bst[tid0] = 0u;
        __syncthreads();
        (void)xcd_barrier_post((unsigned*)(args.ws + WS_CTL), bst, tid0);
    }
    for (int p = lo; p < hi; ++p) {
        int kind, l;
        if (p == 0) { kind = K_PRO; l = 0; }
        else if (p == 1) { kind = K_PRE; l = 0; }
        else {
            const int q = p - 2, pair = q / 17, r = q - pair * 17;
            if (r < 8) { l = 2 * pair; kind = (r == 0) ? K_G1 : (r == 1) ? K_A1 : (r == 2) ? K_A2 : (r == 3) ? K_OUTP : (r == 4) ? K_POST1 : (r == 5) ? K_FF1 : (r == 6) ? K_FF2 : K_POST2; }
            else { const int r2 = r - 8; l = 2 * pair + 1; kind = (r2 == 0) ? K_DOWN : (r2 == 1) ? K_MID : (r2 == 2) ? K_UQKV : (r2 == 3) ? K_MLA : (r2 == 4) ? K_OUTP : (r2 == 5) ? K_POST1 : (r2 == 6) ? K_FF1 : (r2 == 7) ? K_FF2 : K_POST2; }
        }
        const int reps = ((DUP_MASK >> kind) & 1u) ? 2 : 1;
        for (int rep = 0; rep < reps; ++rep) {
        if (rep) __syncthreads();
        Ctx cx; cx.z = 0; MY_TID(cx.tid); cx.bid = blockIdx.x; cx.G = gridDim.x;
        asm volatile("" : "+s"(cx.z), "+s"(kind), "+s"(l), "+v"(cx.tid), "+s"(cx.bid), "+s"(cx.G));
        cx.ws = args.ws + cx.z; cx.out = args.out + cx.z;
        unsigned char* ws = cx.ws;
        const int i = l >> 1, G = cx.G, bid = cx.bid;
        switch (kind) {
        case K_PRO: if (ENB(0)) prologue(args, cx, lds); break;
        case K_PRE: if (ENB(1)) pre_rows(args, cx, 0); break;
        case K_G1: if (ENB(2)) {
            pg8::Gemm g{(const bf16_t*)(ws + WS_H), (const bf16_t*)(ws + WS_WIN) + (size_t)i * NPROJ_PAD * D, T, NPROJ_PAD, D, D, D, NPROJ_PAD / 256, 0};
            pg8::StaticOrder S; S.init(T, NPROJ_PAD, G, bid);
            pg8::EpiProj E{(bf16_t*)(ws + WS_PROJ), cx.out, i};
            pg8::gemm_phase<pg8::EpiProj, pg8::StaticOrder>(lds, g, S, E, cx.tid);
        } break;
        case K_A1:
            if (G == 256) {
                if (bid < 128) { if (ENB(3)) swa_unit(args, cx, lds, i, bid); if (ENB(4)) gla_local_unit(args, cx, lds, i, bid); }
                else { const int q = bid - 128; if (ENB(3)) swa_unit(args, cx, lds, i, 128 + q);
                       if (ENB(4)) { gla_local_unit(args, cx, lds, i, 128 + 2 * q); gla_local_unit(args, cx, lds, i, 128 + 2 * q + 1); } }
            } else { for (int u = bid; u < 640; u += G) { if (u < 256) { if (ENB(3)) swa_unit(args, cx, lds, i, u); } else { if (ENB(4)) gla_local_unit(args, cx, lds, i, u - 256); } } }
            break;
        case K_A2:
            if (G == 256) {
                if (bid < 128) { if (ENB(5)) { gla_out_unit(args, cx, lds, i, 256 + bid); gla_out_unit(args, cx, lds, i, bid); } }
                else { if (ENB(5)) gla_out_unit(args, cx, lds, i, bid); }
            } else { for (int u = bid; u < 384; u += G) if (ENB(5)) gla_out_unit(args, cx, lds, i, u); }
            break;
        case K_MID: if (ENB(7)) mla_mid(args, cx, i); break;
        case K_UQKV: if (ENB(8)) {
            for (int s = 0; s < 2; ++s) {
                pg8::Gemm g;
                if (s == 0) g = pg8::Gemm{(const bf16_t*)(ws + WS_CQ), (const bf16_t*)(ws + WS_WUQ) + (size_t)i * 1536 * 384, T, 1536, 384, 384, 384, 6, 0};
                else        g = pg8::Gemm{(const bf16_t*)(ws + WS_CKV), (const bf16_t*)(ws + WS_WUKV) + (size_t)i * 2048 * 256, T + 1024, 2048, 256, 256, 256, 8, 0};
                pg8::StaticOrder S; S.init(g.M, g.N, G, (s == 0 || G != 256) ? bid : ((bid + 144) & 255));
                pg8::EpiBf16<0> E{s == 0 ? (bf16_t*)(ws + WS_Q) : (bf16_t*)(ws + WS_KVX), g.N};
                pg8::gemm_phase<pg8::EpiBf16<0>, pg8::StaticOrder>(lds, g, S, E, cx.tid);
            }
        } break;
        case K_MLA: if (ENB(9)) {
            if (G == 256) {
                const int xcd = bid & 7, slot = bid >> 3, id = xcd * 4 + (slot >> 3);
                mla_unit(args, cx, lds, id * 8 + (slot & 7));
                mla_unit(args, cx, lds, 256 + bid);
            } else { for (int u = bid; u < 512; u += G) mla_unit(args, cx, lds, u); }
        } break;
        case K_DOWN: if (ENB(10)) {
            pg8::Gemm g{(const bf16_t*)(ws + WS_H), (const bf16_t*)(ws + WS_WDOWN) + (size_t)i * NDOWN_PAD * D, T, 2 * NDOWN_PAD, D / 2, D, D / 2, NDOWN_PAD / 256, D / 2};
            pg8::EpiF32 E{(float*)(ws + WS_OUT), NDOWN_PAD, NDOWN_PAD / 256, DOWN_SPLIT};
            pg8::StaticOrder S; S.init(g.M, g.N, G, bid);
            pg8::gemm_phase<pg8::EpiF32, pg8::StaticOrder>(lds, g, S, E, cx.tid);
        } break;
        case K_OUTP: case K_FF2: if (ENB(10)) {
            pg8::Gemm g;
            if (kind == K_OUTP) {
                const bf16_t* Wt = (l & 1) ? (const bf16_t*)(ws + WS_WO) + (size_t)i * D * D : (const bf16_t*)(ws + WS_WOUT) + (size_t)i * D * D;
                g = pg8::Gemm{(const bf16_t*)(ws + WS_MIX), Wt, T, 2 * D, D / 2, D, D / 2, 4, D / 2};
            } else {
                g = pg8::Gemm{(const bf16_t*)(ws + WS_U), (const bf16_t*)(ws + WS_WFF2) + (size_t)l * FF * D, T, 2 * D, FF / 2, FF, FF / 2, 4, FF / 2};
            }
            pg8::EpiSplitBf16 E{(bf16_t*)(ws + WS_OUT), D, 4, OUT_SPLIT};
            pg8::StaticOrder S; S.init(g.M, g.N, G, bid);
            pg8::gemm_phase<pg8::EpiSplitBf16, pg8::StaticOrder>(lds, g, S, E, cx.tid);
        } break;
        case K_FF1: if (ENB(12)) {
            pg8::Gemm g{(const bf16_t*)(ws + WS_H), (const bf16_t*)(ws + WS_WFF1) + (size_t)l * FF * D, T, FF, D, D, D, FF / 256, 0};
            pg8::StaticOrder S; S.init(T, FF, G, bid);
            pg8::EpiBf16<1> E{(bf16_t*)(ws + WS_U), FF};
            pg8::gemm_phase<pg8::EpiBf16<1>, pg8::StaticOrder>(lds, g, S, E, cx.tid);
        } break;
        case K_POST1: if (ENB(11)) {
            const float* MODL = (const float*)(ws + WS_MOD) + (size_t)l * 3 * 6144; const float* gN = (args.in[12] + cx.z) + (size_t)l * 4 * D;
            post_rows(args, cx, l == 0, MODL + 2 * D, gN + D, true, gN + 2 * D, MODL + 3 * D, MODL + 4 * D, rep + 1 < reps);
        } break;
        case K_POST2: if (ENB(14)) {
            const float* MODL = (const float*)(ws + WS_MOD) + (size_t)l * 3 * 6144; const float* gN = (args.in[12] + cx.z) + (size_t)l * 4 * D;
            const float* MODN = MODL + 3 * 6144; const float* gNn = gN + 4 * D;
            post_rows(args, cx, false, MODL + 5 * D, gN + 3 * D, l < 3, gNn, MODN, MODN + D, rep + 1 < reps);
        } break;
        default: break;
        }
        }
        if (p + 1 < hi) { if (hi < 0) cg::this_grid().sync(); else { XcdBarrier xb; xb.bar = (unsigned*)(args.ws + WS_CTL); xb.x = xb_xcc_id(); xb.st = (volatile LAS unsigned*)(lds + LDS_BYTES - 64); int tidb; MY_TID(tidb); for (int br = 0; br < BAR_REPS; ++br) xcd_barrier(xb, tidb); } }
    }
}

extern "C" void kernel_launch(void* const* d_in, const int* in_sizes, int n_in, void* d_out, int out_size, void* d_ws, size_t ws_size, hipStream_t stream) {
    static int grid = 0;
    if (grid == 0) {
        int dev = 0, cus = 0, per_cu = 0;
        hipGetDevice(&dev);
        hipDeviceGetAttribute(&cus, hipDeviceAttributeMultiprocessorCount, dev);
        hipFuncSetAttribute((const void*)mega_fwd, hipFuncAttributeMaxDynamicSharedMemorySize, LDS_BYTES);
        hipOccupancyMaxActiveBlocksPerMultiprocessor(&per_cu, (const void*)mega_fwd, NTHREADS, LDS_BYTES);
        if (per_cu < 1) { fprintf(stderr, "kernel_launch: occupancy query says %d blocks per CU\n", per_cu); per_cu = 1; }
        (void)hipGetLastError();
        grid = cus;
        if (ws_size < 256 * MiB) fprintf(stderr, "kernel_launch: workspace too small (%zu)\n", ws_size);
    }
    (void)hipMemsetAsync((char*)d_ws + WS_CTL, 0, CTL_BYTES, stream);
    Args a{};
    for (int i = 0; i < 29; ++i) a.in[i] = (const float*)d_in[i];
    a.out = (float*)d_out; a.ws = (unsigned char*)d_ws;
#if MK_ONE_LAUNCH
    a.ph_lo = 0; a.ph_hi = N_PHASES;
    void* kargs[] = {&a};
    hipError_t e = hipLaunchCooperativeKernel((const void*)mega_fwd, dim3(grid), dim3(NTHREADS), kargs, LDS_BYTES, stream);
    if (e != hipSuccess) fprintf(stderr, "cooperative launch failed: %s (grid %d)\n", hipGetErrorString(e), grid);
#else
    for (int p = 0; p < N_PHASES; ++p) {
        a.ph_lo = p; a.ph_hi = p + 1;
        hipLaunchKernelGGL(mega_fwd, dim3(grid), dim3(NTHREADS), LDS_BYTES, stream, a);
    }
#endif
}
```

```cpp
#include <hip/hip_runtime.h>
#include <hip/hip_cooperative_groups.h>
#include <cstdio>
#include <cstdint>
namespace cg = cooperative_groups;

#ifndef MK_ONE_LAUNCH
#define MK_ONE_LAUNCH 1
#endif

#define LAS __attribute__((address_space(3)))
#define GAS __attribute__((address_space(1)))
typedef unsigned short bf16_t;
typedef short bf16x8 __attribute__((ext_vector_type(8)));
typedef float f32x4 __attribute__((ext_vector_type(4)));
typedef float f32x2 __attribute__((ext_vector_type(2)));
typedef unsigned u32x4 __attribute__((ext_vector_type(4)));
typedef unsigned u32x2 __attribute__((ext_vector_type(2)));

constexpr int D = 1024, TP = 4096, TS = 2048, T = TP + TS, FF = 4096;
constexpr int NPROJ = 2336, NPROJ_PAD = 2560, NDOWN = 672, NDOWN_PAD = 768;
constexpr int C_QA = 0, C_KA = 256, C_VA = 512, C_GA = 1024, C_LO = 1536, C_QB = 1568, C_KB = 2080, C_VB = 2208;
constexpr float EPS = 1e-6f;
constexpr int NTHREADS = 512, NWAVES = 8;
constexpr int LDS_BYTES = 147456;

constexpr size_t O_X = 0, O_SF = 6291456, O_SB = 7340032, O_CK = 8388608, O_CV = 9437184, O_CKV = 10485760, O_CKR = 12582912;

constexpr size_t MiB = 1u << 20;
constexpr size_t WS_WFF1 = 0, WS_WFF2 = 32 * MiB, WS_WIN = 64 * MiB, WS_WOUT = 74 * MiB, WS_WDOWN = 78 * MiB, WS_WUQ = 81 * MiB,
                 WS_WUKV = 84 * MiB, WS_WO = 86 * MiB, WS_MOD = 90 * MiB, WS_TAB = 91 * MiB, WS_CSK = 92 * MiB, WS_CSV = 93 * MiB,
                 WS_H = 94 * MiB, WS_MIX = 106 * MiB, WS_OUT = 118 * MiB, WS_U = 166 * MiB, WS_PROJ = 214 * MiB, WS_CTL = 250 * MiB;
constexpr size_t CTL_BYTES = 16384;
constexpr size_t WS_LOC = WS_U, WS_DEC = WS_U + 24 * MiB;
constexpr size_t WS_Q = WS_U, WS_KVX = WS_U + 18 * MiB;
constexpr size_t WS_DOWN = WS_PROJ, WS_CQ = WS_PROJ + 18 * MiB, WS_CKV = WS_PROJ + 23 * MiB, WS_KR = WS_PROJ + 27 * MiB;
constexpr size_t OUT_SPLIT = (size_t)T * D;
constexpr size_t DOWN_SPLIT = (WS_DOWN - WS_OUT) / 4;

__device__ __forceinline__ unsigned f2bf(float f) { unsigned u = __builtin_bit_cast(unsigned, f); return (u + 0x7fffu + ((u >> 16) & 1u)) >> 16; }
__device__ __forceinline__ unsigned pk2(float lo, float hi) { return f2bf(lo) | (f2bf(hi) << 16); }
__device__ __forceinline__ float bf2f(unsigned short b) { return __builtin_bit_cast(float, (unsigned)b << 16); }
__device__ __forceinline__ float bflo(unsigned w) { return __builtin_bit_cast(float, w << 16); }
__device__ __forceinline__ float bfhi(unsigned w) { return __builtin_bit_cast(float, w & 0xffff0000u); }
__device__ __forceinline__ void unpack8(const u32x4 v, float* f) {
    f[0] = bflo(v.x); f[1] = bfhi(v.x); f[2] = bflo(v.y); f[3] = bfhi(v.y); f[4] = bflo(v.z); f[5] = bfhi(v.z); f[6] = bflo(v.w); f[7] = bfhi(v.w);
}
__device__ __forceinline__ u32x4 pack8(const float* f) { u32x4 o; o.x = pk2(f[0], f[1]); o.y = pk2(f[2], f[3]); o.z = pk2(f[4], f[5]); o.w = pk2(f[6], f[7]); return o; }
__device__ __forceinline__ float wave_sum(float v) {
#pragma unroll
    for (int o = 1; o < 64; o <<= 1) v += __shfl_xor(v, o);
    return v;
}
__device__ __forceinline__ float xor16_max(float x) { const unsigned u = __builtin_bit_cast(unsigned, x); auto r = __builtin_amdgcn_permlane16_swap(u, u, false, false); return fmaxf(__builtin_bit_cast(float, (unsigned)r[0]), __builtin_bit_cast(float, (unsigned)r[1])); }
__device__ __forceinline__ float xor32_max(float x) { const unsigned u = __builtin_bit_cast(unsigned, x); auto r = __builtin_amdgcn_permlane32_swap(u, u, false, false); return fmaxf(__builtin_bit_cast(float, (unsigned)r[0]), __builtin_bit_cast(float, (unsigned)r[1])); }
__device__ __forceinline__ float xor16_add(float x) { const unsigned u = __builtin_bit_cast(unsigned, x); auto r = __builtin_amdgcn_permlane16_swap(u, u, false, false); return __builtin_bit_cast(float, (unsigned)r[0]) + __builtin_bit_cast(float, (unsigned)r[1]); }
__device__ __forceinline__ float xor32_add(float x) { const unsigned u = __builtin_bit_cast(unsigned, x); auto r = __builtin_amdgcn_permlane32_swap(u, u, false, false); return __builtin_bit_cast(float, (unsigned)r[0]) + __builtin_bit_cast(float, (unsigned)r[1]); }
__device__ __forceinline__ unsigned cvtpk(float lo, float hi) { unsigned r; asm volatile("v_cvt_pk_bf16_f32 %0, %1, %2" : "=v"(r) : "v"(lo), "v"(hi)); return r; }
__device__ __forceinline__ float silu_f(float x) { return x / (1.f + __expf(-x)); }

namespace pg8 {
constexpr int BM = 256, BK = 64, HALF = 128, HTB = HALF * BK * 2, NXCD = 8, WGM = 8;
__host__ __device__ __forceinline__ int lds_byte(int r, int c) { const int st = (r >> 4) * 2 + (c >> 5), rr = r & 15, cc = c & 31, ob = rr * 64 + cc * 2; return st * 1024 + (ob ^ (((ob >> 9) & 1) << 5)); }
__host__ __device__ __forceinline__ void stage_rc(int b, int& R, int& C) { const int st = b / 1024, sb = b % 1024, swz = sb ^ (((sb >> 9) & 1) << 5); R = (st >> 1) * 16 + swz / 64; C = (st & 1) * 32 + (swz % 64) / 2; }
__host__ __device__ __forceinline__ int perm32(int rho) { const int n = rho >> 4, i = rho & 15; return 8 * (i >> 2) + 4 * n + (i & 3); }

struct Unit { int pm, pn; };
struct Gemm { const bf16_t* A; const bf16_t* Bt; int M, N, K, lda, ldb, npn, a_split; };

struct StaticOrder {
    int nM, nN, nwg, G, c;
    __device__ void init(int M, int N, int G_, int c_) { nM = M / BM; nN = N / BM; nwg = nM * nN; G = G_; c = c_; }
    __device__ bool next(int i, Unit& u) const {
        const long L = (long)i * G + c; if (L >= nwg) return false;
        int wgid = (int)L; { const int q = nwg / NXCD, r = nwg % NXCD, xcd = wgid % NXCD, off = wgid / NXCD; wgid = (xcd < r ? xcd * (q + 1) : r * (q + 1) + (xcd - r) * q) + off; }
        const int nig = WGM * nN, gid = wgid / nig, fm = gid * WGM, gsz = (nM - fm) < WGM ? (nM - fm) : WGM;
        u.pm = fm + ((wgid % nig) % gsz); u.pn = (wgid % nig) / gsz; return true;
    }
};

__device__ __forceinline__ unsigned cvt_pk_bf16(float lo, float hi) { unsigned r; asm volatile("v_cvt_pk_bf16_f32 %0, %1, %2" : "=v"(r) : "v"(lo), "v"(hi)); return r; }

template <int ACT  > struct EpiBf16 {
    static constexpr bool PERM = true;
    bf16_t* O; int ldc;
    __device__ __forceinline__ void operator()(const f32x4 (&acc)[2][2][4][2], const Unit& u, int wr, int wc, int fr, int fq) const {
        const int row0 = u.pm * BM + wr * 64 + fr, col0 = u.pn * BM + wc * 32 + 8 * fq;
#pragma unroll
        for (int ai = 0; ai < 2; ++ai)
#pragma unroll
            for (int m = 0; m < 4; ++m) { __builtin_amdgcn_sched_barrier(0); bf16_t* rowp = O + (size_t)(row0 + ai * HALF + m * 16) * ldc + col0;
#pragma unroll
                for (int bj = 0; bj < 2; ++bj) { f32x4 v0 = acc[ai][bj][m][0], v1 = acc[ai][bj][m][1];
                    if (ACT == 1) {
#pragma unroll
                        for (int j = 0; j < 4; ++j) { float a = fmaxf(v0[j], 0.f), b = fmaxf(v1[j], 0.f); v0[j] = a * a; v1[j] = b * b; } }
                    u32x4 w; w.x = cvt_pk_bf16(v0[0], v0[1]); w.y = cvt_pk_bf16(v0[2], v0[3]); w.z = cvt_pk_bf16(v1[0], v1[1]); w.w = cvt_pk_bf16(v1[2], v1[3]);
                    *(u32x4*)(rowp + bj * HALF) = w; } }
    }
};
struct EpiProj {
    static constexpr bool PERM = true;
    bf16_t* O; float* outp; int li;
    __device__ __forceinline__ void operator()(const f32x4 (&acc)[2][2][4][2], const Unit& u, int wr, int wc, int fr, int fq) const {
        const int row0 = u.pm * BM + wr * 64 + fr, col0 = u.pn * BM + wc * 32 + 8 * fq;
#pragma unroll
        for (int ai = 0; ai < 2; ++ai)
#pragma unroll
            for (int m = 0; m < 4; ++m) { __builtin_amdgcn_sched_barrier(0); const int row = row0 + ai * HALF + m * 16; bf16_t* rowp = O + (size_t)row * NPROJ_PAD + col0;
#pragma unroll
                for (int bj = 0; bj < 2; ++bj) { const f32x4 v0 = acc[ai][bj][m][0], v1 = acc[ai][bj][m][1];
                    u32x4 w; w.x = cvt_pk_bf16(v0[0], v0[1]); w.y = cvt_pk_bf16(v0[2], v0[3]); w.z = cvt_pk_bf16(v1[0], v1[1]); w.w = cvt_pk_bf16(v1[2], v1[3]);
                    *(u32x4*)(rowp + bj * HALF) = w;
                    const int col = col0 + bj * HALF;
                    if (row < TP && col >= C_KB && col < NPROJ) {
                        const int b = row >> 8, t = row & 255;
                        float* dst = outp + ((col < C_VB) ? (O_CK - C_KB) : (O_CV - C_VB)) + ((size_t)((b * 2 + li) * 256 + t)) * 128 + col;
                        *(f32x4*)dst = v0; *(f32x4*)(dst + 4) = v1; } } }
    }
};
struct EpiSplitBf16 {
    static constexpr bool PERM = true;
    bf16_t* O; int ldc; int npn; size_t split_stride;
    __device__ __forceinline__ void operator()(const f32x4 (&acc)[2][2][4][2], const Unit& u, int wr, int wc, int fr, int fq) const {
        const int s = u.pn / npn, pn = u.pn - s * npn;
        bf16_t* base = O + (size_t)s * split_stride;
        const int row0 = u.pm * BM + wr * 64 + fr, col0 = pn * BM + wc * 32 + 8 * fq;
#pragma unroll
        for (int ai = 0; ai < 2; ++ai)
#pragma unroll
            for (int m = 0; m < 4; ++m) { __builtin_amdgcn_sched_barrier(0); bf16_t* rowp = base + (size_t)(row0 + ai * HALF + m * 16) * ldc + col0;
#pragma unroll
                for (int bj = 0; bj < 2; ++bj) { const f32x4 v0 = acc[ai][bj][m][0], v1 = acc[ai][bj][m][1];
                    u32x4 w; w.x = cvt_pk_bf16(v0[0], v0[1]); w.y = cvt_pk_bf16(v0[2], v0[3]); w.z = cvt_pk_bf16(v1[0], v1[1]); w.w = cvt_pk_bf16(v1[2], v1[3]);
                    *(u32x4*)(rowp + bj * HALF) = w; } }
    }
};
struct EpiF32 {
    static constexpr bool PERM = true;
    float* O; int ldc; int npn; size_t split_stride;
    __device__ __forceinline__ void operator()(const f32x4 (&acc)[2][2][4][2], const Unit& u, int wr, int wc, int fr, int fq) const {
        const int s = u.pn / npn, pn = u.pn - s * npn;
        float* base = O + (size_t)s * split_stride;
        const int row0 = u.pm * BM + wr * 64 + fr, col0 = pn * BM + wc * 32 + 8 * fq;
#pragma unroll
        for (int ai = 0; ai < 2; ++ai)
#pragma unroll
            for (int m = 0; m < 4; ++m) { __builtin_amdgcn_sched_barrier(0); float* rowp = base + (size_t)(row0 + ai * HALF + m * 16) * ldc + col0;
#pragma unroll
                for (int bj = 0; bj < 2; ++bj) { *(f32x4*)(rowp + bj * HALF) = acc[ai][bj][m][0]; *(f32x4*)(rowp + bj * HALF + 4) = acc[ai][bj][m][1]; } }
    }
};

template <class Epi, class Sched>
__device__ __forceinline__ void gemm_phase(LAS unsigned char* lds, const Gemm g, const Sched& S, const Epi& E, const int tid) {
    const int wid = __builtin_amdgcn_readfirstlane(tid >> 6), lane = tid & 63, wr = wid >> 2, wc = wid & 3, fr = lane & 15, fq = lane >> 4;
    const int K = g.K, nt = K / BK;
    unsigned voffA[2], voffB[2];
#pragma unroll
    for (int i = 0; i < 2; ++i) { int R, C; stage_rc(tid * 16 + i * 8192, R, C); const int Rb = Epi::PERM ? ((R & ~31) + perm32(R & 31)) : R;
        voffA[i] = (unsigned)(R * g.lda + C) * 2u; voffB[i] = (unsigned)(Rb * g.ldb + C) * 2u; }
    const size_t kstep = (size_t)(BK * 2);
    const size_t hstepA = (size_t)HALF * g.lda * 2, hstepB = (size_t)HALF * g.ldb * 2;
    const size_t tstepA = 2 * hstepA, tstepB = 2 * hstepB;
    const unsigned ldsw = (unsigned)wid * 1024u;
    const int aoff = lds_byte(wr * 64 + fr, fq * 8), boff = lds_byte(wc * 32 + fr, fq * 8);
#define PG8_SA(b, h) (((b) * 2 + (h)) * HTB)
#define PG8_SB(b, h) ((4 + (b) * 2 + (h)) * HTB)
#define PG8_STAGE(bufoff, gbase, voff) do { _Pragma("unroll") for (int _i = 0; _i < 2; ++_i) \
        __builtin_amdgcn_global_load_lds((const unsigned*)((const char*)(gbase) + (voff)[_i]), (LAS unsigned*)(lds + (bufoff) + ldsw + _i * 8192), 16, 0, 0); } while (0)
#define PG8_LDA(dst, b, h) do { _Pragma("unroll") for (int m = 0; m < 4; ++m) _Pragma("unroll") for (int k = 0; k < 2; ++k) dst[m][k] = *(const LAS bf16x8*)(lds + PG8_SA(b, h) + aoff + m * 2048 + k * 1024); } while (0)
#define PG8_LDB(dst, b, h) do { _Pragma("unroll") for (int n = 0; n < 2; ++n) _Pragma("unroll") for (int k = 0; k < 2; ++k) dst[n][k] = *(const LAS bf16x8*)(lds + PG8_SB(b, h) + boff + n * 2048 + k * 1024); } while (0)
#define PG8_MMA(ai, bj, At, Bt) do { __builtin_amdgcn_s_setprio(1); _Pragma("unroll") for (int m = 0; m < 4; ++m) _Pragma("unroll") for (int n = 0; n < 2; ++n) _Pragma("unroll") for (int k = 0; k < 2; ++k) \
        acc[ai][bj][m][n] = __builtin_amdgcn_mfma_f32_16x16x32_bf16(Bt[n][k], At[m][k], acc[ai][bj][m][n], 0, 0, 0); __builtin_amdgcn_s_setprio(0); } while (0)
#define PG8_WAIT_V(n) asm volatile("s_waitcnt vmcnt(" #n ")" ::: "memory")
#define PG8_WAIT_L(n) asm volatile("s_waitcnt lgkmcnt(" #n ")" ::: "memory")
#define PG8_BAR __builtin_amdgcn_s_barrier()
#define PG8_SCHED __builtin_amdgcn_sched_barrier(0)
#define PG8_UA(u) ((const char*)g.A + (size_t)(u).pm * tstepA + (size_t)((u).pn / g.npn) * (size_t)g.a_split * 2)
#define PG8_UB(u) ((const char*)g.Bt + (size_t)(u).pn * tstepB)
    Unit cur, nxt; int ui = 0;
    if (!S.next(0, cur)) return;
    f32x4 acc[2][2][4][2];
#pragma unroll
    for (int a = 0; a < 2; ++a)
#pragma unroll
        for (int b = 0; b < 2; ++b)
#pragma unroll
            for (int m = 0; m < 4; ++m)
#pragma unroll
                for (int n = 0; n < 2; ++n) acc[a][b][m][n] = (f32x4){0.f, 0.f, 0.f, 0.f};
    bf16x8 At[4][2], B0[2][2], B1[2][2];
    const char* cA = PG8_UA(cur); const char* cB = PG8_UB(cur);
    PG8_STAGE(PG8_SB(0, 0), cB, voffB); PG8_STAGE(PG8_SB(0, 1), cB + hstepB, voffB); PG8_STAGE(PG8_SA(0, 0), cA, voffA); PG8_STAGE(PG8_SA(0, 1), cA + hstepA, voffA);
    if (wr == 1) PG8_BAR;
    PG8_WAIT_V(2); PG8_BAR;
    PG8_STAGE(PG8_SB(1, 0), cB + kstep, voffB); PG8_STAGE(PG8_SA(1, 0), cA + kstep, voffA); PG8_STAGE(PG8_SB(1, 1), cB + hstepB + kstep, voffB);
    PG8_WAIT_V(6); PG8_BAR;
    for (;;) {
        const bool has_next = S.next(ui + 1, nxt);
        const char* nA = has_next ? PG8_UA(nxt) : cA; const char* nB = has_next ? PG8_UB(nxt) : cB;
        for (int t = 0; t < nt; t += 2) {
            const bool last = (t == nt - 2);
            const char* a1 = cA + (size_t)(t + 1) * kstep;
            const char* a2 = last ? nA : cA + (size_t)(t + 2) * kstep; const char* b2 = last ? nB : cB + (size_t)(t + 2) * kstep;
            const char* a3 = a2 + kstep; const char* b3 = b2 + kstep;
            PG8_LDB(B0, 0, 0); PG8_LDB(B1, 0, 1); PG8_SCHED; PG8_LDA(At, 0, 0); PG8_STAGE(PG8_SA(1, 1), a1 + hstepA, voffA);
            PG8_WAIT_V(8); PG8_WAIT_L(0); PG8_BAR; PG8_MMA(0, 0, At, B0); PG8_MMA(0, 1, At, B1); PG8_BAR; PG8_SCHED;
            PG8_LDA(At, 0, 1); PG8_STAGE(PG8_SB(0, 0), b2, voffB); PG8_STAGE(PG8_SB(0, 1), b2 + hstepB, voffB); PG8_STAGE(PG8_SA(0, 0), a2, voffA);
            PG8_WAIT_V(8); PG8_WAIT_L(0); PG8_BAR; PG8_MMA(1, 0, At, B0); PG8_MMA(1, 1, At, B1); PG8_BAR; PG8_SCHED;
            PG8_LDB(B0, 1, 0); PG8_LDB(B1, 1, 1); PG8_SCHED; PG8_LDA(At, 1, 0); PG8_STAGE(PG8_SA(0, 1), a2 + hstepA, voffA);
            PG8_WAIT_V(8); PG8_WAIT_L(0); PG8_BAR; PG8_MMA(0, 0, At, B0); PG8_MMA(0, 1, At, B1); PG8_BAR; PG8_SCHED;
            PG8_LDA(At, 1, 1); PG8_STAGE(PG8_SB(1, 0), b3, voffB); PG8_STAGE(PG8_SB(1, 1), b3 + hstepB, voffB); PG8_STAGE(PG8_SA(1, 0), a3, voffA);
            PG8_WAIT_V(8); PG8_WAIT_L(0); PG8_BAR; PG8_MMA(1, 0, At, B0); PG8_MMA(1, 1, At, B1); PG8_BAR; PG8_SCHED;
        }
        if (wr == 0) PG8_BAR;
        E(acc, cur, wr, wc, fr, fq);
        if (!has_next) break;
#pragma unroll
        for (int a = 0; a < 2; ++a)
#pragma unroll
            for (int b = 0; b < 2; ++b)
#pragma unroll
                for (int m = 0; m < 4; ++m)
#pragma unroll
                    for (int n = 0; n < 2; ++n) acc[a][b][m][n] = (f32x4){0.f, 0.f, 0.f, 0.f};
        cur = nxt; cA = nA; cB = nB; ++ui;
        if (wr == 1) PG8_BAR;
    }
    PG8_WAIT_V(0);
    PG8_BAR;
#undef PG8_SA
#undef PG8_SB
#undef PG8_STAGE
#undef PG8_LDA
#undef PG8_LDB
#undef PG8_MMA
#undef PG8_WAIT_V
#undef PG8_WAIT_L
#undef PG8_BAR
#undef PG8_SCHED
#undef PG8_UA
#undef PG8_UB
}
}

struct Args { const float* in[29]; float* out; unsigned char* ws; int ph_lo, ph_hi; };
struct Ctx { unsigned char* ws; float* out; int z, tid, bid, G; };

#define MFMA16(a, b, c) __builtin_amdgcn_mfma_f32_16x16x32_bf16((a), (b), (c), 0, 0, 0)

__device__ __forceinline__ void transpose_load(const float* W, int N, int item, int lane, float (&wv)[32]) {
    const int nblk = N / 32, kb = item / nblk, nb = item % nblk, k0 = 64 * kb, n0 = 32 * nb;
#pragma unroll
    for (int i = 0; i < 32; ++i) { const int kk = 2 * i + (lane >> 5); wv[i] = W[(size_t)(k0 + kk) * N + n0 + (lane & 31)]; }
}
__device__ __forceinline__ void transpose_finish(int N, bf16_t* WT, int npad, int ksub, LAS float* scr, int item, int lane, const float (&wv)[32]) {
    const int nblk = N / 32, kb = item / nblk, nb = item % nblk, k0 = 64 * kb, n0 = 32 * nb;
#pragma unroll
    for (int i = 0; i < 32; ++i) { const int kk = 2 * i + (lane >> 5); scr[kk * 33 + (lane & 31)] = wv[i]; }
    asm volatile("s_waitcnt lgkmcnt(0)" ::: "memory");
    const int c = lane & 7;
    const int ks = k0 / ksub, kin = k0 - ks * ksub;
    bf16_t* dbase = WT + (size_t)ks * npad * ksub + kin + 8 * c;
#pragma unroll
    for (int j = 0; j < 4; ++j) { const int n = (lane >> 3) + 8 * j; const LAS float* s = scr + (8 * c) * 33 + n;
        u32x4 o; o.x = pk2(s[0 * 33], s[1 * 33]); o.y = pk2(s[2 * 33], s[3 * 33]); o.z = pk2(s[4 * 33], s[5 * 33]); o.w = pk2(s[6 * 33], s[7 * 33]);
        *(u32x4*)(dbase + (size_t)(n0 + n) * ksub) = o; }
    asm volatile("s_waitcnt lgkmcnt(0)" ::: "memory");
}

struct MatDesc { const float* W; bf16_t* WT; int K, N, npad, ksub, items; };
__device__ __forceinline__ MatDesc get_mat(const Args& a, const Ctx& cx, int mi) {
    MatDesc m; unsigned char* ws = cx.ws;
    if (mi < 4)       { m.W = (a.in[13] + cx.z) + (size_t)mi * D * FF; m.WT = (bf16_t*)(ws + WS_WFF1) + (size_t)mi * FF * D; m.K = D; m.N = FF; m.npad = FF; m.ksub = D; }
    else if (mi < 8)  { const int l = mi - 4; m.W = (a.in[14] + cx.z) + (size_t)l * FF * D; m.WT = (bf16_t*)(ws + WS_WFF2) + (size_t)l * FF * D; m.K = FF; m.N = D; m.npad = D; m.ksub = FF / 2; }
    else if (mi < 10) { const int i = mi - 8; m.W = (a.in[15] + cx.z) + (size_t)i * D * NPROJ; m.WT = (bf16_t*)(ws + WS_WIN) + (size_t)i * NPROJ_PAD * D; m.K = D; m.N = NPROJ; m.npad = NPROJ_PAD; m.ksub = D; }
    else if (mi < 12) { const int i = mi - 10; m.W = (a.in[22] + cx.z) + (size_t)i * D * D; m.WT = (bf16_t*)(ws + WS_WOUT) + (size_t)i * D * D; m.K = D; m.N = D; m.npad = D; m.ksub = D / 2; }
    else if (mi < 14) { const int i = mi - 12; m.W = (a.in[23] + cx.z) + (size_t)i * D * NDOWN; m.WT = (bf16_t*)(ws + WS_WDOWN) + (size_t)i * NDOWN_PAD * D; m.K = D; m.N = NDOWN; m.npad = NDOWN_PAD; m.ksub = D / 2; }
    else if (mi < 16) { const int i = mi - 14; m.W = (a.in[26] + cx.z) + (size_t)i * 384 * 1536; m.WT = (bf16_t*)(ws + WS_WUQ) + (size_t)i * 1536 * 384; m.K = 384; m.N = 1536; m.npad = 1536; m.ksub = 384; }
    else if (mi < 18) { const int i = mi - 16; m.W = (a.in[27] + cx.z) + (size_t)i * 256 * 2048; m.WT = (bf16_t*)(ws + WS_WUKV) + (size_t)i * 2048 * 256; m.K = 256; m.N = 2048; m.npad = 2048; m.ksub = 256; }
    else              { const int i = mi - 18; m.W = (a.in[28] + cx.z) + (size_t)i * D * D; m.WT = (bf16_t*)(ws + WS_WO) + (size_t)i * D * D; m.K = D; m.N = D; m.npad = D; m.ksub = D / 2; }
    m.items = (m.K / 64) * (m.N / 32);
    return m;
}

__device__ __forceinline__ void prologue(const Args& a, const Ctx& cx, LAS unsigned char* lds, const int mode, const int cg0, const int cgstride, const int cgend) {
    const int tid = cx.tid, lane = tid & 63, wave = tid >> 6, G = cx.G, bid = cx.bid;
    unsigned char* ws = cx.ws;
    if (mode == 0) {
        LAS float* sc = (LAS float*)lds;
        LAS float* red = (LAS float*)(lds + 12288);
        for (int i = tid; i < 3 * D; i += NTHREADS) { const int g = i >> 10, k = i & 1023; const float v = (g == 0) ? (a.in[9] + cx.z)[k] : (a.in[8] + cx.z)[(g - 1) * D + k]; sc[i] = silu_f(v); }
        __syncthreads();
        float* MOD = (float*)(ws + WS_MOD);
        for (int it = bid; it < 4 * 48; it += G) {
            const int l = it / 48, jb = it % 48, jq = tid & 31, kg = tid >> 5, j = jb * 128 + jq * 4;
            const float* wp = (a.in[10] + cx.z) + ((size_t)l * D + kg * 64) * 6144 + j;
            f32x4 a0 = {0.f, 0.f, 0.f, 0.f}, a1 = a0, a2 = a0;
#pragma unroll 32
            for (int k = 0; k < 64; ++k) { const f32x4 w = *(const f32x4*)(wp + (size_t)k * 6144); const int kk = kg * 64 + k;
                a0 += w * sc[kk]; a1 += w * sc[D + kk]; a2 += w * sc[2 * D + kk]; }
#pragma unroll
            for (int e = 0; e < 4; ++e) { red[(kg * 3 + 0) * 128 + jq * 4 + e] = a0[e]; red[(kg * 3 + 1) * 128 + jq * 4 + e] = a1[e]; red[(kg * 3 + 2) * 128 + jq * 4 + e] = a2[e]; }
            __syncthreads();
            if (tid < 384) { const int g = tid >> 7, jj = tid & 127; float s = 0.f;
#pragma unroll
                for (int q = 0; q < 16; ++q) s += red[(q * 3 + g) * 128 + jj];
                MOD[((size_t)l * 3 + g) * 6144 + jb * 128 + jj] = s + (a.in[11] + cx.z)[(size_t)l * 6144 + jb * 128 + jj]; }
            __syncthreads();
        }
    }
    __syncthreads();
    {
        LAS float* scr = (LAS float*)(lds + wave * 16384);
        const int gw = bid * NWAVES + wave, NGW = G * NWAVES;
        const bool l0only = (mode == 0) && (G == 256);
        const int nq = (mode == 1) ? 16 : (l0only ? 4 : 20);
#define PRO_SEQ(q) ((mode == 1) ? (((q) == 0) ? 1 : ((q) == 1) ? 5 : ((q) == 2) ? 12 : ((q) == 3) ? 14 : ((q) == 4) ? 16 : ((q) == 5) ? 18 : ((q) == 6) ? 2 : ((q) == 7) ? 6 : ((q) == 8) ? 9 : ((q) == 9) ? 11 \
                                  : ((q) == 10) ? 3 : ((q) == 11) ? 7 : ((q) == 12) ? 13 : ((q) == 13) ? 15 : ((q) == 14) ? 17 : 19) \
                    : (l0only ? (((q) == 0) ? 0 : ((q) == 1) ? 4 : ((q) == 2) ? 8 : 10) : (q)))
#define PRO_ADV() do { while (qi < nq && g - base >= m.items) { base += m.items; ++qi; if (qi < nq) m = get_mat(a, cx, PRO_SEQ(qi)); } } while (0)
        int qi = 0, base = 0;
        MatDesc m = get_mat(a, cx, PRO_SEQ(0));
        int g = (mode == 1) ? cg0 : gw;
        const int gstride = (mode == 1) ? cgstride : NGW, gend = (mode == 1) ? cgend : 0x7fffffff;
        if (g >= gend) qi = nq;
        PRO_ADV();
        float wv[32];
        if (qi < nq) transpose_load(m.W, m.N, g - base, lane, wv);
        while (qi < nq) {
            const MatDesc mc = m; const int itc = g - base;
            g += gstride;
            if (g >= gend) qi = nq;
            PRO_ADV();
            float wn[32];
            if (qi < nq) transpose_load(m.W, m.N, g - base, lane, wn);
            transpose_finish(mc.N, mc.WT, mc.npad, mc.ksub, scr, itc, lane, wv);
#pragma unroll
            for (int i = 0; i < 32; ++i) wv[i] = wn[i];
        }
    }
    if (mode == 0) {
        const size_t gt = (size_t)bid * NTHREADS + tid, NGT = (size_t)G * NTHREADS;
        for (int i = 0; i < 2; ++i) {
            u32x4* z1 = (u32x4*)((bf16_t*)(ws + WS_WIN) + (size_t)i * NPROJ_PAD * D + (size_t)NPROJ * D);
            for (size_t x = gt; x < (size_t)(NPROJ_PAD - NPROJ) * D / 8; x += NGT) z1[x] = (u32x4){0u, 0u, 0u, 0u};
            for (int ks = 0; ks < 2; ++ks) {
                u32x4* z2 = (u32x4*)((bf16_t*)(ws + WS_WDOWN) + (size_t)i * NDOWN_PAD * D + (size_t)ks * NDOWN_PAD * (D / 2) + (size_t)NDOWN * (D / 2));
                for (size_t x = gt; x < (size_t)(NDOWN_PAD - NDOWN) * (D / 2) / 8; x += NGT) z2[x] = (u32x4){0u, 0u, 0u, 0u}; }
        }
        f32x2* tab64 = (f32x2*)(ws + WS_TAB); f32x2* tab32 = tab64 + 64 * 16;
        for (size_t x = gt; x < 64 * 16; x += NGT) { const int pos = (int)x >> 4, f = (int)x & 15; const float inv = powf(10000.f, -(float)f / 16.f); const float ang = (float)pos * inv; tab64[x] = (f32x2){cosf(ang), sinf(ang)}; }
        for (size_t x = gt; x < 64 * 8; x += NGT) { const int pos = (int)x >> 3, f = (int)x & 7; const float inv = powf(10000.f, -(float)f / 8.f); const float ang = (float)pos * inv; tab32[x] = (f32x2){cosf(ang), sinf(ang)}; }
        bf16_t* csk = (bf16_t*)(ws + WS_CSK); bf16_t* csv = (bf16_t*)(ws + WS_CSV);
        for (size_t x = gt; x < (size_t)2 * 2 * 512 * 128 / 4; x += NGT) {
            const size_t e = x * 4; const int b = (int)(e / (2 * 65536)), i = (int)(e / 65536) & 1; const size_t r = e % 65536;
            const size_t d = ((size_t)(i * 2 + b)) * 65536 + r;
            const f32x4 k = *(const f32x4*)((a.in[4] + cx.z) + e), v = *(const f32x4*)((a.in[5] + cx.z) + e);
            *(u32x2*)(csk + d) = (u32x2){pk2(k[0], k[1]), pk2(k[2], k[3])};
            *(u32x2*)(csv + d) = (u32x2){pk2(v[0], v[1]), pk2(v[2], v[3])};
        }
    }
}

__device__ __forceinline__ int mod_group(int r) { return r < TP ? 0 : 1 + ((r - TP) >> 10); }

__device__ __forceinline__ void pre_rows(const Args& a, const Ctx& cx, int l) {
    constexpr int RB = 3;
    const int lane = cx.tid & 63, gw = cx.bid * NWAVES + (cx.tid >> 6), NGW = cx.G * NWAVES;
    const float* MOD = (const float*)(cx.ws + WS_MOD) + (size_t)l * 3 * 6144;
    const float* gA = (a.in[12] + cx.z) + (size_t)l * 4 * D;
    bf16_t* H = (bf16_t*)(cx.ws + WS_H);
    for (int rb = gw * RB; rb < T; rb += NGW * RB) {
        f32x4 v[RB][4], vg[4]; float s[RB];
#pragma unroll
        for (int j = 0; j < 4; ++j) vg[j] = *(const f32x4*)(gA + lane * 4 + 256 * j);
#pragma unroll
        for (int q = 0; q < RB; ++q) { const int r = (rb + q < T) ? rb + q : T - 1;
            const float* xr = (r < TP) ? (a.in[0] + cx.z) + (size_t)r * D : (a.in[1] + cx.z) + (size_t)(r - TP) * D;
            float t = 0.f;
#pragma unroll
            for (int j = 0; j < 4; ++j) { v[q][j] = *(const f32x4*)(xr + lane * 4 + 256 * j); t += v[q][j][0] * v[q][j][0] + v[q][j][1] * v[q][j][1] + v[q][j][2] * v[q][j][2] + v[q][j][3] * v[q][j][3]; }
            s[q] = t; }
#pragma unroll
        for (int off = 1; off < 64; off <<= 1) {
#pragma unroll
            for (int q = 0; q < RB; ++q) s[q] += __shfl_xor(s[q], off); }
#pragma unroll
        for (int q = 0; q < RB; ++q) { const int r = rb + q; if (r >= T) continue;
            const float rstd = rsqrtf(s[q] * (1.f / D) + EPS);
            const float* m = MOD + (size_t)mod_group(r) * 6144;
#pragma unroll
            for (int j = 0; j < 4; ++j) { const int c = lane * 4 + 256 * j;
                const f32x4 sh = *(const f32x4*)(m + c), scl = *(const f32x4*)(m + D + c);
                const f32x4 h = v[q][j] * rstd * vg[j] * (scl + 1.f) + sh;
                *(u32x2*)(H + (size_t)r * D + c) = (u32x2){pk2(h[0], h[1]), pk2(h[2], h[3])}; } }
    }
}

__device__ __forceinline__ void post_rows(const Args& a, const Ctx& cx, bool x_from_input, const float* gate_base  , const float* gB,
                                          bool has_next, const float* gC, const float* shift_base, const float* scale_base, bool dry) {
    constexpr int RB = 3;
    const int lane = cx.tid & 63, gw = cx.bid * NWAVES + (cx.tid >> 6), NGW = cx.G * NWAVES;
    const bf16_t* OUT = (const bf16_t*)(cx.ws + WS_OUT);
    bf16_t* H = dry ? (bf16_t*)(cx.ws + WS_U + 24 * MiB) : (bf16_t*)(cx.ws + WS_H);
    float* xout = dry ? (float*)(cx.ws + WS_U) : cx.out;
    for (int rb = gw * RB; rb < T; rb += NGW * RB) {
        f32x4 o[RB][4], x[RB][4]; float s[RB], s2[RB]; size_t mg[RB];
        const size_t mg0 = (size_t)mod_group(rb < T ? rb : T - 1) * 6144;
        f32x4 vgB[4], vgt[4];
#pragma unroll
        for (int j = 0; j < 4; ++j) { const int c = lane * 4 + 256 * j; vgB[j] = *(const f32x4*)(gB + c); vgt[j] = *(const f32x4*)(gate_base + mg0 + c); }
#pragma unroll
        for (int q = 0; q < RB; ++q) { const int r = (rb + q < T) ? rb + q : T - 1;
            const float* xr = x_from_input ? ((r < TP) ? (a.in[0] + cx.z) + (size_t)r * D : (a.in[1] + cx.z) + (size_t)(r - TP) * D) : cx.out + (size_t)r * D;
            mg[q] = (size_t)mod_group(r) * 6144;
#pragma unroll
            for (int j = 0; j < 4; ++j) { const int c = lane * 4 + 256 * j;
                { const u32x2 p0 = *(const u32x2*)(OUT + (size_t)r * D + c), p1 = *(const u32x2*)(OUT + OUT_SPLIT + (size_t)r * D + c);
                  o[q][j] = (f32x4){bflo(p0.x) + bflo(p1.x), bfhi(p0.x) + bfhi(p1.x), bflo(p0.y) + bflo(p1.y), bfhi(p0.y) + bfhi(p1.y)}; }
                x[q][j] = *(const f32x4*)(xr + c); } }
#pragma unroll
        for (int q = 0; q < RB; ++q) { float t = 0.f;
#pragma unroll
            for (int j = 0; j < 4; ++j) t += o[q][j][0] * o[q][j][0] + o[q][j][1] * o[q][j][1] + o[q][j][2] * o[q][j][2] + o[q][j][3] * o[q][j][3];
            s[q] = t; }
#pragma unroll
        for (int off = 1; off < 64; off <<= 1) {
#pragma unroll
            for (int q = 0; q < RB; ++q) s[q] += __shfl_xor(s[q], off); }
#pragma unroll
        for (int q = 0; q < RB; ++q) { const int r = rb + q; const float rstd = rsqrtf(s[q] * (1.f / D) + EPS); float t = 0.f;
            const bool same = (mg[q] == mg0);
#pragma unroll
            for (int j = 0; j < 4; ++j) { const int c = lane * 4 + 256 * j;
                const f32x4 gt = same ? vgt[j] : *(const f32x4*)(gate_base + mg[q] + c);
                x[q][j] = x[q][j] + gt * (o[q][j] * rstd * vgB[j]);
                if (r < T) *(f32x4*)(xout + (size_t)r * D + c) = x[q][j];
                t += x[q][j][0] * x[q][j][0] + x[q][j][1] * x[q][j][1] + x[q][j][2] * x[q][j][2] + x[q][j][3] * x[q][j][3]; }
            s2[q] = t; }
        if (has_next) {
            f32x4 vgC[4], vsh[4], vsc[4];
#pragma unroll
            for (int j = 0; j < 4; ++j) { const int c = lane * 4 + 256 * j; vgC[j] = *(const f32x4*)(gC + c); vsh[j] = *(const f32x4*)(shift_base + mg0 + c); vsc[j] = *(const f32x4*)(scale_base + mg0 + c); }
#pragma unroll
            for (int off = 1; off < 64; off <<= 1) {
#pragma unroll
                for (int q = 0; q < RB; ++q) s2[q] += __shfl_xor(s2[q], off); }
#pragma unroll
            for (int q = 0; q < RB; ++q) { const int r = rb + q; const float rstd2 = rsqrtf(s2[q] * (1.f / D) + EPS);
                const bool same = (mg[q] == mg0);
#pragma unroll
                for (int j = 0; j < 4; ++j) { const int c = lane * 4 + 256 * j;
                    const f32x4 sh = same ? vsh[j] : *(const f32x4*)(shift_base + mg[q] + c), scl = same ? vsc[j] : *(const f32x4*)(scale_base + mg[q] + c);
                    const f32x4 h = x[q][j] * rstd2 * vgC[j] * (scl + 1.f) + sh;
                    if (r < T) *(u32x2*)(H + (size_t)r * D + c) = (u32x2){pk2(h[0], h[1]), pk2(h[2], h[3])}; } }
        }
    }
}

__device__ __forceinline__ void mla_mid(const Args& a, const Ctx& cx, int i) {
    constexpr int RB = 3;
    const int lane = cx.tid & 63, gw = cx.bid * NWAVES + (cx.tid >> 6), NGW = cx.G * NWAVES;
    const float* DOWN = (const float*)(cx.ws + WS_OUT);
    bf16_t* CQ = (bf16_t*)(cx.ws + WS_CQ); bf16_t* CKV = (bf16_t*)(cx.ws + WS_CKV); bf16_t* KR = (bf16_t*)(cx.ws + WS_KR);
    const float* gq = (a.in[24] + cx.z) + (size_t)i * 384; const float* gkv = (a.in[25] + cx.z) + (size_t)i * 256;
    const f32x2* tab32 = (const f32x2*)(cx.ws + WS_TAB) + 64 * 16;
    for (int r = T + gw; r < T + 1024; r += NGW) {
        const int rr = r - T, b = rr >> 9, j = rr & 511;
        const float* src = (a.in[6] + cx.z) + ((size_t)((b * 2 + i) * 512 + j)) * 256;
        float v[4];
#pragma unroll
        for (int q = 0; q < 4; ++q) v[q] = src[lane + 64 * q];
        const float kr = (lane < 32) ? (a.in[7] + cx.z)[((size_t)((b * 2 + i) * 512 + j)) * 32 + lane] : 0.f;
#pragma unroll
        for (int q = 0; q < 4; ++q) CKV[(size_t)r * 256 + lane + 64 * q] = (bf16_t)f2bf(v[q]);
        if (lane < 32) KR[(size_t)r * 32 + lane] = (bf16_t)f2bf(kr);
    }
    for (int rb = gw * RB; rb < T; rb += NGW * RB) {
        float q[RB][6], kv[RB][4], kr[RB], ot[RB], sq[RB], sk[RB], vq[6], vk[4];
#pragma unroll
        for (int j = 0; j < 6; ++j) vq[j] = gq[lane + 64 * j];
#pragma unroll
        for (int j = 0; j < 4; ++j) vk[j] = gkv[lane + 64 * j];
#pragma unroll
        for (int u = 0; u < RB; ++u) { const int r = (rb + u < T) ? rb + u : T - 1; const float* dr = DOWN + (size_t)r * NDOWN_PAD;
#pragma unroll
            for (int j = 0; j < 6; ++j) q[u][j] = dr[lane + 64 * j] + dr[DOWN_SPLIT + lane + 64 * j];
#pragma unroll
            for (int j = 0; j < 4; ++j) kv[u][j] = dr[384 + lane + 64 * j] + dr[DOWN_SPLIT + 384 + lane + 64 * j];
            kr[u] = dr[640 + (lane & 31)] + dr[DOWN_SPLIT + 640 + (lane & 31)];
            ot[u] = dr[640 + ((lane & 31) ^ 8)] + dr[DOWN_SPLIT + 640 + ((lane & 31) ^ 8)]; }
#pragma unroll
        for (int u = 0; u < RB; ++u) { float s = 0.f, t = 0.f;
#pragma unroll
            for (int j = 0; j < 6; ++j) s += q[u][j] * q[u][j];
#pragma unroll
            for (int j = 0; j < 4; ++j) t += kv[u][j] * kv[u][j];
            sq[u] = s; sk[u] = t; }
#pragma unroll
        for (int off = 1; off < 64; off <<= 1) {
#pragma unroll
            for (int u = 0; u < RB; ++u) { sq[u] += __shfl_xor(sq[u], off); sk[u] += __shfl_xor(sk[u], off); } }
#pragma unroll
        for (int u = 0; u < RB; ++u) { const int r = rb + u; if (r >= T) continue;
            const float rq = rsqrtf(sq[u] * (1.f / 384.f) + EPS), rk = rsqrtf(sk[u] * (1.f / 256.f) + EPS);
#pragma unroll
            for (int j = 0; j < 6; ++j) CQ[(size_t)r * 384 + lane + 64 * j] = (bf16_t)f2bf(q[u][j] * rq * vq[j]);
#pragma unroll
            for (int j = 0; j < 4; ++j) { const float v = kv[u][j] * rk * vk[j]; CKV[(size_t)r * 256 + lane + 64 * j] = (bf16_t)f2bf(v);
                if (r < TP) { const int b = r >> 8, t = r & 255; cx.out[O_CKV + ((size_t)((b * 2 + i) * 256 + t)) * 256 + lane + 64 * j] = v; } }
            if (lane < 32) {
                if (r < TP) { const int b = r >> 8, t = r & 255; cx.out[O_CKR + ((size_t)((b * 2 + i) * 256 + t)) * 32 + lane] = kr[u]; KR[(size_t)r * 32 + lane] = (bf16_t)f2bf(kr[u]); }
                else {
                    const int t = (r - TP) & 1023, half = lane >> 4, p = (lane >> 3) & 1, f = lane & 7, pos = half ? (t & 63) : (t >> 6);
                    const f32x2 cs = tab32[pos * 8 + f];
                    const float v = p ? (ot[u] * cs[1] + kr[u] * cs[0]) : (kr[u] * cs[0] - ot[u] * cs[1]);
                    KR[(size_t)r * 32 + lane] = (bf16_t)f2bf(v);
                }
            }
        }
    }
}

struct KSeg { const bf16_t* K; int kstride; const bf16_t* K2; const bf16_t* V; int vstride; int k_lo, k_hi; int flags  ; };
struct AttnArgs { const bf16_t* Q; int qstride; int qpos0; int qrope  ; int nseg; KSeg seg0, seg1;
                  float m0, l0, scale; bf16_t* O; int ostride; const f32x2* tab64; };

__device__ __forceinline__ u32x4 rope8l(const u32x4 own, const u32x4 partner, int p, const LAS f32x2* tab) {
    float a[8], b[8], o[8]; unpack8(own, a); unpack8(partner, b);
#pragma unroll
    for (int e = 0; e < 8; ++e) { const f32x2 cs = tab[e]; o[e] = p ? (b[e] * cs[1] + a[e] * cs[0]) : (a[e] * cs[0] - b[e] * cs[1]); }
    return pack8(o);
}
__device__ __forceinline__ u32x4 rope8(const u32x4 own, const u32x4 partner, int p, const f32x2* tab) {
    float a[8], b[8], o[8]; unpack8(own, a); unpack8(partner, b);
#pragma unroll
    for (int e = 0; e < 8; ++e) { const f32x2 cs = tab[e]; o[e] = p ? (b[e] * cs[1] + a[e] * cs[0]) : (a[e] * cs[0] - b[e] * cs[1]); }
    return pack8(o);
}

template <int DQK, int QG>
__device__ __forceinline__ void attn_unit(LAS unsigned char* lds, const AttnArgs& A, const int tid) {
    constexpr int KT = 64;
    constexpr int QS = DQK + 8, VS = KT + 8, NCH = DQK / 8, NKS = DQK / 32, KCH = KT * NCH, KPT = (KCH + NTHREADS - 1) / NTHREADS, VPT = KT / 64, NT = KT / 16, NQ = 128 * QG;
    LAS bf16_t* Qs = (LAS bf16_t*)lds;
    LAS bf16_t* Ks = Qs + NQ * QS;
    LAS bf16_t* VT = Ks + 2 * KT * QS;
    LAS f32x2* TB = (LAS f32x2*)(VT + 2 * 64 * VS);
    const int lane = tid & 63, w = tid >> 6, fr = lane & 15, fq = lane >> 4;
    const int n0 = (A.seg0.k_hi - A.seg0.k_lo) / KT, n1 = (A.nseg > 1) ? ((A.seg1.k_hi - A.seg1.k_lo) / KT) : 0, ntiles = n0 + n1;
    int kkey[KPT], kch[KPT];
#pragma unroll
    for (int i = 0; i < KPT; ++i) { const int c = tid + i * NTHREADS; kkey[i] = c / NCH; kch[i] = c % NCH; }
    const int vkey = tid & 63, vch = tid >> 6;
    u32x4 kr[KPT], kp[KPT], vr[VPT]; int pf_kt = 0, pf_rope = 0, pf_mask = 0;
#define ATT_PREFETCH(j) do { const bool s0_ = (j) < n0; const KSeg S = s0_ ? A.seg0 : A.seg1; const int kt = s0_ ? (A.seg0.k_lo + KT * (j)) : (A.seg1.k_lo + KT * ((j) - n0)); \
        _Pragma("unroll") for (int i = 0; i < KPT; ++i) if (tid + i * NTHREADS < KCH) { const int d0 = kch[i] * 8; \
            if (DQK == 96 && kch[i] >= 8) kr[i] = *(const u32x4*)(S.K2 + (size_t)(kt + kkey[i]) * 32 + (d0 - 64)); \
            else { const bf16_t* src = S.K + (size_t)(kt + kkey[i]) * S.kstride; kr[i] = *(const u32x4*)(src + d0); if (DQK == 64 && (S.flags & 1)) kp[i] = *(const u32x4*)(src + (d0 ^ 16)); } } \
        _Pragma("unroll") for (int i = 0; i < VPT; ++i) vr[i] = *(const u32x4*)(S.V + (size_t)(kt + vkey + 64 * i) * S.vstride + vch * 8); \
        pf_kt = kt; pf_rope = S.flags & 1; pf_mask = S.flags & 2; } while (0)
#define ATT_WRITE(buf) do { LAS bf16_t* Kb = Ks + (buf) * KT * QS; LAS bf16_t* Vb = VT + (buf) * 64 * VS; \
        _Pragma("unroll") for (int i = 0; i < KPT; ++i) if (tid + i * NTHREADS < KCH) { u32x4 v = kr[i]; \
            if (DQK == 64 && pf_rope) { const int t = pf_kt + kkey[i], ch = kch[i], half = ch >> 2, p = (ch >> 1) & 1, f0 = (ch & 1) * 8, pos = half ? (t & 63) : (t >> 6); v = rope8l(v, kp[i], p, TB + pos * 16 + f0); } \
            *(LAS u32x4*)(Kb + kkey[i] * QS + kch[i] * 8) = v; } \
        _Pragma("unroll") for (int i = 0; i < VPT; ++i) { LAS bf16_t* dst = Vb + (vch * 8) * VS + vkey + 64 * i; const u32x4 v = vr[i]; \
          dst[0 * VS] = (bf16_t)(v.x & 0xffff); dst[1 * VS] = (bf16_t)(v.x >> 16); dst[2 * VS] = (bf16_t)(v.y & 0xffff); dst[3 * VS] = (bf16_t)(v.y >> 16); \
          dst[4 * VS] = (bf16_t)(v.z & 0xffff); dst[5 * VS] = (bf16_t)(v.z >> 16); dst[6 * VS] = (bf16_t)(v.w & 0xffff); dst[7 * VS] = (bf16_t)(v.w >> 16); } } while (0)
    ATT_PREFETCH(0);
    if (A.qrope) { for (int x = tid; x < 64 * 24; x += NTHREADS) TB[x] = A.tab64[x]; }
    __syncthreads();
    if constexpr (QG > 1) {
        for (int c = tid; c < NQ * NCH; c += NTHREADS) { const int qi = c / NCH, ch = c % NCH; *(LAS u32x4*)(Qs + qi * QS + ch * 8) = *(const u32x4*)(A.Q + (size_t)qi * A.qstride + ch * 8); }
    } else {
        constexpr int NQC = NQ * NCH / NTHREADS;
        u32x4 qv[NQC], qw[NQC];
#pragma unroll
        for (int i = 0; i < NQC; ++i) { const int c = tid + i * NTHREADS, qi = c / NCH, ch = c % NCH, d0 = ch * 8;
            const bf16_t* src = A.Q + (size_t)qi * A.qstride;
            qv[i] = *(const u32x4*)(src + d0);
            if (QG == 1 && A.qrope == 1) qw[i] = *(const u32x4*)(src + (d0 ^ 16));
            else if (QG == 1 && A.qrope == 2 && ch >= 8) qw[i] = *(const u32x4*)(src + 64 + (((ch - 8) ^ 1) * 8)); }
#pragma unroll
        for (int i = 0; i < NQC; ++i) { const int c = tid + i * NTHREADS, qi = c / NCH, ch = c % NCH, d0 = ch * 8, t = A.qpos0 + qi;
            u32x4 v = qv[i];
            if (QG == 1 && A.qrope == 1) { const int half = ch >> 2, p = (ch >> 1) & 1, f0 = (ch & 1) * 8, pos = half ? (t & 63) : (t >> 6); v = rope8l(v, qw[i], p, TB + pos * 16 + f0); }
            else if (QG == 1 && A.qrope == 2 && ch >= 8) { const int c2 = ch - 8, half = c2 >> 1, p = c2 & 1, pos = half ? (t & 63) : (t >> 6); v = rope8l(v, qw[i], p, TB + 64 * 16 + pos * 8); }
            *(LAS u32x4*)(Qs + qi * QS + d0) = v; }
    }
    ATT_WRITE(0);
    int cur_kt = pf_kt, cur_mask = pf_mask;
    if (ntiles > 1) ATT_PREFETCH(1);
    __syncthreads();
    bf16x8 Qf[QG][NKS];
#pragma unroll
    for (int g = 0; g < QG; ++g)
#pragma unroll
        for (int ks = 0; ks < NKS; ++ks) Qf[g][ks] = *(const LAS bf16x8*)(Qs + (g * 128 + w * 16 + fr) * QS + ks * 32 + fq * 8);
    const float scl2 = A.scale * 1.4426950408889634f;
    float m[QG], l[QG];
    f32x4 Oa[QG][4];
#pragma unroll
    for (int g = 0; g < QG; ++g) { m[g] = (A.m0 > -1e29f) ? A.m0 * 1.4426950408889634f : A.m0; l[g] = (fq == 0) ? A.l0 : 0.f;
#pragma unroll
        for (int dt = 0; dt < 4; ++dt) Oa[g][dt] = (f32x4){0.f, 0.f, 0.f, 0.f}; }
    for (int j = 0; j < ntiles; ++j) {
        const LAS bf16_t* Kb = Ks + (j & 1) * KT * QS; const LAS bf16_t* Vb = VT + (j & 1) * 64 * VS;
        f32x4 st[QG][NT];
#pragma unroll
        for (int nt = 0; nt < NT; ++nt) {
#pragma unroll
            for (int g = 0; g < QG; ++g) st[g][nt] = (f32x4){0.f, 0.f, 0.f, 0.f};
#pragma unroll
            for (int ks = 0; ks < NKS; ++ks) { const bf16x8 kf = *(const LAS bf16x8*)(Kb + (nt * 16 + fr) * QS + ks * 32 + fq * 8);
#pragma unroll
                for (int g = 0; g < QG; ++g) st[g][nt] = MFMA16(kf, Qf[g][ks], st[g][nt]); } }
        if (QG > 1) __builtin_amdgcn_sched_barrier(0);
        bf16x8 pf[QG][KT / 32];
#pragma unroll
        for (int g = 0; g < QG; ++g) {
            const int qp = A.qpos0 + g * 128 + w * 16 + fr;
            float mx = -1e30f;
#pragma unroll
            for (int nt = 0; nt < NT; ++nt)
#pragma unroll
                for (int jj = 0; jj < 4; ++jj) { float sc = st[g][nt][jj] * scl2;
                    if (cur_mask) { const int kpos = cur_kt + nt * 16 + fq * 4 + jj; const int dd = qp - kpos; if (dd > 128 || dd < -128) sc = -1e30f; }
                    st[g][nt][jj] = sc; mx = fmaxf(mx, sc); }
            mx = xor16_max(mx); mx = xor32_max(mx);
            const float mn = fmaxf(m[g], mx), alpha = __builtin_amdgcn_exp2f(m[g] - mn);
            float rs = 0.f;
#pragma unroll
            for (int nt = 0; nt < NT; ++nt)
#pragma unroll
                for (int jj = 0; jj < 4; ++jj) { const float pe = __builtin_amdgcn_exp2f(st[g][nt][jj] - mn); st[g][nt][jj] = pe; rs += pe; }
            l[g] = l[g] * alpha + rs; m[g] = mn;
#pragma unroll
            for (int dt = 0; dt < 4; ++dt) Oa[g][dt] = Oa[g][dt] * alpha;
#pragma unroll
            for (int kk = 0; kk < KT / 32; ++kk) {
                u32x4 pb; pb.x = cvtpk(st[g][2 * kk][0], st[g][2 * kk][1]); pb.y = cvtpk(st[g][2 * kk][2], st[g][2 * kk][3]); pb.z = cvtpk(st[g][2 * kk + 1][0], st[g][2 * kk + 1][1]); pb.w = cvtpk(st[g][2 * kk + 1][2], st[g][2 * kk + 1][3]);
                pf[g][kk] = __builtin_bit_cast(bf16x8, pb); }
        }
        if (QG > 1) __builtin_amdgcn_sched_barrier(0);
#pragma unroll
        for (int kk = 0; kk < KT / 32; ++kk)
#pragma unroll
            for (int dt = 0; dt < 4; ++dt) {
                const LAS bf16_t* vp = Vb + (dt * 16 + fr) * VS + 32 * kk + fq * 4;
                const u32x2 v0 = *(const LAS u32x2*)vp, v1 = *(const LAS u32x2*)(vp + 16);
                const u32x4 vv = {v0.x, v0.y, v1.x, v1.y};
#pragma unroll
                for (int g = 0; g < QG; ++g) Oa[g][dt] = MFMA16(__builtin_bit_cast(bf16x8, vv), pf[g][kk], Oa[g][dt]);
            }
        if (j + 1 < ntiles) { ATT_WRITE((j + 1) & 1); cur_kt = pf_kt; cur_mask = pf_mask; if (j + 2 < ntiles) ATT_PREFETCH(j + 2); }
        __syncthreads();
    }
#undef ATT_PREFETCH
#undef ATT_WRITE
#pragma unroll
    for (int g = 0; g < QG; ++g) {
        float lg = xor16_add(l[g]); lg = xor32_add(lg);
        const float inv = 1.f / lg;
        bf16_t* op = A.O + (size_t)(g * 128 + w * 16 + fr) * A.ostride + fq * 4;
#pragma unroll
        for (int dt = 0; dt < 4; ++dt) *(u32x2*)(op + dt * 16) = (u32x2){pk2(Oa[g][dt][0] * inv, Oa[g][dt][1] * inv), pk2(Oa[g][dt][2] * inv, Oa[g][dt][3] * inv)};
    }
}

__device__ __forceinline__ void swa_unit(const Args& a, const Ctx& cx, LAS unsigned char* lds, int i, int u) {
    const bf16_t* PROJ = (const bf16_t*)(cx.ws + WS_PROJ); bf16_t* MIX = (bf16_t*)(cx.ws + WS_MIX);
    AttnArgs A;
    A.tab64 = (const f32x2*)(cx.ws + WS_TAB);
    A.qstride = NPROJ_PAD; A.ostride = D; A.scale = 0.125f; A.l0 = 1.f;
    int npass, rowq, hq;
    if (u < 128) {
        const int b = u >> 6, qt = u & 7, row0 = TP + b * 1024, q0 = qt * 128; hq = (u >> 3) & 7; const int kv = hq >> 2;
        A.qpos0 = q0; A.qrope = 1; A.nseg = 2; npass = 1; rowq = row0 + q0;
        const bf16_t* csk = (const bf16_t*)(cx.ws + WS_CSK) + ((size_t)(i * 2 + b)) * 65536 + kv * 64;
        const bf16_t* csv = (const bf16_t*)(cx.ws + WS_CSV) + ((size_t)(i * 2 + b)) * 65536 + kv * 64;
        A.seg0 = KSeg{csk, 128, nullptr, csv, 128, 0, 512, 0};
        const int lo = q0 - 128 < 0 ? 0 : q0 - 128, hi = q0 + 256 > 1024 ? 1024 : q0 + 256;
        A.seg1 = KSeg{PROJ + (size_t)row0 * NPROJ_PAD + C_KB + kv * 64, NPROJ_PAD, nullptr, PROJ + (size_t)row0 * NPROJ_PAD + C_VB + kv * 64, NPROJ_PAD, lo, hi, 3};
    } else {
        const int v = u - 128, b = v >> 3, row0 = b * 256; hq = v & 7; const int kv = hq >> 2;
        A.qpos0 = 0; A.qrope = 0; A.nseg = 1; npass = 2; rowq = row0;
        A.seg0 = KSeg{PROJ + (size_t)row0 * NPROJ_PAD + C_KB + kv * 64, NPROJ_PAD, nullptr, PROJ + (size_t)row0 * NPROJ_PAD + C_VB + kv * 64, NPROJ_PAD, 0, 256, 0};
        A.seg1 = A.seg0;
    }
    A.m0 = (a.in[21] + cx.z)[i * 8 + hq];
    for (int ps = 0; ps < npass; ++ps) {
        A.Q = PROJ + (size_t)(rowq + ps * 128) * NPROJ_PAD + C_QB + hq * 64;
        A.O = MIX + (size_t)(rowq + ps * 128) * D + 512 + hq * 64;
        if (ps) A.qpos0 += 128;
        attn_unit<64, 1>(lds, A, cx.tid);
    }
}

__device__ __forceinline__ void mla_unit(const Args& a, const Ctx& cx, LAS unsigned char* lds, int u) {
    const bf16_t* Q = (const bf16_t*)(cx.ws + WS_Q); const bf16_t* KVX = (const bf16_t*)(cx.ws + WS_KVX); const bf16_t* KR = (const bf16_t*)(cx.ws + WS_KR);
    bf16_t* MIX = (bf16_t*)(cx.ws + WS_MIX);
    AttnArgs A;
    A.tab64 = (const f32x2*)(cx.ws + WS_TAB);
    A.qstride = 1536; A.ostride = D; A.scale = 0.10206207261596577f; A.l0 = 0.f; A.m0 = -1e30f;
    if (u < 256) {
        const int b = u >> 7, h = (u >> 3) & 15, qt = u & 7, row0 = TP + b * 1024, q0 = qt * 128, crow0 = T + b * 512;
        A.Q = Q + (size_t)(row0 + q0) * 1536 + h * 96; A.qpos0 = q0; A.qrope = 2; A.nseg = 2;
        A.seg0 = KSeg{KVX + (size_t)crow0 * 2048 + h * 128, 2048, KR + (size_t)crow0 * 32, KVX + (size_t)crow0 * 2048 + h * 128 + 64, 2048, 0, 512, 0};
        A.seg1 = KSeg{KVX + (size_t)row0 * 2048 + h * 128, 2048, KR + (size_t)row0 * 32, KVX + (size_t)row0 * 2048 + h * 128 + 64, 2048, 0, 1024, 0};
        A.O = MIX + (size_t)(row0 + q0) * D + h * 64;
        attn_unit<96, 1>(lds, A, cx.tid);
    } else {
        const int v = u - 256, b = v >> 4, h = v & 15, row0 = b * 256;
        A.Q = Q + (size_t)row0 * 1536 + h * 96; A.qpos0 = 0; A.qrope = 0; A.nseg = 1;
        A.seg0 = KSeg{KVX + (size_t)row0 * 2048 + h * 128, 2048, KR + (size_t)row0 * 32, KVX + (size_t)row0 * 2048 + h * 128 + 64, 2048, 0, 256, 0};
        A.seg1 = A.seg0;
        A.O = MIX + (size_t)row0 * D + h * 64;
        attn_unit<96, 2>(lds, A, cx.tid);
    }
}

constexpr int GL_G = 0;
constexpr int GL_STF = 32768, GL_STB = 51200;
constexpr int GL_LO = 32768, GL_WF = 40960, GL_WB = 45056, GL_BF = 49152, GL_BB = 49408;
constexpr int GL_QF = 69632, GL_KF = 78848, GL_QB = 88064, GL_KB = 97280;
constexpr int GL_VT = 106496;
constexpr int GL_AF = 124928, GL_AB = 134144;

__device__ __forceinline__ void gla_gates(const Args& a, const Ctx& cx, LAS unsigned char* lds, int i, int tok0, int h) {
    const int tid = cx.tid;
    const bf16_t* PROJ = (const bf16_t*)(cx.ws + WS_PROJ);
    LAS float* LO = (LAS float*)(lds + GL_LO); LAS float* WF = (LAS float*)(lds + GL_WF); LAS float* WB = (LAS float*)(lds + GL_WB);
    LAS float* BF = (LAS float*)(lds + GL_BF); LAS float* BB = (LAS float*)(lds + GL_BB);
    LAS float* Gf = (LAS float*)(lds + GL_G); LAS float* Gb = Gf + 4096;
    { const int t = tid >> 3, j0 = (tid & 7) * 4; const u32x2 v = *(const u32x2*)(PROJ + (size_t)(tok0 + t) * NPROJ_PAD + C_LO + j0);
      LO[t * 32 + j0] = bflo(v.x); LO[t * 32 + j0 + 1] = bfhi(v.x); LO[t * 32 + j0 + 2] = bflo(v.y); LO[t * 32 + j0 + 3] = bfhi(v.y); }
    for (int x = tid; x < 1024; x += NTHREADS) { const int r = x >> 6, d = x & 63;
        WF[x] = (a.in[16] + cx.z)[((size_t)i * 16 + r) * 256 + h * 64 + d]; WB[x] = (a.in[18] + cx.z)[((size_t)i * 16 + r) * 256 + h * 64 + d]; }
    if (tid < 64) { BF[tid] = (a.in[17] + cx.z)[i * 256 + h * 64 + tid]; BB[tid] = (a.in[19] + cx.z)[i * 256 + h * 64 + tid]; }
    __syncthreads();
    { const int d = tid & 63, tg = tid >> 6;
      LAS float* SEG = (LAS float*)(lds + GL_LO + 8192 + 8192 + 1024);
      float wf[16], wb[16];
#pragma unroll
      for (int r = 0; r < 16; ++r) { wf[r] = WF[r * 64 + d]; wb[r] = WB[r * 64 + d]; }
      const float bfv = BF[d], bbv = BB[d];
      float gf[8], gb[8];
#pragma unroll
      for (int tt = 0; tt < 8; ++tt) { const int t = tg * 8 + tt; float xf = bfv, xb = bbv;
#pragma unroll
          for (int r = 0; r < 16; ++r) { xf += LO[t * 32 + r] * wf[r]; xb += LO[t * 32 + 16 + r] * wb[r]; }
          gf[tt] = (fminf(xf, 0.f) - log1pf(__expf(-fabsf(xf)))) * (1.f / 16.f); gb[tt] = (fminf(xb, 0.f) - log1pf(__expf(-fabsf(xb)))) * (1.f / 16.f); }
#pragma unroll
      for (int tt = 1; tt < 8; ++tt) gf[tt] += gf[tt - 1];
#pragma unroll
      for (int tt = 6; tt >= 0; --tt) gb[tt] += gb[tt + 1];
      SEG[tg * 64 + d] = gf[7]; SEG[512 + tg * 64 + d] = gb[0];
      __syncthreads();
      float offf = 0.f, offb = 0.f;
#pragma unroll
      for (int q = 0; q < 8; ++q) { const float a_ = SEG[q * 64 + d], b_ = SEG[512 + q * 64 + d]; offf += (q < tg) ? a_ : 0.f; offb += (q > tg) ? b_ : 0.f; }
#pragma unroll
      for (int tt = 0; tt < 8; ++tt) { const int t = tg * 8 + tt; Gf[t * 64 + d] = gf[tt] + offf; Gb[t * 64 + d] = gb[tt] + offb; } }
    __syncthreads();
}

__device__ __forceinline__ void gla_vt_load(const bf16_t* PROJ, int tok0, int h, const int tid, u32x4 (&v)[2]) {
    const int s = tid & 63, e0 = (tid >> 6) * 16;
    const bf16_t* src = PROJ + (size_t)(tok0 + s) * NPROJ_PAD + C_VA + h * 128 + e0;
    v[0] = *(const u32x4*)src; v[1] = *(const u32x4*)(src + 8);
}
__device__ __forceinline__ void gla_vt_store(LAS unsigned char* lds, const int tid, const u32x4 (&vv)[2]) {
    const int s = tid & 63, e0 = (tid >> 6) * 16;
    LAS bf16_t* VT = (LAS bf16_t*)(lds + GL_VT);
#pragma unroll
    for (int q = 0; q < 2; ++q) { const u32x4 v = vv[q]; LAS bf16_t* dst = VT + (e0 + q * 8) * 72 + s;
        dst[0 * 72] = (bf16_t)(v.x & 0xffff); dst[1 * 72] = (bf16_t)(v.x >> 16); dst[2 * 72] = (bf16_t)(v.y & 0xffff); dst[3 * 72] = (bf16_t)(v.y >> 16);
        dst[4 * 72] = (bf16_t)(v.z & 0xffff); dst[5 * 72] = (bf16_t)(v.z >> 16); dst[6 * 72] = (bf16_t)(v.w & 0xffff); dst[7 * 72] = (bf16_t)(v.w >> 16); }
}

__device__ __forceinline__ void gla_local_unit(const Args& a, const Ctx& cx, LAS unsigned char* lds, int i, int u) {
    const int cg_ = u >> 2, h = u & 3, tok0 = cg_ * 64, tid = cx.tid, lane = tid & 63, w = tid >> 6, fr = lane & 15, fq = lane >> 4;
    const bf16_t* PROJ = (const bf16_t*)(cx.ws + WS_PROJ);
    float* LOC = (float*)(cx.ws + WS_LOC); float* DEC = (float*)(cx.ws + WS_DEC);
    u32x4 vpre[2]; gla_vt_load(PROJ, tok0, h, tid, vpre);
    const u32x4 kpre = *(const u32x4*)(PROJ + (size_t)(tok0 + (tid >> 3)) * NPROJ_PAD + C_KA + h * 64 + (tid & 7) * 8);
    __syncthreads();
    gla_gates(a, cx, lds, i, tok0, h);
    LAS float* Gf = (LAS float*)(lds + GL_G); LAS float* Gb = Gf + 4096;
    LAS bf16_t* KTf = (LAS bf16_t*)(lds + GL_KF); LAS bf16_t* KTb = (LAS bf16_t*)(lds + GL_KB);
    LAS bf16_t* VT = (LAS bf16_t*)(lds + GL_VT);
    { const int s = tid >> 3, d0 = (tid & 7) * 8; const u32x4 kv = kpre;
      float k[8]; unpack8(kv, k);
#pragma unroll
      for (int e = 0; e < 8; ++e) { const int d = d0 + e;
          KTf[d * 72 + s] = (bf16_t)f2bf(k[e] * __expf(Gf[63 * 64 + d] - Gf[s * 64 + d]));
          KTb[d * 72 + s] = (bf16_t)f2bf(k[e] * __expf(Gb[d] - Gb[s * 64 + d])); } }
    gla_vt_store(lds, tid, vpre);
    if (tid < 128) { const int dir = tid >> 6, d = tid & 63; DEC[((size_t)(dir * 96 + cg_) * 4 + h) * 64 + d] = __expf(dir ? Gb[d] : Gf[63 * 64 + d]); }
    __syncthreads();
    const int dir = w >> 2, dtile = w & 3;
    const LAS bf16_t* KT = dir ? KTb : KTf;
    bf16x8 af[2];
#pragma unroll
    for (int ks = 0; ks < 2; ++ks) af[ks] = *(const LAS bf16x8*)(KT + (dtile * 16 + fr) * 72 + ks * 32 + fq * 8);
    float* dst = LOC + ((size_t)(dir * 96 + cg_) * 4 + h) * 8192;
#pragma unroll
    for (int et = 0; et < 8; ++et) { f32x4 acc = {0.f, 0.f, 0.f, 0.f};
#pragma unroll
        for (int ks = 0; ks < 2; ++ks) { const bf16x8 bfv = *(const LAS bf16x8*)(VT + (et * 16 + fr) * 72 + ks * 32 + fq * 8); acc = MFMA16(af[ks], bfv, acc); }
#pragma unroll
        for (int j = 0; j < 4; ++j) dst[(dtile * 16 + fq * 4 + j) * 128 + et * 16 + fr] = acc[j]; }
}

__device__ __forceinline__ void gla_out_unit(const Args& a, const Ctx& cx, LAS unsigned char* lds, int i, int u) {
    const int cg_ = u >> 2, h = u & 3, tok0 = cg_ * 64, tid = cx.tid, lane = tid & 63, w = tid >> 6, fr = lane & 15, fq = lane >> 4;
    const bf16_t* PROJ = (const bf16_t*)(cx.ws + WS_PROJ); bf16_t* MIX = (bf16_t*)(cx.ws + WS_MIX);
    const float* LOC = (const float*)(cx.ws + WS_LOC); const float* DEC = (const float*)(cx.ws + WS_DEC);
    u32x4 vpre[2]; gla_vt_load(PROJ, tok0, h, tid, vpre);
    const u32x4 qpre = *(const u32x4*)(PROJ + (size_t)(tok0 + (tid >> 3)) * NPROJ_PAD + C_QA + h * 64 + (tid & 7) * 8);
    const u32x4 kpre = *(const u32x4*)(PROJ + (size_t)(tok0 + (tid >> 3)) * NPROJ_PAD + C_KA + h * 64 + (tid & 7) * 8);
    const bf16_t* gpp = PROJ + (size_t)(tok0 + (tid >> 3)) * NPROJ_PAD + C_GA + h * 128 + (tid & 7) * 16;
    const u32x4 gpre0 = *(const u32x4*)gpp, gpre1 = *(const u32x4*)(gpp + 8);
    f32x4 ggp[4];
    { const float* ggq = (a.in[20] + cx.z) + i * 128 + (tid & 7) * 16;
#pragma unroll
      for (int q = 0; q < 4; ++q) ggp[q] = *(const f32x4*)(ggq + q * 4); }
    const bool fin_f = (cg_ < 64) && ((cg_ & 3) == 3), fin_b = (cg_ < 64) && ((cg_ & 3) == 0);
    f32x4 finl[4]; float find = 0.f;
    if (fin_f || fin_b) { const size_t ix = (size_t)((fin_f ? 0 : 1) * 96 + cg_) * 4 + h; find = DEC[ix * 64 + (tid >> 3)]; const float* lp = LOC + ix * 8192 + (tid >> 3) * 128 + (tid & 7) * 16;
#pragma unroll
        for (int q = 0; q < 4; ++q) finl[q] = *(const f32x4*)(lp + q * 4); }
    __syncthreads();
    gla_gates(a, cx, lds, i, tok0, h);
    LAS float* Gf = (LAS float*)(lds + GL_G); LAS float* Gb = Gf + 4096;
    const bool samp = cg_ >= 64;
    const int b = samp ? (cg_ - 64) >> 4 : cg_ >> 2, c = samp ? (cg_ - 64) & 15 : cg_ & 3, nc = samp ? 16 : 4, cbase = cg_ - c;
    {
        const int d = tid >> 3, e0 = (tid & 7) * 16;
        f32x4 Sf[4], Sb[4];
        if (samp) { const float* s0f = (a.in[2] + cx.z) + ((size_t)((b * 2 + i) * 4 + h)) * 8192 + d * 128 + e0; const float* s0b = (a.in[3] + cx.z) + ((size_t)((b * 2 + i) * 4 + h)) * 8192 + d * 128 + e0;
#pragma unroll
            for (int q = 0; q < 4; ++q) { Sf[q] = *(const f32x4*)(s0f + q * 4); Sb[q] = *(const f32x4*)(s0b + q * 4); } }
        else {
#pragma unroll
            for (int q = 0; q < 4; ++q) { Sf[q] = (f32x4){0.f, 0.f, 0.f, 0.f}; Sb[q] = Sf[q]; } }
        for (int j = 0; j < c; ++j) { const size_t ix = (size_t)(0 * 96 + cbase + j) * 4 + h; const float dec = DEC[ix * 64 + d]; const float* lp = LOC + ix * 8192 + d * 128 + e0;
#pragma unroll
            for (int q = 0; q < 4; ++q) Sf[q] = Sf[q] * dec + *(const f32x4*)(lp + q * 4); }
        for (int j = nc - 1; j > c; --j) { const size_t ix = (size_t)(1 * 96 + cbase + j) * 4 + h; const float dec = DEC[ix * 64 + d]; const float* lp = LOC + ix * 8192 + d * 128 + e0;
#pragma unroll
            for (int q = 0; q < 4; ++q) Sb[q] = Sb[q] * dec + *(const f32x4*)(lp + q * 4); }
        if (fin_f) { float* o = cx.out + O_SF + ((size_t)((b * 2 + i) * 4 + h)) * 8192 + d * 128 + e0;
#pragma unroll
            for (int q = 0; q < 4; ++q) *(f32x4*)(o + q * 4) = Sf[q] * find + finl[q]; }
        if (fin_b) { float* o = cx.out + O_SB + ((size_t)((b * 2 + i) * 4 + h)) * 8192 + d * 128 + e0;
#pragma unroll
            for (int q = 0; q < 4; ++q) *(f32x4*)(o + q * 4) = Sb[q] * find + finl[q]; }
        LAS bf16_t* STf = (LAS bf16_t*)(lds + GL_STF); LAS bf16_t* STb = (LAS bf16_t*)(lds + GL_STB);
#pragma unroll
        for (int q = 0; q < 4; ++q)
#pragma unroll
            for (int e = 0; e < 4; ++e) { STf[(e0 + q * 4 + e) * 72 + d] = (bf16_t)f2bf(Sf[q][e]); STb[(e0 + q * 4 + e) * 72 + d] = (bf16_t)f2bf(Sb[q][e]); }
    }
    {
        const int t = tid >> 3, d0 = (tid & 7) * 8;
        const u32x4 qv = qpre, kv = kpre;
        float q[8], k[8], o1[8], o2[8], o3[8], o4[8]; unpack8(qv, q); unpack8(kv, k);
#pragma unroll
        for (int e = 0; e < 8; ++e) { const float gf = Gf[t * 64 + d0 + e], gb = Gb[t * 64 + d0 + e];
            o1[e] = q[e] * 0.125f * __expf(gf); o2[e] = k[e] * __expf(-gf); o3[e] = q[e] * 0.125f * __expf(gb); o4[e] = k[e] * __expf(-gb); }
        *(LAS u32x4*)((LAS bf16_t*)(lds + GL_QF) + t * 72 + d0) = pack8(o1);
        *(LAS u32x4*)((LAS bf16_t*)(lds + GL_KF) + t * 72 + d0) = pack8(o2);
        *(LAS u32x4*)((LAS bf16_t*)(lds + GL_QB) + t * 72 + d0) = pack8(o3);
        *(LAS u32x4*)((LAS bf16_t*)(lds + GL_KB) + t * 72 + d0) = pack8(o4);
    }
    gla_vt_store(lds, tid, vpre);
    __syncthreads();
    {
        const int dir = w >> 2, tt = w & 3;
        const LAS bf16_t* Qm = (const LAS bf16_t*)(lds + (dir ? GL_QB : GL_QF)); const LAS bf16_t* Km = (const LAS bf16_t*)(lds + (dir ? GL_KB : GL_KF));
        LAS bf16_t* AT = (LAS bf16_t*)(lds + (dir ? GL_AB : GL_AF));
        bf16x8 af[2];
#pragma unroll
        for (int ks = 0; ks < 2; ++ks) af[ks] = *(const LAS bf16x8*)(Qm + (tt * 16 + fr) * 72 + ks * 32 + fq * 8);
#pragma unroll
        for (int st = 0; st < 4; ++st) { f32x4 acc = {0.f, 0.f, 0.f, 0.f};
#pragma unroll
            for (int ks = 0; ks < 2; ++ks) { const bf16x8 bfv = *(const LAS bf16x8*)(Km + (st * 16 + fr) * 72 + ks * 32 + fq * 8); acc = MFMA16(af[ks], bfv, acc); }
#pragma unroll
            for (int j = 0; j < 4; ++j) { const int t = tt * 16 + fq * 4 + j, s = st * 16 + fr; const bool keep = dir ? (s >= t) : (s <= t);
                AT[t * 72 + s] = (bf16_t)f2bf(keep ? acc[j] : 0.f); } }
    }
    __syncthreads();
    {
        const int tt = w & 3, eg = w >> 2;
        LAS float* OS = (LAS float*)(lds + GL_G);
        const LAS bf16_t* VT = (const LAS bf16_t*)(lds + GL_VT);
        bf16x8 a1[2], a2[2], a3[2], a4[2];
#pragma unroll
        for (int ks = 0; ks < 2; ++ks) { const int off = (tt * 16 + fr) * 72 + ks * 32 + fq * 8;
            a1[ks] = *(const LAS bf16x8*)((const LAS bf16_t*)(lds + GL_QF) + off); a2[ks] = *(const LAS bf16x8*)((const LAS bf16_t*)(lds + GL_AF) + off);
            a3[ks] = *(const LAS bf16x8*)((const LAS bf16_t*)(lds + GL_QB) + off); a4[ks] = *(const LAS bf16x8*)((const LAS bf16_t*)(lds + GL_AB) + off); }
        f32x4 accs[4];
#pragma unroll
        for (int q = 0; q < 4; ++q) { const int et = eg * 4 + q; f32x4 acc = {0.f, 0.f, 0.f, 0.f};
#pragma unroll
            for (int ks = 0; ks < 2; ++ks) { const int off = (et * 16 + fr) * 72 + ks * 32 + fq * 8;
                const bf16x8 b1 = *(const LAS bf16x8*)((const LAS bf16_t*)(lds + GL_STF) + off), b2 = *(const LAS bf16x8*)(VT + off), b3 = *(const LAS bf16x8*)((const LAS bf16_t*)(lds + GL_STB) + off);
                acc = MFMA16(a1[ks], b1, acc); acc = MFMA16(a2[ks], b2, acc); acc = MFMA16(a3[ks], b3, acc); acc = MFMA16(a4[ks], b2, acc); }
            accs[q] = acc; }
#pragma unroll
        for (int q = 0; q < 4; ++q)
#pragma unroll
            for (int j = 0; j < 4; ++j) OS[(tt * 16 + fq * 4 + j) * 128 + (eg * 4 + q) * 16 + fr] = accs[q][j];
    }
    __syncthreads();
    {
        const int t = tid >> 3, e0 = (tid & 7) * 16;
        const LAS float* OS = (const LAS float*)(lds + GL_G);
        float o[16]; float ss = 0.f;
#pragma unroll
        for (int e = 0; e < 16; ++e) { o[e] = OS[t * 128 + e0 + e]; ss += o[e] * o[e]; }
        ss += __shfl_xor(ss, 1); ss += __shfl_xor(ss, 2); ss += __shfl_xor(ss, 4);
        const float rstd = rsqrtf(ss * (1.f / 128.f) + EPS);
        float gt[16]; unpack8(gpre0, gt); unpack8(gpre1, gt + 8);
#pragma unroll
        for (int e = 0; e < 16; ++e) o[e] = o[e] * rstd * ggp[e >> 2][e & 3] * silu_f(gt[e]);
        bf16_t* op = MIX + (size_t)(tok0 + t) * D + h * 128 + e0;
        *(u32x4*)op = pack8(o); *(u32x4*)(op + 8) = pack8(o + 8);
    }
}


#define XB_TMO      128
#define XB_XCNT(j)  (256  + 64 * (j))
#define XB_XSUB(j)  (1280 + 64 * (j))
#define XB_XGEN(j)  (2304 + 64 * (j))
#define XB_TOP      3328
#define XB_TOPGEN   3392
#define XCD_BAR_WORDS 3456
#define XB_SPIN_CAP (1u << 18)
__device__ __forceinline__ unsigned xb_ld(unsigned* p)              { return __hip_atomic_load(p, __ATOMIC_RELAXED, __HIP_MEMORY_SCOPE_AGENT); }
__device__ __forceinline__ unsigned xb_add(unsigned* p, unsigned v) { return __hip_atomic_fetch_add(p, v, __ATOMIC_RELAXED, __HIP_MEMORY_SCOPE_AGENT); }
__device__ __forceinline__ unsigned xb_xcc_id() { return (unsigned)__builtin_amdgcn_s_getreg((3 << 11) | 20) & 0xFu; }
#define XB_SPIN(cond, bar) do { unsigned _sp = 0; while (cond) { __builtin_amdgcn_s_sleep(1); \
    if ((++_sp & 255u) == 0u) { if (xb_ld(&(bar)[XB_TMO])) break; if (_sp > XB_SPIN_CAP) { atomicAdd(&(bar)[XB_TMO], 1u); break; } } } } while (0)
struct XcdBarrier { unsigned* bar; unsigned x; volatile LAS unsigned* st; };
__device__ __forceinline__ XcdBarrier xcd_barrier_post(unsigned* bar, volatile LAS unsigned* st, const int tid) {
    XcdBarrier b; b.bar = bar; b.x = xb_xcc_id(); b.st = st;
    if (tid == 0) (void)xb_add(&bar[XB_XCNT(b.x)], 1u);
    return b;
}
__device__ __forceinline__ void xcd_barrier_complete(unsigned* bar, unsigned x, unsigned& nloc, unsigned& nx) {
    const unsigned G = gridDim.x * gridDim.y * gridDim.z;
    unsigned sum, cnt, mine, sp = 0u;
    for (;;) {
        sum = 0u; cnt = 0u; mine = 0u;
#pragma unroll
        for (unsigned j = 0; j < 16; ++j) { const unsigned c = xb_ld(&bar[XB_XCNT(j)]); sum += c; cnt += (c > 0u) ? 1u : 0u; mine = (j == x) ? c : mine; }
        if (sum == G) break;
        __builtin_amdgcn_s_sleep(1);
        if ((++sp & 255u) == 0u) { if (xb_ld(&bar[XB_TMO])) break; if (sp > XB_SPIN_CAP) { atomicAdd(&bar[XB_TMO], 1u); break; } }
    }
    nloc = mine > 0u ? mine : 1u; nx = cnt > 0u ? cnt : 1u;
}
__device__ __forceinline__ void xcd_barrier(const XcdBarrier& b, const int tid) {
    asm volatile("s_waitcnt vmcnt(0)" ::: "memory");
    __syncthreads();
    if (tid == 0) {
        unsigned* bar = b.bar;
        __builtin_amdgcn_s_waitcnt(0);
        unsigned nloc = b.st[0], nx = b.st[1];
        if (nloc == 0u) { xcd_barrier_complete(bar, b.x, nloc, nx); b.st[0] = nloc; b.st[1] = nx; }
        const unsigned old = xb_add(&bar[XB_XSUB(b.x)], 1u);
        const unsigned gen = old / nloc;
        if (old + 1u == (gen + 1u) * nloc) {
            __builtin_amdgcn_fence(__ATOMIC_RELEASE, "agent");
            asm volatile("s_waitcnt vmcnt(0)" ::: "memory");
            const unsigned og = xb_add(&bar[XB_TOP], 1u);
            const unsigned tg = og / nx;
            if (og + 1u == (tg + 1u) * nx) xb_add(&bar[XB_TOPGEN], 1u);
            else XB_SPIN(xb_ld(&bar[XB_TOPGEN]) == tg, bar);
            __builtin_amdgcn_fence(__ATOMIC_ACQUIRE, "agent");
            asm volatile("s_waitcnt vmcnt(0)" ::: "memory");
        } else {
            XB_SPIN(xb_ld(&bar[XB_TOPGEN]) == gen, bar);
            __builtin_amdgcn_fence(__ATOMIC_ACQUIRE, "agent");
            asm volatile("s_waitcnt vmcnt(0)" ::: "memory");
        }
    }
    __syncthreads();
}

enum { K_PRO = 0, K_PRE, K_G1, K_A1, K_A2, K_DOWN, K_MID, K_UQKV, K_MLA, K_OUTP, K_POST1, K_FF1, K_FF2, K_POST2 };
constexpr int N_PHASES = 2 + 2 * 8 + 2 * 9;
#ifndef EN_MASK
#define EN_MASK 0xFFFFFFFFu
#endif
#define ENB(k) (((EN_MASK) >> (k)) & 1u)
#ifndef DUP_MASK
#define DUP_MASK 0u
#endif
#ifndef BAR_REPS
#define BAR_REPS 1
#endif

__global__ void __launch_bounds__(NTHREADS, 2) mega_fwd(Args args) {
    extern __shared__ __attribute__((aligned(16))) unsigned char lds_raw[];
    LAS unsigned char* lds = (LAS unsigned char*)lds_raw;
    const int lo = args.ph_lo, hi = args.ph_hi;
    const int wave_s = __builtin_amdgcn_readfirstlane((int)(threadIdx.x >> 6));
#define MY_TID(dst) do { int _l; asm volatile("v_mbcnt_lo_u32_b32 %0, -1, 0\n\tv_mbcnt_hi_u32_b32 %0, -1, %0" : "=v"(_l)); dst = wave_s * 64 + _l; } while (0)
    {
        int tid0; MY_TID(tid0);
        volatile LAS unsigned* bst = (volatile LAS unsigned*)(lds + LDS_BYTES - 64);
        if (tid0 < 2) bst[tid0] = 0u;
        __syncthreads();
        (void)xcd_barrier_post((unsigned*)(args.ws + WS_CTL), bst, tid0);
    }
    for (int p = lo; p < hi; ++p) {
        int kind, l;
        if (p == 0) { kind = K_PRO; l = 0; }
        else if (p == 1) { kind = K_PRE; l = 0; }
        else {
            const int q = p - 2, pair = q / 17, r = q - pair * 17;
            if (r < 8) { l = 2 * pair; kind = (r == 0) ? K_G1 : (r == 1) ? K_A1 : (r == 2) ? K_A2 : (r == 3) ? K_OUTP : (r == 4) ? K_POST1 : (r == 5) ? K_FF1 : (r == 6) ? K_FF2 : K_POST2; }
            else { const int r2 = r - 8; l = 2 * pair + 1; kind = (r2 == 0) ? K_DOWN : (r2 == 1) ? K_MID : (r2 == 2) ? K_UQKV : (r2 == 3) ? K_MLA : (r2 == 4) ? K_OUTP : (r2 == 5) ? K_POST1 : (r2 == 6) ? K_FF1 : (r2 == 7) ? K_FF2 : K_POST2; }
        }
        int cv_g0 = -1, cv_stride = 1, cv_end = 0;
        if (gridDim.x == 256 && l < 3) {
            const int bidx = blockIdx.x;
            if (kind == K_FF1 && bidx >= 128) { cv_g0 = l * 6144 + (bidx - 128) * NWAVES + wave_s; cv_stride = 1024; cv_end = l * 6144 + 3072; }
            else if (kind == K_FF2 && bidx >= 192) { cv_g0 = l * 6144 + 3072 + (bidx - 192) * NWAVES + wave_s; cv_stride = 512; cv_end = (l + 1) * 6144; }
        }
        const int kind0 = kind;
        const int reps = (cv_g0 >= 0) ? 2 : (((DUP_MASK >> kind) & 1u) ? 2 : 1);
        for (int rep = 0; rep < reps; ++rep) {
        if (rep) __syncthreads();
        int pmode = 0;
        if (rep && cv_g0 >= 0) { kind = K_PRO; pmode = 1; } else kind = kind0;
        Ctx cx; cx.z = 0; MY_TID(cx.tid); cx.bid = blockIdx.x; cx.G = gridDim.x;
        asm volatile("" : "+s"(cx.z), "+s"(kind), "+s"(l), "+v"(cx.tid), "+s"(cx.bid), "+s"(cx.G));
        cx.ws = args.ws + cx.z; cx.out = args.out + cx.z;
        unsigned char* ws = cx.ws;
        const int i = l >> 1, G = cx.G, bid = cx.bid;
        switch (kind) {
        case K_PRO: if (ENB(0)) prologue(args, cx, lds, pmode, cv_g0, cv_stride, cv_end); break;
        case K_PRE: if (ENB(1)) pre_rows(args, cx, 0); break;
        case K_G1: if (ENB(2)) {
            pg8::Gemm g{(const bf16_t*)(ws + WS_H), (const bf16_t*)(ws + WS_WIN) + (size_t)i * NPROJ_PAD * D, T, NPROJ_PAD, D, D, D, NPROJ_PAD / 256, 0};
            pg8::StaticOrder S; S.init(T, NPROJ_PAD, G, bid);
            pg8::EpiProj E{(bf16_t*)(ws + WS_PROJ), cx.out, i};
            pg8::gemm_phase<pg8::EpiProj, pg8::StaticOrder>(lds, g, S, E, cx.tid);
        } break;
        case K_A1:
            if (G == 256) {
                if (bid < 128) { if (ENB(3)) swa_unit(args, cx, lds, i, bid); if (ENB(4)) gla_local_unit(args, cx, lds, i, bid); }
                else { const int q = bid - 128; if (ENB(3)) swa_unit(args, cx, lds, i, 128 + q);
                       if (ENB(4)) { gla_local_unit(args, cx, lds, i, 128 + 2 * q); gla_local_unit(args, cx, lds, i, 128 + 2 * q + 1); } }
            } else { for (int u = bid; u < 640; u += G) { if (u < 256) { if (ENB(3)) swa_unit(args, cx, lds, i, u); } else { if (ENB(4)) gla_local_unit(args, cx, lds, i, u - 256); } } }
            break;
        case K_A2:
            if (G == 256) {
                if (bid < 128) { if (ENB(5)) { gla_out_unit(args, cx, lds, i, 256 + bid); gla_out_unit(args, cx, lds, i, bid); } }
                else { if (ENB(5)) gla_out_unit(args, cx, lds, i, bid); }
            } else { for (int u = bid; u < 384; u += G) if (ENB(5)) gla_out_unit(args, cx, lds, i, u); }
            break;
        case K_MID: if (ENB(7)) mla_mid(args, cx, i); break;
        case K_UQKV: if (ENB(8)) {
            for (int s = 0; s < 2; ++s) {
                pg8::Gemm g;
                if (s == 0) g = pg8::Gemm{(const bf16_t*)(ws + WS_CQ), (const bf16_t*)(ws + WS_WUQ) + (size_t)i * 1536 * 384, T, 1536, 384, 384, 384, 6, 0};
                else        g = pg8::Gemm{(const bf16_t*)(ws + WS_CKV), (const bf16_t*)(ws + WS_WUKV) + (size_t)i * 2048 * 256, T + 1024, 2048, 256, 256, 256, 8, 0};
                pg8::StaticOrder S; S.init(g.M, g.N, G, (s == 0 || G != 256) ? bid : ((bid + 144) & 255));
                pg8::EpiBf16<0> E{s == 0 ? (bf16_t*)(ws + WS_Q) : (bf16_t*)(ws + WS_KVX), g.N};
                pg8::gemm_phase<pg8::EpiBf16<0>, pg8::StaticOrder>(lds, g, S, E, cx.tid);
            }
        } break;
        case K_MLA: if (ENB(9)) {
            if (G == 256) {
                const int xcd = bid & 7, slot = bid >> 3, id = xcd * 4 + (slot >> 3);
                mla_unit(args, cx, lds, id * 8 + (slot & 7));
                mla_unit(args, cx, lds, 256 + bid);
            } else { for (int u = bid; u < 512; u += G) mla_unit(args, cx, lds, u); }
        } break;
        case K_DOWN: if (ENB(10)) {
            pg8::Gemm g{(const bf16_t*)(ws + WS_H), (const bf16_t*)(ws + WS_WDOWN) + (size_t)i * NDOWN_PAD * D, T, 2 * NDOWN_PAD, D / 2, D, D / 2, NDOWN_PAD / 256, D / 2};
            pg8::EpiF32 E{(float*)(ws + WS_OUT), NDOWN_PAD, NDOWN_PAD / 256, DOWN_SPLIT};
            pg8::StaticOrder S; S.init(g.M, g.N, G, bid);
            pg8::gemm_phase<pg8::EpiF32, pg8::StaticOrder>(lds, g, S, E, cx.tid);
        } break;
        case K_OUTP: case K_FF2: if (ENB(10)) {
            pg8::Gemm g;
            if (kind == K_OUTP) {
                const bf16_t* Wt = (l & 1) ? (const bf16_t*)(ws + WS_WO) + (size_t)i * D * D : (const bf16_t*)(ws + WS_WOUT) + (size_t)i * D * D;
                g = pg8::Gemm{(const bf16_t*)(ws + WS_MIX), Wt, T, 2 * D, D / 2, D, D / 2, 4, D / 2};
            } else {
                g = pg8::Gemm{(const bf16_t*)(ws + WS_U), (const bf16_t*)(ws + WS_WFF2) + (size_t)l * FF * D, T, 2 * D, FF / 2, FF, FF / 2, 4, FF / 2};
            }
            pg8::EpiSplitBf16 E{(bf16_t*)(ws + WS_OUT), D, 4, OUT_SPLIT};
            pg8::StaticOrder S; S.init(g.M, g.N, G, bid);
            pg8::gemm_phase<pg8::EpiSplitBf16, pg8::StaticOrder>(lds, g, S, E, cx.tid);
        } break;
        case K_FF1: if (ENB(12)) {
            pg8::Gemm g{(const bf16_t*)(ws + WS_H), (const bf16_t*)(ws + WS_WFF1) + (size_t)l * FF * D, T, FF, D, D, D, FF / 256, 0};
            pg8::StaticOrder S; S.init(T, FF, G, bid);
            pg8::EpiBf16<1> E{(bf16_t*)(ws + WS_U), FF};
            pg8::gemm_phase<pg8::EpiBf16<1>, pg8::StaticOrder>(lds, g, S, E, cx.tid);
        } break;
        case K_POST1: if (ENB(11)) {
            const float* MODL = (const float*)(ws + WS_MOD) + (size_t)l * 3 * 6144; const float* gN = (args.in[12] + cx.z) + (size_t)l * 4 * D;
            post_rows(args, cx, l == 0, MODL + 2 * D, gN + D, true, gN + 2 * D, MODL + 3 * D, MODL + 4 * D, rep + 1 < reps);
        } break;
        case K_POST2: if (ENB(14)) {
            const float* MODL = (const float*)(ws + WS_MOD) + (size_t)l * 3 * 6144; const float* gN = (args.in[12] + cx.z) + (size_t)l * 4 * D;
            const float* MODN = MODL + 3 * 6144; const float* gNn = gN + 4 * D;
            post_rows(args, cx, false, MODL + 5 * D, gN + 3 * D, l < 3, gNn, MODN, MODN + D, rep + 1 < reps);
        } break;
        default: break;
        }
        }
        if (p + 1 < hi) { if (hi < 0) cg::this_grid().sync(); else { XcdBarrier xb; xb.bar = (unsigned*)(args.ws + WS_CTL); xb.x = xb_xcc_id(); xb.st = (volatile LAS unsigned*)(lds + LDS_BYTES - 64); int tidb; MY_TID(tidb); for (int br = 0; br < BAR_REPS; ++br) xcd_barrier(xb, tidb); } }
    }
}

extern "C" void kernel_launch(void* const* d_in, const int* in_sizes, int n_in, void* d_out, int out_size, void* d_ws, size_t ws_size, hipStream_t stream) {
    static int grid = 0;
    if (grid == 0) {
        int dev = 0, cus = 0, per_cu = 0;
        hipGetDevice(&dev);
        hipDeviceGetAttribute(&cus, hipDeviceAttributeMultiprocessorCount, dev);
        hipFuncSetAttribute((const void*)mega_fwd, hipFuncAttributeMaxDynamicSharedMemorySize, LDS_BYTES);
        hipOccupancyMaxActiveBlocksPerMultiprocessor(&per_cu, (const void*)mega_fwd, NTHREADS, LDS_BYTES);
        if (per_cu < 1) { fprintf(stderr, "kernel_launch: occupancy query says %d blocks per CU\n", per_cu); per_cu = 1; }
        (void)hipGetLastError();
        grid = cus;
        if (ws_size < 256 * MiB) fprintf(stderr, "kernel_launch: workspace too small (%zu)\n", ws_size);
    }
    (void)hipMemsetAsync((char*)d_ws + WS_CTL, 0, CTL_BYTES, stream);
    Args a{};
    for (int i = 0; i < 29; ++i) a.in[i] = (const float*)d_in[i];
    a.out = (float*)d_out; a.ws = (unsigned char*)d_ws;
#if MK_ONE_LAUNCH
    a.ph_lo = 0; a.ph_hi = N_PHASES;
    void* kargs[] = {&a};
    hipError_t e = hipLaunchCooperativeKernel((const void*)mega_fwd, dim3(grid), dim3(NTHREADS), kargs, LDS_BYTES, stream);
    if (e != hipSuccess) fprintf(stderr, "cooperative launch failed: %s (grid %d)\n", hipGetErrorString(e), grid);
#else
    for (int p = 0; p < N_PHASES; ++p) {
        a.ph_lo = p; a.ph_hi = p + 1;
        hipLaunchKernelGGL(mega_fwd, dim3(grid), dim3(NTHREADS), LDS_BYTES, stream, a);
    }
#endif
}
```

```cpp
#include <hip/hip_runtime.h>
#include <hip/hip_cooperative_groups.h>
#include <cstdio>
#include <cstdint>
namespace cg = cooperative_groups;

#ifndef MK_ONE_LAUNCH
#define MK_ONE_LAUNCH 1
#endif

#define LAS __attribute__((address_space(3)))
#define GAS __attribute__((address_space(1)))
typedef unsigned short bf16_t;
typedef short bf16x8 __attribute__((ext_vector_type(8)));
typedef float f32x4 __attribute__((ext_vector_type(4)));
typedef float f32x2 __attribute__((ext_vector_type(2)));
typedef unsigned u32x4 __attribute__((ext_vector_type(4)));
typedef unsigned u32x2 __attribute__((ext_vector_type(2)));

constexpr int D = 1024, TP = 4096, TS = 2048, T = TP + TS, FF = 4096;
constexpr int NPROJ = 2336, NPROJ_PAD = 2560, NDOWN = 672, NDOWN_PAD = 768;
constexpr int C_QA = 0, C_KA = 256, C_VA = 512, C_GA = 1024, C_LO = 1536, C_QB = 1568, C_KB = 2080, C_VB = 2208;
constexpr float EPS = 1e-6f;
constexpr int NTHREADS = 512, NWAVES = 8;
constexpr int LDS_BYTES = 147456;

constexpr size_t O_X = 0, O_SF = 6291456, O_SB = 7340032, O_CK = 8388608, O_CV = 9437184, O_CKV = 10485760, O_CKR = 12582912;

constexpr size_t MiB = 1u << 20;
constexpr size_t WS_WFF1 = 0, WS_WFF2 = 32 * MiB, WS_WIN = 64 * MiB, WS_WOUT = 74 * MiB, WS_WDOWN = 78 * MiB, WS_WUQ = 81 * MiB,
                 WS_WUKV = 84 * MiB, WS_WO = 86 * MiB, WS_MOD = 90 * MiB, WS_TAB = 91 * MiB, WS_CSK = 92 * MiB, WS_CSV = 93 * MiB,
                 WS_H = 94 * MiB, WS_MIX = 106 * MiB, WS_OUT = 118 * MiB, WS_U = 166 * MiB, WS_PROJ = 214 * MiB, WS_CTL = 250 * MiB;
constexpr size_t CTL_BYTES = 16384;
constexpr size_t WS_LOC = WS_U, WS_DEC = WS_U + 24 * MiB;
constexpr size_t WS_Q = WS_U, WS_KVX = WS_U + 18 * MiB;
constexpr size_t WS_DOWN = WS_PROJ, WS_CQ = WS_PROJ + 18 * MiB, WS_CKV = WS_PROJ + 23 * MiB, WS_KR = WS_PROJ + 27 * MiB;
constexpr size_t OUT_SPLIT = (size_t)T * D;
constexpr size_t DOWN_SPLIT = (WS_DOWN - WS_OUT) / 4;

__device__ __forceinline__ unsigned f2bf(float f) { unsigned u = __builtin_bit_cast(unsigned, f); return (u + 0x7fffu + ((u >> 16) & 1u)) >> 16; }
__device__ __forceinline__ unsigned pk2(float lo, float hi) { return f2bf(lo) | (f2bf(hi) << 16); }
__device__ __forceinline__ float bf2f(unsigned short b) { return __builtin_bit_cast(float, (unsigned)b << 16); }
__device__ __forceinline__ float bflo(unsigned w) { return __builtin_bit_cast(float, w << 16); }
__device__ __forceinline__ float bfhi(unsigned w) { return __builtin_bit_cast(float, w & 0xffff0000u); }
__device__ __forceinline__ void unpack8(const u32x4 v, float* f) {
    f[0] = bflo(v.x); f[1] = bfhi(v.x); f[2] = bflo(v.y); f[3] = bfhi(v.y); f[4] = bflo(v.z); f[5] = bfhi(v.z); f[6] = bflo(v.w); f[7] = bfhi(v.w);
}
__device__ __forceinline__ u32x4 pack8(const float* f) { u32x4 o; o.x = pk2(f[0], f[1]); o.y = pk2(f[2], f[3]); o.z = pk2(f[4], f[5]); o.w = pk2(f[6], f[7]); return o; }
__device__ __forceinline__ float wave_sum(float v) {
#pragma unroll
    for (int o = 1; o < 64; o <<= 1) v += __shfl_xor(v, o);
    return v;
}
__device__ __forceinline__ float xor16_max(float x) { const unsigned u = __builtin_bit_cast(unsigned, x); auto r = __builtin_amdgcn_permlane16_swap(u, u, false, false); return fmaxf(__builtin_bit_cast(float, (unsigned)r[0]), __builtin_bit_cast(float, (unsigned)r[1])); }
__device__ __forceinline__ float xor32_max(float x) { const unsigned u = __builtin_bit_cast(unsigned, x); auto r = __builtin_amdgcn_permlane32_swap(u, u, false, false); return fmaxf(__builtin_bit_cast(float, (unsigned)r[0]), __builtin_bit_cast(float, (unsigned)r[1])); }
__device__ __forceinline__ float xor16_add(float x) { const unsigned u = __builtin_bit_cast(unsigned, x); auto r = __builtin_amdgcn_permlane16_swap(u, u, false, false); return __builtin_bit_cast(float, (unsigned)r[0]) + __builtin_bit_cast(float, (unsigned)r[1]); }
__device__ __forceinline__ float xor32_add(float x) { const unsigned u = __builtin_bit_cast(unsigned, x); auto r = __builtin_amdgcn_permlane32_swap(u, u, false, false); return __builtin_bit_cast(float, (unsigned)r[0]) + __builtin_bit_cast(float, (unsigned)r[1]); }
__device__ __forceinline__ unsigned cvtpk(float lo, float hi) { unsigned r; asm volatile("v_cvt_pk_bf16_f32 %0, %1, %2" : "=v"(r) : "v"(lo), "v"(hi)); return r; }
__device__ __forceinline__ float silu_f(float x) { return x / (1.f + __expf(-x)); }

namespace pg8 {
constexpr int BM = 256, BK = 64, HALF = 128, HTB = HALF * BK * 2, NXCD = 8, WGM = 8;
__host__ __device__ __forceinline__ int lds_byte(int r, int c) { const int st = (r >> 4) * 2 + (c >> 5), rr = r & 15, cc = c & 31, ob = rr * 64 + cc * 2; return st * 1024 + (ob ^ (((ob >> 9) & 1) << 5)); }
__host__ __device__ __forceinline__ void stage_rc(int b, int& R, int& C) { const int st = b / 1024, sb = b % 1024, swz = sb ^ (((sb >> 9) & 1) << 5); R = (st >> 1) * 16 + swz / 64; C = (st & 1) * 32 + (swz % 64) / 2; }
__host__ __device__ __forceinline__ int perm32(int rho) { const int n = rho >> 4, i = rho & 15; return 8 * (i >> 2) + 4 * n + (i & 3); }

struct Unit { int pm, pn; };
struct Gemm { const bf16_t* A; const bf16_t* Bt; int M, N, K, lda, ldb, npn, a_split; };

struct StaticOrder {
    int nM, nN, nwg, G, c;
    __device__ void init(int M, int N, int G_, int c_) { nM = M / BM; nN = N / BM; nwg = nM * nN; G = G_; c = c_; }
    __device__ bool next(int i, Unit& u) const {
        const long L = (long)i * G + c; if (L >= nwg) return false;
        int wgid = (int)L; { const int q = nwg / NXCD, r = nwg % NXCD, xcd = wgid % NXCD, off = wgid / NXCD; wgid = (xcd < r ? xcd * (q + 1) : r * (q + 1) + (xcd - r) * q) + off; }
        const int nig = WGM * nN, gid = wgid / nig, fm = gid * WGM, gsz = (nM - fm) < WGM ? (nM - fm) : WGM;
        u.pm = fm + ((wgid % nig) % gsz); u.pn = (wgid % nig) / gsz; return true;
    }
};

__device__ __forceinline__ unsigned cvt_pk_bf16(float lo, float hi) { unsigned r; asm volatile("v_cvt_pk_bf16_f32 %0, %1, %2" : "=v"(r) : "v"(lo), "v"(hi)); return r; }

template <int ACT  > struct EpiBf16 {
    static constexpr bool PERM = true;
    bf16_t* O; int ldc;
    __device__ __forceinline__ void operator()(const f32x4 (&acc)[2][2][4][2], const Unit& u, int wr, int wc, int fr, int fq) const {
        const int row0 = u.pm * BM + wr * 64 + fr, col0 = u.pn * BM + wc * 32 + 8 * fq;
#pragma unroll
        for (int ai = 0; ai < 2; ++ai)
#pragma unroll
            for (int m = 0; m < 4; ++m) { __builtin_amdgcn_sched_barrier(0); bf16_t* rowp = O + (size_t)(row0 + ai * HALF + m * 16) * ldc + col0;
#pragma unroll
                for (int bj = 0; bj < 2; ++bj) { f32x4 v0 = acc[ai][bj][m][0], v1 = acc[ai][bj][m][1];
                    if (ACT == 1) {
#pragma unroll
                        for (int j = 0; j < 4; ++j) { float a = fmaxf(v0[j], 0.f), b = fmaxf(v1[j], 0.f); v0[j] = a * a; v1[j] = b * b; } }
                    u32x4 w; w.x = cvt_pk_bf16(v0[0], v0[1]); w.y = cvt_pk_bf16(v0[2], v0[3]); w.z = cvt_pk_bf16(v1[0], v1[1]); w.w = cvt_pk_bf16(v1[2], v1[3]);
                    *(u32x4*)(rowp + bj * HALF) = w; } }
    }
};
struct EpiProj {
    static constexpr bool PERM = true;
    bf16_t* O; float* outp; int li;
    __device__ __forceinline__ void operator()(const f32x4 (&acc)[2][2][4][2], const Unit& u, int wr, int wc, int fr, int fq) const {
        const int row0 = u.pm * BM + wr * 64 + fr, col0 = u.pn * BM + wc * 32 + 8 * fq;
#pragma unroll
        for (int ai = 0; ai < 2; ++ai)
#pragma unroll
            for (int m = 0; m < 4; ++m) { __builtin_amdgcn_sched_barrier(0); const int row = row0 + ai * HALF + m * 16; bf16_t* rowp = O + (size_t)row * NPROJ_PAD + col0;
#pragma unroll
                for (int bj = 0; bj < 2; ++bj) { const f32x4 v0 = acc[ai][bj][m][0], v1 = acc[ai][bj][m][1];
                    u32x4 w; w.x = cvt_pk_bf16(v0[0], v0[1]); w.y = cvt_pk_bf16(v0[2], v0[3]); w.z = cvt_pk_bf16(v1[0], v1[1]); w.w = cvt_pk_bf16(v1[2], v1[3]);
                    *(u32x4*)(rowp + bj * HALF) = w;
                    const int col = col0 + bj * HALF;
                    if (row < TP && col >= C_KB && col < NPROJ) {
                        const int b = row >> 8, t = row & 255;
                        float* dst = outp + ((col < C_VB) ? (O_CK - C_KB) : (O_CV - C_VB)) + ((size_t)((b * 2 + li) * 256 + t)) * 128 + col;
                        *(f32x4*)dst = v0; *(f32x4*)(dst + 4) = v1; } } }
    }
};
struct EpiSplitBf16 {
    static constexpr bool PERM = true;
    bf16_t* O; int ldc; int npn; size_t split_stride;
    __device__ __forceinline__ void operator()(const f32x4 (&acc)[2][2][4][2], const Unit& u, int wr, int wc, int fr, int fq) const {
        const int s = u.pn / npn, pn = u.pn - s * npn;
        bf16_t* base = O + (size_t)s * split_stride;
        const int row0 = u.pm * BM + wr * 64 + fr, col0 = pn * BM + wc * 32 + 8 * fq;
#pragma unroll
        for (int ai = 0; ai < 2; ++ai)
#pragma unroll
            for (int m = 0; m < 4; ++m) { __builtin_amdgcn_sched_barrier(0); bf16_t* rowp = base + (size_t)(row0 + ai * HALF + m * 16) * ldc + col0;
#pragma unroll
                for (int bj = 0; bj < 2; ++bj) { const f32x4 v0 = acc[ai][bj][m][0], v1 = acc[ai][bj][m][1];
                    u32x4 w; w.x = cvt_pk_bf16(v0[0], v0[1]); w.y = cvt_pk_bf16(v0[2], v0[3]); w.z = cvt_pk_bf16(v1[0], v1[1]); w.w = cvt_pk_bf16(v1[2], v1[3]);
                    *(u32x4*)(rowp + bj * HALF) = w; } }
    }
};
struct EpiF32 {
    static constexpr bool PERM = true;
    float* O; int ldc; int npn; size_t split_stride;
    __device__ __forceinline__ void operator()(const f32x4 (&acc)[2][2][4][2], const Unit& u, int wr, int wc, int fr, int fq) const {
        const int s = u.pn / npn, pn = u.pn - s * npn;
        float* base = O + (size_t)s * split_stride;
        const int row0 = u.pm * BM + wr * 64 + fr, col0 = pn * BM + wc * 32 + 8 * fq;
#pragma unroll
        for (int ai = 0; ai < 2; ++ai)
#pragma unroll
            for (int m = 0; m < 4; ++m) { __builtin_amdgcn_sched_barrier(0); float* rowp = base + (size_t)(row0 + ai * HALF + m * 16) * ldc + col0;
#pragma unroll
                for (int bj = 0; bj < 2; ++bj) { *(f32x4*)(rowp + bj * HALF) = acc[ai][bj][m][0]; *(f32x4*)(rowp + bj * HALF + 4) = acc[ai][bj][m][1]; } }
    }
};

template <class Epi, class Sched>
__device__ __forceinline__ void gemm_phase(LAS unsigned char* lds, const Gemm g, const Sched& S, const Epi& E, const int tid) {
    const int wid = __builtin_amdgcn_readfirstlane(tid >> 6), lane = tid & 63, wr = wid >> 2, wc = wid & 3, fr = lane & 15, fq = lane >> 4;
    const int K = g.K, nt = K / BK;
    unsigned voffA[2], voffB[2];
#pragma unroll
    for (int i = 0; i < 2; ++i) { int R, C; stage_rc(tid * 16 + i * 8192, R, C); const int Rb = Epi::PERM ? ((R & ~31) + perm32(R & 31)) : R;
        voffA[i] = (unsigned)(R * g.lda + C) * 2u; voffB[i] = (unsigned)(Rb * g.ldb + C) * 2u; }
    const size_t kstep = (size_t)(BK * 2);
    const size_t hstepA = (size_t)HALF * g.lda * 2, hstepB = (size_t)HALF * g.ldb * 2;
    const size_t tstepA = 2 * hstepA, tstepB = 2 * hstepB;
    const unsigned ldsw = (unsigned)wid * 1024u;
    const int aoff = lds_byte(wr * 64 + fr, fq * 8), boff = lds_byte(wc * 32 + fr, fq * 8);
#define PG8_SA(b, h) (((b) * 2 + (h)) * HTB)
#define PG8_SB(b, h) ((4 + (b) * 2 + (h)) * HTB)
#define PG8_STAGE(bufoff, gbase, voff) do { _Pragma("unroll") for (int _i = 0; _i < 2; ++_i) \
        __builtin_amdgcn_global_load_lds((const unsigned*)((const char*)(gbase) + (voff)[_i]), (LAS unsigned*)(lds + (bufoff) + ldsw + _i * 8192), 16, 0, 0); } while (0)
#define PG8_LDA(dst, b, h) do { _Pragma("unroll") for (int m = 0; m < 4; ++m) _Pragma("unroll") for (int k = 0; k < 2; ++k) dst[m][k] = *(const LAS bf16x8*)(lds + PG8_SA(b, h) + aoff + m * 2048 + k * 1024); } while (0)
#define PG8_LDB(dst, b, h) do { _Pragma("unroll") for (int n = 0; n < 2; ++n) _Pragma("unroll") for (int k = 0; k < 2; ++k) dst[n][k] = *(const LAS bf16x8*)(lds + PG8_SB(b, h) + boff + n * 2048 + k * 1024); } while (0)
#define PG8_MMA(ai, bj, At, Bt) do { __builtin_amdgcn_s_setprio(1); _Pragma("unroll") for (int m = 0; m < 4; ++m) _Pragma("unroll") for (int n = 0; n < 2; ++n) _Pragma("unroll") for (int k = 0; k < 2; ++k) \
        acc[ai][bj][m][n] = __builtin_amdgcn_mfma_f32_16x16x32_bf16(Bt[n][k], At[m][k], acc[ai][bj][m][n], 0, 0, 0); __builtin_amdgcn_s_setprio(0); } while (0)
#define PG8_WAIT_V(n) asm volatile("s_waitcnt vmcnt(" #n ")" ::: "memory")
#define PG8_WAIT_L(n) asm volatile("s_waitcnt lgkmcnt(" #n ")" ::: "memory")
#define PG8_BAR __builtin_amdgcn_s_barrier()
#define PG8_SCHED __builtin_amdgcn_sched_barrier(0)
#define PG8_UA(u) ((const char*)g.A + (size_t)(u).pm * tstepA + (size_t)((u).pn / g.npn) * (size_t)g.a_split * 2)
#define PG8_UB(u) ((const char*)g.Bt + (size_t)(u).pn * tstepB)
    Unit cur, nxt; int ui = 0;
    if (!S.next(0, cur)) return;
    f32x4 acc[2][2][4][2];
#pragma unroll
    for (int a = 0; a < 2; ++a)
#pragma unroll
        for (int b = 0; b < 2; ++b)
#pragma unroll
            for (int m = 0; m < 4; ++m)
#pragma unroll
                for (int n = 0; n < 2; ++n) acc[a][b][m][n] = (f32x4){0.f, 0.f, 0.f, 0.f};
    bf16x8 At[4][2], B0[2][2], B1[2][2];
    const char* cA = PG8_UA(cur); const char* cB = PG8_UB(cur);
    PG8_STAGE(PG8_SB(0, 0), cB, voffB); PG8_STAGE(PG8_SB(0, 1), cB + hstepB, voffB); PG8_STAGE(PG8_SA(0, 0), cA, voffA); PG8_STAGE(PG8_SA(0, 1), cA + hstepA, voffA);
    if (wr == 1) PG8_BAR;
    PG8_WAIT_V(2); PG8_BAR;
    PG8_STAGE(PG8_SB(1, 0), cB + kstep, voffB); PG8_STAGE(PG8_SA(1, 0), cA + kstep, voffA); PG8_STAGE(PG8_SB(1, 1), cB + hstepB + kstep, voffB);
    PG8_WAIT_V(6); PG8_BAR;
    for (;;) {
        const bool has_next = S.next(ui + 1, nxt);
        const char* nA = has_next ? PG8_UA(nxt) : cA; const char* nB = has_next ? PG8_UB(nxt) : cB;
        for (int t = 0; t < nt; t += 2) {
            const bool last = (t == nt - 2);
            const char* a1 = cA + (size_t)(t + 1) * kstep;
            const char* a2 = last ? nA : cA + (size_t)(t + 2) * kstep; const char* b2 = last ? nB : cB + (size_t)(t + 2) * kstep;
            const char* a3 = a2 + kstep; const char* b3 = b2 + kstep;
            PG8_LDB(B0, 0, 0); PG8_LDB(B1, 0, 1); PG8_SCHED; PG8_LDA(At, 0, 0); PG8_STAGE(PG8_SA(1, 1), a1 + hstepA, voffA);
            PG8_WAIT_V(8); PG8_WAIT_L(0); PG8_BAR; PG8_MMA(0, 0, At, B0); PG8_MMA(0, 1, At, B1); PG8_BAR; PG8_SCHED;
            PG8_LDA(At, 0, 1); PG8_STAGE(PG8_SB(0, 0), b2, voffB); PG8_STAGE(PG8_SB(0, 1), b2 + hstepB, voffB); PG8_STAGE(PG8_SA(0, 0), a2, voffA);
            PG8_WAIT_V(8); PG8_WAIT_L(0); PG8_BAR; PG8_MMA(1, 0, At, B0); PG8_MMA(1, 1, At, B1); PG8_BAR; PG8_SCHED;
            PG8_LDB(B0, 1, 0); PG8_LDB(B1, 1, 1); PG8_SCHED; PG8_LDA(At, 1, 0); PG8_STAGE(PG8_SA(0, 1), a2 + hstepA, voffA);
            PG8_WAIT_V(8); PG8_WAIT_L(0); PG8_BAR; PG8_MMA(0, 0, At, B0); PG8_MMA(0, 1, At, B1); PG8_BAR; PG8_SCHED;
            PG8_LDA(At, 1, 1); PG8_STAGE(PG8_SB(1, 0), b3, voffB); PG8_STAGE(PG8_SB(1, 1), b3 + hstepB, voffB); PG8_STAGE(PG8_SA(1, 0), a3, voffA);
            PG8_WAIT_V(8); PG8_WAIT_L(0); PG8_BAR; PG8_MMA(1, 0, At, B0); PG8_MMA(1, 1, At, B1); PG8_BAR; PG8_SCHED;
        }
        if (wr == 0) PG8_BAR;
        E(acc, cur, wr, wc, fr, fq);
        if (!has_next) break;
#pragma unroll
        for (int a = 0; a < 2; ++a)
#pragma unroll
            for (int b = 0; b < 2; ++b)
#pragma unroll
                for (int m = 0; m < 4; ++m)
#pragma unroll
                    for (int n = 0; n < 2; ++n) acc[a][b][m][n] = (f32x4){0.f, 0.f, 0.f, 0.f};
        cur = nxt; cA = nA; cB = nB; ++ui;
        if (wr == 1) PG8_BAR;
    }
    PG8_WAIT_V(0);
    PG8_BAR;
#undef PG8_SA
#undef PG8_SB
#undef PG8_STAGE
#undef PG8_LDA
#undef PG8_LDB
#undef PG8_MMA
#undef PG8_WAIT_V
#undef PG8_WAIT_L
#undef PG8_BAR
#undef PG8_SCHED
#undef PG8_UA
#undef PG8_UB
}
}

struct Args { const float* in[29]; float* out; unsigned char* ws; int ph_lo, ph_hi; };
struct Ctx { unsigned char* ws; float* out; int z, tid, bid, G; };

#define MFMA16(a, b, c) __builtin_amdgcn_mfma_f32_16x16x32_bf16((a), (b), (c), 0, 0, 0)

__device__ __forceinline__ void transpose_load(const float* W, int N, int item, int lane, float (&wv)[32]) {
    const int nblk = N / 32, kb = item / nblk, nb = item % nblk, k0 = 64 * kb, n0 = 32 * nb;
#pragma unroll
    for (int i = 0; i < 32; ++i) { const int kk = 2 * i + (lane >> 5); wv[i] = W[(size_t)(k0 + kk) * N + n0 + (lane & 31)]; }
}
__device__ __forceinline__ void transpose_finish(int N, bf16_t* WT, int npad, int ksub, LAS float* scr, int item, int lane, const float (&wv)[32]) {
    const int nblk = N / 32, kb = item / nblk, nb = item % nblk, k0 = 64 * kb, n0 = 32 * nb;
#pragma unroll
    for (int i = 0; i < 32; ++i) { const int kk = 2 * i + (lane >> 5); scr[kk * 33 + (lane & 31)] = wv[i]; }
    asm volatile("s_waitcnt lgkmcnt(0)" ::: "memory");
    const int c = lane & 7;
    const int ks = k0 / ksub, kin = k0 - ks * ksub;
    bf16_t* dbase = WT + (size_t)ks * npad * ksub + kin + 8 * c;
#pragma unroll
    for (int j = 0; j < 4; ++j) { const int n = (lane >> 3) + 8 * j; const LAS float* s = scr + (8 * c) * 33 + n;
        u32x4 o; o.x = pk2(s[0 * 33], s[1 * 33]); o.y = pk2(s[2 * 33], s[3 * 33]); o.z = pk2(s[4 * 33], s[5 * 33]); o.w = pk2(s[6 * 33], s[7 * 33]);
        *(u32x4*)(dbase + (size_t)(n0 + n) * ksub) = o; }
    asm volatile("s_waitcnt lgkmcnt(0)" ::: "memory");
}

struct MatDesc { const float* W; bf16_t* WT; int K, N, npad, ksub, items; };
__device__ __forceinline__ MatDesc get_mat(const Args& a, const Ctx& cx, int mi) {
    MatDesc m; unsigned char* ws = cx.ws;
    if (mi < 4)       { m.W = (a.in[13] + cx.z) + (size_t)mi * D * FF; m.WT = (bf16_t*)(ws + WS_WFF1) + (size_t)mi * FF * D; m.K = D; m.N = FF; m.npad = FF; m.ksub = D; }
    else if (mi < 8)  { const int l = mi - 4; m.W = (a.in[14] + cx.z) + (size_t)l * FF * D; m.WT = (bf16_t*)(ws + WS_WFF2) + (size_t)l * FF * D; m.K = FF; m.N = D; m.npad = D; m.ksub = FF / 2; }
    else if (mi < 10) { const int i = mi - 8; m.W = (a.in[15] + cx.z) + (size_t)i * D * NPROJ; m.WT = (bf16_t*)(ws + WS_WIN) + (size_t)i * NPROJ_PAD * D; m.K = D; m.N = NPROJ; m.npad = NPROJ_PAD; m.ksub = D; }
    else if (mi < 12) { const int i = mi - 10; m.W = (a.in[22] + cx.z) + (size_t)i * D * D; m.WT = (bf16_t*)(ws + WS_WOUT) + (size_t)i * D * D; m.K = D; m.N = D; m.npad = D; m.ksub = D / 2; }
    else if (mi < 14) { const int i = mi - 12; m.W = (a.in[23] + cx.z) + (size_t)i * D * NDOWN; m.WT = (bf16_t*)(ws + WS_WDOWN) + (size_t)i * NDOWN_PAD * D; m.K = D; m.N = NDOWN; m.npad = NDOWN_PAD; m.ksub = D / 2; }
    else if (mi < 16) { const int i = mi - 14; m.W = (a.in[26] + cx.z) + (size_t)i * 384 * 1536; m.WT = (bf16_t*)(ws + WS_WUQ) + (size_t)i * 1536 * 384; m.K = 384; m.N = 1536; m.npad = 1536; m.ksub = 384; }
    else if (mi < 18) { const int i = mi - 16; m.W = (a.in[27] + cx.z) + (size_t)i * 256 * 2048; m.WT = (bf16_t*)(ws + WS_WUKV) + (size_t)i * 2048 * 256; m.K = 256; m.N = 2048; m.npad = 2048; m.ksub = 256; }
    else              { const int i = mi - 18; m.W = (a.in[28] + cx.z) + (size_t)i * D * D; m.WT = (bf16_t*)(ws + WS_WO) + (size_t)i * D * D; m.K = D; m.N = D; m.npad = D; m.ksub = D / 2; }
    m.items = (m.K / 64) * (m.N / 32);
    return m;
}

__device__ __forceinline__ void prologue(const Args& a, const Ctx& cx, LAS unsigned char* lds, const int mode, const int cg0, const int cgstride, const int cgend) {
    const int tid = cx.tid, lane = tid & 63, wave = tid >> 6, G = cx.G, bid = cx.bid;
    unsigned char* ws = cx.ws;
    if (mode == 0) {
        LAS float* sc = (LAS float*)lds;
        LAS float* red = (LAS float*)(lds + 12288);
        for (int i = tid; i < 3 * D; i += NTHREADS) { const int g = i >> 10, k = i & 1023; const float v = (g == 0) ? (a.in[9] + cx.z)[k] : (a.in[8] + cx.z)[(g - 1) * D + k]; sc[i] = silu_f(v); }
        __syncthreads();
        float* MOD = (float*)(ws + WS_MOD);
        for (int it = bid; it < 4 * 48; it += G) {
            const int l = it / 48, jb = it % 48, jq = tid & 31, kg = tid >> 5, j = jb * 128 + jq * 4;
            const float* wp = (a.in[10] + cx.z) + ((size_t)l * D + kg * 64) * 6144 + j;
            f32x4 a0 = {0.f, 0.f, 0.f, 0.f}, a1 = a0, a2 = a0;
#pragma unroll 32
            for (int k = 0; k < 64; ++k) { const f32x4 w = *(const f32x4*)(wp + (size_t)k * 6144); const int kk = kg * 64 + k;
                a0 += w * sc[kk]; a1 += w * sc[D + kk]; a2 += w * sc[2 * D + kk]; }
#pragma unroll
            for (int e = 0; e < 4; ++e) { red[(kg * 3 + 0) * 128 + jq * 4 + e] = a0[e]; red[(kg * 3 + 1) * 128 + jq * 4 + e] = a1[e]; red[(kg * 3 + 2) * 128 + jq * 4 + e] = a2[e]; }
            __syncthreads();
            if (tid < 384) { const int g = tid >> 7, jj = tid & 127; float s = 0.f;
#pragma unroll
                for (int q = 0; q < 16; ++q) s += red[(q * 3 + g) * 128 + jj];
                MOD[((size_t)l * 3 + g) * 6144 + jb * 128 + jj] = s + (a.in[11] + cx.z)[(size_t)l * 6144 + jb * 128 + jj]; }
            __syncthreads();
        }
    }
    __syncthreads();
    {
        LAS float* scr = (LAS float*)(lds + wave * 16384);
        const int gw = bid * NWAVES + wave, NGW = G * NWAVES;
        const bool l0only = (mode == 0) && (G == 256);
        const int nq = (mode == 1) ? 17 : (l0only ? 3 : 20);
#define PRO_SEQ(q) ((mode == 1) ? (((q) == 0) ? 4 : ((q) == 1) ? 1 : ((q) == 2) ? 5 : ((q) == 3) ? 12 : ((q) == 4) ? 14 : ((q) == 5) ? 16 : ((q) == 6) ? 18 : ((q) == 7) ? 2 : ((q) == 8) ? 6 : ((q) == 9) ? 9 : ((q) == 10) ? 11 \
                                  : ((q) == 11) ? 3 : ((q) == 12) ? 7 : ((q) == 13) ? 13 : ((q) == 14) ? 15 : ((q) == 15) ? 17 : 19) \
                    : (l0only ? (((q) == 0) ? 0 : ((q) == 1) ? 8 : 10) : (q)))
#define PRO_ADV() do { while (qi < nq && g - base >= m.items) { base += m.items; ++qi; if (qi < nq) m = get_mat(a, cx, PRO_SEQ(qi)); } } while (0)
        int qi = 0, base = 0;
        MatDesc m = get_mat(a, cx, PRO_SEQ(0));
        int g = (mode == 1) ? cg0 : gw;
        const int gstride = (mode == 1) ? cgstride : NGW, gend = (mode == 1) ? cgend : 0x7fffffff;
        if (g >= gend) qi = nq;
        PRO_ADV();
        float wv[32];
        if (qi < nq) transpose_load(m.W, m.N, g - base, lane, wv);
        while (qi < nq) {
            const MatDesc mc = m; const int itc = g - base;
            g += gstride;
            if (g >= gend) qi = nq;
            PRO_ADV();
            float wn[32];
            if (qi < nq) transpose_load(m.W, m.N, g - base, lane, wn);
            transpose_finish(mc.N, mc.WT, mc.npad, mc.ksub, scr, itc, lane, wv);
#pragma unroll
            for (int i = 0; i < 32; ++i) wv[i] = wn[i];
        }
    }
    if (mode == 0) {
        const size_t gt = (size_t)bid * NTHREADS + tid, NGT = (size_t)G * NTHREADS;
        for (int i = 0; i < 2; ++i) {
            u32x4* z1 = (u32x4*)((bf16_t*)(ws + WS_WIN) + (size_t)i * NPROJ_PAD * D + (size_t)NPROJ * D);
            for (size_t x = gt; x < (size_t)(NPROJ_PAD - NPROJ) * D / 8; x += NGT) z1[x] = (u32x4){0u, 0u, 0u, 0u};
            for (int ks = 0; ks < 2; ++ks) {
                u32x4* z2 = (u32x4*)((bf16_t*)(ws + WS_WDOWN) + (size_t)i * NDOWN_PAD * D + (size_t)ks * NDOWN_PAD * (D / 2) + (size_t)NDOWN * (D / 2));
                for (size_t x = gt; x < (size_t)(NDOWN_PAD - NDOWN) * (D / 2) / 8; x += NGT) z2[x] = (u32x4){0u, 0u, 0u, 0u}; }
        }
        f32x2* tab64 = (f32x2*)(ws + WS_TAB); f32x2* tab32 = tab64 + 64 * 16;
        for (size_t x = gt; x < 64 * 16; x += NGT) { const int pos = (int)x >> 4, f = (int)x & 15; const float inv = powf(10000.f, -(float)f / 16.f); const float ang = (float)pos * inv; tab64[x] = (f32x2){cosf(ang), sinf(ang)}; }
        for (size_t x = gt; x < 64 * 8; x += NGT) { const int pos = (int)x >> 3, f = (int)x & 7; const float inv = powf(10000.f, -(float)f / 8.f); const float ang = (float)pos * inv; tab32[x] = (f32x2){cosf(ang), sinf(ang)}; }
        bf16_t* csk = (bf16_t*)(ws + WS_CSK); bf16_t* csv = (bf16_t*)(ws + WS_CSV);
        for (size_t x = gt; x < (size_t)2 * 2 * 512 * 128 / 4; x += NGT) {
            const size_t e = x * 4; const int b = (int)(e / (2 * 65536)), i = (int)(e / 65536) & 1; const size_t r = e % 65536;
            const size_t d = ((size_t)(i * 2 + b)) * 65536 + r;
            const f32x4 k = *(const f32x4*)((a.in[4] + cx.z) + e), v = *(const f32x4*)((a.in[5] + cx.z) + e);
            *(u32x2*)(csk + d) = (u32x2){pk2(k[0], k[1]), pk2(k[2], k[3])};
            *(u32x2*)(csv + d) = (u32x2){pk2(v[0], v[1]), pk2(v[2], v[3])};
        }
    }
}

__device__ __forceinline__ int mod_group(int r) { return r < TP ? 0 : 1 + ((r - TP) >> 10); }

__device__ __forceinline__ void pre_rows(const Args& a, const Ctx& cx, int l) {
    constexpr int RB = 3;
    const int lane = cx.tid & 63, gw = cx.bid * NWAVES + (cx.tid >> 6), NGW = cx.G * NWAVES;
    const float* MOD = (const float*)(cx.ws + WS_MOD) + (size_t)l * 3 * 6144;
    const float* gA = (a.in[12] + cx.z) + (size_t)l * 4 * D;
    bf16_t* H = (bf16_t*)(cx.ws + WS_H);
    for (int rb = gw * RB; rb < T; rb += NGW * RB) {
        f32x4 v[RB][4], vg[4]; float s[RB];
#pragma unroll
        for (int j = 0; j < 4; ++j) vg[j] = *(const f32x4*)(gA + lane * 4 + 256 * j);
#pragma unroll
        for (int q = 0; q < RB; ++q) { const int r = (rb + q < T) ? rb + q : T - 1;
            const float* xr = (r < TP) ? (a.in[0] + cx.z) + (size_t)r * D : (a.in[1] + cx.z) + (size_t)(r - TP) * D;
            float t = 0.f;
#pragma unroll
            for (int j = 0; j < 4; ++j) { v[q][j] = *(const f32x4*)(xr + lane * 4 + 256 * j); t += v[q][j][0] * v[q][j][0] + v[q][j][1] * v[q][j][1] + v[q][j][2] * v[q][j][2] + v[q][j][3] * v[q][j][3]; }
            s[q] = t; }
#pragma unroll
        for (int off = 1; off < 64; off <<= 1) {
#pragma unroll
            for (int q = 0; q < RB; ++q) s[q] += __shfl_xor(s[q], off); }
#pragma unroll
        for (int q = 0; q < RB; ++q) { const int r = rb + q; if (r >= T) continue;
            const float rstd = rsqrtf(s[q] * (1.f / D) + EPS);
            const float* m = MOD + (size_t)mod_group(r) * 6144;
#pragma unroll
            for (int j = 0; j < 4; ++j) { const int c = lane * 4 + 256 * j;
                const f32x4 sh = *(const f32x4*)(m + c), scl = *(const f32x4*)(m + D + c);
                const f32x4 h = v[q][j] * rstd * vg[j] * (scl + 1.f) + sh;
                *(u32x2*)(H + (size_t)r * D + c) = (u32x2){pk2(h[0], h[1]), pk2(h[2], h[3])}; } }
    }
}

__device__ __forceinline__ void post_rows(const Args& a, const Ctx& cx, bool x_from_input, const float* gate_base  , const float* gB,
                                          bool has_next, const float* gC, const float* shift_base, const float* scale_base, bool dry) {
    constexpr int RB = 3;
    const int lane = cx.tid & 63, gw = cx.bid * NWAVES + (cx.tid >> 6), NGW = cx.G * NWAVES;
    const bf16_t* OUT = (const bf16_t*)(cx.ws + WS_OUT);
    bf16_t* H = dry ? (bf16_t*)(cx.ws + WS_U + 24 * MiB) : (bf16_t*)(cx.ws + WS_H);
    float* xout = dry ? (float*)(cx.ws + WS_U) : cx.out;
    for (int rb = gw * RB; rb < T; rb += NGW * RB) {
        f32x4 o[RB][4], x[RB][4]; float s[RB], s2[RB]; size_t mg[RB];
        const size_t mg0 = (size_t)mod_group(rb < T ? rb : T - 1) * 6144;
        f32x4 vgB[4], vgt[4];
#pragma unroll
        for (int j = 0; j < 4; ++j) { const int c = lane * 4 + 256 * j; vgB[j] = *(const f32x4*)(gB + c); vgt[j] = *(const f32x4*)(gate_base + mg0 + c); }
#pragma unroll
        for (int q = 0; q < RB; ++q) { const int r = (rb + q < T) ? rb + q : T - 1;
            const float* xr = x_from_input ? ((r < TP) ? (a.in[0] + cx.z) + (size_t)r * D : (a.in[1] + cx.z) + (size_t)(r - TP) * D) : cx.out + (size_t)r * D;
            mg[q] = (size_t)mod_group(r) * 6144;
#pragma unroll
            for (int j = 0; j < 4; ++j) { const int c = lane * 4 + 256 * j;
                { const u32x2 p0 = *(const u32x2*)(OUT + (size_t)r * D + c), p1 = *(const u32x2*)(OUT + OUT_SPLIT + (size_t)r * D + c);
                  o[q][j] = (f32x4){bflo(p0.x) + bflo(p1.x), bfhi(p0.x) + bfhi(p1.x), bflo(p0.y) + bflo(p1.y), bfhi(p0.y) + bfhi(p1.y)}; }
                x[q][j] = *(const f32x4*)(xr + c); } }
#pragma unroll
        for (int q = 0; q < RB; ++q) { float t = 0.f;
#pragma unroll
            for (int j = 0; j < 4; ++j) t += o[q][j][0] * o[q][j][0] + o[q][j][1] * o[q][j][1] + o[q][j][2] * o[q][j][2] + o[q][j][3] * o[q][j][3];
            s[q] = t; }
#pragma unroll
        for (int off = 1; off < 64; off <<= 1) {
#pragma unroll
            for (int q = 0; q < RB; ++q) s[q] += __shfl_xor(s[q], off); }
#pragma unroll
        for (int q = 0; q < RB; ++q) { const int r = rb + q; const float rstd = rsqrtf(s[q] * (1.f / D) + EPS); float t = 0.f;
            const bool same = (mg[q] == mg0);
#pragma unroll
            for (int j = 0; j < 4; ++j) { const int c = lane * 4 + 256 * j;
                const f32x4 gt = same ? vgt[j] : *(const f32x4*)(gate_base + mg[q] + c);
                x[q][j] = x[q][j] + gt * (o[q][j] * rstd * vgB[j]);
                if (r < T) *(f32x4*)(xout + (size_t)r * D + c) = x[q][j];
                t += x[q][j][0] * x[q][j][0] + x[q][j][1] * x[q][j][1] + x[q][j][2] * x[q][j][2] + x[q][j][3] * x[q][j][3]; }
            s2[q] = t; }
        if (has_next) {
            f32x4 vgC[4], vsh[4], vsc[4];
#pragma unroll
            for (int j = 0; j < 4; ++j) { const int c = lane * 4 + 256 * j; vgC[j] = *(const f32x4*)(gC + c); vsh[j] = *(const f32x4*)(shift_base + mg0 + c); vsc[j] = *(const f32x4*)(scale_base + mg0 + c); }
#pragma unroll
            for (int off = 1; off < 64; off <<= 1) {
#pragma unroll
                for (int q = 0; q < RB; ++q) s2[q] += __shfl_xor(s2[q], off); }
#pragma unroll
            for (int q = 0; q < RB; ++q) { const int r = rb + q; const float rstd2 = rsqrtf(s2[q] * (1.f / D) + EPS);
                const bool same = (mg[q] == mg0);
#pragma unroll
                for (int j = 0; j < 4; ++j) { const int c = lane * 4 + 256 * j;
                    const f32x4 sh = same ? vsh[j] : *(const f32x4*)(shift_base + mg[q] + c), scl = same ? vsc[j] : *(const f32x4*)(scale_base + mg[q] + c);
                    const f32x4 h = x[q][j] * rstd2 * vgC[j] * (scl + 1.f) + sh;
                    if (r < T) *(u32x2*)(H + (size_t)r * D + c) = (u32x2){pk2(h[0], h[1]), pk2(h[2], h[3])}; } }
        }
    }
}

__device__ __forceinline__ void mla_mid(const Args& a, const Ctx& cx, int i) {
    constexpr int RB = 3;
    const int lane = cx.tid & 63, gw = cx.bid * NWAVES + (cx.tid >> 6), NGW = cx.G * NWAVES;
    const float* DOWN = (const float*)(cx.ws + WS_OUT);
    bf16_t* CQ = (bf16_t*)(cx.ws + WS_CQ); bf16_t* CKV = (bf16_t*)(cx.ws + WS_CKV); bf16_t* KR = (bf16_t*)(cx.ws + WS_KR);
    const float* gq = (a.in[24] + cx.z) + (size_t)i * 384; const float* gkv = (a.in[25] + cx.z) + (size_t)i * 256;
    const f32x2* tab32 = (const f32x2*)(cx.ws + WS_TAB) + 64 * 16;
    for (int r = T + gw; r < T + 1024; r += NGW) {
        const int rr = r - T, b = rr >> 9, j = rr & 511;
        const float* src = (a.in[6] + cx.z) + ((size_t)((b * 2 + i) * 512 + j)) * 256;
        float v[4];
#pragma unroll
        for (int q = 0; q < 4; ++q) v[q] = src[lane + 64 * q];
        const float kr = (lane < 32) ? (a.in[7] + cx.z)[((size_t)((b * 2 + i) * 512 + j)) * 32 + lane] : 0.f;
#pragma unroll
        for (int q = 0; q < 4; ++q) CKV[(size_t)r * 256 + lane + 64 * q] = (bf16_t)f2bf(v[q]);
        if (lane < 32) KR[(size_t)r * 32 + lane] = (bf16_t)f2bf(kr);
    }
    for (int rb = gw * RB; rb < T; rb += NGW * RB) {
        float q[RB][6], kv[RB][4], kr[RB], ot[RB], sq[RB], sk[RB], vq[6], vk[4];
#pragma unroll
        for (int j = 0; j < 6; ++j) vq[j] = gq[lane + 64 * j];
#pragma unroll
        for (int j = 0; j < 4; ++j) vk[j] = gkv[lane + 64 * j];
#pragma unroll
        for (int u = 0; u < RB; ++u) { const int r = (rb + u < T) ? rb + u : T - 1; const float* dr = DOWN + (size_t)r * NDOWN_PAD;
#pragma unroll
            for (int j = 0; j < 6; ++j) q[u][j] = dr[lane + 64 * j] + dr[DOWN_SPLIT + lane + 64 * j];
#pragma unroll
            for (int j = 0; j < 4; ++j) kv[u][j] = dr[384 + lane + 64 * j] + dr[DOWN_SPLIT + 384 + lane + 64 * j];
            kr[u] = dr[640 + (lane & 31)] + dr[DOWN_SPLIT + 640 + (lane & 31)];
            ot[u] = dr[640 + ((lane & 31) ^ 8)] + dr[DOWN_SPLIT + 640 + ((lane & 31) ^ 8)]; }
#pragma unroll
        for (int u = 0; u < RB; ++u) { float s = 0.f, t = 0.f;
#pragma unroll
            for (int j = 0; j < 6; ++j) s += q[u][j] * q[u][j];
#pragma unroll
            for (int j = 0; j < 4; ++j) t += kv[u][j] * kv[u][j];
            sq[u] = s; sk[u] = t; }
#pragma unroll
        for (int off = 1; off < 64; off <<= 1) {
#pragma unroll
            for (int u = 0; u < RB; ++u) { sq[u] += __shfl_xor(sq[u], off); sk[u] += __shfl_xor(sk[u], off); } }
#pragma unroll
        for (int u = 0; u < RB; ++u) { const int r = rb + u; if (r >= T) continue;
            const float rq = rsqrtf(sq[u] * (1.f / 384.f) + EPS), rk = rsqrtf(sk[u] * (1.f / 256.f) + EPS);
#pragma unroll
            for (int j = 0; j < 6; ++j) CQ[(size_t)r * 384 + lane + 64 * j] = (bf16_t)f2bf(q[u][j] * rq * vq[j]);
#pragma unroll
            for (int j = 0; j < 4; ++j) { const float v = kv[u][j] * rk * vk[j]; CKV[(size_t)r * 256 + lane + 64 * j] = (bf16_t)f2bf(v);
                if (r < TP) { const int b = r >> 8, t = r & 255; cx.out[O_CKV + ((size_t)((b * 2 + i) * 256 + t)) * 256 + lane + 64 * j] = v; } }
            if (lane < 32) {
                if (r < TP) { const int b = r >> 8, t = r & 255; cx.out[O_CKR + ((size_t)((b * 2 + i) * 256 + t)) * 32 + lane] = kr[u]; KR[(size_t)r * 32 + lane] = (bf16_t)f2bf(kr[u]); }
                else {
                    const int t = (r - TP) & 1023, half = lane >> 4, p = (lane >> 3) & 1, f = lane & 7, pos = half ? (t & 63) : (t >> 6);
                    const f32x2 cs = tab32[pos * 8 + f];
                    const float v = p ? (ot[u] * cs[1] + kr[u] * cs[0]) : (kr[u] * cs[0] - ot[u] * cs[1]);
                    KR[(size_t)r * 32 + lane] = (bf16_t)f2bf(v);
                }
            }
        }
    }
}

struct KSeg { const bf16_t* K; int kstride; const bf16_t* K2; const bf16_t* V; int vstride; int k_lo, k_hi; int flags  ; };
struct AttnArgs { const bf16_t* Q; int qstride; int qpos0; int qrope  ; int nseg; KSeg seg0, seg1;
                  float m0, l0, scale; bf16_t* O; int ostride; const f32x2* tab64; };

__device__ __forceinline__ u32x4 rope8l(const u32x4 own, const u32x4 partner, int p, const LAS f32x2* tab) {
    float a[8], b[8], o[8]; unpack8(own, a); unpack8(partner, b);
#pragma unroll
    for (int e = 0; e < 8; ++e) { const f32x2 cs = tab[e]; o[e] = p ? (b[e] * cs[1] + a[e] * cs[0]) : (a[e] * cs[0] - b[e] * cs[1]); }
    return pack8(o);
}
__device__ __forceinline__ u32x4 rope8(const u32x4 own, const u32x4 partner, int p, const f32x2* tab) {
    float a[8], b[8], o[8]; unpack8(own, a); unpack8(partner, b);
#pragma unroll
    for (int e = 0; e < 8; ++e) { const f32x2 cs = tab[e]; o[e] = p ? (b[e] * cs[1] + a[e] * cs[0]) : (a[e] * cs[0] - b[e] * cs[1]); }
    return pack8(o);
}

template <int DQK, int QG>
__device__ __forceinline__ void attn_unit(LAS unsigned char* lds, const AttnArgs& A, const int tid) {
    constexpr int KT = 64;
    constexpr int QS = DQK + 8, VS = KT + 8, NCH = DQK / 8, NKS = DQK / 32, KCH = KT * NCH, KPT = (KCH + NTHREADS - 1) / NTHREADS, VPT = KT / 64, NT = KT / 16, NQ = 128 * QG;
    LAS bf16_t* Qs = (LAS bf16_t*)lds;
    LAS bf16_t* Ks = Qs + NQ * QS;
    LAS bf16_t* VT = Ks + 2 * KT * QS;
    LAS f32x2* TB = (LAS f32x2*)(VT + 2 * 64 * VS);
    const int lane = tid & 63, w = tid >> 6, fr = lane & 15, fq = lane >> 4;
    const int n0 = (A.seg0.k_hi - A.seg0.k_lo) / KT, n1 = (A.nseg > 1) ? ((A.seg1.k_hi - A.seg1.k_lo) / KT) : 0, ntiles = n0 + n1;
    int kkey[KPT], kch[KPT];
#pragma unroll
    for (int i = 0; i < KPT; ++i) { const int c = tid + i * NTHREADS; kkey[i] = c / NCH; kch[i] = c % NCH; }
    const int vkey = tid & 63, vch = tid >> 6;
    u32x4 kr[KPT], kp[KPT], vr[VPT]; int pf_kt = 0, pf_rope = 0, pf_mask = 0;
#define ATT_PREFETCH(j) do { const bool s0_ = (j) < n0; const KSeg S = s0_ ? A.seg0 : A.seg1; const int kt = s0_ ? (A.seg0.k_lo + KT * (j)) : (A.seg1.k_lo + KT * ((j) - n0)); \
        _Pragma("unroll") for (int i = 0; i < KPT; ++i) if (tid + i * NTHREADS < KCH) { const int d0 = kch[i] * 8; \
            if (DQK == 96 && kch[i] >= 8) kr[i] = *(const u32x4*)(S.K2 + (size_t)(kt + kkey[i]) * 32 + (d0 - 64)); \
            else { const bf16_t* src = S.K + (size_t)(kt + kkey[i]) * S.kstride; kr[i] = *(const u32x4*)(src + d0); if (DQK == 64 && (S.flags & 1)) kp[i] = *(const u32x4*)(src + (d0 ^ 16)); } } \
        _Pragma("unroll") for (int i = 0; i < VPT; ++i) vr[i] = *(const u32x4*)(S.V + (size_t)(kt + vkey + 64 * i) * S.vstride + vch * 8); \
        pf_kt = kt; pf_rope = S.flags & 1; pf_mask = S.flags & 2; } while (0)
#define ATT_WRITE(buf) do { LAS bf16_t* Kb = Ks + (buf) * KT * QS; LAS bf16_t* Vb = VT + (buf) * 64 * VS; \
        _Pragma("unroll") for (int i = 0; i < KPT; ++i) if (tid + i * NTHREADS < KCH) { u32x4 v = kr[i]; \
            if (DQK == 64 && pf_rope) { const int t = pf_kt + kkey[i], ch = kch[i], half = ch >> 2, p = (ch >> 1) & 1, f0 = (ch & 1) * 8, pos = half ? (t & 63) : (t >> 6); v = rope8l(v, kp[i], p, TB + pos * 16 + f0); } \
            *(LAS u32x4*)(Kb + kkey[i] * QS + kch[i] * 8) = v; } \
        _Pragma("unroll") for (int i = 0; i < VPT; ++i) { LAS bf16_t* dst = Vb + (vch * 8) * VS + vkey + 64 * i; const u32x4 v = vr[i]; \
          dst[0 * VS] = (bf16_t)(v.x & 0xffff); dst[1 * VS] = (bf16_t)(v.x >> 16); dst[2 * VS] = (bf16_t)(v.y & 0xffff); dst[3 * VS] = (bf16_t)(v.y >> 16); \
          dst[4 * VS] = (bf16_t)(v.z & 0xffff); dst[5 * VS] = (bf16_t)(v.z >> 16); dst[6 * VS] = (bf16_t)(v.w & 0xffff); dst[7 * VS] = (bf16_t)(v.w >> 16); } } while (0)
    ATT_PREFETCH(0);
    if (A.qrope) { for (int x = tid; x < 64 * 24; x += NTHREADS) TB[x] = A.tab64[x]; }
    __syncthreads();
    if constexpr (QG > 1) {
        for (int c = tid; c < NQ * NCH; c += NTHREADS) { const int qi = c / NCH, ch = c % NCH; *(LAS u32x4*)(Qs + qi * QS + ch * 8) = *(const u32x4*)(A.Q + (size_t)qi * A.qstride + ch * 8); }
    } else {
        constexpr int NQC = NQ * NCH / NTHREADS;
        u32x4 qv[NQC], qw[NQC];
#pragma unroll
        for (int i = 0; i < NQC; ++i) { const int c = tid + i * NTHREADS, qi = c / NCH, ch = c % NCH, d0 = ch * 8;
            const bf16_t* src = A.Q + (size_t)qi * A.qstride;
            qv[i] = *(const u32x4*)(src + d0);
            if (QG == 1 && A.qrope == 1) qw[i] = *(const u32x4*)(src + (d0 ^ 16));
            else if (QG == 1 && A.qrope == 2 && ch >= 8) qw[i] = *(const u32x4*)(src + 64 + (((ch - 8) ^ 1) * 8)); }
#pragma unroll
        for (int i = 0; i < NQC; ++i) { const int c = tid + i * NTHREADS, qi = c / NCH, ch = c % NCH, d0 = ch * 8, t = A.qpos0 + qi;
            u32x4 v = qv[i];
            if (QG == 1 && A.qrope == 1) { const int half = ch >> 2, p = (ch >> 1) & 1, f0 = (ch & 1) * 8, pos = half ? (t & 63) : (t >> 6); v = rope8l(v, qw[i], p, TB + pos * 16 + f0); }
            else if (QG == 1 && A.qrope == 2 && ch >= 8) { const int c2 = ch - 8, half = c2 >> 1, p = c2 & 1, pos = half ? (t & 63) : (t >> 6); v = rope8l(v, qw[i], p, TB + 64 * 16 + pos * 8); }
            *(LAS u32x4*)(Qs + qi * QS + d0) = v; }
    }
    ATT_WRITE(0);
    int cur_kt = pf_kt, cur_mask = pf_mask;
    if (ntiles > 1) ATT_PREFETCH(1);
    __syncthreads();
    bf16x8 Qf[QG][NKS];
#pragma unroll
    for (int g = 0; g < QG; ++g)
#pragma unroll
        for (int ks = 0; ks < NKS; ++ks) Qf[g][ks] = *(const LAS bf16x8*)(Qs + (g * 128 + w * 16 + fr) * QS + ks * 32 + fq * 8);
    const float scl2 = A.scale * 1.4426950408889634f;
    float m[QG], l[QG];
    f32x4 Oa[QG][4];
#pragma unroll
    for (int g = 0; g < QG; ++g) { m[g] = (A.m0 > -1e29f) ? A.m0 * 1.4426950408889634f : A.m0; l[g] = (fq == 0) ? A.l0 : 0.f;
#pragma unroll
        for (int dt = 0; dt < 4; ++dt) Oa[g][dt] = (f32x4){0.f, 0.f, 0.f, 0.f}; }
    for (int j = 0; j < ntiles; ++j) {
        const LAS bf16_t* Kb = Ks + (j & 1) * KT * QS; const LAS bf16_t* Vb = VT + (j & 1) * 64 * VS;
        f32x4 st[QG][NT];
#pragma unroll
        for (int nt = 0; nt < NT; ++nt) {
#pragma unroll
            for (int g = 0; g < QG; ++g) st[g][nt] = (f32x4){0.f, 0.f, 0.f, 0.f};
#pragma unroll
            for (int ks = 0; ks < NKS; ++ks) { const bf16x8 kf = *(const LAS bf16x8*)(Kb + (nt * 16 + fr) * QS + ks * 32 + fq * 8);
#pragma unroll
                for (int g = 0; g < QG; ++g) st[g][nt] = MFMA16(kf, Qf[g][ks], st[g][nt]); } }
        if (QG > 1) __builtin_amdgcn_sched_barrier(0);
        bf16x8 pf[QG][KT / 32];
#pragma unroll
        for (int g = 0; g < QG; ++g) {
            const int qp = A.qpos0 + g * 128 + w * 16 + fr;
            float mx = -1e30f;
#pragma unroll
            for (int nt = 0; nt < NT; ++nt)
#pragma unroll
                for (int jj = 0; jj < 4; ++jj) { float sc = st[g][nt][jj] * scl2;
                    if (cur_mask) { const int kpos = cur_kt + nt * 16 + fq * 4 + jj; const int dd = qp - kpos; if (dd > 128 || dd < -128) sc = -1e30f; }
                    st[g][nt][jj] = sc; mx = fmaxf(mx, sc); }
            mx = xor16_max(mx); mx = xor32_max(mx);
            const float mn = fmaxf(m[g], mx), alpha = __builtin_amdgcn_exp2f(m[g] - mn);
            float rs = 0.f;
#pragma unroll
            for (int nt = 0; nt < NT; ++nt)
#pragma unroll
                for (int jj = 0; jj < 4; ++jj) { const float pe = __builtin_amdgcn_exp2f(st[g][nt][jj] - mn); st[g][nt][jj] = pe; rs += pe; }
            l[g] = l[g] * alpha + rs; m[g] = mn;
#pragma unroll
            for (int dt = 0; dt < 4; ++dt) Oa[g][dt] = Oa[g][dt] * alpha;
#pragma unroll
            for (int kk = 0; kk < KT / 32; ++kk) {
                u32x4 pb; pb.x = cvtpk(st[g][2 * kk][0], st[g][2 * kk][1]); pb.y = cvtpk(st[g][2 * kk][2], st[g][2 * kk][3]); pb.z = cvtpk(st[g][2 * kk + 1][0], st[g][2 * kk + 1][1]); pb.w = cvtpk(st[g][2 * kk + 1][2], st[g][2 * kk + 1][3]);
                pf[g][kk] = __builtin_bit_cast(bf16x8, pb); }
        }
        if (QG > 1) __builtin_amdgcn_sched_barrier(0);
#pragma unroll
        for (int kk = 0; kk < KT / 32; ++kk)
#pragma unroll
            for (int dt = 0; dt < 4; ++dt) {
                const LAS bf16_t* vp = Vb + (dt * 16 + fr) * VS + 32 * kk + fq * 4;
                const u32x2 v0 = *(const LAS u32x2*)vp, v1 = *(const LAS u32x2*)(vp + 16);
                const u32x4 vv = {v0.x, v0.y, v1.x, v1.y};
#pragma unroll
                for (int g = 0; g < QG; ++g) Oa[g][dt] = MFMA16(__builtin_bit_cast(bf16x8, vv), pf[g][kk], Oa[g][dt]);
            }
        if (j + 1 < ntiles) { ATT_WRITE((j + 1) & 1); cur_kt = pf_kt; cur_mask = pf_mask; if (j + 2 < ntiles) ATT_PREFETCH(j + 2); }
        __syncthreads();
    }
#undef ATT_PREFETCH
#undef ATT_WRITE
#pragma unroll
    for (int g = 0; g < QG; ++g) {
        float lg = xor16_add(l[g]); lg = xor32_add(lg);
        const float inv = 1.f / lg;
        bf16_t* op = A.O + (size_t)(g * 128 + w * 16 + fr) * A.ostride + fq * 4;
#pragma unroll
        for (int dt = 0; dt < 4; ++dt) *(u32x2*)(op + dt * 16) = (u32x2){pk2(Oa[g][dt][0] * inv, Oa[g][dt][1] * inv), pk2(Oa[g][dt][2] * inv, Oa[g][dt][3] * inv)};
    }
}

__device__ __forceinline__ void swa_unit(const Args& a, const Ctx& cx, LAS unsigned char* lds, int i, int u) {
    const bf16_t* PROJ = (const bf16_t*)(cx.ws + WS_PROJ); bf16_t* MIX = (bf16_t*)(cx.ws + WS_MIX);
    AttnArgs A;
    A.tab64 = (const f32x2*)(cx.ws + WS_TAB);
    A.qstride = NPROJ_PAD; A.ostride = D; A.scale = 0.125f; A.l0 = 1.f;
    int npass, rowq, hq;
    if (u < 128) {
        const int b = u >> 6, qt = u & 7, row0 = TP + b * 1024, q0 = qt * 128; hq = (u >> 3) & 7; const int kv = hq >> 2;
        A.qpos0 = q0; A.qrope = 1; A.nseg = 2; npass = 1; rowq = row0 + q0;
        const bf16_t* csk = (const bf16_t*)(cx.ws + WS_CSK) + ((size_t)(i * 2 + b)) * 65536 + kv * 64;
        const bf16_t* csv = (const bf16_t*)(cx.ws + WS_CSV) + ((size_t)(i * 2 + b)) * 65536 + kv * 64;
        A.seg0 = KSeg{csk, 128, nullptr, csv, 128, 0, 512, 0};
        const int lo = q0 - 128 < 0 ? 0 : q0 - 128, hi = q0 + 256 > 1024 ? 1024 : q0 + 256;
        A.seg1 = KSeg{PROJ + (size_t)row0 * NPROJ_PAD + C_KB + kv * 64, NPROJ_PAD, nullptr, PROJ + (size_t)row0 * NPROJ_PAD + C_VB + kv * 64, NPROJ_PAD, lo, hi, 3};
    } else {
        const int v = u - 128, b = v >> 3, row0 = b * 256; hq = v & 7; const int kv = hq >> 2;
        A.qpos0 = 0; A.qrope = 0; A.nseg = 1; npass = 2; rowq = row0;
        A.seg0 = KSeg{PROJ + (size_t)row0 * NPROJ_PAD + C_KB + kv * 64, NPROJ_PAD, nullptr, PROJ + (size_t)row0 * NPROJ_PAD + C_VB + kv * 64, NPROJ_PAD, 0, 256, 0};
        A.seg1 = A.seg0;
    }
    A.m0 = (a.in[21] + cx.z)[i * 8 + hq];
    for (int ps = 0; ps < npass; ++ps) {
        A.Q = PROJ + (size_t)(rowq + ps * 128) * NPROJ_PAD + C_QB + hq * 64;
        A.O = MIX + (size_t)(rowq + ps * 128) * D + 512 + hq * 64;
        if (ps) A.qpos0 += 128;
        attn_unit<64, 1>(lds, A, cx.tid);
    }
}

__device__ __forceinline__ void mla_unit(const Args& a, const Ctx& cx, LAS unsigned char* lds, int u) {
    const bf16_t* Q = (const bf16_t*)(cx.ws + WS_Q); const bf16_t* KVX = (const bf16_t*)(cx.ws + WS_KVX); const bf16_t* KR = (const bf16_t*)(cx.ws + WS_KR);
    bf16_t* MIX = (bf16_t*)(cx.ws + WS_MIX);
    AttnArgs A;
    A.tab64 = (const f32x2*)(cx.ws + WS_TAB);
    A.qstride = 1536; A.ostride = D; A.scale = 0.10206207261596577f; A.l0 = 0.f; A.m0 = -1e30f;
    if (u < 256) {
        const int b = u >> 7, h = (u >> 3) & 15, qt = u & 7, row0 = TP + b * 1024, q0 = qt * 128, crow0 = T + b * 512;
        A.Q = Q + (size_t)(row0 + q0) * 1536 + h * 96; A.qpos0 = q0; A.qrope = 2; A.nseg = 2;
        A.seg0 = KSeg{KVX + (size_t)crow0 * 2048 + h * 128, 2048, KR + (size_t)crow0 * 32, KVX + (size_t)crow0 * 2048 + h * 128 + 64, 2048, 0, 512, 0};
        A.seg1 = KSeg{KVX + (size_t)row0 * 2048 + h * 128, 2048, KR + (size_t)row0 * 32, KVX + (size_t)row0 * 2048 + h * 128 + 64, 2048, 0, 1024, 0};
        A.O = MIX + (size_t)(row0 + q0) * D + h * 64;
        attn_unit<96, 1>(lds, A, cx.tid);
    } else {
        const int v = u - 256, b = v >> 4, h = v & 15, row0 = b * 256;
        A.Q = Q + (size_t)row0 * 1536 + h * 96; A.qpos0 = 0; A.qrope = 0; A.nseg = 1;
        A.seg0 = KSeg{KVX + (size_t)row0 * 2048 + h * 128, 2048, KR + (size_t)row0 * 32, KVX + (size_t)row0 * 2048 + h * 128 + 64, 2048, 0, 256, 0};
        A.seg1 = A.seg0;
        A.O = MIX + (size_t)row0 * D + h * 64;
        attn_unit<96, 2>(lds, A, cx.tid);
    }
}

constexpr int GL_G = 0;
constexpr int GL_STF = 32768, GL_STB = 51200;
constexpr int GL_LO = 32768, GL_WF = 40960, GL_WB = 45056, GL_BF = 49152, GL_BB = 49408;
constexpr int GL_QF = 69632, GL_KF = 78848, GL_QB = 88064, GL_KB = 97280;
constexpr int GL_VT = 106496;
constexpr int GL_AF = 124928, GL_AB = 134144;

__device__ __forceinline__ void gla_gates(const Args& a, const Ctx& cx, LAS unsigned char* lds, int i, int tok0, int h) {
    const int tid = cx.tid;
    const bf16_t* PROJ = (const bf16_t*)(cx.ws + WS_PROJ);
    LAS float* LO = (LAS float*)(lds + GL_LO); LAS float* WF = (LAS float*)(lds + GL_WF); LAS float* WB = (LAS float*)(lds + GL_WB);
    LAS float* BF = (LAS float*)(lds + GL_BF); LAS float* BB = (LAS float*)(lds + GL_BB);
    LAS float* Gf = (LAS float*)(lds + GL_G); LAS float* Gb = Gf + 4096;
    { const int t = tid >> 3, j0 = (tid & 7) * 4; const u32x2 v = *(const u32x2*)(PROJ + (size_t)(tok0 + t) * NPROJ_PAD + C_LO + j0);
      LO[t * 32 + j0] = bflo(v.x); LO[t * 32 + j0 + 1] = bfhi(v.x); LO[t * 32 + j0 + 2] = bflo(v.y); LO[t * 32 + j0 + 3] = bfhi(v.y); }
    for (int x = tid; x < 1024; x += NTHREADS) { const int r = x >> 6, d = x & 63;
        WF[x] = (a.in[16] + cx.z)[((size_t)i * 16 + r) * 256 + h * 64 + d]; WB[x] = (a.in[18] + cx.z)[((size_t)i * 16 + r) * 256 + h * 64 + d]; }
    if (tid < 64) { BF[tid] = (a.in[17] + cx.z)[i * 256 + h * 64 + tid]; BB[tid] = (a.in[19] + cx.z)[i * 256 + h * 64 + tid]; }
    __syncthreads();
    { const int d = tid & 63, tg = tid >> 6;
      LAS float* SEG = (LAS float*)(lds + GL_LO + 8192 + 8192 + 1024);
      float wf[16], wb[16];
#pragma unroll
      for (int r = 0; r < 16; ++r) { wf[r] = WF[r * 64 + d]; wb[r] = WB[r * 64 + d]; }
      const float bfv = BF[d], bbv = BB[d];
      float gf[8], gb[8];
#pragma unroll
      for (int tt = 0; tt < 8; ++tt) { const int t = tg * 8 + tt; float xf = bfv, xb = bbv;
#pragma unroll
          for (int r = 0; r < 16; ++r) { xf += LO[t * 32 + r] * wf[r]; xb += LO[t * 32 + 16 + r] * wb[r]; }
          gf[tt] = (fminf(xf, 0.f) - log1pf(__expf(-fabsf(xf)))) * (1.f / 16.f); gb[tt] = (fminf(xb, 0.f) - log1pf(__expf(-fabsf(xb)))) * (1.f / 16.f); }
#pragma unroll
      for (int tt = 1; tt < 8; ++tt) gf[tt] += gf[tt - 1];
#pragma unroll
      for (int tt = 6; tt >= 0; --tt) gb[tt] += gb[tt + 1];
      SEG[tg * 64 + d] = gf[7]; SEG[512 + tg * 64 + d] = gb[0];
      __syncthreads();
      float offf = 0.f, offb = 0.f;
#pragma unroll
      for (int q = 0; q < 8; ++q) { const float a_ = SEG[q * 64 + d], b_ = SEG[512 + q * 64 + d]; offf += (q < tg) ? a_ : 0.f; offb += (q > tg) ? b_ : 0.f; }
#pragma unroll
      for (int tt = 0; tt < 8; ++tt) { const int t = tg * 8 + tt; Gf[t * 64 + d] = gf[tt] + offf; Gb[t * 64 + d] = gb[tt] + offb; } }
    __syncthreads();
}

__device__ __forceinline__ void gla_vt_load(const bf16_t* PROJ, int tok0, int h, const int tid, u32x4 (&v)[2]) {
    const int s = tid & 63, e0 = (tid >> 6) * 16;
    const bf16_t* src = PROJ + (size_t)(tok0 + s) * NPROJ_PAD + C_VA + h * 128 + e0;
    v[0] = *(const u32x4*)src; v[1] = *(const u32x4*)(src + 8);
}
__device__ __forceinline__ void gla_vt_store(LAS unsigned char* lds, const int tid, const u32x4 (&vv)[2]) {
    const int s = tid & 63, e0 = (tid >> 6) * 16;
    LAS bf16_t* VT = (LAS bf16_t*)(lds + GL_VT);
#pragma unroll
    for (int q = 0; q < 2; ++q) { const u32x4 v = vv[q]; LAS bf16_t* dst = VT + (e0 + q * 8) * 72 + s;
        dst[0 * 72] = (bf16_t)(v.x & 0xffff); dst[1 * 72] = (bf16_t)(v.x >> 16); dst[2 * 72] = (bf16_t)(v.y & 0xffff); dst[3 * 72] = (bf16_t)(v.y >> 16);
        dst[4 * 72] = (bf16_t)(v.z & 0xffff); dst[5 * 72] = (bf16_t)(v.z >> 16); dst[6 * 72] = (bf16_t)(v.w & 0xffff); dst[7 * 72] = (bf16_t)(v.w >> 16); }
}

__device__ __forceinline__ void gla_local_unit(const Args& a, const Ctx& cx, LAS unsigned char* lds, int i, int u) {
    const int cg_ = u >> 2, h = u & 3, tok0 = cg_ * 64, tid = cx.tid, lane = tid & 63, w = tid >> 6, fr = lane & 15, fq = lane >> 4;
    const bf16_t* PROJ = (const bf16_t*)(cx.ws + WS_PROJ);
    float* LOC = (float*)(cx.ws + WS_LOC); float* DEC = (float*)(cx.ws + WS_DEC);
    u32x4 vpre[2]; gla_vt_load(PROJ, tok0, h, tid, vpre);
    const u32x4 kpre = *(const u32x4*)(PROJ + (size_t)(tok0 + (tid >> 3)) * NPROJ_PAD + C_KA + h * 64 + (tid & 7) * 8);
    __syncthreads();
    gla_gates(a, cx, lds, i, tok0, h);
    LAS float* Gf = (LAS float*)(lds + GL_G); LAS float* Gb = Gf + 4096;
    LAS bf16_t* KTf = (LAS bf16_t*)(lds + GL_KF); LAS bf16_t* KTb = (LAS bf16_t*)(lds + GL_KB);
    LAS bf16_t* VT = (LAS bf16_t*)(lds + GL_VT);
    { const int s = tid >> 3, d0 = (tid & 7) * 8; const u32x4 kv = kpre;
      float k[8]; unpack8(kv, k);
#pragma unroll
      for (int e = 0; e < 8; ++e) { const int d = d0 + e;
          KTf[d * 72 + s] = (bf16_t)f2bf(k[e] * __expf(Gf[63 * 64 + d] - Gf[s * 64 + d]));
          KTb[d * 72 + s] = (bf16_t)f2bf(k[e] * __expf(Gb[d] - Gb[s * 64 + d])); } }
    gla_vt_store(lds, tid, vpre);
    if (tid < 128) { const int dir = tid >> 6, d = tid & 63; DEC[((size_t)(dir * 96 + cg_) * 4 + h) * 64 + d] = __expf(dir ? Gb[d] : Gf[63 * 64 + d]); }
    __syncthreads();
    const int dir = w >> 2, dtile = w & 3;
    const LAS bf16_t* KT = dir ? KTb : KTf;
    bf16x8 af[2];
#pragma unroll
    for (int ks = 0; ks < 2; ++ks) af[ks] = *(const LAS bf16x8*)(KT + (dtile * 16 + fr) * 72 + ks * 32 + fq * 8);
    float* dst = LOC + ((size_t)(dir * 96 + cg_) * 4 + h) * 8192;
#pragma unroll
    for (int et = 0; et < 8; ++et) { f32x4 acc = {0.f, 0.f, 0.f, 0.f};
#pragma unroll
        for (int ks = 0; ks < 2; ++ks) { const bf16x8 bfv = *(const LAS bf16x8*)(VT + (et * 16 + fr) * 72 + ks * 32 + fq * 8); acc = MFMA16(af[ks], bfv, acc); }
#pragma unroll
        for (int j = 0; j < 4; ++j) dst[(dtile * 16 + fq * 4 + j) * 128 + et * 16 + fr] = acc[j]; }
}

__device__ __forceinline__ void gla_out_unit(const Args& a, const Ctx& cx, LAS unsigned char* lds, int i, int u) {
    const int cg_ = u >> 2, h = u & 3, tok0 = cg_ * 64, tid = cx.tid, lane = tid & 63, w = tid >> 6, fr = lane & 15, fq = lane >> 4;
    const bf16_t* PROJ = (const bf16_t*)(cx.ws + WS_PROJ); bf16_t* MIX = (bf16_t*)(cx.ws + WS_MIX);
    const float* LOC = (const float*)(cx.ws + WS_LOC); const float* DEC = (const float*)(cx.ws + WS_DEC);
    u32x4 vpre[2]; gla_vt_load(PROJ, tok0, h, tid, vpre);
    const u32x4 qpre = *(const u32x4*)(PROJ + (size_t)(tok0 + (tid >> 3)) * NPROJ_PAD + C_QA + h * 64 + (tid & 7) * 8);
    const u32x4 kpre = *(const u32x4*)(PROJ + (size_t)(tok0 + (tid >> 3)) * NPROJ_PAD + C_KA + h * 64 + (tid & 7) * 8);
    const bf16_t* gpp = PROJ + (size_t)(tok0 + (tid >> 3)) * NPROJ_PAD + C_GA + h * 128 + (tid & 7) * 16;
    const u32x4 gpre0 = *(const u32x4*)gpp, gpre1 = *(const u32x4*)(gpp + 8);
    f32x4 ggp[4];
    { const float* ggq = (a.in[20] + cx.z) + i * 128 + (tid & 7) * 16;
#pragma unroll
      for (int q = 0; q < 4; ++q) ggp[q] = *(const f32x4*)(ggq + q * 4); }
    const bool fin_f = (cg_ < 64) && ((cg_ & 3) == 3), fin_b = (cg_ < 64) && ((cg_ & 3) == 0);
    f32x4 finl[4]; float find = 0.f;
    if (fin_f || fin_b) { const size_t ix = (size_t)((fin_f ? 0 : 1) * 96 + cg_) * 4 + h; find = DEC[ix * 64 + (tid >> 3)]; const float* lp = LOC + ix * 8192 + (tid >> 3) * 128 + (tid & 7) * 16;
#pragma unroll
        for (int q = 0; q < 4; ++q) finl[q] = *(const f32x4*)(lp + q * 4); }
    __syncthreads();
    gla_gates(a, cx, lds, i, tok0, h);
    LAS float* Gf = (LAS float*)(lds + GL_G); LAS float* Gb = Gf + 4096;
    const bool samp = cg_ >= 64;
    const int b = samp ? (cg_ - 64) >> 4 : cg_ >> 2, c = samp ? (cg_ - 64) & 15 : cg_ & 3, nc = samp ? 16 : 4, cbase = cg_ - c;
    {
        const int d = tid >> 3, e0 = (tid & 7) * 16;
        f32x4 Sf[4], Sb[4];
        if (samp) { const float* s0f = (a.in[2] + cx.z) + ((size_t)((b * 2 + i) * 4 + h)) * 8192 + d * 128 + e0; const float* s0b = (a.in[3] + cx.z) + ((size_t)((b * 2 + i) * 4 + h)) * 8192 + d * 128 + e0;
#pragma unroll
            for (int q = 0; q < 4; ++q) { Sf[q] = *(const f32x4*)(s0f + q * 4); Sb[q] = *(const f32x4*)(s0b + q * 4); } }
        else {
#pragma unroll
            for (int q = 0; q < 4; ++q) { Sf[q] = (f32x4){0.f, 0.f, 0.f, 0.f}; Sb[q] = Sf[q]; } }
        for (int j = 0; j < c; ++j) { const size_t ix = (size_t)(0 * 96 + cbase + j) * 4 + h; const float dec = DEC[ix * 64 + d]; const float* lp = LOC + ix * 8192 + d * 128 + e0;
#pragma unroll
            for (int q = 0; q < 4; ++q) Sf[q] = Sf[q] * dec + *(const f32x4*)(lp + q * 4); }
        for (int j = nc - 1; j > c; --j) { const size_t ix = (size_t)(1 * 96 + cbase + j) * 4 + h; const float dec = DEC[ix * 64 + d]; const float* lp = LOC + ix * 8192 + d * 128 + e0;
#pragma unroll
            for (int q = 0; q < 4; ++q) Sb[q] = Sb[q] * dec + *(const f32x4*)(lp + q * 4); }
        if (fin_f) { float* o = cx.out + O_SF + ((size_t)((b * 2 + i) * 4 + h)) * 8192 + d * 128 + e0;
#pragma unroll
            for (int q = 0; q < 4; ++q) *(f32x4*)(o + q * 4) = Sf[q] * find + finl[q]; }
        if (fin_b) { float* o = cx.out + O_SB + ((size_t)((b * 2 + i) * 4 + h)) * 8192 + d * 128 + e0;
#pragma unroll
            for (int q = 0; q < 4; ++q) *(f32x4*)(o + q * 4) = Sb[q] * find + finl[q]; }
        LAS bf16_t* STf = (LAS bf16_t*)(lds + GL_STF); LAS bf16_t* STb = (LAS bf16_t*)(lds + GL_STB);
#pragma unroll
        for (int q = 0; q < 4; ++q)
#pragma unroll
            for (int e = 0; e < 4; ++e) { STf[(e0 + q * 4 + e) * 72 + d] = (bf16_t)f2bf(Sf[q][e]); STb[(e0 + q * 4 + e) * 72 + d] = (bf16_t)f2bf(Sb[q][e]); }
    }
    {
        const int t = tid >> 3, d0 = (tid & 7) * 8;
        const u32x4 qv = qpre, kv = kpre;
        float q[8], k[8], o1[8], o2[8], o3[8], o4[8]; unpack8(qv, q); unpack8(kv, k);
#pragma unroll
        for (int e = 0; e < 8; ++e) { const float gf = Gf[t * 64 + d0 + e], gb = Gb[t * 64 + d0 + e];
            o1[e] = q[e] * 0.125f * __expf(gf); o2[e] = k[e] * __expf(-gf); o3[e] = q[e] * 0.125f * __expf(gb); o4[e] = k[e] * __expf(-gb); }
        *(LAS u32x4*)((LAS bf16_t*)(lds + GL_QF) + t * 72 + d0) = pack8(o1);
        *(LAS u32x4*)((LAS bf16_t*)(lds + GL_KF) + t * 72 + d0) = pack8(o2);
        *(LAS u32x4*)((LAS bf16_t*)(lds + GL_QB) + t * 72 + d0) = pack8(o3);
        *(LAS u32x4*)((LAS bf16_t*)(lds + GL_KB) + t * 72 + d0) = pack8(o4);
    }
    gla_vt_store(lds, tid, vpre);
    __syncthreads();
    {
        const int dir = w >> 2, tt = w & 3;
        const LAS bf16_t* Qm = (const LAS bf16_t*)(lds + (dir ? GL_QB : GL_QF)); const LAS bf16_t* Km = (const LAS bf16_t*)(lds + (dir ? GL_KB : GL_KF));
        LAS bf16_t* AT = (LAS bf16_t*)(lds + (dir ? GL_AB : GL_AF));
        bf16x8 af[2];
#pragma unroll
        for (int ks = 0; ks < 2; ++ks) af[ks] = *(const LAS bf16x8*)(Qm + (tt * 16 + fr) * 72 + ks * 32 + fq * 8);
#pragma unroll
        for (int st = 0; st < 4; ++st) { f32x4 acc = {0.f, 0.f, 0.f, 0.f};
#pragma unroll
            for (int ks = 0; ks < 2; ++ks) { const bf16x8 bfv = *(const LAS bf16x8*)(Km + (st * 16 + fr) * 72 + ks * 32 + fq * 8); acc = MFMA16(af[ks], bfv, acc); }
#pragma unroll
            for (int j = 0; j < 4; ++j) { const int t = tt * 16 + fq * 4 + j, s = st * 16 + fr; const bool keep = dir ? (s >= t) : (s <= t);
                AT[t * 72 + s] = (bf16_t)f2bf(keep ? acc[j] : 0.f); } }
    }
    __syncthreads();
    {
        const int tt = w & 3, eg = w >> 2;
        LAS float* OS = (LAS float*)(lds + GL_G);
        const LAS bf16_t* VT = (const LAS bf16_t*)(lds + GL_VT);
        bf16x8 a1[2], a2[2], a3[2], a4[2];
#pragma unroll
        for (int ks = 0; ks < 2; ++ks) { const int off = (tt * 16 + fr) * 72 + ks * 32 + fq * 8;
            a1[ks] = *(const LAS bf16x8*)((const LAS bf16_t*)(lds + GL_QF) + off); a2[ks] = *(const LAS bf16x8*)((const LAS bf16_t*)(lds + GL_AF) + off);
            a3[ks] = *(const LAS bf16x8*)((const LAS bf16_t*)(lds + GL_QB) + off); a4[ks] = *(const LAS bf16x8*)((const LAS bf16_t*)(lds + GL_AB) + off); }
        f32x4 accs[4];
#pragma unroll
        for (int q = 0; q < 4; ++q) { const int et = eg * 4 + q; f32x4 acc = {0.f, 0.f, 0.f, 0.f};
#pragma unroll
            for (int ks = 0; ks < 2; ++ks) { const int off = (et * 16 + fr) * 72 + ks * 32 + fq * 8;
                const bf16x8 b1 = *(const LAS bf16x8*)((const LAS bf16_t*)(lds + GL_STF) + off), b2 = *(const LAS bf16x8*)(VT + off), b3 = *(const LAS bf16x8*)((const LAS bf16_t*)(lds + GL_STB) + off);
                acc = MFMA16(a1[ks], b1, acc); acc = MFMA16(a2[ks], b2, acc); acc = MFMA16(a3[ks], b3, acc); acc = MFMA16(a4[ks], b2, acc); }
            accs[q] = acc; }
#pragma unroll
        for (int q = 0; q < 4; ++q)
#pragma unroll
            for (int j = 0; j < 4; ++j) OS[(tt * 16 + fq * 4 + j) * 128 + (eg * 4 + q) * 16 + fr] = accs[q][j];
    }
    __syncthreads();
    {
        const int t = tid >> 3, e0 = (tid & 7) * 16;
        const LAS float* OS = (const LAS float*)(lds + GL_G);
        float o[16]; float ss = 0.f;
#pragma unroll
        for (int e = 0; e < 16; ++e) { o[e] = OS[t * 128 + e0 + e]; ss += o[e] * o[e]; }
        ss += __shfl_xor(ss, 1); ss += __shfl_xor(ss, 2); ss += __shfl_xor(ss, 4);
        const float rstd = rsqrtf(ss * (1.f / 128.f) + EPS);
        float gt[16]; unpack8(gpre0, gt); unpack8(gpre1, gt + 8);
#pragma unroll
        for (int e = 0; e < 16; ++e) o[e] = o[e] * rstd * ggp[e >> 2][e & 3] * silu_f(gt[e]);
        bf16_t* op = MIX + (size_t)(tok0 + t) * D + h * 128 + e0;
        *(u32x4*)op = pack8(o); *(u32x4*)(op + 8) = pack8(o + 8);
    }
}


#define XB_TMO      128
#define XB_XCNT(j)  (256  + 64 * (j))
#define XB_XSUB(j)  (1280 + 64 * (j))
#define XB_XGEN(j)  (2304 + 64 * (j))
#define XB_TOP      3328
#define XB_TOPGEN   3392
#define XCD_BAR_WORDS 3456
#define XB_SPIN_CAP (1u << 18)
__device__ __forceinline__ unsigned xb_ld(unsigned* p)              { return __hip_atomic_load(p, __ATOMIC_RELAXED, __HIP_MEMORY_SCOPE_AGENT); }
__device__ __forceinline__ unsigned xb_add(unsigned* p, unsigned v) { return __hip_atomic_fetch_add(p, v, __ATOMIC_RELAXED, __HIP_MEMORY_SCOPE_AGENT); }
__device__ __forceinline__ unsigned xb_xcc_id() { return (unsigned)__builtin_amdgcn_s_getreg((3 << 11) | 20) & 0xFu; }
#define XB_SPIN(cond, bar) do { unsigned _sp = 0; while (cond) { __builtin_amdgcn_s_sleep(1); \
    if ((++_sp & 255u) == 0u) { if (xb_ld(&(bar)[XB_TMO])) break; if (_sp > XB_SPIN_CAP) { atomicAdd(&(bar)[XB_TMO], 1u); break; } } } } while (0)
struct XcdBarrier { unsigned* bar; unsigned x; volatile LAS unsigned* st; };
__device__ __forceinline__ XcdBarrier xcd_barrier_post(unsigned* bar, volatile LAS unsigned* st, const int tid) {
    XcdBarrier b; b.bar = bar; b.x = xb_xcc_id(); b.st = st;
    if (tid == 0) (void)xb_add(&bar[XB_XCNT(b.x)], 1u);
    return b;
}
__device__ __forceinline__ void xcd_barrier_complete(unsigned* bar, unsigned x, unsigned& nloc, unsigned& nx) {
    const unsigned G = gridDim.x * gridDim.y * gridDim.z;
    unsigned sum, cnt, mine, sp = 0u;
    for (;;) {
        sum = 0u; cnt = 0u; mine = 0u;
#pragma unroll
        for (unsigned j = 0; j < 16; ++j) { const unsigned c = xb_ld(&bar[XB_XCNT(j)]); sum += c; cnt += (c > 0u) ? 1u : 0u; mine = (j == x) ? c : mine; }
        if (sum == G) break;
        __builtin_amdgcn_s_sleep(1);
        if ((++sp & 255u) == 0u) { if (xb_ld(&bar[XB_TMO])) break; if (sp > XB_SPIN_CAP) { atomicAdd(&bar[XB_TMO], 1u); break; } }
    }
    nloc = mine > 0u ? mine : 1u; nx = cnt > 0u ? cnt : 1u;
}
__device__ __forceinline__ void xcd_barrier(const XcdBarrier& b, const int tid) {
    asm volatile("s_waitcnt vmcnt(0)" ::: "memory");
    __syncthreads();
    if (tid == 0) {
        unsigned* bar = b.bar;
        __builtin_amdgcn_s_waitcnt(0);
        unsigned nloc = b.st[0], nx = b.st[1];
        if (nloc == 0u) { xcd_barrier_complete(bar, b.x, nloc, nx); b.st[0] = nloc; b.st[1] = nx; }
        const unsigned old = xb_add(&bar[XB_XSUB(b.x)], 1u);
        const unsigned gen = old / nloc;
        if (old + 1u == (gen + 1u) * nloc) {
            __builtin_amdgcn_fence(__ATOMIC_RELEASE, "agent");
            asm volatile("s_waitcnt vmcnt(0)" ::: "memory");
            const unsigned og = xb_add(&bar[XB_TOP], 1u);
            const unsigned tg = og / nx;
            if (og + 1u == (tg + 1u) * nx) xb_add(&bar[XB_TOPGEN], 1u);
            else XB_SPIN(xb_ld(&bar[XB_TOPGEN]) == tg, bar);
            __builtin_amdgcn_fence(__ATOMIC_ACQUIRE, "agent");
            asm volatile("s_waitcnt vmcnt(0)" ::: "memory");
        } else {
            XB_SPIN(xb_ld(&bar[XB_TOPGEN]) == gen, bar);
            __builtin_amdgcn_fence(__ATOMIC_ACQUIRE, "agent");
            asm volatile("s_waitcnt vmcnt(0)" ::: "memory");
        }
    }
    __syncthreads();
}

enum { K_PRO = 0, K_PRE, K_G1, K_A1, K_A2, K_DOWN, K_MID, K_UQKV, K_MLA, K_OUTP, K_POST1, K_FF1, K_FF2, K_POST2 };
constexpr int N_PHASES = 2 + 2 * 8 + 2 * 9;
#ifndef EN_MASK
#define EN_MASK 0xFFFFFFFFu
#endif
#define ENB(k) (((EN_MASK) >> (k)) & 1u)
#ifndef DUP_MASK
#define DUP_MASK 0u
#endif
#ifndef BAR_REPS
#define BAR_REPS 1
#endif

__global__ void __launch_bounds__(NTHREADS, 2) mega_fwd(Args args) {
    extern __shared__ __attribute__((aligned(16))) unsigned char lds_raw[];
    LAS unsigned char* lds = (LAS unsigned char*)lds_raw;
    const int lo = args.ph_lo, hi = args.ph_hi;
    const int wave_s = __builtin_amdgcn_readfirstlane((int)(threadIdx.x >> 6));
#define MY_TID(dst) do { int _l; asm volatile("v_mbcnt_lo_u32_b32 %0, -1, 0\n\tv_mbcnt_hi_u32_b32 %0, -1, %0" : "=v"(_l)); dst = wave_s * 64 + _l; } while (0)
    {
        int tid0; MY_TID(tid0);
        volatile LAS unsigned* bst = (volatile LAS unsigned*)(lds + LDS_BYTES - 64);
        if (tid0 < 2) bst[tid0] = 0u;
        __syncthreads();
        (void)xcd_barrier_post((unsigned*)(args.ws + WS_CTL), bst, tid0);
    }
    for (int p = lo; p < hi; ++p) {
        int kind, l;
        if (p == 0) { kind = K_PRO; l = 0; }
        else if (p == 1) { kind = K_PRE; l = 0; }
        else {
            const int q = p - 2, pair = q / 17, r = q - pair * 17;
            if (r < 8) { l = 2 * pair; kind = (r == 0) ? K_G1 : (r == 1) ? K_A1 : (r == 2) ? K_A2 : (r == 3) ? K_OUTP : (r == 4) ? K_POST1 : (r == 5) ? K_FF1 : (r == 6) ? K_FF2 : K_POST2; }
            else { const int r2 = r - 8; l = 2 * pair + 1; kind = (r2 == 0) ? K_DOWN : (r2 == 1) ? K_MID : (r2 == 2) ? K_UQKV : (r2 == 3) ? K_MLA : (r2 == 4) ? K_OUTP : (r2 == 5) ? K_POST1 : (r2 == 6) ? K_FF1 : (r2 == 7) ? K_FF2 : K_POST2; }
        }
        int cv_g0 = -1, cv_stride = 1, cv_end = 0;
        if (gridDim.x == 256 && l < 3) {
            const int bidx = blockIdx.x;
            const int b0 = (l == 0) ? 0 : 8192 + 6144 * (l - 1), f1 = (l == 0) ? 5120 : 3072;
            if (kind == K_FF1 && bidx >= 128) { cv_g0 = b0 + (bidx - 128) * NWAVES + wave_s; cv_stride = 1024; cv_end = b0 + f1; }
            else if (kind == K_FF2 && bidx >= 192) { cv_g0 = b0 + f1 + (bidx - 192) * NWAVES + wave_s; cv_stride = 512; cv_end = b0 + f1 + 3072; }
        }
        const int kind0 = kind;
        const int reps = (cv_g0 >= 0) ? 2 : (((DUP_MASK >> kind) & 1u) ? 2 : 1);
        for (int rep = 0; rep < reps; ++rep) {
        if (rep) __syncthreads();
        int pmode = 0;
        if (rep && cv_g0 >= 0) { kind = K_PRO; pmode = 1; } else kind = kind0;
        Ctx cx; cx.z = 0; MY_TID(cx.tid); cx.bid = blockIdx.x; cx.G = gridDim.x;
        asm volatile("" : "+s"(cx.z), "+s"(kind), "+s"(l), "+v"(cx.tid), "+s"(cx.bid), "+s"(cx.G));
        cx.ws = args.ws + cx.z; cx.out = args.out + cx.z;
        unsigned char* ws = cx.ws;
        const int i = l >> 1, G = cx.G, bid = cx.bid;
        switch (kind) {
        case K_PRO: if (ENB(0)) prologue(args, cx, lds, pmode, cv_g0, cv_stride, cv_end); break;
        case K_PRE: if (ENB(1)) pre_rows(args, cx, 0); break;
        case K_G1: if (ENB(2)) {
            pg8::Gemm g{(const bf16_t*)(ws + WS_H), (const bf16_t*)(ws + WS_WIN) + (size_t)i * NPROJ_PAD * D, T, NPROJ_PAD, D, D, D, NPROJ_PAD / 256, 0};
            pg8::StaticOrder S; S.init(T, NPROJ_PAD, G, bid);
            pg8::EpiProj E{(bf16_t*)(ws + WS_PROJ), cx.out, i};
            pg8::gemm_phase<pg8::EpiProj, pg8::StaticOrder>(lds, g, S, E, cx.tid);
        } break;
        case K_A1:
            if (G == 256) {
                if (bid < 128) { if (ENB(3)) swa_unit(args, cx, lds, i, bid); if (ENB(4)) gla_local_unit(args, cx, lds, i, bid); }
                else { const int q = bid - 128; if (ENB(3)) swa_unit(args, cx, lds, i, 128 + q);
                       if (ENB(4)) { gla_local_unit(args, cx, lds, i, 128 + 2 * q); gla_local_unit(args, cx, lds, i, 128 + 2 * q + 1); } }
            } else { for (int u = bid; u < 640; u += G) { if (u < 256) { if (ENB(3)) swa_unit(args, cx, lds, i, u); } else { if (ENB(4)) gla_local_unit(args, cx, lds, i, u - 256); } } }
            break;
        case K_A2:
            if (G == 256) {
                if (bid < 128) { if (ENB(5)) { gla_out_unit(args, cx, lds, i, 256 + bid); gla_out_unit(args, cx, lds, i, bid); } }
                else { if (ENB(5)) gla_out_unit(args, cx, lds, i, bid); }
            } else { for (int u = bid; u < 384; u += G) if (ENB(5)) gla_out_unit(args, cx, lds, i, u); }
            break;
        case K_MID: if (ENB(7)) mla_mid(args, cx, i); break;
        case K_UQKV: if (ENB(8)) {
            for (int s = 0; s < 2; ++s) {
                pg8::Gemm g;
                if (s == 0) g = pg8::Gemm{(const bf16_t*)(ws + WS_CQ), (const bf16_t*)(ws + WS_WUQ) + (size_t)i * 1536 * 384, T, 1536, 384, 384, 384, 6, 0};
                else        g = pg8::Gemm{(const bf16_t*)(ws + WS_CKV), (const bf16_t*)(ws + WS_WUKV) + (size_t)i * 2048 * 256, T + 1024, 2048, 256, 256, 256, 8, 0};
                pg8::StaticOrder S; S.init(g.M, g.N, G, (s == 0 || G != 256) ? bid : ((bid + 144) & 255));
                pg8::EpiBf16<0> E{s == 0 ? (bf16_t*)(ws + WS_Q) : (bf16_t*)(ws + WS_KVX), g.N};
                pg8::gemm_phase<pg8::EpiBf16<0>, pg8::StaticOrder>(lds, g, S, E, cx.tid);
            }
        } break;
        case K_MLA: if (ENB(9)) {
            if (G == 256) {
                const int xcd = bid & 7, slot = bid >> 3, id = xcd * 4 + (slot >> 3);
                mla_unit(args, cx, lds, id * 8 + (slot & 7));
                mla_unit(args, cx, lds, 256 + bid);
            } else { for (int u = bid; u < 512; u += G) mla_unit(args, cx, lds, u); }
        } break;
        case K_DOWN: if (ENB(10)) {
            pg8::Gemm g{(const bf16_t*)(ws + WS_H), (const bf16_t*)(ws + WS_WDOWN) + (size_t)i * NDOWN_PAD * D, T, 2 * NDOWN_PAD, D / 2, D, D / 2, NDOWN_PAD / 256, D / 2};
            pg8::EpiF32 E{(float*)(ws + WS_OUT), NDOWN_PAD, NDOWN_PAD / 256, DOWN_SPLIT};
            pg8::StaticOrder S; S.init(g.M, g.N, G, bid);
            pg8::gemm_phase<pg8::EpiF32, pg8::StaticOrder>(lds, g, S, E, cx.tid);
        } break;
        case K_OUTP: case K_FF2: if (ENB(10)) {
            pg8::Gemm g;
            if (kind == K_OUTP) {
                const bf16_t* Wt = (l & 1) ? (const bf16_t*)(ws + WS_WO) + (size_t)i * D * D : (const bf16_t*)(ws + WS_WOUT) + (size_t)i * D * D;
                g = pg8::Gemm{(const bf16_t*)(ws + WS_MIX), Wt, T, 2 * D, D / 2, D, D / 2, 4, D / 2};
            } else {
                g = pg8::Gemm{(const bf16_t*)(ws + WS_U), (const bf16_t*)(ws + WS_WFF2) + (size_t)l * FF * D, T, 2 * D, FF / 2, FF, FF / 2, 4, FF / 2};
            }
            pg8::EpiSplitBf16 E{(bf16_t*)(ws + WS_OUT), D, 4, OUT_SPLIT};
            pg8::StaticOrder S; S.init(g.M, g.N, G, bid);
            pg8::gemm_phase<pg8::EpiSplitBf16, pg8::StaticOrder>(lds, g, S, E, cx.tid);
        } break;
        case K_FF1: if (ENB(12)) {
            pg8::Gemm g{(const bf16_t*)(ws + WS_H), (const bf16_t*)(ws + WS_WFF1) + (size_t)l * FF * D, T, FF, D, D, D, FF / 256, 0};
            pg8::StaticOrder S; S.init(T, FF, G, bid);
            pg8::EpiBf16<1> E{(bf16_t*)(ws + WS_U), FF};
            pg8::gemm_phase<pg8::EpiBf16<1>, pg8::StaticOrder>(lds, g, S, E, cx.tid);
        } break;
        case K_POST1: if (ENB(11)) {
            const float* MODL = (const float*)(ws + WS_MOD) + (size_t)l * 3 * 6144; const float* gN = (args.in[12] + cx.z) + (size_t)l * 4 * D;
            post_rows(args, cx, l == 0, MODL + 2 * D, gN + D, true, gN + 2 * D, MODL + 3 * D, MODL + 4 * D, rep + 1 < reps);
        } break;
        case K_POST2: if (ENB(14)) {
            const float* MODL = (const float*)(ws + WS_MOD) + (size_t)l * 3 * 6144; const float* gN = (args.in[12] + cx.z) + (size_t)l * 4 * D;
            const float* MODN = MODL + 3 * 6144; const float* gNn = gN + 4 * D;
            post_rows(args, cx, false, MODL + 5 * D, gN + 3 * D, l < 3, gNn, MODN, MODN + D, rep + 1 < reps);
        } break;
        default: break;
        }
        }
        if (p + 1 < hi) { if (hi < 0) cg::this_grid().sync(); else { XcdBarrier xb; xb.bar = (unsigned*)(args.ws + WS_CTL); xb.x = xb_xcc_id(); xb.st = (volatile LAS unsigned*)(lds + LDS_BYTES - 64); int tidb; MY_TID(tidb); for (int br = 0; br < BAR_REPS; ++br) xcd_barrier(xb, tidb); } }
    }
}

extern "C" void kernel_launch(void* const* d_in, const int* in_sizes, int n_in, void* d_out, int out_size, void* d_ws, size_t ws_size, hipStream_t stream) {
    static int grid = 0;
    if (grid == 0) {
        int dev = 0, cus = 0, per_cu = 0;
        hipGetDevice(&dev);
        hipDeviceGetAttribute(&cus, hipDeviceAttributeMultiprocessorCount, dev);
        hipFuncSetAttribute((const void*)mega_fwd, hipFuncAttributeMaxDynamicSharedMemorySize, LDS_BYTES);
        hipOccupancyMaxActiveBlocksPerMultiprocessor(&per_cu, (const void*)mega_fwd, NTHREADS, LDS_BYTES);
        if (per_cu < 1) { fprintf(stderr, "kernel_launch: occupancy query says %d blocks per CU\n", per_cu); per_cu = 1; }
        (void)hipGetLastError();
        grid = cus;
        if (ws_size < 256 * MiB) fprintf(stderr, "kernel_launch: workspace too small (%zu)\n", ws_size);
    }
    (void)hipMemsetAsync((char*)d_ws + WS_CTL, 0, CTL_BYTES, stream);
    Args a{};
    for (int i = 0; i < 29; ++i) a.in[i] = (const float*)d_in[i];
    a.out = (float*)d_out; a.ws = (unsigned char*)d_ws;
#if MK_ONE_LAUNCH
    a.ph_lo = 0; a.ph_hi = N_PHASES;
    void* kargs[] = {&a};
    hipError_t e = hipLaunchCooperativeKernel((const void*)mega_fwd, dim3(grid), dim3(NTHREADS), kargs, LDS_BYTES, stream);
    if (e != hipSuccess) fprintf(stderr, "cooperative launch failed: %s (grid %d)\n", hipGetErrorString(e), grid);
#else
    for (int p = 0; p < N_PHASES; ++p) {
        a.ph_lo = p; a.ph_hi = p + 1;
        hipLaunchKernelGGL(mega_fwd, dim3(grid), dim3(NTHREADS), LDS_BYTES, stream, a);
    }
#endif
}
```

```cpp
#include <hip/hip_runtime.h>
#include <hip/hip_cooperative_groups.h>
#include <cstdio>
#include <cstdint>
namespace cg = cooperative_groups;

#ifndef MK_ONE_LAUNCH
#define MK_ONE_LAUNCH 1
#endif

#define LAS __attribute__((address_space(3)))
#define GAS __attribute__((address_space(1)))
typedef unsigned short bf16_t;
typedef short bf16x8 __attribute__((ext_vector_type(8)));
typedef float f32x4 __attribute__((ext_vector_type(4)));
typedef float f32x2 __attribute__((ext_vector_type(2)));
typedef unsigned u32x4 __attribute__((ext_vector_type(4)));
typedef unsigned u32x2 __attribute__((ext_vector_type(2)));

constexpr int D = 1024, TP = 4096, TS = 2048, T = TP + TS, FF = 4096;
constexpr int NPROJ = 2336, NPROJ_PAD = 2560, NDOWN = 672, NDOWN_PAD = 768;
constexpr int C_QA = 0, C_KA = 256, C_VA = 512, C_GA = 1024, C_LO = 1536, C_QB = 1568, C_KB = 2080, C_VB = 2208;
constexpr float EPS = 1e-6f;
constexpr int NTHREADS = 512, NWAVES = 8;
constexpr int LDS_BYTES = 147456;

constexpr size_t O_X = 0, O_SF = 6291456, O_SB = 7340032, O_CK = 8388608, O_CV = 9437184, O_CKV = 10485760, O_CKR = 12582912;

constexpr size_t MiB = 1u << 20;
constexpr size_t WS_WFF1 = 0, WS_WFF2 = 32 * MiB, WS_WIN = 64 * MiB, WS_WOUT = 74 * MiB, WS_WDOWN = 78 * MiB, WS_WUQ = 81 * MiB,
                 WS_WUKV = 84 * MiB, WS_WO = 86 * MiB, WS_MOD = 90 * MiB, WS_TAB = 91 * MiB, WS_CSK = 92 * MiB, WS_CSV = 93 * MiB,
                 WS_H = 94 * MiB, WS_MIX = 106 * MiB, WS_OUT = 118 * MiB, WS_U = 166 * MiB, WS_PROJ = 214 * MiB, WS_CTL = 250 * MiB;
constexpr size_t CTL_BYTES = 16384;
constexpr size_t WS_LOC = WS_U, WS_DEC = WS_U + 24 * MiB;
constexpr size_t WS_Q = WS_U, WS_KVX = WS_U + 18 * MiB;
constexpr size_t WS_DOWN = WS_PROJ, WS_CQ = WS_PROJ + 18 * MiB, WS_CKV = WS_PROJ + 23 * MiB, WS_KR = WS_PROJ + 27 * MiB;
constexpr size_t OUT_SPLIT = (size_t)T * D;
constexpr size_t DOWN_SPLIT = (WS_DOWN - WS_OUT) / 4;

__device__ __forceinline__ unsigned f2bf(float f) { unsigned u = __builtin_bit_cast(unsigned, f); return (u + 0x7fffu + ((u >> 16) & 1u)) >> 16; }
__device__ __forceinline__ unsigned pk2(float lo, float hi) { return f2bf(lo) | (f2bf(hi) << 16); }
__device__ __forceinline__ float bf2f(unsigned short b) { return __builtin_bit_cast(float, (unsigned)b << 16); }
__device__ __forceinline__ float bflo(unsigned w) { return __builtin_bit_cast(float, w << 16); }
__device__ __forceinline__ float bfhi(unsigned w) { return __builtin_bit_cast(float, w & 0xffff0000u); }
__device__ __forceinline__ void unpack8(const u32x4 v, float* f) {
    f[0] = bflo(v.x); f[1] = bfhi(v.x); f[2] = bflo(v.y); f[3] = bfhi(v.y); f[4] = bflo(v.z); f[5] = bfhi(v.z); f[6] = bflo(v.w); f[7] = bfhi(v.w);
}
__device__ __forceinline__ u32x4 pack8(const float* f) { u32x4 o; o.x = pk2(f[0], f[1]); o.y = pk2(f[2], f[3]); o.z = pk2(f[4], f[5]); o.w = pk2(f[6], f[7]); return o; }
__device__ __forceinline__ float wave_sum(float v) {
#pragma unroll
    for (int o = 1; o < 64; o <<= 1) v += __shfl_xor(v, o);
    return v;
}
__device__ __forceinline__ float xor16_max(float x) { const unsigned u = __builtin_bit_cast(unsigned, x); auto r = __builtin_amdgcn_permlane16_swap(u, u, false, false); return fmaxf(__builtin_bit_cast(float, (unsigned)r[0]), __builtin_bit_cast(float, (unsigned)r[1])); }
__device__ __forceinline__ float xor32_max(float x) { const unsigned u = __builtin_bit_cast(unsigned, x); auto r = __builtin_amdgcn_permlane32_swap(u, u, false, false); return fmaxf(__builtin_bit_cast(float, (unsigned)r[0]), __builtin_bit_cast(float, (unsigned)r[1])); }
__device__ __forceinline__ float xor16_add(float x) { const unsigned u = __builtin_bit_cast(unsigned, x); auto r = __builtin_amdgcn_permlane16_swap(u, u, false, false); return __builtin_bit_cast(float, (unsigned)r[0]) + __builtin_bit_cast(float, (unsigned)r[1]); }
__device__ __forceinline__ float xor32_add(float x) { const unsigned u = __builtin_bit_cast(unsigned, x); auto r = __builtin_amdgcn_permlane32_swap(u, u, false, false); return __builtin_bit_cast(float, (unsigned)r[0]) + __builtin_bit_cast(float, (unsigned)r[1]); }
__device__ __forceinline__ unsigned cvtpk(float lo, float hi) { unsigned r; asm volatile("v_cvt_pk_bf16_f32 %0, %1, %2" : "=v"(r) : "v"(lo), "v"(hi)); return r; }
__device__ __forceinline__ float silu_f(float x) { return x / (1.f + __expf(-x)); }

namespace pg8 {
constexpr int BM = 256, BK = 64, HALF = 128, HTB = HALF * BK * 2, NXCD = 8, WGM = 8;
__host__ __device__ __forceinline__ int lds_byte(int r, int c) { const int st = (r >> 4) * 2 + (c >> 5), rr = r & 15, cc = c & 31, ob = rr * 64 + cc * 2; return st * 1024 + (ob ^ (((ob >> 9) & 1) << 5)); }
__host__ __device__ __forceinline__ void stage_rc(int b, int& R, int& C) { const int st = b / 1024, sb = b % 1024, swz = sb ^ (((sb >> 9) & 1) << 5); R = (st >> 1) * 16 + swz / 64; C = (st & 1) * 32 + (swz % 64) / 2; }
__host__ __device__ __forceinline__ int perm32(int rho) { const int n = rho >> 4, i = rho & 15; return 8 * (i >> 2) + 4 * n + (i & 3); }

struct Unit { int pm, pn; };
struct Gemm { const bf16_t* A; const bf16_t* Bt; int M, N, K, lda, ldb, npn, a_split; };

struct StaticOrder {
    int nM, nN, nwg, G, c;
    __device__ void init(int M, int N, int G_, int c_) { nM = M / BM; nN = N / BM; nwg = nM * nN; G = G_; c = c_; }
    __device__ bool next(int i, Unit& u) const {
        const long L = (long)i * G + c; if (L >= nwg) return false;
        int wgid = (int)L; { const int q = nwg / NXCD, r = nwg % NXCD, xcd = wgid % NXCD, off = wgid / NXCD; wgid = (xcd < r ? xcd * (q + 1) : r * (q + 1) + (xcd - r) * q) + off; }
        const int nig = WGM * nN, gid = wgid / nig, fm = gid * WGM, gsz = (nM - fm) < WGM ? (nM - fm) : WGM;
        u.pm = fm + ((wgid % nig) % gsz); u.pn = (wgid % nig) / gsz; return true;
    }
};

__device__ __forceinline__ unsigned cvt_pk_bf16(float lo, float hi) { unsigned r; asm volatile("v_cvt_pk_bf16_f32 %0, %1, %2" : "=v"(r) : "v"(lo), "v"(hi)); return r; }

template <int ACT  > struct EpiBf16 {
    static constexpr bool PERM = true;
    bf16_t* O; int ldc;
    __device__ __forceinline__ void operator()(const f32x4 (&acc)[2][2][4][2], const Unit& u, int wr, int wc, int fr, int fq) const {
        const int row0 = u.pm * BM + wr * 64 + fr, col0 = u.pn * BM + wc * 32 + 8 * fq;
#pragma unroll
        for (int ai = 0; ai < 2; ++ai)
#pragma unroll
            for (int m = 0; m < 4; ++m) { __builtin_amdgcn_sched_barrier(0); bf16_t* rowp = O + (size_t)(row0 + ai * HALF + m * 16) * ldc + col0;
#pragma unroll
                for (int bj = 0; bj < 2; ++bj) { f32x4 v0 = acc[ai][bj][m][0], v1 = acc[ai][bj][m][1];
                    if (ACT == 1) {
#pragma unroll
                        for (int j = 0; j < 4; ++j) { float a = fmaxf(v0[j], 0.f), b = fmaxf(v1[j], 0.f); v0[j] = a * a; v1[j] = b * b; } }
                    u32x4 w; w.x = cvt_pk_bf16(v0[0], v0[1]); w.y = cvt_pk_bf16(v0[2], v0[3]); w.z = cvt_pk_bf16(v1[0], v1[1]); w.w = cvt_pk_bf16(v1[2], v1[3]);
                    *(u32x4*)(rowp + bj * HALF) = w; } }
    }
};
struct EpiProj {
    static constexpr bool PERM = true;
    bf16_t* O; float* outp; int li;
    __device__ __forceinline__ void operator()(const f32x4 (&acc)[2][2][4][2], const Unit& u, int wr, int wc, int fr, int fq) const {
        const int row0 = u.pm * BM + wr * 64 + fr, col0 = u.pn * BM + wc * 32 + 8 * fq;
#pragma unroll
        for (int ai = 0; ai < 2; ++ai)
#pragma unroll
            for (int m = 0; m < 4; ++m) { __builtin_amdgcn_sched_barrier(0); const int row = row0 + ai * HALF + m * 16; bf16_t* rowp = O + (size_t)row * NPROJ_PAD + col0;
#pragma unroll
                for (int bj = 0; bj < 2; ++bj) { const f32x4 v0 = acc[ai][bj][m][0], v1 = acc[ai][bj][m][1];
                    u32x4 w; w.x = cvt_pk_bf16(v0[0], v0[1]); w.y = cvt_pk_bf16(v0[2], v0[3]); w.z = cvt_pk_bf16(v1[0], v1[1]); w.w = cvt_pk_bf16(v1[2], v1[3]);
                    *(u32x4*)(rowp + bj * HALF) = w;
                    const int col = col0 + bj * HALF;
                    if (row < TP && col >= C_KB && col < NPROJ) {
                        const int b = row >> 8, t = row & 255;
                        float* dst = outp + ((col < C_VB) ? (O_CK - C_KB) : (O_CV - C_VB)) + ((size_t)((b * 2 + li) * 256 + t)) * 128 + col;
                        *(f32x4*)dst = v0; *(f32x4*)(dst + 4) = v1; } } }
    }
};
struct EpiSplitBf16 {
    static constexpr bool PERM = true;
    bf16_t* O; int ldc; int npn; size_t split_stride;
    __device__ __forceinline__ void operator()(const f32x4 (&acc)[2][2][4][2], const Unit& u, int wr, int wc, int fr, int fq) const {
        const int s = u.pn / npn, pn = u.pn - s * npn;
        bf16_t* base = O + (size_t)s * split_stride;
        const int row0 = u.pm * BM + wr * 64 + fr, col0 = pn * BM + wc * 32 + 8 * fq;
#pragma unroll
        for (int ai = 0; ai < 2; ++ai)
#pragma unroll
            for (int m = 0; m < 4; ++m) { __builtin_amdgcn_sched_barrier(0); bf16_t* rowp = base + (size_t)(row0 + ai * HALF + m * 16) * ldc + col0;
#pragma unroll
                for (int bj = 0; bj < 2; ++bj) { const f32x4 v0 = acc[ai][bj][m][0], v1 = acc[ai][bj][m][1];
                    u32x4 w; w.x = cvt_pk_bf16(v0[0], v0[1]); w.y = cvt_pk_bf16(v0[2], v0[3]); w.z = cvt_pk_bf16(v1[0], v1[1]); w.w = cvt_pk_bf16(v1[2], v1[3]);
                    *(u32x4*)(rowp + bj * HALF) = w; } }
    }
};
struct EpiF32 {
    static constexpr bool PERM = true;
    float* O; int ldc; int npn; size_t split_stride;
    __device__ __forceinline__ void operator()(const f32x4 (&acc)[2][2][4][2], const Unit& u, int wr, int wc, int fr, int fq) const {
        const int s = u.pn / npn, pn = u.pn - s * npn;
        float* base = O + (size_t)s * split_stride;
        const int row0 = u.pm * BM + wr * 64 + fr, col0 = pn * BM + wc * 32 + 8 * fq;
#pragma unroll
        for (int ai = 0; ai < 2; ++ai)
#pragma unroll
            for (int m = 0; m < 4; ++m) { __builtin_amdgcn_sched_barrier(0); float* rowp = base + (size_t)(row0 + ai * HALF + m * 16) * ldc + col0;
#pragma unroll
                for (int bj = 0; bj < 2; ++bj) { *(f32x4*)(rowp + bj * HALF) = acc[ai][bj][m][0]; *(f32x4*)(rowp + bj * HALF + 4) = acc[ai][bj][m][1]; } }
    }
};

template <class Epi, class Sched>
__device__ __forceinline__ void gemm_phase(LAS unsigned char* lds, const Gemm g, const Sched& S, const Epi& E, const int tid) {
    const int wid = __builtin_amdgcn_readfirstlane(tid >> 6), lane = tid & 63, wr = wid >> 2, wc = wid & 3, fr = lane & 15, fq = lane >> 4;
    const int K = g.K, nt = K / BK;
    unsigned voffA[2], voffB[2];
#pragma unroll
    for (int i = 0; i < 2; ++i) { int R, C; stage_rc(tid * 16 + i * 8192, R, C); const int Rb = Epi::PERM ? ((R & ~31) + perm32(R & 31)) : R;
        voffA[i] = (unsigned)(R * g.lda + C) * 2u; voffB[i] = (unsigned)(Rb * g.ldb + C) * 2u; }
    const size_t kstep = (size_t)(BK * 2);
    const size_t hstepA = (size_t)HALF * g.lda * 2, hstepB = (size_t)HALF * g.ldb * 2;
    const size_t tstepA = 2 * hstepA, tstepB = 2 * hstepB;
    const unsigned ldsw = (unsigned)wid * 1024u;
    const int aoff = lds_byte(wr * 64 + fr, fq * 8), boff = lds_byte(wc * 32 + fr, fq * 8);
#define PG8_SA(b, h) (((b) * 2 + (h)) * HTB)
#define PG8_SB(b, h) ((4 + (b) * 2 + (h)) * HTB)
#define PG8_STAGE(bufoff, gbase, voff) do { _Pragma("unroll") for (int _i = 0; _i < 2; ++_i) \
        __builtin_amdgcn_global_load_lds((const unsigned*)((const char*)(gbase) + (voff)[_i]), (LAS unsigned*)(lds + (bufoff) + ldsw + _i * 8192), 16, 0, 0); } while (0)
#define PG8_LDA(dst, b, h) do { _Pragma("unroll") for (int m = 0; m < 4; ++m) _Pragma("unroll") for (int k = 0; k < 2; ++k) dst[m][k] = *(const LAS bf16x8*)(lds + PG8_SA(b, h) + aoff + m * 2048 + k * 1024); } while (0)
#define PG8_LDB(dst, b, h) do { _Pragma("unroll") for (int n = 0; n < 2; ++n) _Pragma("unroll") for (int k = 0; k < 2; ++k) dst[n][k] = *(const LAS bf16x8*)(lds + PG8_SB(b, h) + boff + n * 2048 + k * 1024); } while (0)
#define PG8_MMA(ai, bj, At, Bt) do { __builtin_amdgcn_s_setprio(1); _Pragma("unroll") for (int m = 0; m < 4; ++m) _Pragma("unroll") for (int n = 0; n < 2; ++n) _Pragma("unroll") for (int k = 0; k < 2; ++k) \
        acc[ai][bj][m][n] = __builtin_amdgcn_mfma_f32_16x16x32_bf16(Bt[n][k], At[m][k], acc[ai][bj][m][n], 0, 0, 0); __builtin_amdgcn_s_setprio(0); } while (0)
#define PG8_WAIT_V(n) asm volatile("s_waitcnt vmcnt(" #n ")" ::: "memory")
#define PG8_WAIT_L(n) asm volatile("s_waitcnt lgkmcnt(" #n ")" ::: "memory")
#define PG8_BAR __builtin_amdgcn_s_barrier()
#define PG8_SCHED __builtin_amdgcn_sched_barrier(0)
#define PG8_UA(u) ((const char*)g.A + (size_t)(u).pm * tstepA + (size_t)((u).pn / g.npn) * (size_t)g.a_split * 2)
#define PG8_UB(u) ((const char*)g.Bt + (size_t)(u).pn * tstepB)
    Unit cur, nxt; int ui = 0;
    if (!S.next(0, cur)) return;
    f32x4 acc[2][2][4][2];
#pragma unroll
    for (int a = 0; a < 2; ++a)
#pragma unroll
        for (int b = 0; b < 2; ++b)
#pragma unroll
            for (int m = 0; m < 4; ++m)
#pragma unroll
                for (int n = 0; n < 2; ++n) acc[a][b][m][n] = (f32x4){0.f, 0.f, 0.f, 0.f};
    bf16x8 At[4][2], B0[2][2], B1[2][2];
    const char* cA = PG8_UA(cur); const char* cB = PG8_UB(cur);
    PG8_STAGE(PG8_SB(0, 0), cB, voffB); PG8_STAGE(PG8_SB(0, 1), cB + hstepB, voffB); PG8_STAGE(PG8_SA(0, 0), cA, voffA); PG8_STAGE(PG8_SA(0, 1), cA + hstepA, voffA);
    if (wr == 1) PG8_BAR;
    PG8_WAIT_V(2); PG8_BAR;
    PG8_STAGE(PG8_SB(1, 0), cB + kstep, voffB); PG8_STAGE(PG8_SA(1, 0), cA + kstep, voffA); PG8_STAGE(PG8_SB(1, 1), cB + hstepB + kstep, voffB);
    PG8_WAIT_V(6); PG8_BAR;
    for (;;) {
        const bool has_next = S.next(ui + 1, nxt);
        const char* nA = has_next ? PG8_UA(nxt) : cA; const char* nB = has_next ? PG8_UB(nxt) : cB;
        for (int t = 0; t < nt; t += 2) {
            const bool last = (t == nt - 2);
            const char* a1 = cA + (size_t)(t + 1) * kstep;
            const char* a2 = last ? nA : cA + (size_t)(t + 2) * kstep; const char* b2 = last ? nB : cB + (size_t)(t + 2) * kstep;
            const char* a3 = a2 + kstep; const char* b3 = b2 + kstep;
            PG8_LDB(B0, 0, 0); PG8_LDB(B1, 0, 1); PG8_SCHED; PG8_LDA(At, 0, 0); PG8_STAGE(PG8_SA(1, 1), a1 + hstepA, voffA);
            PG8_WAIT_V(8); PG8_WAIT_L(0); PG8_BAR; PG8_MMA(0, 0, At, B0); PG8_MMA(0, 1, At, B1); PG8_BAR; PG8_SCHED;
            PG8_LDA(At, 0, 1); PG8_STAGE(PG8_SB(0, 0), b2, voffB); PG8_STAGE(PG8_SB(0, 1), b2 + hstepB, voffB); PG8_STAGE(PG8_SA(0, 0), a2, voffA);
            PG8_WAIT_V(8); PG8_WAIT_L(0); PG8_BAR; PG8_MMA(1, 0, At, B0); PG8_MMA(1, 1, At, B1); PG8_BAR; PG8_SCHED;
            PG8_LDB(B0, 1, 0); PG8_LDB(B1, 1, 1); PG8_SCHED; PG8_LDA(At, 1, 0); PG8_STAGE(PG8_SA(0, 1), a2 + hstepA, voffA);
            PG8_WAIT_V(8); PG8_WAIT_L(0); PG8_BAR; PG8_MMA(0, 0, At, B0); PG8_MMA(0, 1, At, B1); PG8_BAR; PG8_SCHED;
            PG8_LDA(At, 1, 1); PG8_STAGE(PG8_SB(1, 0), b3, voffB); PG8_STAGE(PG8_SB(1, 1), b3 + hstepB, voffB); PG8_STAGE(PG8_SA(1, 0), a3, voffA);
            PG8_WAIT_V(8); PG8_WAIT_L(0); PG8_BAR; PG8_MMA(1, 0, At, B0); PG8_MMA(1, 1, At, B1); PG8_BAR; PG8_SCHED;
        }
        if (wr == 0) PG8_BAR;
        E(acc, cur, wr, wc, fr, fq);
        if (!has_next) break;
#pragma unroll
        for (int a = 0; a < 2; ++a)
#pragma unroll
            for (int b = 0; b < 2; ++b)
#pragma unroll
                for (int m = 0; m < 4; ++m)
#pragma unroll
                    for (int n = 0; n < 2; ++n) acc[a][b][m][n] = (f32x4){0.f, 0.f, 0.f, 0.f};
        cur = nxt; cA = nA; cB = nB; ++ui;
        if (wr == 1) PG8_BAR;
    }
    PG8_WAIT_V(0);
    PG8_BAR;
#undef PG8_SA
#undef PG8_SB
#undef PG8_STAGE
#undef PG8_LDA
#undef PG8_LDB
#undef PG8_MMA
#undef PG8_WAIT_V
#undef PG8_WAIT_L
#undef PG8_BAR
#undef PG8_SCHED
#undef PG8_UA
#undef PG8_UB
}
}

struct Args { const float* in[29]; float* out; unsigned char* ws; int ph_lo, ph_hi; };
struct Ctx { unsigned char* ws; float* out; int z, tid, bid, G; };

#define MFMA16(a, b, c) __builtin_amdgcn_mfma_f32_16x16x32_bf16((a), (b), (c), 0, 0, 0)

__device__ __forceinline__ void transpose_load(const float* W, int N, int item, int lane, float (&wv)[32]) {
    const int nblk = N / 32, kb = item / nblk, nb = item % nblk, k0 = 64 * kb, n0 = 32 * nb;
#pragma unroll
    for (int i = 0; i < 32; ++i) { const int kk = 2 * i + (lane >> 5); wv[i] = W[(size_t)(k0 + kk) * N + n0 + (lane & 31)]; }
}
__device__ __forceinline__ void transpose_finish(int N, bf16_t* WT, int npad, int ksub, LAS float* scr, int item, int lane, const float (&wv)[32]) {
    const int nblk = N / 32, kb = item / nblk, nb = item % nblk, k0 = 64 * kb, n0 = 32 * nb;
#pragma unroll
    for (int i = 0; i < 32; ++i) { const int kk = 2 * i + (lane >> 5); scr[kk * 33 + (lane & 31)] = wv[i]; }
    asm volatile("s_waitcnt lgkmcnt(0)" ::: "memory");
    const int c = lane & 7;
    const int ks = k0 / ksub, kin = k0 - ks * ksub;
    bf16_t* dbase = WT + (size_t)ks * npad * ksub + kin + 8 * c;
#pragma unroll
    for (int j = 0; j < 4; ++j) { const int n = (lane >> 3) + 8 * j; const LAS float* s = scr + (8 * c) * 33 + n;
        u32x4 o; o.x = pk2(s[0 * 33], s[1 * 33]); o.y = pk2(s[2 * 33], s[3 * 33]); o.z = pk2(s[4 * 33], s[5 * 33]); o.w = pk2(s[6 * 33], s[7 * 33]);
        *(u32x4*)(dbase + (size_t)(n0 + n) * ksub) = o; }
    asm volatile("s_waitcnt lgkmcnt(0)" ::: "memory");
}

struct MatDesc { const float* W; bf16_t* WT; int K, N, npad, ksub, items; };
__device__ __forceinline__ MatDesc get_mat(const Args& a, const Ctx& cx, int mi) {
    MatDesc m; unsigned char* ws = cx.ws;
    if (mi < 4)       { m.W = (a.in[13] + cx.z) + (size_t)mi * D * FF; m.WT = (bf16_t*)(ws + WS_WFF1) + (size_t)mi * FF * D; m.K = D; m.N = FF; m.npad = FF; m.ksub = D; }
    else if (mi < 8)  { const int l = mi - 4; m.W = (a.in[14] + cx.z) + (size_t)l * FF * D; m.WT = (bf16_t*)(ws + WS_WFF2) + (size_t)l * FF * D; m.K = FF; m.N = D; m.npad = D; m.ksub = FF / 2; }
    else if (mi < 10) { const int i = mi - 8; m.W = (a.in[15] + cx.z) + (size_t)i * D * NPROJ; m.WT = (bf16_t*)(ws + WS_WIN) + (size_t)i * NPROJ_PAD * D; m.K = D; m.N = NPROJ; m.npad = NPROJ_PAD; m.ksub = D; }
    else if (mi < 12) { const int i = mi - 10; m.W = (a.in[22] + cx.z) + (size_t)i * D * D; m.WT = (bf16_t*)(ws + WS_WOUT) + (size_t)i * D * D; m.K = D; m.N = D; m.npad = D; m.ksub = D / 2; }
    else if (mi < 14) { const int i = mi - 12; m.W = (a.in[23] + cx.z) + (size_t)i * D * NDOWN; m.WT = (bf16_t*)(ws + WS_WDOWN) + (size_t)i * NDOWN_PAD * D; m.K = D; m.N = NDOWN; m.npad = NDOWN_PAD; m.ksub = D / 2; }
    else if (mi < 16) { const int i = mi - 14; m.W = (a.in[26] + cx.z) + (size_t)i * 384 * 1536; m.WT = (bf16_t*)(ws + WS_WUQ) + (size_t)i * 1536 * 384; m.K = 384; m.N = 1536; m.npad = 1536; m.ksub = 384; }
    else if (mi < 18) { const int i = mi - 16; m.W = (a.in[27] + cx.z) + (size_t)i * 256 * 2048; m.WT = (bf16_t*)(ws + WS_WUKV) + (size_t)i * 2048 * 256; m.K = 256; m.N = 2048; m.npad = 2048; m.ksub = 256; }
    else              { const int i = mi - 18; m.W = (a.in[28] + cx.z) + (size_t)i * D * D; m.WT = (bf16_t*)(ws + WS_WO) + (size_t)i * D * D; m.K = D; m.N = D; m.npad = D; m.ksub = D / 2; }
    m.items = (m.K / 64) * (m.N / 32);
    return m;
}

__device__ __forceinline__ void prologue(const Args& a, const Ctx& cx, LAS unsigned char* lds, const int mode, const int cg0, const int cgstride, const int cgend) {
    const int tid = cx.tid, lane = tid & 63, wave = tid >> 6, G = cx.G, bid = cx.bid;
    unsigned char* ws = cx.ws;
    if (mode == 0) {
        LAS float* sc = (LAS float*)lds;
        LAS float* red = (LAS float*)(lds + 12288);
        for (int i = tid; i < 3 * D; i += NTHREADS) { const int g = i >> 10, k = i & 1023; const float v = (g == 0) ? (a.in[9] + cx.z)[k] : (a.in[8] + cx.z)[(g - 1) * D + k]; sc[i] = silu_f(v); }
        __syncthreads();
        float* MOD = (float*)(ws + WS_MOD);
        for (int it = bid; it < 4 * 48; it += G) {
            const int l = it / 48, jb = it % 48, jq = tid & 31, kg = tid >> 5, j = jb * 128 + jq * 4;
            const float* wp = (a.in[10] + cx.z) + ((size_t)l * D + kg * 64) * 6144 + j;
            f32x4 a0 = {0.f, 0.f, 0.f, 0.f}, a1 = a0, a2 = a0;
#pragma unroll 32
            for (int k = 0; k < 64; ++k) { const f32x4 w = *(const f32x4*)(wp + (size_t)k * 6144); const int kk = kg * 64 + k;
                a0 += w * sc[kk]; a1 += w * sc[D + kk]; a2 += w * sc[2 * D + kk]; }
#pragma unroll
            for (int e = 0; e < 4; ++e) { red[(kg * 3 + 0) * 128 + jq * 4 + e] = a0[e]; red[(kg * 3 + 1) * 128 + jq * 4 + e] = a1[e]; red[(kg * 3 + 2) * 128 + jq * 4 + e] = a2[e]; }
            __syncthreads();
            if (tid < 384) { const int g = tid >> 7, jj = tid & 127; float s = 0.f;
#pragma unroll
                for (int q = 0; q < 16; ++q) s += red[(q * 3 + g) * 128 + jj];
                MOD[((size_t)l * 3 + g) * 6144 + jb * 128 + jj] = s + (a.in[11] + cx.z)[(size_t)l * 6144 + jb * 128 + jj]; }
            __syncthreads();
        }
    }
    __syncthreads();
    {
        LAS float* scr = (LAS float*)(lds + wave * 16384);
        const int gw = bid * NWAVES + wave, NGW = G * NWAVES;
        const bool l0only = (mode == 0) && (G == 256);
        const int nq = (mode == 1) ? 19 : (l0only ? 1 : 20);
#define PRO_SEQ(q) ((mode == 1) ? (((q) == 0) ? 10 : ((q) == 1) ? 0 : ((q) == 2) ? 4 : ((q) == 3) ? 1 : ((q) == 4) ? 5 : ((q) == 5) ? 12 : ((q) == 6) ? 14 : ((q) == 7) ? 16 : ((q) == 8) ? 18 : ((q) == 9) ? 2 : ((q) == 10) ? 6 : ((q) == 11) ? 9 : ((q) == 12) ? 11 \
                                  : ((q) == 13) ? 3 : ((q) == 14) ? 7 : ((q) == 15) ? 13 : ((q) == 16) ? 15 : ((q) == 17) ? 17 : 19) \
                    : (l0only ? 8 : (q)))
#define PRO_ADV() do { while (qi < nq && g - base >= m.items) { base += m.items; ++qi; if (qi < nq) m = get_mat(a, cx, PRO_SEQ(qi)); } } while (0)
        int qi = 0, base = 0;
        MatDesc m = get_mat(a, cx, PRO_SEQ(0));
        int g = (mode == 1) ? cg0 : gw;
        const int gstride = (mode == 1) ? cgstride : NGW, gend = (mode == 1) ? cgend : 0x7fffffff;
        if (g >= gend) qi = nq;
        PRO_ADV();
        float wv[32];
        if (qi < nq) transpose_load(m.W, m.N, g - base, lane, wv);
        while (qi < nq) {
            const MatDesc mc = m; const int itc = g - base;
            g += gstride;
            if (g >= gend) qi = nq;
            PRO_ADV();
            float wn[32];
            if (qi < nq) transpose_load(m.W, m.N, g - base, lane, wn);
            transpose_finish(mc.N, mc.WT, mc.npad, mc.ksub, scr, itc, lane, wv);
#pragma unroll
            for (int i = 0; i < 32; ++i) wv[i] = wn[i];
        }
    }
    if (mode == 0) {
        const size_t gt = (size_t)bid * NTHREADS + tid, NGT = (size_t)G * NTHREADS;
        for (int i = 0; i < 2; ++i) {
            u32x4* z1 = (u32x4*)((bf16_t*)(ws + WS_WIN) + (size_t)i * NPROJ_PAD * D + (size_t)NPROJ * D);
            for (size_t x = gt; x < (size_t)(NPROJ_PAD - NPROJ) * D / 8; x += NGT) z1[x] = (u32x4){0u, 0u, 0u, 0u};
            for (int ks = 0; ks < 2; ++ks) {
                u32x4* z2 = (u32x4*)((bf16_t*)(ws + WS_WDOWN) + (size_t)i * NDOWN_PAD * D + (size_t)ks * NDOWN_PAD * (D / 2) + (size_t)NDOWN * (D / 2));
                for (size_t x = gt; x < (size_t)(NDOWN_PAD - NDOWN) * (D / 2) / 8; x += NGT) z2[x] = (u32x4){0u, 0u, 0u, 0u}; }
        }
        f32x2* tab64 = (f32x2*)(ws + WS_TAB); f32x2* tab32 = tab64 + 64 * 16;
        for (size_t x = gt; x < 64 * 16; x += NGT) { const int pos = (int)x >> 4, f = (int)x & 15; const float inv = powf(10000.f, -(float)f / 16.f); const float ang = (float)pos * inv; tab64[x] = (f32x2){cosf(ang), sinf(ang)}; }
        for (size_t x = gt; x < 64 * 8; x += NGT) { const int pos = (int)x >> 3, f = (int)x & 7; const float inv = powf(10000.f, -(float)f / 8.f); const float ang = (float)pos * inv; tab32[x] = (f32x2){cosf(ang), sinf(ang)}; }
        bf16_t* csk = (bf16_t*)(ws + WS_CSK); bf16_t* csv = (bf16_t*)(ws + WS_CSV);
        for (size_t x = gt; x < (size_t)2 * 2 * 512 * 128 / 4; x += NGT) {
            const size_t e = x * 4; const int b = (int)(e / (2 * 65536)), i = (int)(e / 65536) & 1; const size_t r = e % 65536;
            const size_t d = ((size_t)(i * 2 + b)) * 65536 + r;
            const f32x4 k = *(const f32x4*)((a.in[4] + cx.z) + e), v = *(const f32x4*)((a.in[5] + cx.z) + e);
            *(u32x2*)(csk + d) = (u32x2){pk2(k[0], k[1]), pk2(k[2], k[3])};
            *(u32x2*)(csv + d) = (u32x2){pk2(v[0], v[1]), pk2(v[2], v[3])};
        }
    }
}

__device__ __forceinline__ int mod_group(int r) { return r < TP ? 0 : 1 + ((r - TP) >> 10); }

__device__ __forceinline__ void pre_rows(const Args& a, const Ctx& cx, int l) {
    constexpr int RB = 3;
    const int lane = cx.tid & 63, gw = cx.bid * NWAVES + (cx.tid >> 6), NGW = cx.G * NWAVES;
    const float* MOD = (const float*)(cx.ws + WS_MOD) + (size_t)l * 3 * 6144;
    const float* gA = (a.in[12] + cx.z) + (size_t)l * 4 * D;
    bf16_t* H = (bf16_t*)(cx.ws + WS_H);
    for (int rb = gw * RB; rb < T; rb += NGW * RB) {
        f32x4 v[RB][4], vg[4]; float s[RB];
#pragma unroll
        for (int j = 0; j < 4; ++j) vg[j] = *(const f32x4*)(gA + lane * 4 + 256 * j);
#pragma unroll
        for (int q = 0; q < RB; ++q) { const int r = (rb + q < T) ? rb + q : T - 1;
            const float* xr = (r < TP) ? (a.in[0] + cx.z) + (size_t)r * D : (a.in[1] + cx.z) + (size_t)(r - TP) * D;
            float t = 0.f;
#pragma unroll
            for (int j = 0; j < 4; ++j) { v[q][j] = *(const f32x4*)(xr + lane * 4 + 256 * j); t += v[q][j][0] * v[q][j][0] + v[q][j][1] * v[q][j][1] + v[q][j][2] * v[q][j][2] + v[q][j][3] * v[q][j][3]; }
            s[q] = t; }
#pragma unroll
        for (int off = 1; off < 64; off <<= 1) {
#pragma unroll
            for (int q = 0; q < RB; ++q) s[q] += __shfl_xor(s[q], off); }
#pragma unroll
        for (int q = 0; q < RB; ++q) { const int r = rb + q; if (r >= T) continue;
            const float rstd = rsqrtf(s[q] * (1.f / D) + EPS);
            const float* m = MOD + (size_t)mod_group(r) * 6144;
#pragma unroll
            for (int j = 0; j < 4; ++j) { const int c = lane * 4 + 256 * j;
                const f32x4 sh = *(const f32x4*)(m + c), scl = *(const f32x4*)(m + D + c);
                const f32x4 h = v[q][j] * rstd * vg[j] * (scl + 1.f) + sh;
                *(u32x2*)(H + (size_t)r * D + c) = (u32x2){pk2(h[0], h[1]), pk2(h[2], h[3])}; } }
    }
}

__device__ __forceinline__ void post_rows(const Args& a, const Ctx& cx, bool x_from_input, const float* gate_base  , const float* gB,
                                          bool has_next, const float* gC, const float* shift_base, const float* scale_base, bool dry) {
    constexpr int RB = 3;
    const int lane = cx.tid & 63, gw = cx.bid * NWAVES + (cx.tid >> 6), NGW = cx.G * NWAVES;
    const bf16_t* OUT = (const bf16_t*)(cx.ws + WS_OUT);
    bf16_t* H = dry ? (bf16_t*)(cx.ws + WS_U + 24 * MiB) : (bf16_t*)(cx.ws + WS_H);
    float* xout = dry ? (float*)(cx.ws + WS_U) : cx.out;
    for (int rb = gw * RB; rb < T; rb += NGW * RB) {
        f32x4 o[RB][4], x[RB][4]; float s[RB], s2[RB]; size_t mg[RB];
        const size_t mg0 = (size_t)mod_group(rb < T ? rb : T - 1) * 6144;
        f32x4 vgB[4], vgt[4];
#pragma unroll
        for (int j = 0; j < 4; ++j) { const int c = lane * 4 + 256 * j; vgB[j] = *(const f32x4*)(gB + c); vgt[j] = *(const f32x4*)(gate_base + mg0 + c); }
#pragma unroll
        for (int q = 0; q < RB; ++q) { const int r = (rb + q < T) ? rb + q : T - 1;
            const float* xr = x_from_input ? ((r < TP) ? (a.in[0] + cx.z) + (size_t)r * D : (a.in[1] + cx.z) + (size_t)(r - TP) * D) : cx.out + (size_t)r * D;
            mg[q] = (size_t)mod_group(r) * 6144;
#pragma unroll
            for (int j = 0; j < 4; ++j) { const int c = lane * 4 + 256 * j;
                { const u32x2 p0 = *(const u32x2*)(OUT + (size_t)r * D + c), p1 = *(const u32x2*)(OUT + OUT_SPLIT + (size_t)r * D + c);
                  o[q][j] = (f32x4){bflo(p0.x) + bflo(p1.x), bfhi(p0.x) + bfhi(p1.x), bflo(p0.y) + bflo(p1.y), bfhi(p0.y) + bfhi(p1.y)}; }
                x[q][j] = *(const f32x4*)(xr + c); } }
#pragma unroll
        for (int q = 0; q < RB; ++q) { float t = 0.f;
#pragma unroll
            for (int j = 0; j < 4; ++j) t += o[q][j][0] * o[q][j][0] + o[q][j][1] * o[q][j][1] + o[q][j][2] * o[q][j][2] + o[q][j][3] * o[q][j][3];
            s[q] = t; }
#pragma unroll
        for (int off = 1; off < 64; off <<= 1) {
#pragma unroll
            for (int q = 0; q < RB; ++q) s[q] += __shfl_xor(s[q], off); }
#pragma unroll
        for (int q = 0; q < RB; ++q) { const int r = rb + q; const float rstd = rsqrtf(s[q] * (1.f / D) + EPS); float t = 0.f;
            const bool same = (mg[q] == mg0);
#pragma unroll
            for (int j = 0; j < 4; ++j) { const int c = lane * 4 + 256 * j;
                const f32x4 gt = same ? vgt[j] : *(const f32x4*)(gate_base + mg[q] + c);
                x[q][j] = x[q][j] + gt * (o[q][j] * rstd * vgB[j]);
                if (r < T) *(f32x4*)(xout + (size_t)r * D + c) = x[q][j];
                t += x[q][j][0] * x[q][j][0] + x[q][j][1] * x[q][j][1] + x[q][j][2] * x[q][j][2] + x[q][j][3] * x[q][j][3]; }
            s2[q] = t; }
        if (has_next) {
            f32x4 vgC[4], vsh[4], vsc[4];
#pragma unroll
            for (int j = 0; j < 4; ++j) { const int c = lane * 4 + 256 * j; vgC[j] = *(const f32x4*)(gC + c); vsh[j] = *(const f32x4*)(shift_base + mg0 + c); vsc[j] = *(const f32x4*)(scale_base + mg0 + c); }
#pragma unroll
            for (int off = 1; off < 64; off <<= 1) {
#pragma unroll
                for (int q = 0; q < RB; ++q) s2[q] += __shfl_xor(s2[q], off); }
#pragma unroll
            for (int q = 0; q < RB; ++q) { const int r = rb + q; const float rstd2 = rsqrtf(s2[q] * (1.f / D) + EPS);
                const bool same = (mg[q] == mg0);
#pragma unroll
                for (int j = 0; j < 4; ++j) { const int c = lane * 4 + 256 * j;
                    const f32x4 sh = same ? vsh[j] : *(const f32x4*)(shift_base + mg[q] + c), scl = same ? vsc[j] : *(const f32x4*)(scale_base + mg[q] + c);
                    const f32x4 h = x[q][j] * rstd2 * vgC[j] * (scl + 1.f) + sh;
                    if (r < T) *(u32x2*)(H + (size_t)r * D + c) = (u32x2){pk2(h[0], h[1]), pk2(h[2], h[3])}; } }
        }
    }
}

__device__ __forceinline__ void mla_mid(const Args& a, const Ctx& cx, int i) {
    constexpr int RB = 3;
    const int lane = cx.tid & 63, gw = cx.bid * NWAVES + (cx.tid >> 6), NGW = cx.G * NWAVES;
    const float* DOWN = (const float*)(cx.ws + WS_OUT);
    bf16_t* CQ = (bf16_t*)(cx.ws + WS_CQ); bf16_t* CKV = (bf16_t*)(cx.ws + WS_CKV); bf16_t* KR = (bf16_t*)(cx.ws + WS_KR);
    const float* gq = (a.in[24] + cx.z) + (size_t)i * 384; const float* gkv = (a.in[25] + cx.z) + (size_t)i * 256;
    const f32x2* tab32 = (const f32x2*)(cx.ws + WS_TAB) + 64 * 16;
    for (int r = T + gw; r < T + 1024; r += NGW) {
        const int rr = r - T, b = rr >> 9, j = rr & 511;
        const float* src = (a.in[6] + cx.z) + ((size_t)((b * 2 + i) * 512 + j)) * 256;
        float v[4];
#pragma unroll
        for (int q = 0; q < 4; ++q) v[q] = src[lane + 64 * q];
        const float kr = (lane < 32) ? (a.in[7] + cx.z)[((size_t)((b * 2 + i) * 512 + j)) * 32 + lane] : 0.f;
#pragma unroll
        for (int q = 0; q < 4; ++q) CKV[(size_t)r * 256 + lane + 64 * q] = (bf16_t)f2bf(v[q]);
        if (lane < 32) KR[(size_t)r * 32 + lane] = (bf16_t)f2bf(kr);
    }
    for (int rb = gw * RB; rb < T; rb += NGW * RB) {
        float q[RB][6], kv[RB][4], kr[RB], ot[RB], sq[RB], sk[RB], vq[6], vk[4];
#pragma unroll
        for (int j = 0; j < 6; ++j) vq[j] = gq[lane + 64 * j];
#pragma unroll
        for (int j = 0; j < 4; ++j) vk[j] = gkv[lane + 64 * j];
#pragma unroll
        for (int u = 0; u < RB; ++u) { const int r = (rb + u < T) ? rb + u : T - 1; const float* dr = DOWN + (size_t)r * NDOWN_PAD;
#pragma unroll
            for (int j = 0; j < 6; ++j) q[u][j] = dr[lane + 64 * j] + dr[DOWN_SPLIT + lane + 64 * j];
#pragma unroll
            for (int j = 0; j < 4; ++j) kv[u][j] = dr[384 + lane + 64 * j] + dr[DOWN_SPLIT + 384 + lane + 64 * j];
            kr[u] = dr[640 + (lane & 31)] + dr[DOWN_SPLIT + 640 + (lane & 31)];
            ot[u] = dr[640 + ((lane & 31) ^ 8)] + dr[DOWN_SPLIT + 640 + ((lane & 31) ^ 8)]; }
#pragma unroll
        for (int u = 0; u < RB; ++u) { float s = 0.f, t = 0.f;
#pragma unroll
            for (int j = 0; j < 6; ++j) s += q[u][j] * q[u][j];
#pragma unroll
            for (int j = 0; j < 4; ++j) t += kv[u][j] * kv[u][j];
            sq[u] = s; sk[u] = t; }
#pragma unroll
        for (int off = 1; off < 64; off <<= 1) {
#pragma unroll
            for (int u = 0; u < RB; ++u) { sq[u] += __shfl_xor(sq[u], off); sk[u] += __shfl_xor(sk[u], off); } }
#pragma unroll
        for (int u = 0; u < RB; ++u) { const int r = rb + u; if (r >= T) continue;
            const float rq = rsqrtf(sq[u] * (1.f / 384.f) + EPS), rk = rsqrtf(sk[u] * (1.f / 256.f) + EPS);
#pragma unroll
            for (int j = 0; j < 6; ++j) CQ[(size_t)r * 384 + lane + 64 * j] = (bf16_t)f2bf(q[u][j] * rq * vq[j]);
#pragma unroll
            for (int j = 0; j < 4; ++j) { const float v = kv[u][j] * rk * vk[j]; CKV[(size_t)r * 256 + lane + 64 * j] = (bf16_t)f2bf(v);
                if (r < TP) { const int b = r >> 8, t = r & 255; cx.out[O_CKV + ((size_t)((b * 2 + i) * 256 + t)) * 256 + lane + 64 * j] = v; } }
            if (lane < 32) {
                if (r < TP) { const int b = r >> 8, t = r & 255; cx.out[O_CKR + ((size_t)((b * 2 + i) * 256 + t)) * 32 + lane] = kr[u]; KR[(size_t)r * 32 + lane] = (bf16_t)f2bf(kr[u]); }
                else {
                    const int t = (r - TP) & 1023, half = lane >> 4, p = (lane >> 3) & 1, f = lane & 7, pos = half ? (t & 63) : (t >> 6);
                    const f32x2 cs = tab32[pos * 8 + f];
                    const float v = p ? (ot[u] * cs[1] + kr[u] * cs[0]) : (kr[u] * cs[0] - ot[u] * cs[1]);
                    KR[(size_t)r * 32 + lane] = (bf16_t)f2bf(v);
                }
            }
        }
    }
}

struct KSeg { const bf16_t* K; int kstride; const bf16_t* K2; const bf16_t* V; int vstride; int k_lo, k_hi; int flags  ; };
struct AttnArgs { const bf16_t* Q; int qstride; int qpos0; int qrope  ; int nseg; KSeg seg0, seg1;
                  float m0, l0, scale; bf16_t* O; int ostride; const f32x2* tab64; };

__device__ __forceinline__ u32x4 rope8l(const u32x4 own, const u32x4 partner, int p, const LAS f32x2* tab) {
    float a[8], b[8], o[8]; unpack8(own, a); unpack8(partner, b);
#pragma unroll
    for (int e = 0; e < 8; ++e) { const f32x2 cs = tab[e]; o[e] = p ? (b[e] * cs[1] + a[e] * cs[0]) : (a[e] * cs[0] - b[e] * cs[1]); }
    return pack8(o);
}
__device__ __forceinline__ u32x4 rope8(const u32x4 own, const u32x4 partner, int p, const f32x2* tab) {
    float a[8], b[8], o[8]; unpack8(own, a); unpack8(partner, b);
#pragma unroll
    for (int e = 0; e < 8; ++e) { const f32x2 cs = tab[e]; o[e] = p ? (b[e] * cs[1] + a[e] * cs[0]) : (a[e] * cs[0] - b[e] * cs[1]); }
    return pack8(o);
}

template <int DQK, int QG>
__device__ __forceinline__ void attn_unit(LAS unsigned char* lds, const AttnArgs& A, const int tid) {
    constexpr int KT = 64;
    constexpr int QS = DQK + 8, VS = KT + 8, NCH = DQK / 8, NKS = DQK / 32, KCH = KT * NCH, KPT = (KCH + NTHREADS - 1) / NTHREADS, VPT = KT / 64, NT = KT / 16, NQ = 128 * QG;
    LAS bf16_t* Qs = (LAS bf16_t*)lds;
    LAS bf16_t* Ks = Qs + NQ * QS;
    LAS bf16_t* VT = Ks + 2 * KT * QS;
    LAS f32x2* TB = (LAS f32x2*)(VT + 2 * 64 * VS);
    const int lane = tid & 63, w = tid >> 6, fr = lane & 15, fq = lane >> 4;
    const int n0 = (A.seg0.k_hi - A.seg0.k_lo) / KT, n1 = (A.nseg > 1) ? ((A.seg1.k_hi - A.seg1.k_lo) / KT) : 0, ntiles = n0 + n1;
    int kkey[KPT], kch[KPT];
#pragma unroll
    for (int i = 0; i < KPT; ++i) { const int c = tid + i * NTHREADS; kkey[i] = c / NCH; kch[i] = c % NCH; }
    const int vkey = tid & 63, vch = tid >> 6;
    u32x4 kr[KPT], kp[KPT], vr[VPT]; int pf_kt = 0, pf_rope = 0, pf_mask = 0;
#define ATT_PREFETCH(j) do { const bool s0_ = (j) < n0; const KSeg S = s0_ ? A.seg0 : A.seg1; const int kt = s0_ ? (A.seg0.k_lo + KT * (j)) : (A.seg1.k_lo + KT * ((j) - n0)); \
        _Pragma("unroll") for (int i = 0; i < KPT; ++i) if (tid + i * NTHREADS < KCH) { const int d0 = kch[i] * 8; \
            if (DQK == 96 && kch[i] >= 8) kr[i] = *(const u32x4*)(S.K2 + (size_t)(kt + kkey[i]) * 32 + (d0 - 64)); \
            else { const bf16_t* src = S.K + (size_t)(kt + kkey[i]) * S.kstride; kr[i] = *(const u32x4*)(src + d0); if (DQK == 64 && (S.flags & 1)) kp[i] = *(const u32x4*)(src + (d0 ^ 16)); } } \
        _Pragma("unroll") for (int i = 0; i < VPT; ++i) vr[i] = *(const u32x4*)(S.V + (size_t)(kt + vkey + 64 * i) * S.vstride + vch * 8); \
        pf_kt = kt; pf_rope = S.flags & 1; pf_mask = S.flags & 2; } while (0)
#define ATT_WRITE(buf) do { LAS bf16_t* Kb = Ks + (buf) * KT * QS; LAS bf16_t* Vb = VT + (buf) * 64 * VS; \
        _Pragma("unroll") for (int i = 0; i < KPT; ++i) if (tid + i * NTHREADS < KCH) { u32x4 v = kr[i]; \
            if (DQK == 64 && pf_rope) { const int t = pf_kt + kkey[i], ch = kch[i], half = ch >> 2, p = (ch >> 1) & 1, f0 = (ch & 1) * 8, pos = half ? (t & 63) : (t >> 6); v = rope8l(v, kp[i], p, TB + pos * 16 + f0); } \
            *(LAS u32x4*)(Kb + kkey[i] * QS + kch[i] * 8) = v; } \
        _Pragma("unroll") for (int i = 0; i < VPT; ++i) { LAS bf16_t* dst = Vb + (vch * 8) * VS + vkey + 64 * i; const u32x4 v = vr[i]; \
          dst[0 * VS] = (bf16_t)(v.x & 0xffff); dst[1 * VS] = (bf16_t)(v.x >> 16); dst[2 * VS] = (bf16_t)(v.y & 0xffff); dst[3 * VS] = (bf16_t)(v.y >> 16); \
          dst[4 * VS] = (bf16_t)(v.z & 0xffff); dst[5 * VS] = (bf16_t)(v.z >> 16); dst[6 * VS] = (bf16_t)(v.w & 0xffff); dst[7 * VS] = (bf16_t)(v.w >> 16); } } while (0)
    ATT_PREFETCH(0);
    if (A.qrope) { for (int x = tid; x < 64 * 24; x += NTHREADS) TB[x] = A.tab64[x]; }
    __syncthreads();
    if constexpr (QG > 1) {
        for (int c = tid; c < NQ * NCH; c += NTHREADS) { const int qi = c / NCH, ch = c % NCH; *(LAS u32x4*)(Qs + qi * QS + ch * 8) = *(const u32x4*)(A.Q + (size_t)qi * A.qstride + ch * 8); }
    } else {
        constexpr int NQC = NQ * NCH / NTHREADS;
        u32x4 qv[NQC], qw[NQC];
#pragma unroll
        for (int i = 0; i < NQC; ++i) { const int c = tid + i * NTHREADS, qi = c / NCH, ch = c % NCH, d0 = ch * 8;
            const bf16_t* src = A.Q + (size_t)qi * A.qstride;
            qv[i] = *(const u32x4*)(src + d0);
            if (QG == 1 && A.qrope == 1) qw[i] = *(const u32x4*)(src + (d0 ^ 16));
            else if (QG == 1 && A.qrope == 2 && ch >= 8) qw[i] = *(const u32x4*)(src + 64 + (((ch - 8) ^ 1) * 8)); }
#pragma unroll
        for (int i = 0; i < NQC; ++i) { const int c = tid + i * NTHREADS, qi = c / NCH, ch = c % NCH, d0 = ch * 8, t = A.qpos0 + qi;
            u32x4 v = qv[i];
            if (QG == 1 && A.qrope == 1) { const int half = ch >> 2, p = (ch >> 1) & 1, f0 = (ch & 1) * 8, pos = half ? (t & 63) : (t >> 6); v = rope8l(v, qw[i], p, TB + pos * 16 + f0); }
            else if (QG == 1 && A.qrope == 2 && ch >= 8) { const int c2 = ch - 8, half = c2 >> 1, p = c2 & 1, pos = half ? (t & 63) : (t >> 6); v = rope8l(v, qw[i], p, TB + 64 * 16 + pos * 8); }
            *(LAS u32x4*)(Qs + qi * QS + d0) = v; }
    }
    ATT_WRITE(0);
    int cur_kt = pf_kt, cur_mask = pf_mask;
    if (ntiles > 1) ATT_PREFETCH(1);
    __syncthreads();
    bf16x8 Qf[QG][NKS];
#pragma unroll
    for (int g = 0; g < QG; ++g)
#pragma unroll
        for (int ks = 0; ks < NKS; ++ks) Qf[g][ks] = *(const LAS bf16x8*)(Qs + (g * 128 + w * 16 + fr) * QS + ks * 32 + fq * 8);
    const float scl2 = A.scale * 1.4426950408889634f;
    float m[QG], l[QG];
    f32x4 Oa[QG][4];
#pragma unroll
    for (int g = 0; g < QG; ++g) { m[g] = (A.m0 > -1e29f) ? A.m0 * 1.4426950408889634f : A.m0; l[g] = (fq == 0) ? A.l0 : 0.f;
#pragma unroll
        for (int dt = 0; dt < 4; ++dt) Oa[g][dt] = (f32x4){0.f, 0.f, 0.f, 0.f}; }
    for (int j = 0; j < ntiles; ++j) {
        const LAS bf16_t* Kb = Ks + (j & 1) * KT * QS; const LAS bf16_t* Vb = VT + (j & 1) * 64 * VS;
        f32x4 st[QG][NT];
#pragma unroll
        for (int nt = 0; nt < NT; ++nt) {
#pragma unroll
            for (int g = 0; g < QG; ++g) st[g][nt] = (f32x4){0.f, 0.f, 0.f, 0.f};
#pragma unroll
            for (int ks = 0; ks < NKS; ++ks) { const bf16x8 kf = *(const LAS bf16x8*)(Kb + (nt * 16 + fr) * QS + ks * 32 + fq * 8);
#pragma unroll
                for (int g = 0; g < QG; ++g) st[g][nt] = MFMA16(kf, Qf[g][ks], st[g][nt]); } }
        if (QG > 1) __builtin_amdgcn_sched_barrier(0);
        bf16x8 pf[QG][KT / 32];
#pragma unroll
        for (int g = 0; g < QG; ++g) {
            const int qp = A.qpos0 + g * 128 + w * 16 + fr;
            float mx = -1e30f;
#pragma unroll
            for (int nt = 0; nt < NT; ++nt)
#pragma unroll
                for (int jj = 0; jj < 4; ++jj) { float sc = st[g][nt][jj] * scl2;
                    if (cur_mask) { const int kpos = cur_kt + nt * 16 + fq * 4 + jj; const int dd = qp - kpos; if (dd > 128 || dd < -128) sc = -1e30f; }
                    st[g][nt][jj] = sc; mx = fmaxf(mx, sc); }
            mx = xor16_max(mx); mx = xor32_max(mx);
            const float mn = fmaxf(m[g], mx), alpha = __builtin_amdgcn_exp2f(m[g] - mn);
            float rs = 0.f;
#pragma unroll
            for (int nt = 0; nt < NT; ++nt)
#pragma unroll
                for (int jj = 0; jj < 4; ++jj) { const float pe = __builtin_amdgcn_exp2f(st[g][nt][jj] - mn); st[g][nt][jj] = pe; rs += pe; }
            l[g] = l[g] * alpha + rs; m[g] = mn;
#pragma unroll
            for (int dt = 0; dt < 4; ++dt) Oa[g][dt] = Oa[g][dt] * alpha;
#pragma unroll
            for (int kk = 0; kk < KT / 32; ++kk) {
                u32x4 pb; pb.x = cvtpk(st[g][2 * kk][0], st[g][2 * kk][1]); pb.y = cvtpk(st[g][2 * kk][2], st[g][2 * kk][3]); pb.z = cvtpk(st[g][2 * kk + 1][0], st[g][2 * kk + 1][1]); pb.w = cvtpk(st[g][2 * kk + 1][2], st[g][2 * kk + 1][3]);
                pf[g][kk] = __builtin_bit_cast(bf16x8, pb); }
        }
        if (QG > 1) __builtin_amdgcn_sched_barrier(0);
#pragma unroll
        for (int kk = 0; kk < KT / 32; ++kk)
#pragma unroll
            for (int dt = 0; dt < 4; ++dt) {
                const LAS bf16_t* vp = Vb + (dt * 16 + fr) * VS + 32 * kk + fq * 4;
                const u32x2 v0 = *(const LAS u32x2*)vp, v1 = *(const LAS u32x2*)(vp + 16);
                const u32x4 vv = {v0.x, v0.y, v1.x, v1.y};
#pragma unroll
                for (int g = 0; g < QG; ++g) Oa[g][dt] = MFMA16(__builtin_bit_cast(bf16x8, vv), pf[g][kk], Oa[g][dt]);
            }
        if (j + 1 < ntiles) { ATT_WRITE((j + 1) & 1); cur_kt = pf_kt; cur_mask = pf_mask; if (j + 2 < ntiles) ATT_PREFETCH(j + 2); }
        __syncthreads();
    }
#undef ATT_PREFETCH
#undef ATT_WRITE
#pragma unroll
    for (int g = 0; g < QG; ++g) {
        float lg = xor16_add(l[g]); lg = xor32_add(lg);
        const float inv = 1.f / lg;
        bf16_t* op = A.O + (size_t)(g * 128 + w * 16 + fr) * A.ostride + fq * 4;
#pragma unroll
        for (int dt = 0; dt < 4; ++dt) *(u32x2*)(op + dt * 16) = (u32x2){pk2(Oa[g][dt][0] * inv, Oa[g][dt][1] * inv), pk2(Oa[g][dt][2] * inv, Oa[g][dt][3] * inv)};
    }
}

__device__ __forceinline__ void swa_unit(const Args& a, const Ctx& cx, LAS unsigned char* lds, int i, int u) {
    const bf16_t* PROJ = (const bf16_t*)(cx.ws + WS_PROJ); bf16_t* MIX = (bf16_t*)(cx.ws + WS_MIX);
    AttnArgs A;
    A.tab64 = (const f32x2*)(cx.ws + WS_TAB);
    A.qstride = NPROJ_PAD; A.ostride = D; A.scale = 0.125f; A.l0 = 1.f;
    int npass, rowq, hq;
    if (u < 128) {
        const int b = u >> 6, qt = u & 7, row0 = TP + b * 1024, q0 = qt * 128; hq = (u >> 3) & 7; const int kv = hq >> 2;
        A.qpos0 = q0; A.qrope = 1; A.nseg = 2; npass = 1; rowq = row0 + q0;
        const bf16_t* csk = (const bf16_t*)(cx.ws + WS_CSK) + ((size_t)(i * 2 + b)) * 65536 + kv * 64;
        const bf16_t* csv = (const bf16_t*)(cx.ws + WS_CSV) + ((size_t)(i * 2 + b)) * 65536 + kv * 64;
        A.seg0 = KSeg{csk, 128, nullptr, csv, 128, 0, 512, 0};
        const int lo = q0 - 128 < 0 ? 0 : q0 - 128, hi = q0 + 256 > 1024 ? 1024 : q0 + 256;
        A.seg1 = KSeg{PROJ + (size_t)row0 * NPROJ_PAD + C_KB + kv * 64, NPROJ_PAD, nullptr, PROJ + (size_t)row0 * NPROJ_PAD + C_VB + kv * 64, NPROJ_PAD, lo, hi, 3};
    } else {
        const int v = u - 128, b = v >> 3, row0 = b * 256; hq = v & 7; const int kv = hq >> 2;
        A.qpos0 = 0; A.qrope = 0; A.nseg = 1; npass = 2; rowq = row0;
        A.seg0 = KSeg{PROJ + (size_t)row0 * NPROJ_PAD + C_KB + kv * 64, NPROJ_PAD, nullptr, PROJ + (size_t)row0 * NPROJ_PAD + C_VB + kv * 64, NPROJ_PAD, 0, 256, 0};
        A.seg1 = A.seg0;
    }
    A.m0 = (a.in[21] + cx.z)[i * 8 + hq];
    for (int ps = 0; ps < npass; ++ps) {
        A.Q = PROJ + (size_t)(rowq + ps * 128) * NPROJ_PAD + C_QB + hq * 64;
        A.O = MIX + (size_t)(rowq + ps * 128) * D + 512 + hq * 64;
        if (ps) A.qpos0 += 128;
        attn_unit<64, 1>(lds, A, cx.tid);
    }
}

__device__ __forceinline__ void mla_unit(const Args& a, const Ctx& cx, LAS unsigned char* lds, int u) {
    const bf16_t* Q = (const bf16_t*)(cx.ws + WS_Q); const bf16_t* KVX = (const bf16_t*)(cx.ws + WS_KVX); const bf16_t* KR = (const bf16_t*)(cx.ws + WS_KR);
    bf16_t* MIX = (bf16_t*)(cx.ws + WS_MIX);
    AttnArgs A;
    A.tab64 = (const f32x2*)(cx.ws + WS_TAB);
    A.qstride = 1536; A.ostride = D; A.scale = 0.10206207261596577f; A.l0 = 0.f; A.m0 = -1e30f;
    if (u < 256) {
        const int b = u >> 7, h = (u >> 3) & 15, qt = u & 7, row0 = TP + b * 1024, q0 = qt * 128, crow0 = T + b * 512;
        A.Q = Q + (size_t)(row0 + q0) * 1536 + h * 96; A.qpos0 = q0; A.qrope = 2; A.nseg = 2;
        A.seg0 = KSeg{KVX + (size_t)crow0 * 2048 + h * 128, 2048, KR + (size_t)crow0 * 32, KVX + (size_t)crow0 * 2048 + h * 128 + 64, 2048, 0, 512, 0};
        A.seg1 = KSeg{KVX + (size_t)row0 * 2048 + h * 128, 2048, KR + (size_t)row0 * 32, KVX + (size_t)row0 * 2048 + h * 128 + 64, 2048, 0, 1024, 0};
        A.O = MIX + (size_t)(row0 + q0) * D + h * 64;
        attn_unit<96, 1>(lds, A, cx.tid);
    } else {
        const int v = u - 256, b = v >> 4, h = v & 15, row0 = b * 256;
        A.Q = Q + (size_t)row0 * 1536 + h * 96; A.qpos0 = 0; A.qrope = 0; A.nseg = 1;
        A.seg0 = KSeg{KVX + (size_t)row0 * 2048 + h * 128, 2048, KR + (size_t)row0 * 32, KVX + (size_t)row0 * 2048 + h * 128 + 64, 2048, 0, 256, 0};
        A.seg1 = A.seg0;
        A.O = MIX + (size_t)row0 * D + h * 64;
        attn_unit<96, 2>(lds, A, cx.tid);
    }
}

constexpr int GL_G = 0;
constexpr int GL_STF = 32768, GL_STB = 51200;
constexpr int GL_LO = 32768, GL_WF = 40960, GL_WB = 45056, GL_BF = 49152, GL_BB = 49408;
constexpr int GL_QF = 69632, GL_KF = 78848, GL_QB = 88064, GL_KB = 97280;
constexpr int GL_VT = 106496;
constexpr int GL_AF = 124928, GL_AB = 134144;

__device__ __forceinline__ void gla_gates(const Args& a, const Ctx& cx, LAS unsigned char* lds, int i, int tok0, int h) {
    const int tid = cx.tid;
    const bf16_t* PROJ = (const bf16_t*)(cx.ws + WS_PROJ);
    LAS float* LO = (LAS float*)(lds + GL_LO); LAS float* WF = (LAS float*)(lds + GL_WF); LAS float* WB = (LAS float*)(lds + GL_WB);
    LAS float* BF = (LAS float*)(lds + GL_BF); LAS float* BB = (LAS float*)(lds + GL_BB);
    LAS float* Gf = (LAS float*)(lds + GL_G); LAS float* Gb = Gf + 4096;
    { const int t = tid >> 3, j0 = (tid & 7) * 4; const u32x2 v = *(const u32x2*)(PROJ + (size_t)(tok0 + t) * NPROJ_PAD + C_LO + j0);
      LO[t * 32 + j0] = bflo(v.x); LO[t * 32 + j0 + 1] = bfhi(v.x); LO[t * 32 + j0 + 2] = bflo(v.y); LO[t * 32 + j0 + 3] = bfhi(v.y); }
    for (int x = tid; x < 1024; x += NTHREADS) { const int r = x >> 6, d = x & 63;
        WF[x] = (a.in[16] + cx.z)[((size_t)i * 16 + r) * 256 + h * 64 + d]; WB[x] = (a.in[18] + cx.z)[((size_t)i * 16 + r) * 256 + h * 64 + d]; }
    if (tid < 64) { BF[tid] = (a.in[17] + cx.z)[i * 256 + h * 64 + tid]; BB[tid] = (a.in[19] + cx.z)[i * 256 + h * 64 + tid]; }
    __syncthreads();
    { const int d = tid & 63, tg = tid >> 6;
      LAS float* SEG = (LAS float*)(lds + GL_LO + 8192 + 8192 + 1024);
      float wf[16], wb[16];
#pragma unroll
      for (int r = 0; r < 16; ++r) { wf[r] = WF[r * 64 + d]; wb[r] = WB[r * 64 + d]; }
      const float bfv = BF[d], bbv = BB[d];
      float gf[8], gb[8];
#pragma unroll
      for (int tt = 0; tt < 8; ++tt) { const int t = tg * 8 + tt; float xf = bfv, xb = bbv;
#pragma unroll
          for (int r = 0; r < 16; ++r) { xf += LO[t * 32 + r] * wf[r]; xb += LO[t * 32 + 16 + r] * wb[r]; }
          gf[tt] = (fminf(xf, 0.f) - log1pf(__expf(-fabsf(xf)))) * (1.f / 16.f); gb[tt] = (fminf(xb, 0.f) - log1pf(__expf(-fabsf(xb)))) * (1.f / 16.f); }
#pragma unroll
      for (int tt = 1; tt < 8; ++tt) gf[tt] += gf[tt - 1];
#pragma unroll
      for (int tt = 6; tt >= 0; --tt) gb[tt] += gb[tt + 1];
      SEG[tg * 64 + d] = gf[7]; SEG[512 + tg * 64 + d] = gb[0];
      __syncthreads();
      float offf = 0.f, offb = 0.f;
#pragma unroll
      for (int q = 0; q < 8; ++q) { const float a_ = SEG[q * 64 + d], b_ = SEG[512 + q * 64 + d]; offf += (q < tg) ? a_ : 0.f; offb += (q > tg) ? b_ : 0.f; }
#pragma unroll
      for (int tt = 0; tt < 8; ++tt) { const int t = tg * 8 + tt; Gf[t * 64 + d] = gf[tt] + offf; Gb[t * 64 + d] = gb[tt] + offb; } }
    __syncthreads();
}

__device__ __forceinline__ void gla_vt_load(const bf16_t* PROJ, int tok0, int h, const int tid, u32x4 (&v)[2]) {
    const int s = tid & 63, e0 = (tid >> 6) * 16;
    const bf16_t* src = PROJ + (size_t)(tok0 + s) * NPROJ_PAD + C_VA + h * 128 + e0;
    v[0] = *(const u32x4*)src; v[1] = *(const u32x4*)(src + 8);
}
__device__ __forceinline__ void gla_vt_store(LAS unsigned char* lds, const int tid, const u32x4 (&vv)[2]) {
    const int s = tid & 63, e0 = (tid >> 6) * 16;
    LAS bf16_t* VT = (LAS bf16_t*)(lds + GL_VT);
#pragma unroll
    for (int q = 0; q < 2; ++q) { const u32x4 v = vv[q]; LAS bf16_t* dst = VT + (e0 + q * 8) * 72 + s;
        dst[0 * 72] = (bf16_t)(v.x & 0xffff); dst[1 * 72] = (bf16_t)(v.x >> 16); dst[2 * 72] = (bf16_t)(v.y & 0xffff); dst[3 * 72] = (bf16_t)(v.y >> 16);
        dst[4 * 72] = (bf16_t)(v.z & 0xffff); dst[5 * 72] = (bf16_t)(v.z >> 16); dst[6 * 72] = (bf16_t)(v.w & 0xffff); dst[7 * 72] = (bf16_t)(v.w >> 16); }
}

__device__ __forceinline__ void gla_local_unit(const Args& a, const Ctx& cx, LAS unsigned char* lds, int i, int u) {
    const int cg_ = u >> 2, h = u & 3, tok0 = cg_ * 64, tid = cx.tid, lane = tid & 63, w = tid >> 6, fr = lane & 15, fq = lane >> 4;
    const bf16_t* PROJ = (const bf16_t*)(cx.ws + WS_PROJ);
    float* LOC = (float*)(cx.ws + WS_LOC); float* DEC = (float*)(cx.ws + WS_DEC);
    u32x4 vpre[2]; gla_vt_load(PROJ, tok0, h, tid, vpre);
    const u32x4 kpre = *(const u32x4*)(PROJ + (size_t)(tok0 + (tid >> 3)) * NPROJ_PAD + C_KA + h * 64 + (tid & 7) * 8);
    __syncthreads();
    gla_gates(a, cx, lds, i, tok0, h);
    LAS float* Gf = (LAS float*)(lds + GL_G); LAS float* Gb = Gf + 4096;
    LAS bf16_t* KTf = (LAS bf16_t*)(lds + GL_KF); LAS bf16_t* KTb = (LAS bf16_t*)(lds + GL_KB);
    LAS bf16_t* VT = (LAS bf16_t*)(lds + GL_VT);
    { const int s = tid >> 3, d0 = (tid & 7) * 8; const u32x4 kv = kpre;
      float k[8]; unpack8(kv, k);
#pragma unroll
      for (int e = 0; e < 8; ++e) { const int d = d0 + e;
          KTf[d * 72 + s] = (bf16_t)f2bf(k[e] * __expf(Gf[63 * 64 + d] - Gf[s * 64 + d]));
          KTb[d * 72 + s] = (bf16_t)f2bf(k[e] * __expf(Gb[d] - Gb[s * 64 + d])); } }
    gla_vt_store(lds, tid, vpre);
    if (tid < 128) { const int dir = tid >> 6, d = tid & 63; DEC[((size_t)(dir * 96 + cg_) * 4 + h) * 64 + d] = __expf(dir ? Gb[d] : Gf[63 * 64 + d]); }
    __syncthreads();
    const int dir = w >> 2, dtile = w & 3;
    const LAS bf16_t* KT = dir ? KTb : KTf;
    bf16x8 af[2];
#pragma unroll
    for (int ks = 0; ks < 2; ++ks) af[ks] = *(const LAS bf16x8*)(KT + (dtile * 16 + fr) * 72 + ks * 32 + fq * 8);
    float* dst = LOC + ((size_t)(dir * 96 + cg_) * 4 + h) * 8192;
#pragma unroll
    for (int et = 0; et < 8; ++et) { f32x4 acc = {0.f, 0.f, 0.f, 0.f};
#pragma unroll
        for (int ks = 0; ks < 2; ++ks) { const bf16x8 bfv = *(const LAS bf16x8*)(VT + (et * 16 + fr) * 72 + ks * 32 + fq * 8); acc = MFMA16(af[ks], bfv, acc); }
#pragma unroll
        for (int j = 0; j < 4; ++j) dst[(dtile * 16 + fq * 4 + j) * 128 + et * 16 + fr] = acc[j]; }
}

__device__ __forceinline__ void gla_out_unit(const Args& a, const Ctx& cx, LAS unsigned char* lds, int i, int u) {
    const int cg_ = u >> 2, h = u & 3, tok0 = cg_ * 64, tid = cx.tid, lane = tid & 63, w = tid >> 6, fr = lane & 15, fq = lane >> 4;
    const bf16_t* PROJ = (const bf16_t*)(cx.ws + WS_PROJ); bf16_t* MIX = (bf16_t*)(cx.ws + WS_MIX);
    const float* LOC = (const float*)(cx.ws + WS_LOC); const float* DEC = (const float*)(cx.ws + WS_DEC);
    u32x4 vpre[2]; gla_vt_load(PROJ, tok0, h, tid, vpre);
    const u32x4 qpre = *(const u32x4*)(PROJ + (size_t)(tok0 + (tid >> 3)) * NPROJ_PAD + C_QA + h * 64 + (tid & 7) * 8);
    const u32x4 kpre = *(const u32x4*)(PROJ + (size_t)(tok0 + (tid >> 3)) * NPROJ_PAD + C_KA + h * 64 + (tid & 7) * 8);
    const bf16_t* gpp = PROJ + (size_t)(tok0 + (tid >> 3)) * NPROJ_PAD + C_GA + h * 128 + (tid & 7) * 16;
    const u32x4 gpre0 = *(const u32x4*)gpp, gpre1 = *(const u32x4*)(gpp + 8);
    f32x4 ggp[4];
    { const float* ggq = (a.in[20] + cx.z) + i * 128 + (tid & 7) * 16;
#pragma unroll
      for (int q = 0; q < 4; ++q) ggp[q] = *(const f32x4*)(ggq + q * 4); }
    const bool fin_f = (cg_ < 64) && ((cg_ & 3) == 3), fin_b = (cg_ < 64) && ((cg_ & 3) == 0);
    f32x4 finl[4]; float find = 0.f;
    if (fin_f || fin_b) { const size_t ix = (size_t)((fin_f ? 0 : 1) * 96 + cg_) * 4 + h; find = DEC[ix * 64 + (tid >> 3)]; const float* lp = LOC + ix * 8192 + (tid >> 3) * 128 + (tid & 7) * 16;
#pragma unroll
        for (int q = 0; q < 4; ++q) finl[q] = *(const f32x4*)(lp + q * 4); }
    __syncthreads();
    gla_gates(a, cx, lds, i, tok0, h);
    LAS float* Gf = (LAS float*)(lds + GL_G); LAS float* Gb = Gf + 4096;
    const bool samp = cg_ >= 64;
    const int b = samp ? (cg_ - 64) >> 4 : cg_ >> 2, c = samp ? (cg_ - 64) & 15 : cg_ & 3, nc = samp ? 16 : 4, cbase = cg_ - c;
    {
        const int d = tid >> 3, e0 = (tid & 7) * 16;
        f32x4 Sf[4], Sb[4];
        if (samp) { const float* s0f = (a.in[2] + cx.z) + ((size_t)((b * 2 + i) * 4 + h)) * 8192 + d * 128 + e0; const float* s0b = (a.in[3] + cx.z) + ((size_t)((b * 2 + i) * 4 + h)) * 8192 + d * 128 + e0;
#pragma unroll
            for (int q = 0; q < 4; ++q) { Sf[q] = *(const f32x4*)(s0f + q * 4); Sb[q] = *(const f32x4*)(s0b + q * 4); } }
        else {
#pragma unroll
            for (int q = 0; q < 4; ++q) { Sf[q] = (f32x4){0.f, 0.f, 0.f, 0.f}; Sb[q] = Sf[q]; } }
        for (int j = 0; j < c; ++j) { const size_t ix = (size_t)(0 * 96 + cbase + j) * 4 + h; const float dec = DEC[ix * 64 + d]; const float* lp = LOC + ix * 8192 + d * 128 + e0;
#pragma unroll
            for (int q = 0; q < 4; ++q) Sf[q] = Sf[q] * dec + *(const f32x4*)(lp + q * 4); }
        for (int j = nc - 1; j > c; --j) { const size_t ix = (size_t)(1 * 96 + cbase + j) * 4 + h; const float dec = DEC[ix * 64 + d]; const float* lp = LOC + ix * 8192 + d * 128 + e0;
#pragma unroll
            for (int q = 0; q < 4; ++q) Sb[q] = Sb[q] * dec + *(const f32x4*)(lp + q * 4); }
        if (fin_f) { float* o = cx.out + O_SF + ((size_t)((b * 2 + i) * 4 + h)) * 8192 + d * 128 + e0;
#pragma unroll
            for (int q = 0; q < 4; ++q) *(f32x4*)(o + q * 4) = Sf[q] * find + finl[q]; }
        if (fin_b) { float* o = cx.out + O_SB + ((size_t)((b * 2 + i) * 4 + h)) * 8192 + d * 128 + e0;
#pragma unroll
            for (int q = 0; q < 4; ++q) *(f32x4*)(o + q * 4) = Sb[q] * find + finl[q]; }
        LAS bf16_t* STf = (LAS bf16_t*)(lds + GL_STF); LAS bf16_t* STb = (LAS bf16_t*)(lds + GL_STB);
#pragma unroll
        for (int q = 0; q < 4; ++q)
#pragma unroll
            for (int e = 0; e < 4; ++e) { STf[(e0 + q * 4 + e) * 72 + d] = (bf16_t)f2bf(Sf[q][e]); STb[(e0 + q * 4 + e) * 72 + d] = (bf16_t)f2bf(Sb[q][e]); }
    }
    {
        const int t = tid >> 3, d0 = (tid & 7) * 8;
        const u32x4 qv = qpre, kv = kpre;
        float q[8], k[8], o1[8], o2[8], o3[8], o4[8]; unpack8(qv, q); unpack8(kv, k);
#pragma unroll
        for (int e = 0; e < 8; ++e) { const float gf = Gf[t * 64 + d0 + e], gb = Gb[t * 64 + d0 + e];
            o1[e] = q[e] * 0.125f * __expf(gf); o2[e] = k[e] * __expf(-gf); o3[e] = q[e] * 0.125f * __expf(gb); o4[e] = k[e] * __expf(-gb); }
        *(LAS u32x4*)((LAS bf16_t*)(lds + GL_QF) + t * 72 + d0) = pack8(o1);
        *(LAS u32x4*)((LAS bf16_t*)(lds + GL_KF) + t * 72 + d0) = pack8(o2);
        *(LAS u32x4*)((LAS bf16_t*)(lds + GL_QB) + t * 72 + d0) = pack8(o3);
        *(LAS u32x4*)((LAS bf16_t*)(lds + GL_KB) + t * 72 + d0) = pack8(o4);
    }
    gla_vt_store(lds, tid, vpre);
    __syncthreads();
    {
        const int dir = w >> 2, tt = w & 3;
        const LAS bf16_t* Qm = (const LAS bf16_t*)(lds + (dir ? GL_QB : GL_QF)); const LAS bf16_t* Km = (const LAS bf16_t*)(lds + (dir ? GL_KB : GL_KF));
        LAS bf16_t* AT = (LAS bf16_t*)(lds + (dir ? GL_AB : GL_AF));
        bf16x8 af[2];
#pragma unroll
        for (int ks = 0; ks < 2; ++ks) af[ks] = *(const LAS bf16x8*)(Qm + (tt * 16 + fr) * 72 + ks * 32 + fq * 8);
#pragma unroll
        for (int st = 0; st < 4; ++st) { f32x4 acc = {0.f, 0.f, 0.f, 0.f};
#pragma unroll
            for (int ks = 0; ks < 2; ++ks) { const bf16x8 bfv = *(const LAS bf16x8*)(Km + (st * 16 + fr) * 72 + ks * 32 + fq * 8); acc = MFMA16(af[ks], bfv, acc); }
#pragma unroll
            for (int j = 0; j < 4; ++j) { const int t = tt * 16 + fq * 4 + j, s = st * 16 + fr; const bool keep = dir ? (s >= t) : (s <= t);
                AT[t * 72 + s] = (bf16_t)f2bf(keep ? acc[j] : 0.f); } }
    }
    __syncthreads();
    {
        const int tt = w & 3, eg = w >> 2;
        LAS float* OS = (LAS float*)(lds + GL_G);
        const LAS bf16_t* VT = (const LAS bf16_t*)(lds + GL_VT);
        bf16x8 a1[2], a2[2], a3[2], a4[2];
#pragma unroll
        for (int ks = 0; ks < 2; ++ks) { const int off = (tt * 16 + fr) * 72 + ks * 32 + fq * 8;
            a1[ks] = *(const LAS bf16x8*)((const LAS bf16_t*)(lds + GL_QF) + off); a2[ks] = *(const LAS bf16x8*)((const LAS bf16_t*)(lds + GL_AF) + off);
            a3[ks] = *(const LAS bf16x8*)((const LAS bf16_t*)(lds + GL_QB) + off); a4[ks] = *(const LAS bf16x8*)((const LAS bf16_t*)(lds + GL_AB) + off); }
        f32x4 accs[4];
#pragma unroll
        for (int q = 0; q < 4; ++q) { const int et = eg * 4 + q; f32x4 acc = {0.f, 0.f, 0.f, 0.f};
#pragma unroll
            for (int ks = 0; ks < 2; ++ks) { const int off = (et * 16 + fr) * 72 + ks * 32 + fq * 8;
                const bf16x8 b1 = *(const LAS bf16x8*)((const LAS bf16_t*)(lds + GL_STF) + off), b2 = *(const LAS bf16x8*)(VT + off), b3 = *(const LAS bf16x8*)((const LAS bf16_t*)(lds + GL_STB) + off);
                acc = MFMA16(a1[ks], b1, acc); acc = MFMA16(a2[ks], b2, acc); acc = MFMA16(a3[ks], b3, acc); acc = MFMA16(a4[ks], b2, acc); }
            accs[q] = acc; }
#pragma unroll
        for (int q = 0; q < 4; ++q)
#pragma unroll
            for (int j = 0; j < 4; ++j) OS[(tt * 16 + fq * 4 + j) * 128 + (eg * 4 + q) * 16 + fr] = accs[q][j];
    }
    __syncthreads();
    {
        const int t = tid >> 3, e0 = (tid & 7) * 16;
        const LAS float* OS = (const LAS float*)(lds + GL_G);
        float o[16]; float ss = 0.f;
#pragma unroll
        for (int e = 0; e < 16; ++e) { o[e] = OS[t * 128 + e0 + e]; ss += o[e] * o[e]; }
        ss += __shfl_xor(ss, 1); ss += __shfl_xor(ss, 2); ss += __shfl_xor(ss, 4);
        const float rstd = rsqrtf(ss * (1.f / 128.f) + EPS);
        float gt[16]; unpack8(gpre0, gt); unpack8(gpre1, gt + 8);
#pragma unroll
        for (int e = 0; e < 16; ++e) o[e] = o[e] * rstd * ggp[e >> 2][e & 3] * silu_f(gt[e]);
        bf16_t* op = MIX + (size_t)(tok0 + t) * D + h * 128 + e0;
        *(u32x4*)op = pack8(o); *(u32x4*)(op + 8) = pack8(o + 8);
    }
}


#define XB_TMO      128
#define XB_XCNT(j)  (256  + 64 * (j))
#define XB_XSUB(j)  (1280 + 64 * (j))
#define XB_XGEN(j)  (2304 + 64 * (j))
#define XB_TOP      3328
#define XB_TOPGEN   3392
#define XCD_BAR_WORDS 3456
#define XB_SPIN_CAP (1u << 18)
__device__ __forceinline__ unsigned xb_ld(unsigned* p)              { return __hip_atomic_load(p, __ATOMIC_RELAXED, __HIP_MEMORY_SCOPE_AGENT); }
__device__ __forceinline__ unsigned xb_add(unsigned* p, unsigned v) { return __hip_atomic_fetch_add(p, v, __ATOMIC_RELAXED, __HIP_MEMORY_SCOPE_AGENT); }
__device__ __forceinline__ unsigned xb_xcc_id() { return (unsigned)__builtin_amdgcn_s_getreg((3 << 11) | 20) & 0xFu; }
#define XB_SPIN(cond, bar) do { unsigned _sp = 0; while (cond) { __builtin_amdgcn_s_sleep(1); \
    if ((++_sp & 255u) == 0u) { if (xb_ld(&(bar)[XB_TMO])) break; if (_sp > XB_SPIN_CAP) { atomicAdd(&(bar)[XB_TMO], 1u); break; } } } } while (0)
struct XcdBarrier { unsigned* bar; unsigned x; volatile LAS unsigned* st; };
__device__ __forceinline__ XcdBarrier xcd_barrier_post(unsigned* bar, volatile LAS unsigned* st, const int tid) {
    XcdBarrier b; b.bar = bar; b.x = xb_xcc_id(); b.st = st;
    if (tid == 0) (void)xb_add(&bar[XB_XCNT(b.x)], 1u);
    return b;
}
__device__ __forceinline__ void xcd_barrier_complete(unsigned* bar, unsigned x, unsigned& nloc, unsigned& nx) {
    const unsigned G = gridDim.x * gridDim.y * gridDim.z;
    unsigned sum, cnt, mine, sp = 0u;
    for (;;) {
        sum = 0u; cnt = 0u; mine = 0u;
#pragma unroll
        for (unsigned j = 0; j < 16; ++j) { const unsigned c = xb_ld(&bar[XB_XCNT(j)]); sum += c; cnt += (c > 0u) ? 1u : 0u; mine = (j == x) ? c : mine; }
        if (sum == G) break;
        __builtin_amdgcn_s_sleep(1);
        if ((++sp & 255u) == 0u) { if (xb_ld(&bar[XB_TMO])) break; if (sp > XB_SPIN_CAP) { atomicAdd(&bar[XB_TMO], 1u); break; } }
    }
    nloc = mine > 0u ? mine : 1u; nx = cnt > 0u ? cnt : 1u;
}
__device__ __forceinline__ void xcd_barrier(const XcdBarrier& b, const int tid) {
    asm volatile("s_waitcnt vmcnt(0)" ::: "memory");
    __syncthreads();
    if (tid == 0) {
        unsigned* bar = b.bar;
        __builtin_amdgcn_s_waitcnt(0);
        unsigned nloc = b.st[0], nx = b.st[1];
        if (nloc == 0u) { xcd_barrier_complete(bar, b.x, nloc, nx); b.st[0] = nloc; b.st[1] = nx; }
        const unsigned old = xb_add(&bar[XB_XSUB(b.x)], 1u);
        const unsigned gen = old / nloc;
        if (old + 1u == (gen + 1u) * nloc) {
            __builtin_amdgcn_fence(__ATOMIC_RELEASE, "agent");
            asm volatile("s_waitcnt vmcnt(0)" ::: "memory");
            const unsigned og = xb_add(&bar[XB_TOP], 1u);
            const unsigned tg = og / nx;
            if (og + 1u == (tg + 1u) * nx) xb_add(&bar[XB_TOPGEN], 1u);
            else XB_SPIN(xb_ld(&bar[XB_TOPGEN]) == tg, bar);
            __builtin_amdgcn_fence(__ATOMIC_ACQUIRE, "agent");
            asm volatile("s_waitcnt vmcnt(0)" ::: "memory");
        } else {
            XB_SPIN(xb_ld(&bar[XB_TOPGEN]) == gen, bar);
            __builtin_amdgcn_fence(__ATOMIC_ACQUIRE, "agent");
            asm volatile("s_waitcnt vmcnt(0)" ::: "memory");
        }
    }
    __syncthreads();
}

enum { K_PRO = 0, K_PRE, K_G1, K_A1, K_A2, K_DOWN, K_MID, K_UQKV, K_MLA, K_OUTP, K_POST1, K_FF1, K_FF2, K_POST2 };
constexpr int N_PHASES = 2 + 2 * 8 + 2 * 9;
#ifndef EN_MASK
#define EN_MASK 0xFFFFFFFFu
#endif
#define ENB(k) (((EN_MASK) >> (k)) & 1u)
#ifndef DUP_MASK
#define DUP_MASK 0u
#endif
#ifndef BAR_REPS
#define BAR_REPS 1
#endif

__global__ void __launch_bounds__(NTHREADS, 2) mega_fwd(Args args) {
    extern __shared__ __attribute__((aligned(16))) unsigned char lds_raw[];
    LAS unsigned char* lds = (LAS unsigned char*)lds_raw;
    const int lo = args.ph_lo, hi = args.ph_hi;
    const int wave_s = __builtin_amdgcn_readfirstlane((int)(threadIdx.x >> 6));
#define MY_TID(dst) do { int _l; asm volatile("v_mbcnt_lo_u32_b32 %0, -1, 0\n\tv_mbcnt_hi_u32_b32 %0, -1, %0" : "=v"(_l)); dst = wave_s * 64 + _l; } while (0)
    {
        int tid0; MY_TID(tid0);
        volatile LAS unsigned* bst = (volatile LAS unsigned*)(lds + LDS_BYTES - 64);
        if (tid0 < 2) bst[tid0] = 0u;
        __syncthreads();
        (void)xcd_barrier_post((unsigned*)(args.ws + WS_CTL), bst, tid0);
    }
    for (int p = lo; p < hi; ++p) {
        int kind, l;
        if (p == 0) { kind = K_PRO; l = 0; }
        else if (p == 1) { kind = K_PRE; l = 0; }
        else {
            const int q = p - 2, pair = q / 17, r = q - pair * 17;
            if (r < 8) { l = 2 * pair; kind = (r == 0) ? K_G1 : (r == 1) ? K_A1 : (r == 2) ? K_A2 : (r == 3) ? K_OUTP : (r == 4) ? K_POST1 : (r == 5) ? K_FF1 : (r == 6) ? K_FF2 : K_POST2; }
            else { const int r2 = r - 8; l = 2 * pair + 1; kind = (r2 == 0) ? K_DOWN : (r2 == 1) ? K_MID : (r2 == 2) ? K_UQKV : (r2 == 3) ? K_MLA : (r2 == 4) ? K_OUTP : (r2 == 5) ? K_POST1 : (r2 == 6) ? K_FF1 : (r2 == 7) ? K_FF2 : K_POST2; }
        }
        int cv_g0 = -1, cv_stride = 1, cv_end = 0;
        if (gridDim.x == 256 && l < 3) {
            const int bidx = blockIdx.x;
            const int b0 = (l == 0) ? 2560 : 10752 + 6144 * (l - 1), f1 = (l == 0) ? 5120 : 3072;
            if (kind == K_FF1 && bidx >= 128) { cv_g0 = b0 + (bidx - 128) * NWAVES + wave_s; cv_stride = 1024; cv_end = b0 + f1; }
            else if (kind == K_FF2 && bidx >= 192) { cv_g0 = b0 + f1 + (bidx - 192) * NWAVES + wave_s; cv_stride = 512; cv_end = b0 + f1 + 3072; }
            else if (l == 0 && kind == K_G1 && bidx >= 240) { cv_g0 = (bidx - 240) * NWAVES + wave_s; cv_stride = 128; cv_end = 512; }
            else if (l == 0 && kind == K_OUTP && bidx >= 192) { cv_g0 = 512 + (bidx - 192) * NWAVES + wave_s; cv_stride = 512; cv_end = 2560; }
        }
        const int kind0 = kind;
        const int reps = (cv_g0 >= 0) ? 2 : (((DUP_MASK >> kind) & 1u) ? 2 : 1);
        for (int rep = 0; rep < reps; ++rep) {
        if (rep) __syncthreads();
        int pmode = 0;
        if (rep && cv_g0 >= 0) { kind = K_PRO; pmode = 1; } else kind = kind0;
        Ctx cx; cx.z = 0; MY_TID(cx.tid); cx.bid = blockIdx.x; cx.G = gridDim.x;
        asm volatile("" : "+s"(cx.z), "+s"(kind), "+s"(l), "+v"(cx.tid), "+s"(cx.bid), "+s"(cx.G));
        cx.ws = args.ws + cx.z; cx.out = args.out + cx.z;
        unsigned char* ws = cx.ws;
        const int i = l >> 1, G = cx.G, bid = cx.bid;
        switch (kind) {
        case K_PRO: if (ENB(0)) prologue(args, cx, lds, pmode, cv_g0, cv_stride, cv_end); break;
        case K_PRE: if (ENB(1)) pre_rows(args, cx, 0); break;
        case K_G1: if (ENB(2)) {
            pg8::Gemm g{(const bf16_t*)(ws + WS_H), (const bf16_t*)(ws + WS_WIN) + (size_t)i * NPROJ_PAD * D, T, NPROJ_PAD, D, D, D, NPROJ_PAD / 256, 0};
            pg8::StaticOrder S; S.init(T, NPROJ_PAD, G, bid);
            pg8::EpiProj E{(bf16_t*)(ws + WS_PROJ), cx.out, i};
            pg8::gemm_phase<pg8::EpiProj, pg8::StaticOrder>(lds, g, S, E, cx.tid);
        } break;
        case K_A1:
            if (G == 256) {
                if (bid < 128) { if (ENB(3)) swa_unit(args, cx, lds, i, bid); if (ENB(4)) gla_local_unit(args, cx, lds, i, bid); }
                else { const int q = bid - 128; if (ENB(3)) swa_unit(args, cx, lds, i, 128 + q);
                       if (ENB(4)) { gla_local_unit(args, cx, lds, i, 128 + 2 * q); gla_local_unit(args, cx, lds, i, 128 + 2 * q + 1); } }
            } else { for (int u = bid; u < 640; u += G) { if (u < 256) { if (ENB(3)) swa_unit(args, cx, lds, i, u); } else { if (ENB(4)) gla_local_unit(args, cx, lds, i, u - 256); } } }
            break;
        case K_A2:
            if (G == 256) {
                if (bid < 128) { if (ENB(5)) { gla_out_unit(args, cx, lds, i, 256 + bid); gla_out_unit(args, cx, lds, i, bid); } }
                else { if (ENB(5)) gla_out_unit(args, cx, lds, i, bid); }
            } else { for (int u = bid; u < 384; u += G) if (ENB(5)) gla_out_unit(args, cx, lds, i, u); }
            break;
        case K_MID: if (ENB(7)) mla_mid(args, cx, i); break;
        case K_UQKV: if (ENB(8)) {
            for (int s = 0; s < 2; ++s) {
                pg8::Gemm g;
                if (s == 0) g = pg8::Gemm{(const bf16_t*)(ws + WS_CQ), (const bf16_t*)(ws + WS_WUQ) + (size_t)i * 1536 * 384, T, 1536, 384, 384, 384, 6, 0};
                else        g = pg8::Gemm{(const bf16_t*)(ws + WS_CKV), (const bf16_t*)(ws + WS_WUKV) + (size_t)i * 2048 * 256, T + 1024, 2048, 256, 256, 256, 8, 0};
                pg8::StaticOrder S; S.init(g.M, g.N, G, (s == 0 || G != 256) ? bid : ((bid + 144) & 255));
                pg8::EpiBf16<0> E{s == 0 ? (bf16_t*)(ws + WS_Q) : (bf16_t*)(ws + WS_KVX), g.N};
                pg8::gemm_phase<pg8::EpiBf16<0>, pg8::StaticOrder>(lds, g, S, E, cx.tid);
            }
        } break;
        case K_MLA: if (ENB(9)) {
            if (G == 256) {
                const int xcd = bid & 7, slot = bid >> 3, id = xcd * 4 + (slot >> 3);
                mla_unit(args, cx, lds, id * 8 + (slot & 7));
                mla_unit(args, cx, lds, 256 + bid);
            } else { for (int u = bid; u < 512; u += G) mla_unit(args, cx, lds, u); }
        } break;
        case K_DOWN: if (ENB(10)) {
            pg8::Gemm g{(const bf16_t*)(ws + WS_H), (const bf16_t*)(ws + WS_WDOWN) + (size_t)i * NDOWN_PAD * D, T, 2 * NDOWN_PAD, D / 2, D, D / 2, NDOWN_PAD / 256, D / 2};
            pg8::EpiF32 E{(float*)(ws + WS_OUT), NDOWN_PAD, NDOWN_PAD / 256, DOWN_SPLIT};
            pg8::StaticOrder S; S.init(g.M, g.N, G, bid);
            pg8::gemm_phase<pg8::EpiF32, pg8::StaticOrder>(lds, g, S, E, cx.tid);
        } break;
        case K_OUTP: case K_FF2: if (ENB(10)) {
            pg8::Gemm g;
            if (kind == K_OUTP) {
                const bf16_t* Wt = (l & 1) ? (const bf16_t*)(ws + WS_WO) + (size_t)i * D * D : (const bf16_t*)(ws + WS_WOUT) + (size_t)i * D * D;
                g = pg8::Gemm{(const bf16_t*)(ws + WS_MIX), Wt, T, 2 * D, D / 2, D, D / 2, 4, D / 2};
            } else {
                g = pg8::Gemm{(const bf16_t*)(ws + WS_U), (const bf16_t*)(ws + WS_WFF2) + (size_t)l * FF * D, T, 2 * D, FF / 2, FF, FF / 2, 4, FF / 2};
            }
            pg8::EpiSplitBf16 E{(bf16_t*)(ws + WS_OUT), D, 4, OUT_SPLIT};
            pg8::StaticOrder S; S.init(g.M, g.N, G, bid);
            pg8::gemm_phase<pg8::EpiSplitBf16, pg8::StaticOrder>(lds, g, S, E, cx.tid);
        } break;
        case K_FF1: if (ENB(12)) {
            pg8::Gemm g{(const bf16_t*)(ws + WS_H), (const bf16_t*)(ws + WS_WFF1) + (size_t)l * FF * D, T, FF, D, D, D, FF / 256, 0};
            pg8::StaticOrder S; S.init(T, FF, G, bid);
            pg8::EpiBf16<1> E{(bf16_t*)(ws + WS_U), FF};
            pg8::gemm_phase<pg8::EpiBf16<1>, pg8::StaticOrder>(lds, g, S, E, cx.tid);
        } break;
        case K_POST1: if (ENB(11)) {
            const float* MODL = (const float*)(ws + WS_MOD) + (size_t)l * 3 * 6144; const float* gN = (args.in[12] + cx.z) + (size_t)l * 4 * D;
            post_rows(args, cx, l == 0, MODL + 2 * D, gN + D, true, gN + 2 * D, MODL + 3 * D, MODL + 4 * D, rep + 1 < reps);
        } break;
        case K_POST2: if (ENB(14)) {
            const float* MODL = (const float*)(ws + WS_MOD) + (size_t)l * 3 * 6144; const float* gN = (args.in[12] + cx.z) + (size_t)l * 4 * D;
            const float* MODN = MODL + 3 * 6144; const float* gNn = gN + 4 * D;
            post_rows(args, cx, false, MODL + 5 * D, gN + 3 * D, l < 3, gNn, MODN, MODN + D, rep + 1 < reps);
        } break;
        default: break;
        }
        }
        if (p + 1 < hi) { if (hi < 0) cg::this_grid().sync(); else { XcdBarrier xb; xb.bar = (unsigned*)(args.ws + WS_CTL); xb.x = xb_xcc_id(); xb.st = (volatile LAS unsigned*)(lds + LDS_BYTES - 64); int tidb; MY_TID(tidb); for (int br = 0; br < BAR_REPS; ++br) xcd_barrier(xb, tidb); } }
    }
}

extern "C" void kernel_launch(void* const* d_in, const int* in_sizes, int n_in, void* d_out, int out_size, void* d_ws, size_t ws_size, hipStream_t stream) {
    static int grid = 0;
    if (grid == 0) {
        int dev = 0, cus = 0, per_cu = 0;
        hipGetDevice(&dev);
        hipDeviceGetAttribute(&cus, hipDeviceAttributeMultiprocessorCount, dev);
        hipFuncSetAttribute((const void*)mega_fwd, hipFuncAttributeMaxDynamicSharedMemorySize, LDS_BYTES);
        hipOccupancyMaxActiveBlocksPerMultiprocessor(&per_cu, (const void*)mega_fwd, NTHREADS, LDS_BYTES);
        if (per_cu < 1) { fprintf(stderr, "kernel_launch: occupancy query says %d blocks per CU\n", per_cu); per_cu = 1; }
        (void)hipGetLastError();
        grid = cus;
        if (ws_size < 256 * MiB) fprintf(stderr, "kernel_launch: workspace too small (%zu)\n", ws_size);
    }
    (void)hipMemsetAsync((char*)d_ws + WS_CTL, 0, CTL_BYTES, stream);
    Args a{};
    for (int i = 0; i < 29; ++i) a.in[i] = (const float*)d_in[i];
    a.out = (float*)d_out; a.ws = (unsigned char*)d_ws;
#if MK_ONE_LAUNCH
    a.ph_lo = 0; a.ph_hi = N_PHASES;
    void* kargs[] = {&a};
    hipError_t e = hipLaunchCooperativeKernel((const void*)mega_fwd, dim3(grid), dim3(NTHREADS), kargs, LDS_BYTES, stream);
    if (e != hipSuccess) fprintf(stderr, "cooperative launch failed: %s (grid %d)\n", hipGetErrorString(e), grid);
#else
    for (int p = 0; p < N_PHASES; ++p) {
        a.ph_lo = p; a.ph_hi = p + 1;
        hipLaunchKernelGGL(mega_fwd, dim3(grid), dim3(NTHREADS), LDS_BYTES, stream, a);
    }
#endif
}
```
